# Optimizing an MI355X kernel written in HIP

```python
import math
import jax
import jax.numpy as jnp
from jax import lax
import numpy as np

D_MODEL = 1024
BATCH = 16
SEQ = 2048
DEPTH = 2

N_EVEN = (DEPTH + 1) // 2
N_ODD = DEPTH // 2
SB_HEADS = 8
SB_HEAD_DIM = 64
SB_WIDTH = SB_HEADS * SB_HEAD_DIM
QUERY_BLOCK = 128
POOL_WINDOWS = (2, 4, 8, 16)
POOL_WIDTH = D_MODEL - SB_WIDTH
POOL_GROUP = POOL_WIDTH // len(POOL_WINDOWS)
AB_IN_WIDTH = 3 * SB_WIDTH + POOL_WIDTH
SSM_WIDTH = D_MODEL
SSM_GROUP = 16
SSM_GROUPS = SSM_WIDTH // SSM_GROUP
SSM_STATE = 64
DT_MIN = 1e-3
DT_MAX = 1e-1
MEM_LEN = 256
XA_HEADS = 4
XA_HEAD_DIM = D_MODEL // XA_HEADS
D_FF = 2816
CONV_WIDTH = 3
EPS = 1e-6

kernel_name = "hybrid_stickbreak_pool_s5_block"


def rmsnorm(x, g):
    xf = x.astype(jnp.float32)
    xf = xf * lax.rsqrt(jnp.mean(xf * xf, axis=-1, keepdims=True) + EPS)
    return (xf * g.astype(jnp.float32)).astype(x.dtype)


def stick_breaking_attention(q, k, v):
    seq = q.shape[1]
    scale = q.shape[-1] ** -0.5
    outs = []
    for t0 in range(0, seq, QUERY_BLOCK):
        t1 = t0 + QUERY_BLOCK
        z = jnp.einsum('bqhd,bkhd->bhqk', q[:, t0:t1], k[:, :t1]).astype(jnp.float32) * scale
        causal = jnp.arange(t1)[None, :] < (t0 + jnp.arange(QUERY_BLOCK))[:, None]
        log_beta = jax.nn.log_sigmoid(z)
        log_keep = jnp.where(causal, log_beta - z, 0.0)
        after = lax.cumsum(log_keep, axis=3, reverse=True) - log_keep
        w = jnp.where(causal, jnp.exp(log_beta + after), 0.0)
        outs.append(jnp.einsum('bhqk,bkhd->bqhd', w.astype(v.dtype), v[:, :t1]))
    return jnp.concatenate(outs, axis=1)


def multiscale_pool(u, w_grp, scale):
    bsz, seq, _ = u.shape
    ug = u.astype(jnp.float32).reshape(bsz, seq, len(POOL_WINDOWS), POOL_GROUP)
    cs = jnp.concatenate([jnp.zeros_like(ug[:, :1]), jnp.cumsum(ug, axis=1)], axis=1)
    t = jnp.arange(seq)
    pooled = []
    for g, win in enumerate(POOL_WINDOWS):
        cs_g = cs[:, :, g]
        lo = jnp.maximum(t + 1 - win, 0)
        cnt = jnp.minimum(t + 1, win).astype(jnp.float32)[None, :, None]
        mean = (cs_g[:, 1:] - cs_g[:, lo]) / cnt
        pooled.append(mean - ug[:, :, g])
    p = jnp.stack(pooled, axis=2)
    y = jnp.einsum('bsgc,gcd->bsgd', p, w_grp.astype(jnp.float32)).reshape(bsz, seq, POOL_WIDTH)
    return (y * scale.astype(jnp.float32)).astype(u.dtype)


def _complex_linear_combine(left, right):
    a1r, a1i, b1r, b1i = left
    a2r, a2i, b2r, b2i = right
    ar = a1r * a2r - a1i * a2i
    ai = a1r * a2i + a1i * a2r
    br = a2r * b1r - a2i * b1i + b2r
    bi = a2r * b1i + a2i * b1r + b2i
    return (ar, ai, br, bi)


def s5_ssm(u, lam_re, lam_im, log_dt, b_re, b_im, c_re, c_im, d_skip):
    bsz, seq, _ = u.shape
    f32 = jnp.float32
    uf = u.astype(f32)
    ug = uf.reshape(bsz, seq, SSM_GROUPS, SSM_GROUP)
    lam_re = lam_re.astype(f32)
    lam_im = lam_im.astype(f32)
    dt = jnp.exp(log_dt.astype(f32))[:, None]
    mag = jnp.exp(lam_re * dt)
    ang = lam_im * dt
    lb_re = mag * jnp.cos(ang)
    lb_im = mag * jnp.sin(ang)
    n_re = lb_re - 1.0
    den = lam_re * lam_re + lam_im * lam_im
    coef_re = (n_re * lam_re + lb_im * lam_im) / den
    coef_im = (lb_im * lam_re - n_re * lam_im) / den
    b_re = b_re.astype(f32)
    b_im = b_im.astype(f32)
    bb_re = coef_re[..., None] * b_re - coef_im[..., None] * b_im
    bb_im = coef_re[..., None] * b_im + coef_im[..., None] * b_re
    bu_re = jnp.einsum('bsgc,gpc->bsgp', ug, bb_re)
    bu_im = jnp.einsum('bsgc,gpc->bsgp', ug, bb_im)
    a_re = jnp.broadcast_to(lb_re, (1, seq) + lb_re.shape)
    a_im = jnp.broadcast_to(lb_im, (1, seq) + lb_im.shape)
    _, _, h_re, h_im = lax.associative_scan(
        _complex_linear_combine, (a_re, a_im, bu_re, bu_im), axis=1)
    y = (jnp.einsum('bsgp,gcp->bsgc', h_re, c_re.astype(f32))
         - jnp.einsum('bsgp,gcp->bsgc', h_im, c_im.astype(f32)))
    return y.reshape(bsz, seq, SSM_WIDTH) + d_skip.astype(f32) * uf


def memory_cross_attention(h, mem_n, w_q, w_kv, w_o):
    bsz, seq, _ = h.shape
    m = mem_n.shape[1]
    q = (h @ w_q).reshape(bsz, seq, XA_HEADS, XA_HEAD_DIM)
    k, v = jnp.split(mem_n @ w_kv, 2, axis=-1)
    k = k.reshape(bsz, m, XA_HEADS, XA_HEAD_DIM)
    v = v.reshape(bsz, m, XA_HEADS, XA_HEAD_DIM)
    scores = jnp.einsum('bshd,bmhd->bhsm', q, k).astype(jnp.float32) * (XA_HEAD_DIM ** -0.5)
    p = jax.nn.softmax(scores, axis=-1).astype(v.dtype)
    o = jnp.einsum('bhsm,bmhd->bshd', p, v).reshape(bsz, seq, D_MODEL)
    return o @ w_o


def conv_gated_mlp(h, w_up, conv_w, conv_b, w_down):
    up = h @ w_up
    seq = up.shape[1]
    padded = jnp.pad(up, ((0, 0), (CONV_WIDTH - 1, 0), (0, 0)))
    conv = conv_b
    for i in range(CONV_WIDTH):
        conv = conv + conv_w[i] * padded[:, i:i + seq]
    val, gate = jnp.split(conv, 2, axis=-1)
    return (jax.nn.silu(gate) * val) @ w_down


def setup_inputs(seed: int = 0) -> dict:
    key = jax.random.key(seed)
    ks = iter(jax.random.split(key, 40))

    def nrm(shape, fan_in):
        return jax.random.normal(next(ks), shape, jnp.float32) * (fan_in ** -0.5)

    def gain(shape):
        return 1.0 + 0.02 * jax.random.normal(next(ks), shape, jnp.float32)

    n_arange = jnp.arange(SSM_STATE, dtype=jnp.float32)
    return {
        "x": jax.random.normal(next(ks), (BATCH, SEQ, D_MODEL), jnp.float32),
        "mem": jax.random.normal(next(ks), (BATCH, MEM_LEN, D_MODEL), jnp.float32),
        "norm_mix": gain((DEPTH, D_MODEL)),
        "norm_xattn": gain((DEPTH, D_MODEL)),
        "norm_ffn": gain((DEPTH, D_MODEL)),
        "norm_mem": gain((D_MODEL,)),
        "norm_final": gain((D_MODEL,)),
        "ab_w_in": nrm((N_EVEN, D_MODEL, AB_IN_WIDTH), D_MODEL),
        "pool_w": nrm((N_EVEN, len(POOL_WINDOWS), POOL_GROUP, POOL_GROUP), POOL_GROUP),
        "pool_scale": gain((N_EVEN, POOL_WIDTH)),
        "ab_w_out": nrm((N_EVEN, SB_WIDTH + POOL_WIDTH, D_MODEL), SB_WIDTH + POOL_WIDTH),
        "ssm_w_in": nrm((N_ODD, D_MODEL, SSM_WIDTH), D_MODEL),
        "ssm_lam_re": -0.5 + 0.01 * jax.random.normal(next(ks), (N_ODD, SSM_GROUPS, SSM_STATE), jnp.float32),
        "ssm_lam_im": math.pi * n_arange + 0.01 * jax.random.normal(next(ks), (N_ODD, SSM_GROUPS, SSM_STATE), jnp.float32),
        "ssm_log_dt": jax.random.uniform(next(ks), (N_ODD, SSM_GROUPS), jnp.float32,
                                         math.log(DT_MIN), math.log(DT_MAX)),
        "ssm_b_re": nrm((N_ODD, SSM_GROUPS, SSM_STATE, SSM_GROUP), 2 * SSM_GROUP),
        "ssm_b_im": nrm((N_ODD, SSM_GROUPS, SSM_STATE, SSM_GROUP), 2 * SSM_GROUP),
        "ssm_c_re": nrm((N_ODD, SSM_GROUPS, SSM_GROUP, SSM_STATE), SSM_STATE),
        "ssm_c_im": nrm((N_ODD, SSM_GROUPS, SSM_GROUP, SSM_STATE), SSM_STATE),
        "ssm_d": jax.random.normal(next(ks), (N_ODD, SSM_WIDTH), jnp.float32),
        "ssm_w_glu": nrm((N_ODD, SSM_WIDTH, 2 * D_MODEL), SSM_WIDTH),
        "xa_w_q": nrm((DEPTH, D_MODEL, D_MODEL), D_MODEL),
        "xa_w_kv": nrm((DEPTH, D_MODEL, 2 * D_MODEL), D_MODEL),
        "xa_w_o": nrm((DEPTH, D_MODEL, D_MODEL), D_MODEL),
        "ffn_w_up": nrm((DEPTH, D_MODEL, 2 * D_FF), D_MODEL),
        "ffn_conv_w": nrm((DEPTH, CONV_WIDTH, 2 * D_FF), CONV_WIDTH),
        "ffn_conv_b": 0.01 * jax.random.normal(next(ks), (DEPTH, 2 * D_FF), jnp.float32),
        "ffn_w_down": nrm((DEPTH, D_FF, D_MODEL), D_FF),
    }


def reference(x, mem, norm_mix, norm_xattn, norm_ffn, norm_mem, norm_final,
              ab_w_in, pool_w, pool_scale, ab_w_out,
              ssm_w_in, ssm_lam_re, ssm_lam_im, ssm_log_dt, ssm_b_re, ssm_b_im,
              ssm_c_re, ssm_c_im, ssm_d, ssm_w_glu,
              xa_w_q, xa_w_kv, xa_w_o,
              ffn_w_up, ffn_conv_w, ffn_conv_b, ffn_w_down):
    bsz, seq, _ = x.shape
    mem_n = rmsnorm(mem, norm_mem)
    for layer in range(DEPTH):
        h = rmsnorm(x, norm_mix[layer])
        if layer % 2 == 0:
            e = layer // 2
            proj = h @ ab_w_in[e]
            q, k, v, u = jnp.split(proj, [SB_WIDTH, 2 * SB_WIDTH, 3 * SB_WIDTH], axis=-1)
            q = q.reshape(bsz, seq, SB_HEADS, SB_HEAD_DIM)
            k = k.reshape(bsz, seq, SB_HEADS, SB_HEAD_DIM)
            v = v.reshape(bsz, seq, SB_HEADS, SB_HEAD_DIM)
            a_out = stick_breaking_attention(q, k, v).reshape(bsz, seq, SB_WIDTH)
            p_out = multiscale_pool(u, pool_w[e], pool_scale[e])
            mix = jnp.concatenate([a_out, p_out], axis=-1) @ ab_w_out[e]
        else:
            o = layer // 2
            u = h @ ssm_w_in[o]
            y = s5_ssm(u, ssm_lam_re[o], ssm_lam_im[o], ssm_log_dt[o], ssm_b_re[o],
                       ssm_b_im[o], ssm_c_re[o], ssm_c_im[o], ssm_d[o])
            glu = jax.nn.gelu(y).astype(x.dtype) @ ssm_w_glu[o]
            val, gate = jnp.split(glu, 2, axis=-1)
            mix = val * jax.nn.sigmoid(gate)
        x = x + mix
        x = x + memory_cross_attention(rmsnorm(x, norm_xattn[layer]), mem_n,
                                       xa_w_q[layer], xa_w_kv[layer], xa_w_o[layer])
        x = x + conv_gated_mlp(rmsnorm(x, norm_ffn[layer]), ffn_w_up[layer],
                               ffn_conv_w[layer], ffn_conv_b[layer], ffn_w_down[layer])
    return rmsnorm(x, norm_final)
```

```cpp
#include <hip/hip_runtime.h>
#include <hip/hip_cooperative_groups.h>
#include <cstdio>
#include <cstdint>
namespace cg = cooperative_groups;

#ifndef MK_MULTI_LAUNCH
#define MK_MULTI_LAUNCH 0
#endif

#define LAS __attribute__((address_space(3)))
typedef unsigned short bf16_t;
typedef short bf16x8 __attribute__((ext_vector_type(8)));
typedef short s16x4 __attribute__((ext_vector_type(4)));
typedef float f32x4 __attribute__((ext_vector_type(4)));
typedef float f32x16 __attribute__((ext_vector_type(16)));
typedef unsigned u32x4 __attribute__((ext_vector_type(4)));
typedef unsigned u32x2 __attribute__((ext_vector_type(2)));

constexpr int MTOK = 32768, DM = 1024, SEQ = 2048, NBATCH = 16, DFF = 2816, DFF2 = 5632, MEMTOK = 4096;
constexpr int MHALF = 16384;
constexpr float EPS = 1e-6f;
constexpr float LOG2E = 1.4426950408889634f, LN2 = 0.6931471805599453f;

constexpr size_t MiB = 1u << 20;
constexpr size_t WS_SSQ = 1 * MiB;
constexpr size_t WS_WIN = 5 * MiB;
constexpr size_t WS_WOUT = 9 * MiB;
constexpr size_t WS_WSSM = 11 * MiB;
constexpr size_t WS_WGLU = 13 * MiB;
constexpr size_t WS_LAYER = 17 * MiB, LAYER_STRIDE = 25 * MiB;
constexpr size_t LO_WQ = 0, LO_WKV = 2 * MiB, LO_WO = 6 * MiB, LO_WUP = 8 * MiB, LO_WDN = 19 * MiB;
constexpr size_t WS_WEND = 67 * MiB;
constexpr size_t WS_TG = 83 * MiB;
constexpr size_t WS_MEMN = 123 * MiB;
constexpr size_t WS_MEMK = 131 * MiB;
constexpr size_t WS_MEMVT = 147 * MiB, MEMVT_STRIDE = 9 * MiB;
constexpr size_t WS_XB = 165 * MiB;
constexpr size_t WS_T = 229 * MiB;
constexpr size_t WS_QKU = WS_T, WS_VT = WS_T + 96 * MiB, WS_CAT = WS_T + 132 * MiB;
constexpr int VT_LD = MTOK + 128, MVT_LD = 4096 + 128;
constexpr size_t WS_QX = WS_T, WS_P = WS_T + 64 * MiB, WS_O = WS_T + 128 * MiB;
constexpr size_t WS_H = WS_T, WS_HALO = WS_T + 176 * MiB;
constexpr size_t WS_UG = WS_T, WS_HEND = WS_T + 80 * MiB, WS_YG = WS_T + 112 * MiB;
constexpr size_t WS_GT = 426 * MiB;
constexpr size_t WS_END = 512 * MiB;
static_assert(WS_H + (size_t)MTOK * DFF * 2 <= WS_HALO && WS_HALO + (size_t)128 * 4 * DFF2 * 2 <= WS_GT && WS_CAT + (size_t)MTOK * DM * 2 <= WS_GT && WS_GT + 64 * MiB <= WS_END, "ws map");

__device__ __forceinline__ unsigned cvt_pk_bf16(float lo, float hi) { unsigned r; asm volatile("v_cvt_pk_bf16_f32 %0, %1, %2" : "=v"(r) : "v"(lo), "v"(hi)); return r; }
__device__ __forceinline__ float bf2f(unsigned short b) { return __uint_as_float(((unsigned)b) << 16); }
__device__ __forceinline__ float bflo(unsigned w) { return __uint_as_float(w << 16); }
__device__ __forceinline__ float bfhi(unsigned w) { return __uint_as_float(w & 0xffff0000u); }
__device__ __forceinline__ float fexp2(float x) { return __builtin_amdgcn_exp2f(x); }
__device__ __forceinline__ float flog2(float x) { return __builtin_amdgcn_logf(x); }
__device__ __forceinline__ float fexp(float x) { return __builtin_amdgcn_exp2f(x * LOG2E); }
__device__ __forceinline__ float frcp(float x) { return __builtin_amdgcn_rcpf(x); }
template <int M> __device__ __forceinline__ float swz_xor(float v) { return __int_as_float(__builtin_amdgcn_ds_swizzle(__float_as_int(v), (M << 10) | 0x1f)); }
__device__ __forceinline__ float sum_x16(float v) { auto r = __builtin_amdgcn_permlane16_swap(__float_as_uint(v), __float_as_uint(v), false, false); return __uint_as_float(r[0]) + __uint_as_float(r[1]); }
__device__ __forceinline__ float sum_x32(float v) { auto r = __builtin_amdgcn_permlane32_swap(__float_as_uint(v), __float_as_uint(v), false, false); return __uint_as_float(r[0]) + __uint_as_float(r[1]); }
__device__ __forceinline__ float max_x16(float v) { auto r = __builtin_amdgcn_permlane16_swap(__float_as_uint(v), __float_as_uint(v), false, false); return fmaxf(__uint_as_float(r[0]), __uint_as_float(r[1])); }
__device__ __forceinline__ float max_x32(float v) { auto r = __builtin_amdgcn_permlane32_swap(__float_as_uint(v), __float_as_uint(v), false, false); return fmaxf(__uint_as_float(r[0]), __uint_as_float(r[1])); }
__device__ __forceinline__ float partner32(float v, int hi) { auto r = __builtin_amdgcn_permlane32_swap(__float_as_uint(v), __float_as_uint(v), false, false); return hi ? __uint_as_float(r[0]) : __uint_as_float(r[1]); }
__device__ __forceinline__ float wave_sum(float v) {
    v += swz_xor<1>(v); v += swz_xor<2>(v); v += swz_xor<4>(v); v += swz_xor<8>(v); v = sum_x16(v); v = sum_x32(v);
    return v;
}
#define LDS_WAIT() asm volatile("s_waitcnt lgkmcnt(0)" ::: "memory")

namespace pg8 {
constexpr int BM = 256, BK = 64, HALF = 128, HTB = HALF * BK * 2, STAGE_BYTES = 8 * HTB, NXCD = 8, WGM = 8;
__host__ __device__ __forceinline__ int lds_byte(int r, int c) { const int st = (r >> 4) * 2 + (c >> 5), rr = r & 15, cc = c & 31, ob = rr * 64 + cc * 2; return st * 1024 + (ob ^ (((ob >> 9) & 1) << 5)); }
__host__ __device__ __forceinline__ void stage_rc(int b, int& R, int& C) { const int st = b / 1024, sb = b % 1024, swz = sb ^ (((sb >> 9) & 1) << 5); R = (st >> 1) * 16 + swz / 64; C = (st & 1) * 32 + (swz % 64) / 2; }
__host__ __device__ __forceinline__ int perm32(int rho) { const int n = rho >> 4, i = rho & 15; return 8 * (i >> 2) + 4 * n + (i & 3); }

struct Unit { int pm, pn; const char* a; const char* b; };

struct SchedStd {
    const char* A; const char* B; unsigned sA, sB; int nM, nN, G, c;
    __device__ __forceinline__ void init(const void* A_, unsigned sA_, const void* B_, unsigned sB_, int nM_, int nN_, int G_, int c_) { A = (const char*)A_; B = (const char*)B_; sA = sA_; sB = sB_; nM = nM_; nN = nN_; G = G_; c = c_; }
    __device__ __forceinline__ bool next(int i, Unit& u) const {
        const int nwg = nM * nN; const long L = (long)i * G + c; if (L >= nwg) return false;
        int wgid = (int)L; { const int q = nwg / NXCD, r = nwg % NXCD, xcd = wgid % NXCD, off = wgid / NXCD; wgid = (xcd < r ? xcd * (q + 1) : r * (q + 1) + (xcd - r) * q) + off; }
        const int nig = WGM * nN, gid = wgid / nig, fm = gid * WGM, gsz = (nM - fm) < WGM ? (nM - fm) : WGM;
        u.pm = fm + ((wgid % nig) % gsz); u.pn = (wgid % nig) / gsz;
        u.a = A + (size_t)u.pm * sA; u.b = B + (size_t)u.pn * sB; return true;
    }
};
struct SchedXS {
    const char* A; const char* B; int G, c;
    __device__ __forceinline__ bool next(int i, Unit& u) const {
        const long L = (long)i * G + c; if (L >= 512) return false;
        u.pm = (int)(L >> 2); u.pn = (int)(L & 3);
        u.a = A + (size_t)u.pm * 256 * 2048 + u.pn * 512; u.b = B + (size_t)(u.pm >> 3) * 256 * 2048 + u.pn * 512; return true;
    }
};
struct SchedXQ {
    const char* A; const char* B; int G, c;
    __device__ __forceinline__ bool next(int i, Unit& u) const {
        const long L = (long)i * G + c; if (L >= 512) return false;
        u.pm = (int)(L >> 2); u.pn = (int)(L & 3);
        u.a = A + (size_t)u.pm * 256 * 2048; u.b = B + (size_t)u.pn * 256 * 2048; return true;
    }
};
struct SchedG {
    const char* MK; const char* WQ; int G, c;
    __device__ __forceinline__ bool next(int i, Unit& u) const {
        const long L = (long)i * G + c; if (L >= 512) return false;
        const int l = (int)(L >> 8), r = (int)(L & 255), b = r >> 4, h = (r >> 2) & 3, pn = r & 3;
        u.pm = l * 64 + b * 4 + h; u.pn = pn;
        u.a = MK + (size_t)l * 8 * 1048576 + (size_t)b * 256 * 2048 + h * 512; u.b = WQ + (size_t)l * LAYER_STRIDE + (size_t)pn * 256 * 2048 + h * 512; return true;
    }
};
struct SchedXS2 {
    const char* A; const char* B; int G, c;
    __device__ __forceinline__ bool next(int i, Unit& u) const {
        const long L = (long)i * G + c; if (L >= 512) return false;
        u.pm = (int)(L >> 2); u.pn = (int)(L & 3);
        u.a = A + (size_t)u.pm * 256 * 2048; u.b = B + (size_t)((u.pm >> 3) * 4 + u.pn) * 256 * 2048; return true;
    }
};
struct SchedVW {
    const char* WO; const char* MV; int G, c;
    __device__ __forceinline__ bool next(int i, Unit& u) const {
        const long L = (long)i * G + c; if (L >= 256) return false;
        const int b = (int)(L >> 4), pq = (int)(L >> 2) & 3, h = (int)L & 3;
        u.pm = b * 4 + pq; u.pn = h;
        u.a = WO + (size_t)pq * 256 * 2048 + h * 512; u.b = MV + (size_t)b * 256 * 2048 + h * 512; return true;
    }
};
struct SchedXOut {
    const char* A; const char* B; int G, c;
    __device__ __forceinline__ bool next(int i, Unit& u) const {
        const long L = (long)i * G + c; if (L >= 512) return false;
        u.pm = (int)(L >> 2); u.pn = (int)(L & 3);
        u.a = A + (size_t)u.pm * 256 * 2048; u.b = B + ((size_t)(u.pm >> 3) * 1024 + (size_t)u.pn * 256) * 2048; return true;
    }
};
struct SchedXO {
    const char* A; const char* B; int G, c;
    __device__ __forceinline__ bool next(int i, Unit& u) const {
        const long L = (long)i * G + c; if (L >= 512) return false;
        u.pm = (int)(L >> 2); u.pn = (int)(L & 3);
        u.a = A + (size_t)u.pm * 256 * 2048 + u.pn * 512; u.b = B + (size_t)u.pn * 256 * (MVT_LD * 2) + (size_t)(u.pm >> 3) * 512; return true;
    }
};
struct SchedS2 {
    const char* A; const char* B; int G, c;
    __device__ __forceinline__ bool next(int i, Unit& u) const {
        const long L = (long)i * G + c; if (L >= 256) return false;
        u.pm = (int)L; u.pn = 0;
        u.a = A + (size_t)L * 256 * 1280; u.b = B + (size_t)(L >> 2) * 256 * 1024; return true;
    }
};
struct SchedS4 {
    const char* A; const char* B; int G, c;
    __device__ __forceinline__ bool next(int i, Unit& u) const {
        const long L = (long)i * G + c; if (L >= 512) return false;
        u.pm = (int)(L >> 1); u.pn = (int)(L & 1);
        u.a = A + (size_t)u.pm * 256 * 1280; u.b = B + ((size_t)(L >> 3) * 512 + (size_t)u.pn * 256) * 1280; return true;
    }
};

typedef f32x4 Acc[2][2][4][2];

__device__ __forceinline__ float row_rstd(const float* ssq_row, int nslots) {
    float s = 0.f;
    const f32x4* p = (const f32x4*)ssq_row;
    for (int i = 0; i < nslots / 4; ++i) { const f32x4 v = p[i]; s += (v[0] + v[1]) + (v[2] + v[3]); }
    return 1.0f / sqrtf(s * (1.0f / DM) + EPS);
}

struct EpiStore {
    static constexpr bool PERM = true;
    bf16_t* O; int ldc; const float* ssq; int nslots; float cs; int mode;
    __device__ __forceinline__ void operator()(Acc& acc, const Unit& u, int wr, int wc, int fr, int fq, LAS unsigned char*) const {
        const int row0 = u.pm * BM + wr * 64 + fr, col0 = u.pn * BM + wc * 32 + 8 * fq;
#pragma unroll
        for (int ai = 0; ai < 2; ++ai)
#pragma unroll
            for (int m = 0; m < 4; ++m) {
                const int row = row0 + ai * HALF + m * 16;
                float sc = cs;
                if (ssq) sc *= row_rstd(ssq + (size_t)row * 32, nslots);
#pragma unroll
                for (int bj = 0; bj < 2; ++bj) {
                    const int col = col0 + bj * HALF;
                    const f32x4 v0 = acc[ai][bj][m][0] * sc, v1 = acc[ai][bj][m][1] * sc;
                    u32x4 w; w.x = cvt_pk_bf16(v0[0], v0[1]); w.y = cvt_pk_bf16(v0[2], v0[3]); w.z = cvt_pk_bf16(v1[0], v1[1]); w.w = cvt_pk_bf16(v1[2], v1[3]);
                    bf16_t* p = (mode == 0) ? O + (size_t)row * ldc + col
                                            : O + ((size_t)(col >> 4) * 1024 + (row >> 5)) * 640 + (row & 31) * 16 + (col & 15);
                    *(u32x4*)p = w;
                }
            }
    }
};

struct EpiResid {
    static constexpr bool PERM = false;
    const float* xf; bf16_t* xb; float* ssq;
    __device__ __forceinline__ void operator()(Acc& acc, const Unit& u, int wr, int wc, int fr, int fq, LAS unsigned char*) const {
        const int row0 = u.pm * BM + wr * 64 + fr, col0 = u.pn * BM + wc * 32 + 4 * fq;
#pragma unroll
        for (int ai = 0; ai < 2; ++ai)
#pragma unroll
            for (int m = 0; m < 4; ++m) {
                const int row = row0 + ai * HALF + m * 16; float q = 0.f;
#pragma unroll
                for (int bj = 0; bj < 2; ++bj)
#pragma unroll
                    for (int n = 0; n < 2; ++n) {
                        const int col = col0 + bj * HALF + n * 16; const size_t off = (size_t)row * DM + col;
                        f32x4 v;
                        if (xf) v = *(const f32x4*)(xf + off);
                        else { const u32x2 o = *(const u32x2*)(xb + off); v = (f32x4){bflo(o.x), bfhi(o.x), bflo(o.y), bfhi(o.y)}; }
                        v += acc[ai][bj][m][n];
                        q += (v[0] * v[0] + v[1] * v[1]) + (v[2] * v[2] + v[3] * v[3]);
                        u32x2 w; w.x = cvt_pk_bf16(v[0], v[1]); w.y = cvt_pk_bf16(v[2], v[3]);
                        *(u32x2*)(xb + off) = w;
                    }
                q = sum_x16(q); q = sum_x32(q);
                if (fq == 0) ssq[(size_t)row * 32 + u.pn * 4 + wc] = q;
            }
    }
};

struct EpiGlu {
    static constexpr bool PERM = false;
    bf16_t* xb; float* ssq;
    __device__ __forceinline__ void operator()(Acc& acc, const Unit& u, int wr, int wc, int fr, int fq, LAS unsigned char*) const {
        const int row0 = u.pm * BM + wr * 64 + fr, col0 = u.pn * HALF + wc * 32 + 4 * fq;
#pragma unroll
        for (int ai = 0; ai < 2; ++ai)
#pragma unroll
            for (int m = 0; m < 4; ++m) {
                const int row = row0 + ai * HALF + m * 16; float q = 0.f;
#pragma unroll
                for (int n = 0; n < 2; ++n) {
                    const int col = col0 + n * 16; const size_t off = (size_t)row * DM + col;
                    const f32x4 val = acc[ai][0][m][n], gt = acc[ai][1][m][n];
                    const u32x2 o = *(const u32x2*)(xb + off);
                    f32x4 v = (f32x4){bflo(o.x), bfhi(o.x), bflo(o.y), bfhi(o.y)};
#pragma unroll
                    for (int j = 0; j < 4; ++j) v[j] += val[j] * frcp(1.0f + fexp(-gt[j]));
                    q += (v[0] * v[0] + v[1] * v[1]) + (v[2] * v[2] + v[3] * v[3]);
                    u32x2 w; w.x = cvt_pk_bf16(v[0], v[1]); w.y = cvt_pk_bf16(v[2], v[3]);
                    *(u32x2*)(xb + off) = w;
                }
                q = sum_x16(q); q = sum_x32(q);
                if (fq == 0) ssq[(size_t)row * 32 + u.pn * 4 + wc] = q;
            }
    }
};

struct EpiSoftmax {
    static constexpr bool PERM = true;
    bf16_t* O; const float* ssq; int nslots; float cs;
    __device__ __forceinline__ void operator()(Acc& acc, const Unit& u, int wr, int wc, int fr, int fq, LAS unsigned char* xl) const {
        LAS float* tmax = (LAS float*)xl; LAS float* tsum = tmax + 1024;
#pragma unroll
        for (int ai = 0; ai < 2; ++ai)
#pragma unroll
            for (int m = 0; m < 4; ++m) {
                const float sc = cs * row_rstd(ssq + (size_t)(u.pm * BM + ai * HALF + wr * 64 + m * 16 + fr) * 32, nslots);
#pragma unroll
                for (int bj = 0; bj < 2; ++bj)
#pragma unroll
                    for (int n = 0; n < 2; ++n) acc[ai][bj][m][n] *= sc;
                float mx = -3.0e38f;
#pragma unroll
                for (int bj = 0; bj < 2; ++bj)
#pragma unroll
                    for (int n = 0; n < 2; ++n) { const f32x4 x = acc[ai][bj][m][n]; mx = fmaxf(mx, fmaxf(fmaxf(x[0], x[1]), fmaxf(x[2], x[3]))); }
                mx = max_x16(mx); mx = max_x32(mx);
                if (fq == 0) tmax[(ai * HALF + wr * 64 + m * 16 + fr) * 4 + wc] = mx;
            }
        LDS_WAIT(); __builtin_amdgcn_s_barrier(); asm volatile("" ::: "memory");
#pragma unroll
        for (int ai = 0; ai < 2; ++ai)
#pragma unroll
            for (int m = 0; m < 4; ++m) {
                const int r = ai * HALF + wr * 64 + m * 16 + fr;
                const f32x4 t = *(const LAS f32x4*)(tmax + r * 4);
                const float gm = fmaxf(fmaxf(t[0], t[1]), fmaxf(t[2], t[3])) * LOG2E; float s = 0.f;
#pragma unroll
                for (int bj = 0; bj < 2; ++bj)
#pragma unroll
                    for (int n = 0; n < 2; ++n) {
                        f32x4 x = acc[ai][bj][m][n];
#pragma unroll
                        for (int j = 0; j < 4; ++j) { x[j] = fexp2(x[j] * LOG2E - gm); s += x[j]; }
                        acc[ai][bj][m][n] = x;
                    }
                s = sum_x16(s); s = sum_x32(s);
                if (fq == 0) tsum[r * 4 + wc] = s;
            }
        LDS_WAIT(); __builtin_amdgcn_s_barrier(); asm volatile("" ::: "memory");
        const int row0 = u.pm * BM + wr * 64 + fr, col0 = u.pn * BM + wc * 32 + 8 * fq;
#pragma unroll
        for (int ai = 0; ai < 2; ++ai)
#pragma unroll
            for (int m = 0; m < 4; ++m) {
                const int r = ai * HALF + wr * 64 + m * 16 + fr;
                const f32x4 t = *(const LAS f32x4*)(tsum + r * 4);
                const float inv = 1.0f / ((t[0] + t[1]) + (t[2] + t[3]));
#pragma unroll
                for (int bj = 0; bj < 2; ++bj) {
                    const f32x4 v0 = acc[ai][bj][m][0] * inv, v1 = acc[ai][bj][m][1] * inv;
                    u32x4 w; w.x = cvt_pk_bf16(v0[0], v0[1]); w.y = cvt_pk_bf16(v0[2], v0[3]); w.z = cvt_pk_bf16(v1[0], v1[1]); w.w = cvt_pk_bf16(v1[2], v1[3]);
                    *(u32x4*)(O + (size_t)(row0 + ai * HALF + m * 16) * DM + col0 + bj * HALF) = w;
                }
            }
    }
};


__device__ __forceinline__ float dpp_ror1(float x) { return __int_as_float(__builtin_amdgcn_update_dpp(0, __float_as_int(x), 0x121, 0xf, 0xf, false)); }
__device__ __forceinline__ float dpp_ror2(float x) { return __int_as_float(__builtin_amdgcn_update_dpp(0, __float_as_int(x), 0x122, 0xf, 0xf, false)); }
__device__ __forceinline__ float dpp_ror1u(float x) { return __int_as_float(__builtin_amdgcn_mov_dpp(__float_as_int(x), 0x121, 0xf, 0xf, false)); }
__device__ __forceinline__ float dpp_ror2u(float x) { return __int_as_float(__builtin_amdgcn_mov_dpp(__float_as_int(x), 0x122, 0xf, 0xf, false)); }
__device__ __forceinline__ float dpp_shr1_old(float old, float x) { return __int_as_float(__builtin_amdgcn_update_dpp(__float_as_int(old), __float_as_int(x), 0x111, 0xf, 0xf, false)); }
__device__ __forceinline__ float dpp_shr2_old(float old, float x) { return __int_as_float(__builtin_amdgcn_update_dpp(__float_as_int(old), __float_as_int(x), 0x112, 0xf, 0xf, false)); }
struct EpiUpConv {
    static constexpr bool PERM = true;
    bf16_t* H; bf16_t* HALO; const float* ssq; const float* cw; const float* cb;
    __device__ __forceinline__ void operator()(Acc& acc, const Unit& u, int wr, int wc, int fr, int fq, LAS unsigned char* xl) const {
        LAS float* B = (LAS float*)xl;
        LAS float* Wl = B + 2048;
        LAS float* R = Wl + 1024;
        const int wid = wr * 4 + wc, lane = fq * 16 + fr, tid = wid * 64 + lane;
        const int row0 = u.pm * BM + wr * 64 + fr, colb = wc * 32 + 8 * fq, ch0 = u.pn * HALF + colb;
        {
#pragma unroll
            for (int i = 0; i < 2; ++i) { const int idx = tid + i * 512, t = idx >> 8, bj = (idx >> 7) & 1, chl = idx & 127;
                Wl[idx] = (t < 3) ? cw[t * DFF2 + bj * DFF + u.pn * HALF + chl] : cb[bj * DFF + u.pn * HALF + chl]; }
            if (lane < 32) R[wid * 32 + lane] = row_rstd(ssq + (size_t)(u.pm * BM + wid * 32 + lane) * 32, 16);
        }
        LDS_WAIT(); __builtin_amdgcn_s_barrier(); asm volatile("" ::: "memory");
#pragma unroll
        for (int ai = 0; ai < 2; ++ai)
#pragma unroll
            for (int m = 0; m < 4; ++m) {
                const float sc = R[ai * HALF + wr * 64 + m * 16 + fr];
#pragma unroll
                for (int bj = 0; bj < 2; ++bj)
#pragma unroll
                    for (int n = 0; n < 2; ++n) acc[ai][bj][m][n] *= sc;
            }
        if (fr >= 14) {
#pragma unroll
            for (int ai = 0; ai < 2; ++ai)
#pragma unroll
                for (int bj = 0; bj < 2; ++bj)
#pragma unroll
                    for (int n = 0; n < 2; ++n) *(LAS f32x4*)(B + ((ai * 2 + wr) * 2 + (fr - 14)) * 256 + bj * HALF + colb + 4 * n) = acc[ai][bj][3][n];
        }
        if (wr == 0 && fr < 2) {
#pragma unroll
            for (int bj = 0; bj < 2; ++bj) { const f32x4 v0 = acc[0][bj][0][0], v1 = acc[0][bj][0][1];
                u32x4 w; w.x = cvt_pk_bf16(v0[0], v0[1]); w.y = cvt_pk_bf16(v0[2], v0[3]); w.z = cvt_pk_bf16(v1[0], v1[1]); w.w = cvt_pk_bf16(v1[2], v1[3]);
                *(u32x4*)(HALO + (size_t)(u.pm * 4 + fr) * DFF2 + bj * DFF + ch0) = w; }
        }
        if (wr == 1 && fr >= 14) {
#pragma unroll
            for (int bj = 0; bj < 2; ++bj) { const f32x4 v0 = acc[1][bj][3][0], v1 = acc[1][bj][3][1];
                u32x4 w; w.x = cvt_pk_bf16(v0[0], v0[1]); w.y = cvt_pk_bf16(v0[2], v0[3]); w.z = cvt_pk_bf16(v1[0], v1[1]); w.w = cvt_pk_bf16(v1[2], v1[3]);
                *(u32x4*)(HALO + (size_t)(u.pm * 4 + 2 + (fr - 14)) * DFF2 + bj * DFF + ch0) = w; }
        }
        LDS_WAIT(); __builtin_amdgcn_s_barrier(); asm volatile("" ::: "memory");
#pragma unroll
        for (int ai = 0; ai < 2; ++ai) {
            const bool has = (wr == 1) || (ai == 1);
            const int sb = (wr == 1) ? (ai * 2) : 1;
#pragma unroll
            for (int n = 0; n < 2; ++n) {
                asm volatile("" ::: "memory");
                const int cl = colb + 4 * n;
                float hv[4][4];
                const f32x4 wv0 = *(const LAS f32x4*)(Wl + 0 * 128 + cl), wg0 = *(const LAS f32x4*)(Wl + 1 * 128 + cl);
                const f32x4 wv1 = *(const LAS f32x4*)(Wl + 2 * 128 + cl), wg1 = *(const LAS f32x4*)(Wl + 3 * 128 + cl);
                const f32x4 wv2 = *(const LAS f32x4*)(Wl + 4 * 128 + cl), wg2 = *(const LAS f32x4*)(Wl + 5 * 128 + cl);
                const f32x4 bvv = *(const LAS f32x4*)(Wl + 6 * 128 + cl), bgv = *(const LAS f32x4*)(Wl + 7 * 128 + cl);
                f32x4 b1v = (f32x4){0.f, 0.f, 0.f, 0.f}, b2v = b1v, b1g = b1v, b2g = b1v;
                if (has) {
                    b1v = *(const LAS f32x4*)(B + (sb * 2 + 1) * 256 + cl); b2v = *(const LAS f32x4*)(B + (sb * 2 + (fr & 1)) * 256 + cl);
                    b1g = *(const LAS f32x4*)(B + (sb * 2 + 1) * 256 + HALF + cl); b2g = *(const LAS f32x4*)(B + (sb * 2 + (fr & 1)) * 256 + HALF + cl);
                }
#pragma unroll
                for (int j = 0; j < 4; ++j) {
                    float r1p = b1v[j], r2p = b2v[j], q1p = b1g[j], q2p = b2g[j];
#pragma unroll
                    for (int m = 0; m < 4; ++m) {
                        const float xv = acc[ai][0][m][n][j], xg = acc[ai][1][m][n][j];
                        const float pv1 = dpp_shr1_old(r1p, xv), pv2 = dpp_shr2_old(r2p, xv), pg1 = dpp_shr1_old(q1p, xg), pg2 = dpp_shr2_old(q2p, xg);
                        const float cv = bvv[j] + wv0[j] * pv2 + wv1[j] * pv1 + wv2[j] * xv;
                        const float cg = bgv[j] + wg0[j] * pg2 + wg1[j] * pg1 + wg2[j] * xg;
                        hv[m][j] = cv * cg * frcp(1.0f + fexp(-cg));
                        if (m < 3) { r1p = dpp_ror1u(xv); r2p = dpp_ror2u(xv); q1p = dpp_ror1u(xg); q2p = dpp_ror2u(xg); }
                    }
                    __builtin_amdgcn_sched_barrier(0);
                }
#pragma unroll
                for (int m = 0; m < 4; ++m) {
                    u32x2 w; w.x = cvt_pk_bf16(hv[m][0], hv[m][1]); w.y = cvt_pk_bf16(hv[m][2], hv[m][3]);
                    *(u32x2*)(H + (size_t)(row0 + ai * HALF + m * 16) * DFF + ch0 + 4 * n) = w;
                }
            }
        }
    }
};

struct EpiHend {
    static constexpr bool PERM = false;
    float* Hout;
    __device__ __forceinline__ void operator()(Acc& acc, const Unit& u, int wr, int wc, int fr, int fq, LAS unsigned char*) const {
        const int row0 = u.pm * BM + wr * 64 + fr, col0 = wc * 32 + 4 * fq;
#pragma unroll
        for (int ai = 0; ai < 2; ++ai)
#pragma unroll
            for (int m = 0; m < 4; ++m)
#pragma unroll
                for (int n = 0; n < 2; ++n)
                    *(f32x4*)(Hout + (size_t)(row0 + ai * HALF + m * 16) * 128 + col0 + n * 16) = acc[ai][0][m][n];
    }
};

struct EpiSsmY {
    static constexpr bool PERM = true;
    const bf16_t* Ug; const float* Dskip; bf16_t* Yg;
    __device__ __forceinline__ void operator()(Acc& acc, const Unit& u, int wr, int wc, int fr, int fq, LAS unsigned char*) const {
        const int g = u.pm >> 2;
        const int rg0 = (u.pm & 3) * BM + wr * 64 + fr, col0 = u.pn * BM + wc * 32 + 8 * fq;
        const int co = col0 & 15;
        const f32x4 d0 = *(const f32x4*)(Dskip + g * 16 + co), d1 = *(const f32x4*)(Dskip + g * 16 + co + 4);
#pragma unroll
        for (int ai = 0; ai < 2; ++ai)
#pragma unroll
            for (int m = 0; m < 4; ++m) {
                const int rg = rg0 + ai * HALF + m * 16;
#pragma unroll
                for (int bj = 0; bj < 2; ++bj) {
                    const int col = col0 + bj * HALF;
                    const u32x4 uu = *(const u32x4*)(Ug + ((size_t)g * 1024 + rg) * 640 + col);
                    float y[8];
                    y[0] = acc[ai][bj][m][0][0] + d0[0] * bflo(uu.x); y[1] = acc[ai][bj][m][0][1] + d0[1] * bfhi(uu.x);
                    y[2] = acc[ai][bj][m][0][2] + d0[2] * bflo(uu.y); y[3] = acc[ai][bj][m][0][3] + d0[3] * bfhi(uu.y);
                    y[4] = acc[ai][bj][m][1][0] + d1[0] * bflo(uu.z); y[5] = acc[ai][bj][m][1][1] + d1[1] * bfhi(uu.z);
                    y[6] = acc[ai][bj][m][1][2] + d1[2] * bflo(uu.w); y[7] = acc[ai][bj][m][1][3] + d1[3] * bfhi(uu.w);
#pragma unroll
                    for (int j = 0; j < 8; ++j) { const float x = y[j]; const float k2 = 1.5957691216f * (x + 0.044715f * x * x * x); y[j] = x * frcp(1.0f + fexp(-k2)); }
                    u32x4 w; w.x = cvt_pk_bf16(y[0], y[1]); w.y = cvt_pk_bf16(y[2], y[3]); w.z = cvt_pk_bf16(y[4], y[5]); w.w = cvt_pk_bf16(y[6], y[7]);
                    const size_t tok = (size_t)rg * 32 + (col >> 4);
                    *(u32x4*)(Yg + tok * DM + g * 16 + co) = w;
                }
            }
    }
};

template <class Epi, class Sched>
__device__ __forceinline__ void gemm_phase(LAS unsigned char* lds, LAS unsigned char* xl, const int lda, const int ldb, const int K, const Sched& S, const Epi& E) {
    int tid_ = threadIdx.x; asm volatile("" : "+v"(tid_));
    const int tid = tid_, wid = __builtin_amdgcn_readfirstlane(tid >> 6), lane = tid & 63, wr = wid >> 2, wc = wid & 3, fr = lane & 15, fq = lane >> 4;
    const int nt = K / BK;
    unsigned voffA, voffB;
    { int R, C; stage_rc(tid * 16, R, C); const int Rb = Epi::PERM ? ((R & ~31) + perm32(R & 31)) : R;
      voffA = (unsigned)(R * lda + C) * 2u; voffB = (unsigned)(Rb * ldb + C) * 2u; }
    const size_t qstepA = (size_t)64 * lda * 2, qstepB = (size_t)64 * ldb * 2;
    const size_t kstep = (size_t)(BK * 2);
    const size_t hstepA = (size_t)HALF * lda * 2, hstepB = (size_t)HALF * ldb * 2;
    const unsigned ldsw = (unsigned)wid * 1024u;
    const int aoff = lds_byte(wr * 64 + fr, fq * 8), boff = lds_byte(wc * 32 + fr, fq * 8);
#define PG8_SA(b, h) (((b) * 2 + (h)) * HTB)
#define PG8_SB(b, h) ((4 + (b) * 2 + (h)) * HTB)
#define PG8_STAGE(bufoff, gbase, voff) do { _Pragma("unroll") for (int _i = 0; _i < 2; ++_i) \
        { const char* _gb = (const char*)(gbase) + (size_t)_i * q##voff; asm volatile("" : "+s"(_gb)); \
          __builtin_amdgcn_global_load_lds((const unsigned*)(_gb + (voff)), (LAS unsigned*)(lds + (bufoff) + ldsw + _i * 8192), 16, 0, 0); } } while (0)
#define qvoffA qstepA
#define qvoffB qstepB
#define PG8_LDA(dst, b, h) do { _Pragma("unroll") for (int m = 0; m < 4; ++m) _Pragma("unroll") for (int k = 0; k < 2; ++k) dst[m][k] = *(const LAS bf16x8*)(lds + PG8_SA(b, h) + aoff + m * 2048 + k * 1024); } while (0)
#define PG8_LDB(dst, b, h) do { _Pragma("unroll") for (int n = 0; n < 2; ++n) _Pragma("unroll") for (int k = 0; k < 2; ++k) dst[n][k] = *(const LAS bf16x8*)(lds + PG8_SB(b, h) + boff + n * 2048 + k * 1024); } while (0)
#define PG8_MMA(ai, bj, At, Bt) do { __builtin_amdgcn_s_setprio(1); _Pragma("unroll") for (int m = 0; m < 4; ++m) _Pragma("unroll") for (int n = 0; n < 2; ++n) _Pragma("unroll") for (int k = 0; k < 2; ++k) \
        acc[ai][bj][m][n] = __builtin_amdgcn_mfma_f32_16x16x32_bf16(Bt[n][k], At[m][k], acc[ai][bj][m][n], 0, 0, 0); __builtin_amdgcn_s_setprio(0); } while (0)
#define PG8_WAIT_V(n) asm volatile("s_waitcnt vmcnt(" #n ")" ::: "memory")
#define PG8_WAIT_L(n) asm volatile("s_waitcnt lgkmcnt(" #n ")" ::: "memory")
#define PG8_BAR __builtin_amdgcn_s_barrier()
#define PG8_SCHED __builtin_amdgcn_sched_barrier(0)
    Unit cur, nxt; int ui = 0;
    if (!S.next(0, cur)) return;
    Acc acc;
#pragma unroll
    for (int a = 0; a < 2; ++a)
#pragma unroll
        for (int b = 0; b < 2; ++b)
#pragma unroll
            for (int m = 0; m < 4; ++m)
#pragma unroll
                for (int n = 0; n < 2; ++n) acc[a][b][m][n] = (f32x4){0.f, 0.f, 0.f, 0.f};
    bf16x8 At[4][2], B0[2][2], B1[2][2];
    const char* cA = cur.a; const char* cB = cur.b;
    PG8_STAGE(PG8_SB(0, 0), cB, voffB); PG8_STAGE(PG8_SB(0, 1), cB + hstepB, voffB); PG8_STAGE(PG8_SA(0, 0), cA, voffA); PG8_STAGE(PG8_SA(0, 1), cA + hstepA, voffA);
    if (wr == 1) PG8_BAR;
    PG8_WAIT_V(2); PG8_BAR;
    PG8_STAGE(PG8_SB(1, 0), cB + kstep, voffB); PG8_STAGE(PG8_SA(1, 0), cA + kstep, voffA); PG8_STAGE(PG8_SB(1, 1), cB + hstepB + kstep, voffB);
    PG8_WAIT_V(6); PG8_BAR;
    for (;;) {
        const bool has_next = S.next(ui + 1, nxt);
        const char* nA = has_next ? nxt.a : cA; const char* nB = has_next ? nxt.b : cB;
        for (int t = 0; t < nt; t += 2) {
            const bool last = (t == nt - 2);
            const char* a1 = cA + (size_t)(t + 1) * kstep;
            const char* a2 = last ? nA : cA + (size_t)(t + 2) * kstep; const char* b2 = last ? nB : cB + (size_t)(t + 2) * kstep;
            const char* a3 = a2 + kstep; const char* b3 = b2 + kstep;
            PG8_LDB(B0, 0, 0); PG8_LDB(B1, 0, 1); PG8_SCHED; PG8_LDA(At, 0, 0); PG8_STAGE(PG8_SA(1, 1), a1 + hstepA, voffA);
            PG8_WAIT_V(8); PG8_WAIT_L(0); PG8_BAR; PG8_MMA(0, 0, At, B0); PG8_MMA(0, 1, At, B1); PG8_BAR; PG8_SCHED;
            PG8_LDA(At, 0, 1); PG8_STAGE(PG8_SB(0, 0), b2, voffB); PG8_STAGE(PG8_SB(0, 1), b2 + hstepB, voffB); PG8_STAGE(PG8_SA(0, 0), a2, voffA);
            PG8_WAIT_V(8); PG8_WAIT_L(0); PG8_BAR; PG8_MMA(1, 0, At, B0); PG8_MMA(1, 1, At, B1); PG8_BAR; PG8_SCHED;
            PG8_LDB(B0, 1, 0); PG8_LDB(B1, 1, 1); PG8_SCHED; PG8_LDA(At, 1, 0); PG8_STAGE(PG8_SA(0, 1), a2 + hstepA, voffA);
            PG8_WAIT_V(8); PG8_WAIT_L(0); PG8_BAR; PG8_MMA(0, 0, At, B0); PG8_MMA(0, 1, At, B1); PG8_BAR; PG8_SCHED;
            PG8_LDA(At, 1, 1); PG8_STAGE(PG8_SB(1, 0), b3, voffB); PG8_STAGE(PG8_SB(1, 1), b3 + hstepB, voffB); PG8_STAGE(PG8_SA(1, 0), a3, voffA);
            PG8_WAIT_V(8); PG8_WAIT_L(0); PG8_BAR; PG8_MMA(1, 0, At, B0); PG8_MMA(1, 1, At, B1); PG8_BAR; PG8_SCHED;
        }
        if (wr == 0) PG8_BAR;
        __builtin_amdgcn_sched_barrier(0); asm volatile("s_nop 15\n\ts_nop 15\n\ts_nop 15" ::: "memory"); __builtin_amdgcn_sched_barrier(0);
        { int t2 = threadIdx.x; asm volatile("" : "+v"(t2)); E(acc, cur, wr, wc, t2 & 15, (t2 >> 4) & 3, xl); }
        if (!has_next) break;
#pragma unroll
        for (int a = 0; a < 2; ++a)
#pragma unroll
            for (int b = 0; b < 2; ++b)
#pragma unroll
                for (int m = 0; m < 4; ++m)
#pragma unroll
                    for (int n = 0; n < 2; ++n) acc[a][b][m][n] = (f32x4){0.f, 0.f, 0.f, 0.f};
        cur = nxt; cA = nA; cB = nB; ++ui;
        if (wr == 1) PG8_BAR;
    }
    PG8_WAIT_V(0);
    PG8_BAR;
#undef PG8_SA
#undef PG8_SB
#undef PG8_STAGE
#undef qvoffA
#undef qvoffB
#undef PG8_LDA
#undef PG8_LDB
#undef PG8_MMA
#undef PG8_WAIT_V
#undef PG8_WAIT_L
#undef PG8_BAR
#undef PG8_SCHED
}
}

constexpr int RING_BYTES = 131072, XL_OFF = RING_BYTES, XBST_OFF = XL_OFF + 14336, LDS_BYTES = 147456;

struct TItem { const float* W; const float* gk; bf16_t* D; int N, ldt, drow0, k0, n0; };
__device__ __forceinline__ void titem_load(float (&v)[32], const TItem& t, int lane) {
#pragma unroll
    for (int i = 0; i < 32; ++i) { const int kk = 2 * i + (lane >> 5); v[i] = t.W[(size_t)(t.k0 + kk) * t.N + t.n0 + (lane & 31)]; }
}
__device__ __forceinline__ void titem_to_lds(const float (&v)[32], LAS float* scr, int lane) {
#pragma unroll
    for (int i = 0; i < 32; ++i) { const int kk = 2 * i + (lane >> 5); scr[kk * 33 + (lane & 31)] = v[i]; }
    LDS_WAIT(); asm volatile("" ::: "memory");
}
__device__ __forceinline__ void titem_store(const TItem& t, LAS float* scr, int lane) {
    const int c = lane & 7;
    f32x4 g0 = (f32x4){1.f, 1.f, 1.f, 1.f}, g1 = g0;
    if (t.gk) { g0 = *(const f32x4*)(t.gk + t.k0 + 8 * c); g1 = *(const f32x4*)(t.gk + t.k0 + 8 * c + 4); }
#pragma unroll
    for (int j = 0; j < 4; ++j) { const int n = (lane >> 3) + 8 * j; const LAS float* s = scr + (8 * c) * 33 + n;
        u32x4 o; o.x = cvt_pk_bf16(s[0 * 33] * g0[0], s[1 * 33] * g0[1]); o.y = cvt_pk_bf16(s[2 * 33] * g0[2], s[3 * 33] * g0[3]);
        o.z = cvt_pk_bf16(s[4 * 33] * g1[0], s[5 * 33] * g1[1]); o.w = cvt_pk_bf16(s[6 * 33] * g1[2], s[7 * 33] * g1[3]);
        *(u32x4*)(t.D + (size_t)(t.drow0 + n) * t.ldt + t.k0 + 8 * c) = o; }
    LDS_WAIT(); asm volatile("" ::: "memory");
}
__device__ __forceinline__ void rms_row_to_bf16(const float* xrow, const float* g, bf16_t* orow, int lane) {
    const f32x4* xr = (const f32x4*)xrow + lane; const f32x4* gr = (const f32x4*)g + lane;
    f32x4 v[4]; float s = 0.f;
#pragma unroll
    for (int j = 0; j < 4; ++j) { v[j] = xr[64 * j]; s += (v[j].x * v[j].x + v[j].y * v[j].y) + (v[j].z * v[j].z + v[j].w * v[j].w); }
    const float rstd = 1.f / sqrtf(wave_sum(s) * (1.f / DM) + EPS);
    u32x2* o8 = (u32x2*)orow + lane;
#pragma unroll
    for (int j = 0; j < 4; ++j) { const f32x4 gg = gr[64 * j]; u32x2 w; w.x = cvt_pk_bf16(v[j].x * rstd * gg.x, v[j].y * rstd * gg.y); w.y = cvt_pk_bf16(v[j].z * rstd * gg.z, v[j].w * rstd * gg.w); o8[64 * j] = w; }
}

__device__ __forceinline__ void rms_rows4_to_bf16(const float* xrow, const float* g, bf16_t* orow, int lane) {
    f32x4 v[4][4]; float s[4];
#pragma unroll
    for (int r = 0; r < 4; ++r)
#pragma unroll
        for (int j = 0; j < 4; ++j) v[r][j] = *((const f32x4*)(xrow + (size_t)r * DM) + lane + 64 * j);
#pragma unroll
    for (int r = 0; r < 4; ++r) { s[r] = 0.f;
#pragma unroll
        for (int j = 0; j < 4; ++j) s[r] += (v[r][j].x * v[r][j].x + v[r][j].y * v[r][j].y) + (v[r][j].z * v[r][j].z + v[r][j].w * v[r][j].w); }
#pragma unroll
    for (int r = 0; r < 4; ++r) s[r] = 1.f / sqrtf(wave_sum(s[r]) * (1.f / DM) + EPS);
#pragma unroll
    for (int j = 0; j < 4; ++j) { const f32x4 gg = *((const f32x4*)g + lane + 64 * j);
#pragma unroll
        for (int r = 0; r < 4; ++r) { u32x2 w; w.x = cvt_pk_bf16(v[r][j].x * s[r] * gg.x, v[r][j].y * s[r] * gg.y); w.y = cvt_pk_bf16(v[r][j].z * s[r] * gg.z, v[r][j].w * s[r] * gg.w);
            *((u32x2*)(orow + (size_t)r * DM) + lane + 64 * j) = w; } }
}

struct Args { const float* in[28]; float* out; unsigned char* ws; int ph_lo, ph_hi; };
typedef const __attribute__((address_space(4))) Args* KArgs;
__device__ __forceinline__ KArgs kargs() { KArgs p = (KArgs)__builtin_amdgcn_kernarg_segment_ptr(); asm volatile("" : "+s"(p)); return p; }

__device__ __forceinline__ void ssm_tables(KArgs ap, int g, LAS unsigned char* lds, bf16_t* Tg, bf16_t* Wend) {
    LAS float* Lre = (LAS float*)lds;
    LAS float* Lim = Lre + 33 * 64;
    LAS float* Bre = Lim + 33 * 64;
    LAS float* Bim = Bre + 1024;
    LAS float* Cre = Bim + 1024;
    LAS float* Cim = Cre + 1024;
    LAS float* Kern = Cim + 1024;
    const int tid = threadIdx.x;
    const float* lam_re = ap->in[12] + g * 64; const float* lam_im = ap->in[13] + g * 64;
    const float dt = expf(ap->in[14][g]);
    for (int idx = tid; idx < 33 * 64; idx += 512) {
        const int tau = idx >> 6, p = idx & 63;
        const float mag = expf((float)tau * (lam_re[p] * dt)); const float ang = (float)tau * (lam_im[p] * dt);
        Lre[idx] = mag * cosf(ang); Lim[idx] = mag * sinf(ang);
    }
    __syncthreads();
    for (int idx = tid; idx < 1024; idx += 512) {
        {
            const int p = idx >> 4;
            const float lr = lam_re[p], li = lam_im[p], lbr = Lre[64 + p], lbi = Lim[64 + p];
            const float nre = lbr - 1.0f, den = lr * lr + li * li;
            const float cr = (nre * lr + lbi * li) / den, ci = (lbi * lr - nre * li) / den;
            const float br = ap->in[15][(size_t)g * 1024 + idx], bi = ap->in[16][(size_t)g * 1024 + idx];
            Bre[idx] = cr * br - ci * bi; Bim[idx] = cr * bi + ci * br;
        }
        Cre[idx] = ap->in[17][(size_t)g * 1024 + idx]; Cim[idx] = ap->in[18][(size_t)g * 1024 + idx];
    }
    __syncthreads();
    {
        const int tau = tid >> 4, co = tid & 15; float kacc[16];
#pragma unroll
        for (int ci = 0; ci < 16; ++ci) kacc[ci] = 0.f;
        for (int p = 0; p < 64; ++p) {
            const float cr = Cre[co * 64 + p], cim = Cim[co * 64 + p], lr = Lre[tau * 64 + p], li = Lim[tau * 64 + p];
            const float gr = cr * lr - cim * li, gi = cr * li + cim * lr;
#pragma unroll
            for (int q = 0; q < 4; ++q) { const f32x4 br = *(const LAS f32x4*)(Bre + p * 16 + 4 * q), bi = *(const LAS f32x4*)(Bim + p * 16 + 4 * q);
#pragma unroll
                for (int e = 0; e < 4; ++e) kacc[4 * q + e] += gr * br[e] - gi * bi[e]; }
        }
#pragma unroll
        for (int ci = 0; ci < 16; ++ci) Kern[tid * 16 + ci] = kacc[ci];
    }
    __syncthreads();
    bf16_t* T = Tg + (size_t)g * 512 * 640;
    for (int idx = tid; idx < 512 * 80; idx += 512) {
        const int n = idx / 80, k8 = (idx % 80) * 8; const int t = n >> 4, co = n & 15;
        float v[8];
        if (k8 < 512) { const int s = k8 >> 4, ci = k8 & 15;
#pragma unroll
            for (int j = 0; j < 8; ++j) v[j] = (s <= t) ? Kern[((t - s) * 16 + co) * 16 + ci + j] : 0.f;
        } else { const int q = k8 - 512, im = q >> 6, p0 = q & 63;
#pragma unroll
            for (int j = 0; j < 8; ++j) { const int p = p0 + j; const float cr = Cre[co * 64 + p], cim = Cim[co * 64 + p], lr = Lre[(t + 1) * 64 + p], li = Lim[(t + 1) * 64 + p];
                v[j] = im ? -(cr * li + cim * lr) : (cr * lr - cim * li); }
        }
        u32x4 w; w.x = cvt_pk_bf16(v[0], v[1]); w.y = cvt_pk_bf16(v[2], v[3]); w.z = cvt_pk_bf16(v[4], v[5]); w.w = cvt_pk_bf16(v[6], v[7]);
        *(u32x4*)(T + (size_t)n * 640 + k8) = w;
    }
    bf16_t* We = Wend + (size_t)g * 256 * 512;
    for (int idx = tid; idx < 256 * 64; idx += 512) {
        const int j = idx >> 6, k8 = (idx & 63) * 8; float v[8];
        if (j < 128) { const int p = j & 63, im = j >> 6, s = k8 >> 4, ci = k8 & 15; const float lr = Lre[(31 - s) * 64 + p], li = Lim[(31 - s) * 64 + p];
#pragma unroll
            for (int e = 0; e < 8; ++e) { const float br = Bre[p * 16 + ci + e], bi = Bim[p * 16 + ci + e]; v[e] = im ? (lr * bi + li * br) : (lr * br - li * bi); }
        } else {
#pragma unroll
            for (int e = 0; e < 8; ++e) v[e] = 0.f;
        }
        u32x4 w; w.x = cvt_pk_bf16(v[0], v[1]); w.y = cvt_pk_bf16(v[2], v[3]); w.z = cvt_pk_bf16(v[4], v[5]); w.w = cvt_pk_bf16(v[6], v[7]);
        *(u32x4*)(We + (size_t)j * 512 + k8) = w;
    }
    __syncthreads();
}


template <int W> __device__ __forceinline__ u32x4 pool_item(const bf16_t* up, int t) {
    const int cnt = (t + 1 < W) ? t + 1 : W;
    u32x4 v[W];
#pragma unroll
    for (int i = 0; i < W; ++i) v[i] = (i < cnt) ? *(const u32x4*)(up - (size_t)i * 1536) : (u32x4){0u, 0u, 0u, 0u};
    float s[8];
#pragma unroll
    for (int j = 0; j < 8; ++j) s[j] = 0.f;
#pragma unroll
    for (int i = 0; i < W; ++i) { s[0] += bflo(v[i].x); s[1] += bfhi(v[i].x); s[2] += bflo(v[i].y); s[3] += bfhi(v[i].y); s[4] += bflo(v[i].z); s[5] += bfhi(v[i].z); s[6] += bflo(v[i].w); s[7] += bfhi(v[i].w); }
    const float inv = 1.0f / (float)cnt;
    u32x4 w; w.x = cvt_pk_bf16(s[0] * inv - bflo(v[0].x), s[1] * inv - bfhi(v[0].x)); w.y = cvt_pk_bf16(s[2] * inv - bflo(v[0].y), s[3] * inv - bfhi(v[0].y));
    w.z = cvt_pk_bf16(s[4] * inv - bflo(v[0].z), s[5] * inv - bfhi(v[0].z)); w.w = cvt_pk_bf16(s[6] * inv - bflo(v[0].w), s[7] * inv - bfhi(v[0].w));
    return w;
}

__device__ __forceinline__ void bf8_to_f(const u32x4 v, float (&f)[8]) { f[0] = bflo(v.x); f[1] = bfhi(v.x); f[2] = bflo(v.y); f[3] = bfhi(v.y); f[4] = bflo(v.z); f[5] = bfhi(v.z); f[6] = bflo(v.w); f[7] = bfhi(v.w); }
template <int W> __device__ __forceinline__ void pool_segment(const bf16_t* up, bf16_t* op, int t0) {
    float s[8];
#pragma unroll
    for (int j = 0; j < 8; ++j) s[j] = 0.f;
#pragma unroll
    for (int i = 1; i < W; ++i) {
        u32x4 v = (u32x4){0u, 0u, 0u, 0u};
        if (t0 - i >= 0) v = *(const u32x4*)(up - (size_t)i * 1536);
        float f[8]; bf8_to_f(v, f);
#pragma unroll
        for (int j = 0; j < 8; ++j) s[j] += f[j];
    }
#pragma unroll 4
    for (int r = 0; r < 32; ++r) {
        const int t = t0 + r;
        const u32x4 vc = *(const u32x4*)(up + (size_t)r * 1536);
        u32x4 vo = (u32x4){0u, 0u, 0u, 0u};
        if (t - (W - 1) >= 0) vo = *(const u32x4*)(up + (size_t)(r - (W - 1)) * 1536);
        float fc[8], fo[8]; bf8_to_f(vc, fc); bf8_to_f(vo, fo);
        const float inv = 1.0f / (float)((t + 1 < W) ? t + 1 : W);
        float o[8];
#pragma unroll
        for (int j = 0; j < 8; ++j) { s[j] += fc[j]; o[j] = s[j] * inv - fc[j]; s[j] -= fo[j]; }
        u32x4 w; w.x = cvt_pk_bf16(o[0], o[1]); w.y = cvt_pk_bf16(o[2], o[3]); w.z = cvt_pk_bf16(o[4], o[5]); w.w = cvt_pk_bf16(o[6], o[7]);
        *(u32x4*)(op + (size_t)r * DM) = w;
    }
}

__device__ __forceinline__ int crow(int r, int hi) { return (r & 3) + 8 * (r >> 2) + 4 * hi; }
__device__ __forceinline__ void sb_attn_task(const bf16_t* __restrict__ QKU, const bf16_t* __restrict__ VT, bf16_t* __restrict__ CAT, int b, int h, int qb, int lane) {
    const int r32 = lane & 31, hi = lane >> 5;
    const size_t tok0 = (size_t)b * SEQ; const int q0 = qb * 32;
    const bf16_t* qp = QKU + (tok0 + q0 + r32) * 1536 + h * 64 + 8 * hi;
    bf16x8 qf[4];
#pragma unroll
    for (int j = 0; j < 4; ++j) qf[j] = *(const bf16x8*)(qp + 16 * j);
    const bf16_t* kp = QKU + (tok0 + r32) * 1536 + 512 + h * 64 + 8 * hi;
    const bf16_t* vp = VT + (size_t)(h * 64 + r32) * VT_LD + tok0 + 4 * hi;
    f32x16 o0, o1;
#pragma unroll
    for (int r = 0; r < 16; ++r) { o0[r] = 0.f; o1[r] = 0.f; }
    float carry = 0.f;
    bf16x8 kf[4]; s16x4 va[2][4]; bf16x8 k1[4]; s16x4 v1[2][4];
#define SB_LOAD(KF, VA, K0) do { const int k0_ = (K0); \
        _Pragma("unroll") for (int j = 0; j < 4; ++j) KF[j] = *(const bf16x8*)(kp + (size_t)k0_ * 1536 + 16 * j); \
        _Pragma("unroll") for (int dh = 0; dh < 2; ++dh) _Pragma("unroll") for (int c = 0; c < 4; ++c) VA[dh][c] = *(const s16x4*)(vp + (size_t)dh * 32 * VT_LD + k0_ + 8 * c); } while (0)
    asm volatile("s_waitcnt vmcnt(0)" ::: "memory");
    SB_LOAD(kf, va, q0);
    SB_LOAD(k1, v1, qb > 0 ? q0 - 32 : q0);
    for (int kt = qb; kt >= 0; --kt) {
        bf16x8 kn[4]; s16x4 vn[2][4];
        SB_LOAD(kn, vn, kt >= 2 ? (kt - 2) * 32 : 0);
        f32x16 s;
#pragma unroll
        for (int r = 0; r < 16; ++r) s[r] = 0.f;
#pragma unroll
        for (int j = 0; j < 4; ++j) s = __builtin_amdgcn_mfma_f32_32x32x16_bf16(kf[j], qf[j], s, 0, 0, 0);
        const bool diag = (kt == qb);
        float sp[16], lb[16];
#pragma unroll
        for (int r = 0; r < 16; ++r) {
            const float z = s[r] * (0.125f * LOG2E);
            const float e = fexp2(-fabsf(z));
            float spv = fmaxf(z, 0.f) + flog2(1.0f + e);
            const bool valid = !diag || (crow(r, hi) < r32);
            spv = valid ? spv : 0.f;
            sp[r] = spv; lb[r] = valid ? (z - spv) : -1.0e30f;
        }
        float gs[4], pg[4];
#pragma unroll
        for (int g = 0; g < 4; ++g) { gs[g] = (sp[4 * g] + sp[4 * g + 1]) + (sp[4 * g + 2] + sp[4 * g + 3]); pg[g] = partner32(gs[g], hi); }
        float tap[4];
        tap[3] = 0.f; tap[2] = gs[3] + pg[3]; tap[1] = tap[2] + (gs[2] + pg[2]); tap[0] = tap[1] + (gs[1] + pg[1]);
        const float total = tap[0] + (gs[0] + pg[0]);
        float w[16];
#pragma unroll
        for (int g = 0; g < 4; ++g) {
            const float base = carry + tap[g] + (hi ? 0.f : pg[g]);
            const float a3 = base, a2 = a3 + sp[4 * g + 3], a1 = a2 + sp[4 * g + 2], a0 = a1 + sp[4 * g + 1];
            w[4 * g + 3] = fexp2(lb[4 * g + 3] - a3);
            w[4 * g + 2] = fexp2(lb[4 * g + 2] - a2);
            w[4 * g + 1] = fexp2(lb[4 * g + 1] - a1);
            w[4 * g + 0] = fexp2(lb[4 * g + 0] - a0);
        }
        carry += total;
        u32x4 p0, p1;
        p0.x = cvt_pk_bf16(w[0], w[1]); p0.y = cvt_pk_bf16(w[2], w[3]); p0.z = cvt_pk_bf16(w[4], w[5]); p0.w = cvt_pk_bf16(w[6], w[7]);
        p1.x = cvt_pk_bf16(w[8], w[9]); p1.y = cvt_pk_bf16(w[10], w[11]); p1.z = cvt_pk_bf16(w[12], w[13]); p1.w = cvt_pk_bf16(w[14], w[15]);
        const bf16x8 pb0 = __builtin_bit_cast(bf16x8, p0), pb1 = __builtin_bit_cast(bf16x8, p1);
#define VA8(dh, c) (bf16x8){va[dh][c][0], va[dh][c][1], va[dh][c][2], va[dh][c][3], va[dh][(c) + 1][0], va[dh][(c) + 1][1], va[dh][(c) + 1][2], va[dh][(c) + 1][3]}
        o0 = __builtin_amdgcn_mfma_f32_32x32x16_bf16(VA8(0, 0), pb0, o0, 0, 0, 0);
        o0 = __builtin_amdgcn_mfma_f32_32x32x16_bf16(VA8(0, 2), pb1, o0, 0, 0, 0);
        o1 = __builtin_amdgcn_mfma_f32_32x32x16_bf16(VA8(1, 0), pb0, o1, 0, 0, 0);
        o1 = __builtin_amdgcn_mfma_f32_32x32x16_bf16(VA8(1, 2), pb1, o1, 0, 0, 0);
#undef VA8
        if (__all(carry > 160.0f)) break;
        __builtin_amdgcn_sched_barrier(0);
        asm volatile("s_nop 15\n\ts_nop 15\n\ts_nop 15\n\ts_nop 15\n\ts_nop 15" ::: "memory");
        __builtin_amdgcn_sched_barrier(0);
#pragma unroll
        for (int j = 0; j < 4; ++j) { kf[j] = k1[j]; k1[j] = kn[j]; }
#pragma unroll
        for (int dh = 0; dh < 2; ++dh)
#pragma unroll
            for (int c = 0; c < 4; ++c) { va[dh][c] = v1[dh][c]; v1[dh][c] = vn[dh][c]; }
    }
#undef SB_LOAD
    bf16_t* op = CAT + (tok0 + q0 + r32) * DM + h * 64 + 4 * hi;
#pragma unroll
    for (int g = 0; g < 4; ++g) {
        u32x2 w0, w1;
        w0.x = cvt_pk_bf16(o0[4 * g], o0[4 * g + 1]); w0.y = cvt_pk_bf16(o0[4 * g + 2], o0[4 * g + 3]);
        w1.x = cvt_pk_bf16(o1[4 * g], o1[4 * g + 1]); w1.y = cvt_pk_bf16(o1[4 * g + 2], o1[4 * g + 3]);
        *(u32x2*)(op + 8 * g) = w0; *(u32x2*)(op + 32 + 8 * g) = w1;
    }
}


#define XB_TMO      128
#define XB_XCNT(j)  (256  + 64 * (j))
#define XB_XSUB(j)  (1280 + 64 * (j))
#define XB_XGEN(j)  (2304 + 64 * (j))
#define XB_TOP      3328
#define XB_TOPGEN   3392
#define XCD_BAR_WORDS 3456
#define XB_SPIN_CAP (1u << 22)
__device__ __forceinline__ unsigned xb_ld(unsigned* p)              { return __hip_atomic_load(p, __ATOMIC_RELAXED, __HIP_MEMORY_SCOPE_AGENT); }
__device__ __forceinline__ unsigned xb_add(unsigned* p, unsigned v) { return __hip_atomic_fetch_add(p, v, __ATOMIC_RELAXED, __HIP_MEMORY_SCOPE_AGENT); }
__device__ __forceinline__ unsigned xb_xcc_id() { return (unsigned)__builtin_amdgcn_s_getreg((3 << 11) | 20) & 0xFu; }
#define XB_SPIN(cond, bar) do { unsigned _sp = 0; while (cond) { __builtin_amdgcn_s_sleep(1); \
    if ((++_sp & 255u) == 0u) { if (xb_ld(&(bar)[XB_TMO])) break; if (_sp > XB_SPIN_CAP) { atomicAdd(&(bar)[XB_TMO], 1u); break; } } } } while (0)
__device__ __forceinline__ void xcd_barrier_complete(unsigned* bar, unsigned x, unsigned G, unsigned& nloc, unsigned& nx) {
    unsigned sum, cnt, mine, sp = 0u;
    for (;;) {
        sum = 0u; cnt = 0u; mine = 0u;
#pragma unroll
        for (unsigned j = 0; j < 16; ++j) { const unsigned c = xb_ld(&bar[XB_XCNT(j)]); sum += c; cnt += (c > 0u) ? 1u : 0u; mine = (j == x) ? c : mine; }
        if (sum == G) break;
        __builtin_amdgcn_s_sleep(1);
        if ((++sp & 255u) == 0u) { if (xb_ld(&bar[XB_TMO])) break; if (sp > XB_SPIN_CAP) { atomicAdd(&bar[XB_TMO], 1u); break; } }
    }
    nloc = mine > 0u ? mine : 1u; nx = cnt > 0u ? cnt : 1u;
}
__device__ __forceinline__ void xcd_barrier(unsigned* bar, volatile LAS unsigned* st, bool leader, unsigned G) {
    asm volatile("s_waitcnt vmcnt(0)" ::: "memory");
    __syncthreads();
    if (leader) {
        const unsigned x = xb_xcc_id();
        __builtin_amdgcn_s_waitcnt(0);
        unsigned nloc = st[0], nx = st[1];
        if (nloc == 0u) { xcd_barrier_complete(bar, x, G, nloc, nx); st[0] = nloc; st[1] = nx; }
        const unsigned old = xb_add(&bar[XB_XSUB(x)], 1u);
        const unsigned gen = old / nloc;
        if (old + 1u == (gen + 1u) * nloc) {
            __builtin_amdgcn_fence(__ATOMIC_RELEASE, "agent");
            asm volatile("s_waitcnt vmcnt(0)" ::: "memory");
            const unsigned og = xb_add(&bar[XB_TOP], 1u);
            const unsigned tg = og / nx;
            if (og + 1u == (tg + 1u) * nx) xb_add(&bar[XB_TOPGEN], 1u);
            else XB_SPIN(xb_ld(&bar[XB_TOPGEN]) == tg, bar);
            __builtin_amdgcn_fence(__ATOMIC_ACQUIRE, "agent");
            xb_add(&bar[XB_XGEN(x)], 1u);
            asm volatile("s_waitcnt vmcnt(0)" ::: "memory");
        } else {
            XB_SPIN(xb_ld(&bar[XB_XGEN(x)]) == gen, bar);
            __builtin_amdgcn_fence(__ATOMIC_ACQUIRE, "agent");
            asm volatile("s_waitcnt vmcnt(0)" ::: "memory");
        }
    }
    __syncthreads();
}

__global__ void __launch_bounds__(512) mega_fwd(Args a) {
    __builtin_assume(__builtin_amdgcn_workitem_id_y() == 0); __builtin_assume(__builtin_amdgcn_workitem_id_z() == 0);
    extern __shared__ __attribute__((aligned(16))) unsigned char lds_raw[];
    LAS unsigned char* lds = (LAS unsigned char*)lds_raw;
    LAS unsigned char* xl = lds + XL_OFF;
    cg::grid_group grid = cg::this_grid();
#if !MK_MULTI_LAUNCH
    {
        volatile LAS unsigned* st = (volatile LAS unsigned*)(lds + XBST_OFF);
        if (threadIdx.x == 0) { st[0] = 0u; st[1] = 0u; KArgs ap0 = kargs(); xb_add(&((unsigned*)ap0->ws)[XB_XCNT(xb_xcc_id())], 1u); }
        if (a.ph_lo < 0) grid.sync();
        __syncthreads();
    }
#endif
#if MK_MULTI_LAUNCH
    const int lo = a.ph_lo, hi = a.ph_hi;
    int ph = 0;
#endif
#define PH_VARS int tid = threadIdx.x; asm volatile("" : "+v"(tid)); const int lane = tid & 63, wave = __builtin_amdgcn_readfirstlane(tid >> 6); int G_ = gridDim.x, bid_ = blockIdx.x; asm volatile("" : "+s"(G_), "+s"(bid_)); const int G = G_, bid = bid_; \
    const int gw = bid * 8 + wave, NGW = G * 8, gt = bid * 512 + tid, NGT = G * 512; (void)lane; (void)gw; (void)NGW; (void)gt; (void)NGT; KArgs ap = kargs(); unsigned char* ws = ap->ws; float* X = ap->out; float* SSQ = (float*)(ws + WS_SSQ); bf16_t* XB = (bf16_t*)(ws + WS_XB); bf16_t* MEMN = (bf16_t*)(ws + WS_MEMN); (void)X; (void)SSQ; (void)XB; (void)MEMN;
#if MK_MULTI_LAUNCH
#define PHASE_ON (ph >= lo && ph < hi)
#define PHASE_END do { if (ph >= lo && ph + 1 < hi) grid.sync(); ++ph; } while (0)
#define LOCAL_SEAM PHASE_END
#else
#define PHASE_ON (true)
#define LOCAL_SEAM do { asm volatile("s_waitcnt vmcnt(0)" ::: "memory"); __syncthreads(); { int tl = threadIdx.x; asm volatile("" : "+v"(tl)); \
    if (tl == 0) { __builtin_amdgcn_fence(__ATOMIC_ACQUIRE, "agent"); asm volatile("s_waitcnt vmcnt(0)" ::: "memory"); } } __syncthreads(); } while (0)
#define PHASE_END do { KArgs apb = kargs(); int tb = threadIdx.x; asm volatile("" : "+v"(tb)); int Gb = gridDim.x; asm volatile("" : "+s"(Gb)); \
    xcd_barrier((unsigned*)apb->ws, (volatile LAS unsigned*)(lds + XBST_OFF), tb == 0, (unsigned)Gb); } while (0)
#endif

    if (PHASE_ON) { PH_VARS
        if (bid < 64) ssm_tables(ap, bid, lds, (bf16_t*)(ws + WS_TG), (bf16_t*)(ws + WS_WEND));
        LAS float* scr = (LAS float*)(lds + wave * 16384);
        const bool weighted = (G > 64);
        const int n_tw = weighted ? 64 * 8 : 0, n_nw = weighted ? (G - 64) * 8 : G * 8;
        const int spw = weighted ? 4 : 1, S = n_nw * spw + n_tw;
        const bool is_tw = weighted && bid < 64;
        const int slot0 = is_tw ? n_nw * spw + gw : (weighted ? (gw - 512) * 4 : gw), nslot = is_tw ? 1 : spw;
        if (!is_tw) {
            const int nb_ = weighted ? G - 64 : G, b_ = weighted ? bid - 64 : bid;
            for (int it = b_ + wave * nb_; it < 256; it += nb_ * 8) {
                const int g = it >> 6, cb = (it >> 2) & 15, nb = it & 3;
                const float* pw = ap->in[8] + (size_t)(g * 128 + cb * 8) * 128; const float* sc = ap->in[9] + g * 128;
                const float* wo = ap->in[10] + (size_t)(512 + g * 128) * 1024 + nb * 256 + lane * 4;
                f32x4 acc8[8];
#pragma unroll
                for (int j = 0; j < 8; ++j) acc8[j] = (f32x4){0.f, 0.f, 0.f, 0.f};
#pragma unroll 8
                for (int d = 0; d < 128; ++d) {
                    const f32x4 wv = *(const f32x4*)(wo + (size_t)d * 1024); const float sd = sc[d];
#pragma unroll
                    for (int j = 0; j < 8; ++j) acc8[j] += wv * (pw[j * 128 + d] * sd);
                }
                bf16_t* D = (bf16_t*)(ws + WS_WOUT) + (size_t)(nb * 256 + lane * 4) * 1024 + 512 + g * 128 + cb * 8;
#pragma unroll
                for (int e = 0; e < 4; ++e) {
                    u32x4 w; w.x = cvt_pk_bf16(acc8[0][e], acc8[1][e]); w.y = cvt_pk_bf16(acc8[2][e], acc8[3][e]); w.z = cvt_pk_bf16(acc8[4][e], acc8[5][e]); w.w = cvt_pk_bf16(acc8[6][e], acc8[7][e]);
                    *(u32x4*)(D + (size_t)e * 1024) = w;
                }
            }
        }
        {
            float tv[32]; TItem cur, nxt; bool have = false, have_next = false;
            int sl = 0, it = slot0;
            auto decode = [&](int item, TItem& t) -> bool {
                int r = item; const float* W = nullptr; const float* gk = nullptr; int N = 0; bf16_t* D = nullptr; int ldt = 0, mode = 0; bool found = false;
#define TJOB(Wp, Kk, Nn, Dp, Ld, Md, Gp) if (!found) { const int cnt = ((Kk) / 64) * ((Nn) / 32); if (r < cnt) { W = (Wp); N = (Nn); D = (bf16_t*)(Dp); ldt = (Ld); mode = (Md); gk = (Gp); found = true; } else r -= cnt; }
                TJOB(ap->in[7], 1024, 2048, ws + WS_WIN, 1024, 1, nullptr)
            TJOB(ap->in[10], 512, 1024, ws + WS_WOUT, 1024, 0, nullptr)
            TJOB(ap->in[11], 1024, 1024, ws + WS_WSSM, 1024, 0, ap->in[2] + 1024)
            TJOB(ap->in[20], 1024, 2048, ws + WS_WGLU, 1024, 2, nullptr)
#pragma unroll
            for (int l = 0; l < 2; ++l) {
                unsigned char* lb = ws + WS_LAYER + l * LAYER_STRIDE;
                TJOB(ap->in[22] + (size_t)l * 1024 * 2048, 1024, 2048, lb + LO_WKV, 1024, 0, nullptr)
                TJOB(ap->in[23] + (size_t)l * 1024 * 1024, 1024, 1024, lb + LO_WO, 1024, 0, nullptr)
                TJOB(ap->in[24] + (size_t)l * 1024 * DFF2, 1024, DFF2, lb + LO_WUP, 1024, 3, ap->in[4] + l * 1024)
                TJOB(ap->in[27] + (size_t)l * DFF * 1024, DFF, 1024, lb + LO_WDN, DFF, 0, nullptr)
            }
#undef TJOB
                if (!found) return false;
                const int nblk = N / 32, kb = r / nblk, nb = r % nblk, n0 = nb * 32;
                int drow0 = n0;
                if (mode == 1) drow0 = (n0 < 1024) ? n0 : (n0 < 1536 ? n0 + 512 : n0 - 512);
                else if (mode == 2) drow0 = (n0 < 1024) ? (256 * (n0 >> 7) + (n0 & 127)) : (256 * ((n0 - 1024) >> 7) + 128 + ((n0 - 1024) & 127));
                else if (mode == 3) drow0 = (n0 < DFF) ? (256 * (n0 >> 7) + (n0 & 127)) : (256 * ((n0 - DFF) >> 7) + 128 + ((n0 - DFF) & 127));
                t.W = W; t.gk = gk; t.D = D; t.N = N; t.ldt = ldt; t.drow0 = drow0; t.k0 = kb * 64; t.n0 = n0; return true;
            };
            auto advance = [&](TItem& t) -> bool {
                while (sl < nslot) { if (decode(it, t)) { it += S; return true; } ++sl; it = slot0 + sl; }
                return false;
            };
            have = advance(cur);
            if (have) titem_load(tv, cur, lane);
            while (have) {
                titem_to_lds(tv, scr, lane);
                have_next = advance(nxt);
                if (have_next) titem_load(tv, nxt, lane);
                titem_store(cur, scr, lane);
                cur = nxt; have = have_next;
            }
        }
        for (int it = gt; it < 2 * 1024 * 256; it += NGT) {
            const int l = it >> 18, e = it & 262143, k = e >> 8, n4 = (e & 255) * 4;
            const f32x4 w = *(const f32x4*)(ap->in[21] + (size_t)l * 1048576 + (size_t)k * 1024 + n4); const float gk = ap->in[3][l * 1024 + k];
            u32x2 o; o.x = cvt_pk_bf16(w[0] * gk, w[1] * gk); o.y = cvt_pk_bf16(w[2] * gk, w[3] * gk);
            *(u32x2*)((bf16_t*)(ws + WS_LAYER + l * LAYER_STRIDE + LO_WQ) + (size_t)k * 1024 + n4) = o;
        }
        for (int r = gw; r < MEMTOK / 4; r += NGW) rms_rows4_to_bf16(ap->in[1] + (size_t)r * 4 * DM, ap->in[5], MEMN + (size_t)r * 4 * DM, lane);
        for (int r = gw; r < MTOK / 4; r += NGW) rms_rows4_to_bf16(ap->in[0] + (size_t)r * 4 * DM, ap->in[2], XB + (size_t)r * 4 * DM, lane);
        __syncthreads();
    }
    PHASE_END;

    if (PHASE_ON) { PH_VARS
        bf16_t* WIN = (bf16_t*)(ws + WS_WIN);
        { pg8::SchedStd S; S.init(XB, 256 * 2048, WIN, 256 * 2048, 128, 6, G, bid);
          pg8::EpiStore E{(bf16_t*)(ws + WS_QKU), 1536, nullptr, 0, 1.0f, 0};
          pg8::gemm_phase(lds, xl, 1024, 1024, 1024, S, E); }
        { pg8::SchedStd S; S.init(WIN + (size_t)1536 * 1024, 256 * 2048, XB, 256 * 2048, 2, 128, G, bid);
          pg8::EpiStore E{(bf16_t*)(ws + WS_VT), VT_LD, nullptr, 0, 1.0f, 0};
          pg8::gemm_phase(lds, xl, 1024, 1024, 1024, S, E); }
        for (int j = 0; j < 4; ++j) {
            const int l = j >> 1, isv = j & 1;
            bf16_t* WKV = (bf16_t*)(ws + WS_LAYER + l * LAYER_STRIDE + LO_WKV);
            const int c = (bid + 64 * (j + 1)) % G;
            pg8::SchedStd S;
            S.init(MEMN, 256 * 2048, WKV + (size_t)isv * 1024 * 1024, 256 * 2048, 16, 4, G, c);
            pg8::EpiStore E{isv ? (bf16_t*)(ws + WS_MEMVT + l * MEMVT_STRIDE) : (bf16_t*)(ws + WS_MEMK + l * 8 * MiB), 1024, nullptr, 0, 1.0f, 0};
            pg8::gemm_phase(lds, xl, 1024, 1024, 1024, S, E);
        }
    }
    PHASE_END;

    if (PHASE_ON) { PH_VARS
        const bf16_t* QKU = (const bf16_t*)(ws + WS_QKU); bf16_t* CAT = (bf16_t*)(ws + WS_CAT);
        for (int it = gt; it < 64 * (MTOK / 32); it += NGT) {
            const int ch = it & 63, seg = it >> 6, g = ch >> 4;
            const bf16_t* up = QKU + (size_t)seg * 32 * 1536 + 1024 + ch * 8;
            bf16_t* op = CAT + (size_t)seg * 32 * DM + 512 + ch * 8;
            const int t0 = (seg * 32) & (SEQ - 1);
            if (g == 0) pool_segment<2>(up, op, t0); else if (g == 1) pool_segment<4>(up, op, t0); else if (g == 2) pool_segment<8>(up, op, t0); else pool_segment<16>(up, op, t0);
        }
        for (int task = gw; task < 128 * 64; task += NGW) {
            const int bh = task >> 6; int qb = task & 63; if ((bh >> 5) & 1) qb = 63 - qb;
            sb_attn_task(QKU, (const bf16_t*)(ws + WS_VT), CAT, bh >> 3, bh & 7, qb, lane);
        }
    }
    PHASE_END;

    if (PHASE_ON) { PH_VARS
        pg8::SchedStd S; S.init(ws + WS_CAT, 256 * 2048, ws + WS_WOUT, 256 * 2048, 128, 4, G, bid);
        pg8::EpiResid E{ap->in[0], XB, SSQ};
        pg8::gemm_phase(lds, xl, 1024, 1024, 1024, S, E);
        pg8::SchedG SG{(const char*)(ws + WS_MEMK), (const char*)(ws + WS_LAYER + LO_WQ), G, bid};
        pg8::EpiStore EG{(bf16_t*)(ws + WS_GT), 1024, nullptr, 0, 1.0f, 0};
        pg8::gemm_phase(lds, xl, 1024, 1024, 256, SG, EG);
    }
    PHASE_END;

#pragma nounroll
    for (int layer = 0; layer < 2; ++layer) {
        if (layer == 1) {
            if (PHASE_ON) { PH_VARS
                pg8::SchedStd S; S.init(XB, 256 * 2048, ws + WS_WSSM, 256 * 2048, 128, 4, G, bid);
                pg8::EpiStore E{(bf16_t*)(ws + WS_UG), 0, SSQ, 16, 1.0f, 1};
                pg8::gemm_phase(lds, xl, 1024, 1024, 1024, S, E);
            }
            PHASE_END;
            if (PHASE_ON) { PH_VARS
                pg8::SchedS2 S{(const char*)(ws + WS_UG), (const char*)(ws + WS_WEND), G, bid};
                pg8::EpiHend E{(float*)(ws + WS_HEND)};
                pg8::gemm_phase(lds, xl, 640, 512, 512, S, E);
            }
            PHASE_END;
            if (PHASE_ON) { PH_VARS
                bf16_t* UG = (bf16_t*)(ws + WS_UG); const float* HE = (const float*)(ws + WS_HEND);
                for (int it = gt; it < NBATCH * 64 * 64; it += NGT) {
                    const int p = it & 63, g = (it >> 6) & 63, b = it >> 12;
                    const float dt = expf(ap->in[14][g]);
                    const float mag = expf(32.0f * (ap->in[12][g * 64 + p] * dt)), ang = 32.0f * (ap->in[13][g * 64 + p] * dt);
                    const float lr = mag * cosf(ang), li = mag * sinf(ang);
                    float hr = 0.f, hi_ = 0.f;
                    for (int c0 = 0; c0 < 64; c0 += 8) {
                        const size_t row0 = (size_t)g * 1024 + b * 64 + c0;
                        float er[8], ei[8];
#pragma unroll
                        for (int j = 0; j < 8; ++j) { er[j] = HE[(row0 + j) * 128 + p]; ei[j] = HE[(row0 + j) * 128 + 64 + p]; }
#pragma unroll
                        for (int j = 0; j < 8; ++j) {
                            UG[(row0 + j) * 640 + 512 + p] = (bf16_t)(cvt_pk_bf16(hr, 0.f) & 0xffffu);
                            UG[(row0 + j) * 640 + 576 + p] = (bf16_t)(cvt_pk_bf16(hi_, 0.f) & 0xffffu);
                            const float nr = lr * hr - li * hi_ + er[j], ni = lr * hi_ + li * hr + ei[j];
                            hr = nr; hi_ = ni;
                        }
                    }
                }
            }
            PHASE_END;
            if (PHASE_ON) { PH_VARS
                pg8::SchedS4 S{(const char*)(ws + WS_UG), (const char*)(ws + WS_TG), G, bid};
                pg8::EpiSsmY E{(const bf16_t*)(ws + WS_UG), ap->in[19], (bf16_t*)(ws + WS_YG)};
                pg8::gemm_phase(lds, xl, 640, 640, 640, S, E);
            }
            PHASE_END;
            if (PHASE_ON) { PH_VARS
                pg8::SchedStd S; S.init(ws + WS_YG, 256 * 2048, ws + WS_WGLU, 256 * 2048, 128, 8, G, bid);
                pg8::EpiGlu E{XB, SSQ};
                pg8::gemm_phase(lds, xl, 1024, 1024, 1024, S, E);
            }
            PHASE_END;
        }
        if (PHASE_ON) { PH_VARS
            pg8::SchedXS2 S{(const char*)XB, (const char*)(ws + WS_GT + (size_t)layer * 32 * MiB), G, bid};
            pg8::EpiSoftmax E{(bf16_t*)(ws + WS_P), SSQ, layer == 0 ? 16 : 32, 0.0625f};
            pg8::gemm_phase(lds, xl, 1024, 1024, 1024, S, E);
        }
        if (PHASE_ON) { PH_VARS
            unsigned char* lb = ws + WS_LAYER + layer * LAYER_STRIDE;
            pg8::SchedVW S{(const char*)(lb + LO_WO), (const char*)(ws + WS_MEMVT + layer * MEMVT_STRIDE), G, bid};
            pg8::EpiStore E{(bf16_t*)(ws + WS_QX), 1024, nullptr, 0, 1.0f, 0};
            pg8::gemm_phase(lds, xl, 1024, 1024, 256, S, E);
        }
        PHASE_END;
        if (PHASE_ON) { PH_VARS
            pg8::SchedXOut S{(const char*)(ws + WS_P), (const char*)(ws + WS_QX), G, bid};
            pg8::EpiResid E{nullptr, XB, SSQ};
            pg8::gemm_phase(lds, xl, 1024, 1024, 1024, S, E);
        }
        PHASE_END;
        if (PHASE_ON) { PH_VARS
            unsigned char* lb = ws + WS_LAYER + layer * LAYER_STRIDE;
            pg8::SchedStd S; S.init(XB, 256 * 2048, lb + LO_WUP, 256 * 2048, 128, 22, G, bid);
            pg8::EpiUpConv E{(bf16_t*)(ws + WS_H), (bf16_t*)(ws + WS_HALO), SSQ, ap->in[25] + (size_t)layer * 3 * DFF2, ap->in[26] + (size_t)layer * DFF2};
            pg8::gemm_phase(lds, xl, 1024, 1024, 1024, S, E);
        }
        PHASE_END;
        if (PHASE_ON) { PH_VARS
            const bf16_t* HALO = (const bf16_t*)(ws + WS_HALO); bf16_t* H = (bf16_t*)(ws + WS_H);
            const float* cw = ap->in[25] + (size_t)layer * 3 * DFF2; const float* cb = ap->in[26] + (size_t)layer * DFF2;
            pg8::SchedStd S0; S0.init(ws + WS_H, 256u * DFF * 2, ws, 0u, 128, 4, G, bid);
            pg8::Unit uu;
            for (int ui = 0; S0.next(ui, uu); ++ui) {
                const int pm = uu.pm;
                if ((pm & 7) == 0) continue;
                for (int it = tid; it < 2 * 352; it += 512) {
                    const int chk = it % 352, rr = it / 352, c0 = chk * 8;
                    const bf16_t* cur = HALO + (size_t)(pm * 4 + rr) * DFF2;
                    const bf16_t* p1 = rr ? HALO + (size_t)(pm * 4) * DFF2 : HALO + (size_t)(pm * 4 - 1) * DFF2;
                    const bf16_t* p2 = rr ? HALO + (size_t)(pm * 4 - 1) * DFF2 : HALO + (size_t)(pm * 4 - 2) * DFF2;
                    float o[8];
                    const u32x4 av = *(const u32x4*)(cur + c0), ag = *(const u32x4*)(cur + DFF + c0);
                    const u32x4 a1 = *(const u32x4*)(p1 + c0), g1 = *(const u32x4*)(p1 + DFF + c0), a2 = *(const u32x4*)(p2 + c0), g2 = *(const u32x4*)(p2 + DFF + c0);
                    const float v0[8] = {bflo(av.x), bfhi(av.x), bflo(av.y), bfhi(av.y), bflo(av.z), bfhi(av.z), bflo(av.w), bfhi(av.w)};
                    const float g0[8] = {bflo(ag.x), bfhi(ag.x), bflo(ag.y), bfhi(ag.y), bflo(ag.z), bfhi(ag.z), bflo(ag.w), bfhi(ag.w)};
                    const float v1[8] = {bflo(a1.x), bfhi(a1.x), bflo(a1.y), bfhi(a1.y), bflo(a1.z), bfhi(a1.z), bflo(a1.w), bfhi(a1.w)};
                    const float gg1[8] = {bflo(g1.x), bfhi(g1.x), bflo(g1.y), bfhi(g1.y), bflo(g1.z), bfhi(g1.z), bflo(g1.w), bfhi(g1.w)};
                    const float v2[8] = {bflo(a2.x), bfhi(a2.x), bflo(a2.y), bfhi(a2.y), bflo(a2.z), bfhi(a2.z), bflo(a2.w), bfhi(a2.w)};
                    const float gg2[8] = {bflo(g2.x), bfhi(g2.x), bflo(g2.y), bfhi(g2.y), bflo(g2.z), bfhi(g2.z), bflo(g2.w), bfhi(g2.w)};
    #pragma unroll
                    for (int j = 0; j < 8; ++j) {
                        const int c = c0 + j;
                        const float cv = cb[c] + cw[c] * v2[j] + cw[DFF2 + c] * v1[j] + cw[2 * DFF2 + c] * v0[j];
                        const float cgt = cb[DFF + c] + cw[DFF + c] * gg2[j] + cw[DFF2 + DFF + c] * gg1[j] + cw[2 * DFF2 + DFF + c] * g0[j];
                        o[j] = cv * cgt * frcp(1.0f + fexp(-cgt));
                    }
                    u32x4 w; w.x = cvt_pk_bf16(o[0], o[1]); w.y = cvt_pk_bf16(o[2], o[3]); w.z = cvt_pk_bf16(o[4], o[5]); w.w = cvt_pk_bf16(o[6], o[7]);
                    *(u32x4*)(H + (size_t)(pm * 256 + rr) * DFF + c0) = w;
                }
            }
        }
        LOCAL_SEAM;
        if (PHASE_ON) { PH_VARS
            unsigned char* lb = ws + WS_LAYER + layer * LAYER_STRIDE;
            pg8::SchedStd S; S.init(ws + WS_H, 256u * DFF * 2, lb + LO_WDN, 256u * DFF * 2, 128, 4, G, bid);
            pg8::EpiResid E{nullptr, XB, SSQ};
            pg8::gemm_phase(lds, xl, DFF, DFF, DFF, S, E);
        }
        PHASE_END;
    }

    if (PHASE_ON) { PH_VARS
        for (int m4 = gw; m4 < MTOK / 4; m4 += NGW) {
            const f32x4* gr = (const f32x4*)ap->in[6] + lane;
            f32x4 v[4][4]; float sq[4];
#pragma unroll
            for (int r = 0; r < 4; ++r)
#pragma unroll
                for (int j = 0; j < 4; ++j) { const u32x2 o = *((const u32x2*)(XB + (size_t)(m4 * 4 + r) * DM) + lane + 64 * j); v[r][j] = (f32x4){bflo(o.x), bfhi(o.x), bflo(o.y), bfhi(o.y)}; }
#pragma unroll
            for (int r = 0; r < 4; ++r) { sq[r] = 0.f;
#pragma unroll
                for (int j = 0; j < 4; ++j) sq[r] += (v[r][j].x * v[r][j].x + v[r][j].y * v[r][j].y) + (v[r][j].z * v[r][j].z + v[r][j].w * v[r][j].w); }
#pragma unroll
            for (int r = 0; r < 4; ++r) sq[r] = 1.f / sqrtf(wave_sum(sq[r]) * (1.f / DM) + EPS);
#pragma unroll
            for (int j = 0; j < 4; ++j) { const f32x4 gg = gr[64 * j];
#pragma unroll
                for (int r = 0; r < 4; ++r) *((f32x4*)(X + (size_t)(m4 * 4 + r) * DM) + lane + 64 * j) = v[r][j] * sq[r] * gg; }
        }
    }
#undef PHASE_ON
#undef PHASE_END
}

constexpr int N_PHASES = 4 + 7 + 5 + 7 + 1;

extern "C" void kernel_launch(void* const* d_in, const int* in_sizes, int n_in, void* d_out, int out_size, void* d_ws, size_t ws_size, hipStream_t stream) {
    static int grid = 0;
    if (grid == 0) {
        if (n_in != 28 || in_sizes[0] != MTOK * DM || out_size != MTOK * DM || ws_size < WS_END) {
            fprintf(stderr, "kernel_launch: unexpected shapes (n_in %d, in0 %d, out %d, ws %zu); nothing launched\n", n_in, n_in > 0 ? in_sizes[0] : -1, out_size, ws_size); grid = -1; return; }
        int dev = 0, cus = 0, per_cu = 0;
        if (hipGetDevice(&dev) != hipSuccess || hipDeviceGetAttribute(&cus, hipDeviceAttributeMultiprocessorCount, dev) != hipSuccess) { grid = -1; return; }
        if (hipFuncSetAttribute((const void*)mega_fwd, hipFuncAttributeMaxDynamicSharedMemorySize, LDS_BYTES) != hipSuccess) { fprintf(stderr, "kernel_launch: hipFuncSetAttribute failed\n"); grid = -1; return; }
        if (hipOccupancyMaxActiveBlocksPerMultiprocessor(&per_cu, (const void*)mega_fwd, 512, LDS_BYTES) != hipSuccess || per_cu < 1) per_cu = 1;
        (void)hipGetLastError();
        grid = cus * per_cu;
    }
    if (grid < 0) return;
    Args a{};
    for (int i = 0; i < 28; ++i) a.in[i] = (const float*)d_in[i];
    a.out = (float*)d_out; a.ws = (unsigned char*)d_ws;
#if MK_MULTI_LAUNCH
    for (int p = 0; p < N_PHASES; ++p) {
        a.ph_lo = p; a.ph_hi = p + 1;
        hipLaunchKernelGGL(mega_fwd, dim3(grid), dim3(512), LDS_BYTES, stream, a);
    }
#else
    a.ph_lo = 0; a.ph_hi = N_PHASES;
    if (hipMemsetAsync(d_ws, 0, 16384, stream) != hipSuccess) { fprintf(stderr, "kernel_launch: memset of the barrier words failed\n"); return; }
    void* args[] = {&a};
    hipError_t e = hipLaunchCooperativeKernel((const void*)mega_fwd, dim3(grid), dim3(512), args, LDS_BYTES, stream);
    if (e != hipSuccess) fprintf(stderr, "cooperative launch failed: %s (grid %d)\n", hipGetErrorString(e), grid);
#endif
}
```

```cpp
#include <hip/hip_runtime.h>
#include <hip/hip_cooperative_groups.h>
#include <cstdio>
#include <cstdint>
namespace cg = cooperative_groups;

#ifndef MK_MULTI_LAUNCH
#define MK_MULTI_LAUNCH 0
#endif

#define LAS __attribute__((address_space(3)))
typedef unsigned short bf16_t;
typedef short bf16x8 __attribute__((ext_vector_type(8)));
typedef short s16x4 __attribute__((ext_vector_type(4)));
typedef float f32x4 __attribute__((ext_vector_type(4)));
typedef float f32x16 __attribute__((ext_vector_type(16)));
typedef unsigned u32x4 __attribute__((ext_vector_type(4)));
typedef unsigned u32x2 __attribute__((ext_vector_type(2)));

constexpr int MTOK = 32768, DM = 1024, SEQ = 2048, NBATCH = 16, DFF = 2816, DFF2 = 5632, MEMTOK = 4096;
constexpr int MHALF = 16384;
constexpr float EPS = 1e-6f;
constexpr float LOG2E = 1.4426950408889634f, LN2 = 0.6931471805599453f;

constexpr size_t MiB = 1u << 20;
constexpr size_t WS_SSQ = 1 * MiB;
constexpr size_t WS_WIN = 5 * MiB;
constexpr size_t WS_WOUT = 9 * MiB;
constexpr size_t WS_WSSM = 11 * MiB;
constexpr size_t WS_WGLU = 13 * MiB;
constexpr size_t WS_LAYER = 17 * MiB, LAYER_STRIDE = 25 * MiB;
constexpr size_t LO_WQ = 0, LO_WKV = 2 * MiB, LO_WO = 6 * MiB, LO_WUP = 8 * MiB, LO_WDN = 19 * MiB;
constexpr size_t WS_WEND = 67 * MiB;
constexpr size_t WS_TG = 83 * MiB;
constexpr size_t WS_MEMN = 123 * MiB;
constexpr size_t WS_MEMK = 131 * MiB;
constexpr size_t WS_MEMVT = 147 * MiB, MEMVT_STRIDE = 9 * MiB;
constexpr size_t WS_XB = 165 * MiB;
constexpr size_t WS_T = 229 * MiB;
constexpr size_t WS_QKU = WS_T, WS_VT = WS_T + 96 * MiB, WS_CAT = WS_T + 132 * MiB;
constexpr int VT_LD = MTOK + 128, MVT_LD = 4096 + 128;
constexpr size_t WS_QX = WS_T, WS_P = WS_T + 64 * MiB, WS_O = WS_T + 128 * MiB;
constexpr size_t WS_H = WS_T, WS_HALO = WS_T + 176 * MiB;
constexpr size_t WS_UG = WS_T, WS_HEND = WS_T + 80 * MiB, WS_YG = WS_T + 112 * MiB;
constexpr size_t WS_GT = 426 * MiB;
constexpr size_t WS_END = 512 * MiB;
static_assert(WS_H + (size_t)MTOK * DFF * 2 <= WS_HALO && WS_HALO + (size_t)128 * 4 * DFF2 * 2 <= WS_GT && WS_CAT + (size_t)MTOK * DM * 2 <= WS_GT && WS_GT + 64 * MiB <= WS_END, "ws map");

typedef float f32x2_t __attribute__((ext_vector_type(2))); typedef __bf16 bf16x2_t __attribute__((ext_vector_type(2)));
__device__ __forceinline__ unsigned cvt_pk_bf16(float lo, float hi) { f32x2_t v = {lo, hi}; bf16x2_t b = __builtin_convertvector(v, bf16x2_t); return __builtin_bit_cast(unsigned, b); }
__device__ __forceinline__ float bf2f(unsigned short b) { return __uint_as_float(((unsigned)b) << 16); }
__device__ __forceinline__ float bflo(unsigned w) { return __uint_as_float(w << 16); }
__device__ __forceinline__ float bfhi(unsigned w) { return __uint_as_float(w & 0xffff0000u); }
__device__ __forceinline__ float fexp2(float x) { return __builtin_amdgcn_exp2f(x); }
__device__ __forceinline__ float flog2(float x) { return __builtin_amdgcn_logf(x); }
__device__ __forceinline__ float fexp(float x) { return __builtin_amdgcn_exp2f(x * LOG2E); }
__device__ __forceinline__ float frcp(float x) { return __builtin_amdgcn_rcpf(x); }
template <int M> __device__ __forceinline__ float swz_xor(float v) { return __int_as_float(__builtin_amdgcn_ds_swizzle(__float_as_int(v), (M << 10) | 0x1f)); }
__device__ __forceinline__ float sum_x16(float v) { auto r = __builtin_amdgcn_permlane16_swap(__float_as_uint(v), __float_as_uint(v), false, false); return __uint_as_float(r[0]) + __uint_as_float(r[1]); }
__device__ __forceinline__ float sum_x32(float v) { auto r = __builtin_amdgcn_permlane32_swap(__float_as_uint(v), __float_as_uint(v), false, false); return __uint_as_float(r[0]) + __uint_as_float(r[1]); }
__device__ __forceinline__ float max_x16(float v) { auto r = __builtin_amdgcn_permlane16_swap(__float_as_uint(v), __float_as_uint(v), false, false); return fmaxf(__uint_as_float(r[0]), __uint_as_float(r[1])); }
__device__ __forceinline__ float max_x32(float v) { auto r = __builtin_amdgcn_permlane32_swap(__float_as_uint(v), __float_as_uint(v), false, false); return fmaxf(__uint_as_float(r[0]), __uint_as_float(r[1])); }
__device__ __forceinline__ float partner32(float v, int hi) { auto r = __builtin_amdgcn_permlane32_swap(__float_as_uint(v), __float_as_uint(v), false, false); return hi ? __uint_as_float(r[0]) : __uint_as_float(r[1]); }
__device__ __forceinline__ float wave_sum(float v) {
    v += swz_xor<1>(v); v += swz_xor<2>(v); v += swz_xor<4>(v); v += swz_xor<8>(v); v = sum_x16(v); v = sum_x32(v);
    return v;
}
#define LDS_WAIT() asm volatile("s_waitcnt lgkmcnt(0)" ::: "memory")

namespace pg8 {
constexpr int BM = 256, BK = 64, HALF = 128, HTB = HALF * BK * 2, STAGE_BYTES = 8 * HTB, NXCD = 8, WGM = 8;
__host__ __device__ __forceinline__ int lds_byte(int r, int c) { const int st = (r >> 4) * 2 + (c >> 5), rr = r & 15, cc = c & 31, ob = rr * 64 + cc * 2; return st * 1024 + (ob ^ (((ob >> 9) & 1) << 5)); }
__host__ __device__ __forceinline__ void stage_rc(int b, int& R, int& C) { const int st = b / 1024, sb = b % 1024, swz = sb ^ (((sb >> 9) & 1) << 5); R = (st >> 1) * 16 + swz / 64; C = (st & 1) * 32 + (swz % 64) / 2; }
__host__ __device__ __forceinline__ int perm32(int rho) { const int n = rho >> 4, i = rho & 15; return 8 * (i >> 2) + 4 * n + (i & 3); }

struct Unit { int pm, pn; const char* a; const char* b; };

struct SchedStd {
    const char* A; const char* B; unsigned sA, sB; int nM, nN, G, c;
    __device__ __forceinline__ void init(const void* A_, unsigned sA_, const void* B_, unsigned sB_, int nM_, int nN_, int G_, int c_) { A = (const char*)A_; B = (const char*)B_; sA = sA_; sB = sB_; nM = nM_; nN = nN_; G = G_; c = c_; }
    __device__ __forceinline__ bool next(int i, Unit& u) const {
        const int nwg = nM * nN; const long L = (long)i * G + c; if (L >= nwg) return false;
        int wgid = (int)L; { const int q = nwg / NXCD, r = nwg % NXCD, xcd = wgid % NXCD, off = wgid / NXCD; wgid = (xcd < r ? xcd * (q + 1) : r * (q + 1) + (xcd - r) * q) + off; }
        const int nig = WGM * nN, gid = wgid / nig, fm = gid * WGM, gsz = (nM - fm) < WGM ? (nM - fm) : WGM;
        u.pm = fm + ((wgid % nig) % gsz); u.pn = (wgid % nig) / gsz;
        u.a = A + (size_t)u.pm * sA; u.b = B + (size_t)u.pn * sB; return true;
    }
};
struct SchedXS {
    const char* A; const char* B; int G, c;
    __device__ __forceinline__ bool next(int i, Unit& u) const {
        const long L = (long)i * G + c; if (L >= 512) return false;
        u.pm = (int)(L >> 2); u.pn = (int)(L & 3);
        u.a = A + (size_t)u.pm * 256 * 2048 + u.pn * 512; u.b = B + (size_t)(u.pm >> 3) * 256 * 2048 + u.pn * 512; return true;
    }
};
struct SchedXQ {
    const char* A; const char* B; int G, c;
    __device__ __forceinline__ bool next(int i, Unit& u) const {
        const long L = (long)i * G + c; if (L >= 512) return false;
        u.pm = (int)(L >> 2); u.pn = (int)(L & 3);
        u.a = A + (size_t)u.pm * 256 * 2048; u.b = B + (size_t)u.pn * 256 * 2048; return true;
    }
};
struct SchedG {
    const char* MK; const char* WQ; int G, c;
    __device__ __forceinline__ bool next(int i, Unit& u) const {
        const long L = (long)i * G + c; if (L >= 512) return false;
        const int l = (int)(L >> 8), r = (int)(L & 255), b = r >> 4, h = (r >> 2) & 3, pn = r & 3;
        u.pm = l * 64 + b * 4 + h; u.pn = pn;
        u.a = MK + (size_t)l * 8 * 1048576 + (size_t)b * 256 * 2048 + h * 512; u.b = WQ + (size_t)l * LAYER_STRIDE + (size_t)pn * 256 * 2048 + h * 512; return true;
    }
};
struct SchedXS2 {
    const char* A; const char* B; int G, c;
    __device__ __forceinline__ bool next(int i, Unit& u) const {
        const long L = (long)i * G + c; if (L >= 512) return false;
        u.pm = (int)(L >> 2); u.pn = (int)(L & 3);
        u.a = A + (size_t)u.pm * 256 * 2048; u.b = B + (size_t)((u.pm >> 3) * 4 + u.pn) * 256 * 2048; return true;
    }
};
struct SchedVW {
    const char* WO; const char* MV; int G, c;
    __device__ __forceinline__ bool next(int i, Unit& u) const {
        const long L = (long)i * G + c; if (L >= 256) return false;
        const int b = (int)(L >> 4), pq = (int)(L >> 2) & 3, h = (int)L & 3;
        u.pm = b * 4 + pq; u.pn = h;
        u.a = WO + (size_t)pq * 256 * 2048 + h * 512; u.b = MV + (size_t)b * 256 * 2048 + h * 512; return true;
    }
};
struct SchedXOut {
    const char* A; const char* B; int G, c;
    __device__ __forceinline__ bool next(int i, Unit& u) const {
        const long L = (long)i * G + c; if (L >= 512) return false;
        u.pm = (int)(L >> 2); u.pn = (int)(L & 3);
        u.a = A + (size_t)u.pm * 256 * 2048; u.b = B + ((size_t)(u.pm >> 3) * 1024 + (size_t)u.pn * 256) * 2048; return true;
    }
};
struct SchedXO {
    const char* A; const char* B; int G, c;
    __device__ __forceinline__ bool next(int i, Unit& u) const {
        const long L = (long)i * G + c; if (L >= 512) return false;
        u.pm = (int)(L >> 2); u.pn = (int)(L & 3);
        u.a = A + (size_t)u.pm * 256 * 2048 + u.pn * 512; u.b = B + (size_t)u.pn * 256 * (MVT_LD * 2) + (size_t)(u.pm >> 3) * 512; return true;
    }
};
struct SchedS2 {
    const char* A; const char* B; int G, c;
    __device__ __forceinline__ bool next(int i, Unit& u) const {
        const long L = (long)i * G + c; if (L >= 256) return false;
        u.pm = (int)L; u.pn = 0;
        u.a = A + (size_t)L * 256 * 1280; u.b = B + (size_t)(L >> 2) * 256 * 1024; return true;
    }
};
struct SchedS4 {
    const char* A; const char* B; int G, c;
    __device__ __forceinline__ bool next(int i, Unit& u) const {
        const long L = (long)i * G + c; if (L >= 512) return false;
        u.pm = (int)(L >> 1); u.pn = (int)(L & 1);
        u.a = A + (size_t)u.pm * 256 * 1280; u.b = B + ((size_t)(L >> 3) * 512 + (size_t)u.pn * 256) * 1280; return true;
    }
};

typedef f32x4 Acc[2][2][4][2];

__device__ __forceinline__ float row_rstd(const float* ssq_row, int nslots) {
    float s = 0.f;
    const f32x4* p = (const f32x4*)ssq_row;
    for (int i = 0; i < nslots / 4; ++i) { const f32x4 v = p[i]; s += (v[0] + v[1]) + (v[2] + v[3]); }
    return 1.0f / sqrtf(s * (1.0f / DM) + EPS);
}

struct EpiStore {
    static constexpr bool PERM = true;
    bf16_t* O; int ldc; const float* ssq; int nslots; float cs; int mode;
    __device__ __forceinline__ void operator()(Acc& acc, const Unit& u, int wr, int wc, int fr, int fq, LAS unsigned char*) const {
        const int row0 = u.pm * BM + wr * 64 + fr, col0 = u.pn * BM + wc * 32 + 8 * fq;
#pragma unroll
        for (int ai = 0; ai < 2; ++ai)
#pragma unroll
            for (int m = 0; m < 4; ++m) {
                const int row = row0 + ai * HALF + m * 16;
                float sc = cs;
                if (ssq) sc *= row_rstd(ssq + (size_t)row * 32, nslots);
#pragma unroll
                for (int bj = 0; bj < 2; ++bj) {
                    const int col = col0 + bj * HALF;
                    const f32x4 v0 = acc[ai][bj][m][0] * sc, v1 = acc[ai][bj][m][1] * sc;
                    u32x4 w; w.x = cvt_pk_bf16(v0[0], v0[1]); w.y = cvt_pk_bf16(v0[2], v0[3]); w.z = cvt_pk_bf16(v1[0], v1[1]); w.w = cvt_pk_bf16(v1[2], v1[3]);
                    bf16_t* p = (mode == 0) ? O + (size_t)row * ldc + col
                                            : O + ((size_t)(col >> 4) * 1024 + (row >> 5)) * 640 + (row & 31) * 16 + (col & 15);
                    *(u32x4*)p = w;
                }
            }
    }
};

struct EpiResid {
    static constexpr bool PERM = false;
    const float* xf; bf16_t* xb; float* ssq;
    __device__ __forceinline__ void operator()(Acc& acc, const Unit& u, int wr, int wc, int fr, int fq, LAS unsigned char*) const {
        const int row0 = u.pm * BM + wr * 64 + fr, col0 = u.pn * BM + wc * 32 + 4 * fq;
#pragma unroll
        for (int ai = 0; ai < 2; ++ai)
#pragma unroll
            for (int m = 0; m < 4; ++m) {
                const int row = row0 + ai * HALF + m * 16; float q = 0.f;
#pragma unroll
                for (int bj = 0; bj < 2; ++bj)
#pragma unroll
                    for (int n = 0; n < 2; ++n) {
                        const int col = col0 + bj * HALF + n * 16; const size_t off = (size_t)row * DM + col;
                        f32x4 v;
                        if (xf) v = *(const f32x4*)(xf + off);
                        else { const u32x2 o = *(const u32x2*)(xb + off); v = (f32x4){bflo(o.x), bfhi(o.x), bflo(o.y), bfhi(o.y)}; }
                        v += acc[ai][bj][m][n];
                        q += (v[0] * v[0] + v[1] * v[1]) + (v[2] * v[2] + v[3] * v[3]);
                        u32x2 w; w.x = cvt_pk_bf16(v[0], v[1]); w.y = cvt_pk_bf16(v[2], v[3]);
                        *(u32x2*)(xb + off) = w;
                    }
                q = sum_x16(q); q = sum_x32(q);
                if (fq == 0) ssq[(size_t)row * 32 + u.pn * 4 + wc] = q;
            }
    }
};

struct EpiGlu {
    static constexpr bool PERM = false;
    bf16_t* xb; float* ssq;
    __device__ __forceinline__ void operator()(Acc& acc, const Unit& u, int wr, int wc, int fr, int fq, LAS unsigned char*) const {
        const int row0 = u.pm * BM + wr * 64 + fr, col0 = u.pn * HALF + wc * 32 + 4 * fq;
#pragma unroll
        for (int ai = 0; ai < 2; ++ai)
#pragma unroll
            for (int m = 0; m < 4; ++m) {
                const int row = row0 + ai * HALF + m * 16; float q = 0.f;
#pragma unroll
                for (int n = 0; n < 2; ++n) {
                    const int col = col0 + n * 16; const size_t off = (size_t)row * DM + col;
                    const f32x4 val = acc[ai][0][m][n], gt = acc[ai][1][m][n];
                    const u32x2 o = *(const u32x2*)(xb + off);
                    f32x4 v = (f32x4){bflo(o.x), bfhi(o.x), bflo(o.y), bfhi(o.y)};
#pragma unroll
                    for (int j = 0; j < 4; ++j) v[j] += val[j] * frcp(1.0f + fexp(-gt[j]));
                    q += (v[0] * v[0] + v[1] * v[1]) + (v[2] * v[2] + v[3] * v[3]);
                    u32x2 w; w.x = cvt_pk_bf16(v[0], v[1]); w.y = cvt_pk_bf16(v[2], v[3]);
                    *(u32x2*)(xb + off) = w;
                }
                q = sum_x16(q); q = sum_x32(q);
                if (fq == 0) ssq[(size_t)row * 32 + u.pn * 4 + wc] = q;
            }
    }
};

struct EpiSoftmax {
    static constexpr bool PERM = true;
    bf16_t* O; const float* ssq; int nslots; float cs;
    __device__ __forceinline__ void operator()(Acc& acc, const Unit& u, int wr, int wc, int fr, int fq, LAS unsigned char* xl) const {
        LAS float* tmax = (LAS float*)xl; LAS float* tsum = tmax + 1024;
#pragma unroll
        for (int ai = 0; ai < 2; ++ai)
#pragma unroll
            for (int m = 0; m < 4; ++m) {
                const float sc = cs * row_rstd(ssq + (size_t)(u.pm * BM + ai * HALF + wr * 64 + m * 16 + fr) * 32, nslots);
#pragma unroll
                for (int bj = 0; bj < 2; ++bj)
#pragma unroll
                    for (int n = 0; n < 2; ++n) acc[ai][bj][m][n] *= sc;
                float mx = -3.0e38f;
#pragma unroll
                for (int bj = 0; bj < 2; ++bj)
#pragma unroll
                    for (int n = 0; n < 2; ++n) { const f32x4 x = acc[ai][bj][m][n]; mx = fmaxf(mx, fmaxf(fmaxf(x[0], x[1]), fmaxf(x[2], x[3]))); }
                mx = max_x16(mx); mx = max_x32(mx);
                if (fq == 0) tmax[(ai * HALF + wr * 64 + m * 16 + fr) * 4 + wc] = mx;
            }
        LDS_WAIT(); __builtin_amdgcn_s_barrier(); asm volatile("" ::: "memory");
#pragma unroll
        for (int ai = 0; ai < 2; ++ai)
#pragma unroll
            for (int m = 0; m < 4; ++m) {
                const int r = ai * HALF + wr * 64 + m * 16 + fr;
                const f32x4 t = *(const LAS f32x4*)(tmax + r * 4);
                const float gm = fmaxf(fmaxf(t[0], t[1]), fmaxf(t[2], t[3])) * LOG2E; float s = 0.f;
#pragma unroll
                for (int bj = 0; bj < 2; ++bj)
#pragma unroll
                    for (int n = 0; n < 2; ++n) {
                        f32x4 x = acc[ai][bj][m][n];
#pragma unroll
                        for (int j = 0; j < 4; ++j) { x[j] = fexp2(x[j] * LOG2E - gm); s += x[j]; }
                        acc[ai][bj][m][n] = x;
                    }
                s = sum_x16(s); s = sum_x32(s);
                if (fq == 0) tsum[r * 4 + wc] = s;
            }
        LDS_WAIT(); __builtin_amdgcn_s_barrier(); asm volatile("" ::: "memory");
        const int row0 = u.pm * BM + wr * 64 + fr, col0 = u.pn * BM + wc * 32 + 8 * fq;
#pragma unroll
        for (int ai = 0; ai < 2; ++ai)
#pragma unroll
            for (int m = 0; m < 4; ++m) {
                const int r = ai * HALF + wr * 64 + m * 16 + fr;
                const f32x4 t = *(const LAS f32x4*)(tsum + r * 4);
                const float inv = 1.0f / ((t[0] + t[1]) + (t[2] + t[3]));
#pragma unroll
                for (int bj = 0; bj < 2; ++bj) {
                    const f32x4 v0 = acc[ai][bj][m][0] * inv, v1 = acc[ai][bj][m][1] * inv;
                    u32x4 w; w.x = cvt_pk_bf16(v0[0], v0[1]); w.y = cvt_pk_bf16(v0[2], v0[3]); w.z = cvt_pk_bf16(v1[0], v1[1]); w.w = cvt_pk_bf16(v1[2], v1[3]);
                    *(u32x4*)(O + (size_t)(row0 + ai * HALF + m * 16) * DM + col0 + bj * HALF) = w;
                }
            }
    }
};


__device__ __forceinline__ float dpp_ror1(float x) { return __int_as_float(__builtin_amdgcn_update_dpp(0, __float_as_int(x), 0x121, 0xf, 0xf, false)); }
__device__ __forceinline__ float dpp_ror2(float x) { return __int_as_float(__builtin_amdgcn_update_dpp(0, __float_as_int(x), 0x122, 0xf, 0xf, false)); }
__device__ __forceinline__ float dpp_ror1u(float x) { return __int_as_float(__builtin_amdgcn_mov_dpp(__float_as_int(x), 0x121, 0xf, 0xf, false)); }
__device__ __forceinline__ float dpp_ror2u(float x) { return __int_as_float(__builtin_amdgcn_mov_dpp(__float_as_int(x), 0x122, 0xf, 0xf, false)); }
__device__ __forceinline__ float dpp_shr1_old(float old, float x) { return __int_as_float(__builtin_amdgcn_update_dpp(__float_as_int(old), __float_as_int(x), 0x111, 0xf, 0xf, false)); }
__device__ __forceinline__ float dpp_shr2_old(float old, float x) { return __int_as_float(__builtin_amdgcn_update_dpp(__float_as_int(old), __float_as_int(x), 0x112, 0xf, 0xf, false)); }
struct EpiUpConv {
    static constexpr bool PERM = true;
    bf16_t* H; bf16_t* HALO; const float* ssq; const float* cw; const float* cb;
    __device__ __forceinline__ void operator()(Acc& acc, const Unit& u, int wr, int wc, int fr, int fq, LAS unsigned char* xl) const {
        LAS float* B = (LAS float*)xl;
        LAS float* Wl = B + 2048;
        LAS float* R = Wl + 1024;
        const int wid = wr * 4 + wc, lane = fq * 16 + fr, tid = wid * 64 + lane;
        const int row0 = u.pm * BM + wr * 64 + fr, colb = wc * 32 + 8 * fq, ch0 = u.pn * HALF + colb;
        {
#pragma unroll
            for (int i = 0; i < 2; ++i) { const int idx = tid + i * 512, t = idx >> 8, bj = (idx >> 7) & 1, chl = idx & 127;
                Wl[idx] = (t < 3) ? cw[t * DFF2 + bj * DFF + u.pn * HALF + chl] : cb[bj * DFF + u.pn * HALF + chl]; }
            if (lane < 32) R[wid * 32 + lane] = row_rstd(ssq + (size_t)(u.pm * BM + wid * 32 + lane) * 32, 16);
        }
        LDS_WAIT(); __builtin_amdgcn_s_barrier(); asm volatile("" ::: "memory");
#pragma unroll
        for (int ai = 0; ai < 2; ++ai)
#pragma unroll
            for (int m = 0; m < 4; ++m) {
                const float sc = R[ai * HALF + wr * 64 + m * 16 + fr];
#pragma unroll
                for (int bj = 0; bj < 2; ++bj)
#pragma unroll
                    for (int n = 0; n < 2; ++n) acc[ai][bj][m][n] *= sc;
            }
        if (fr >= 14) {
#pragma unroll
            for (int ai = 0; ai < 2; ++ai)
#pragma unroll
                for (int bj = 0; bj < 2; ++bj)
#pragma unroll
                    for (int n = 0; n < 2; ++n) *(LAS f32x4*)(B + ((ai * 2 + wr) * 2 + (fr - 14)) * 256 + bj * HALF + colb + 4 * n) = acc[ai][bj][3][n];
        }
        if (wr == 0 && fr < 2) {
#pragma unroll
            for (int bj = 0; bj < 2; ++bj) { const f32x4 v0 = acc[0][bj][0][0], v1 = acc[0][bj][0][1];
                u32x4 w; w.x = cvt_pk_bf16(v0[0], v0[1]); w.y = cvt_pk_bf16(v0[2], v0[3]); w.z = cvt_pk_bf16(v1[0], v1[1]); w.w = cvt_pk_bf16(v1[2], v1[3]);
                *(u32x4*)(HALO + (size_t)(u.pm * 4 + fr) * DFF2 + bj * DFF + ch0) = w; }
        }
        if (wr == 1 && fr >= 14) {
#pragma unroll
            for (int bj = 0; bj < 2; ++bj) { const f32x4 v0 = acc[1][bj][3][0], v1 = acc[1][bj][3][1];
                u32x4 w; w.x = cvt_pk_bf16(v0[0], v0[1]); w.y = cvt_pk_bf16(v0[2], v0[3]); w.z = cvt_pk_bf16(v1[0], v1[1]); w.w = cvt_pk_bf16(v1[2], v1[3]);
                *(u32x4*)(HALO + (size_t)(u.pm * 4 + 2 + (fr - 14)) * DFF2 + bj * DFF + ch0) = w; }
        }
        LDS_WAIT(); __builtin_amdgcn_s_barrier(); asm volatile("" ::: "memory");
#pragma unroll
        for (int ai = 0; ai < 2; ++ai) {
            const bool has = (wr == 1) || (ai == 1);
            const int sb = (wr == 1) ? (ai * 2) : 1;
#pragma unroll
            for (int n = 0; n < 2; ++n) {
                asm volatile("" ::: "memory");
                const int cl = colb + 4 * n;
                float hv[4][4];
                const f32x4 wv0 = *(const LAS f32x4*)(Wl + 0 * 128 + cl), wg0 = *(const LAS f32x4*)(Wl + 1 * 128 + cl);
                const f32x4 wv1 = *(const LAS f32x4*)(Wl + 2 * 128 + cl), wg1 = *(const LAS f32x4*)(Wl + 3 * 128 + cl);
                const f32x4 wv2 = *(const LAS f32x4*)(Wl + 4 * 128 + cl), wg2 = *(const LAS f32x4*)(Wl + 5 * 128 + cl);
                const f32x4 bvv = *(const LAS f32x4*)(Wl + 6 * 128 + cl), bgv = *(const LAS f32x4*)(Wl + 7 * 128 + cl);
                f32x4 b1v = (f32x4){0.f, 0.f, 0.f, 0.f}, b2v = b1v, b1g = b1v, b2g = b1v;
                if (has) {
                    b1v = *(const LAS f32x4*)(B + (sb * 2 + 1) * 256 + cl); b2v = *(const LAS f32x4*)(B + (sb * 2 + (fr & 1)) * 256 + cl);
                    b1g = *(const LAS f32x4*)(B + (sb * 2 + 1) * 256 + HALF + cl); b2g = *(const LAS f32x4*)(B + (sb * 2 + (fr & 1)) * 256 + HALF + cl);
                }
#pragma unroll
                for (int j = 0; j < 4; ++j) {
                    float r1p = b1v[j], r2p = b2v[j], q1p = b1g[j], q2p = b2g[j];
#pragma unroll
                    for (int m = 0; m < 4; ++m) {
                        const float xv = acc[ai][0][m][n][j], xg = acc[ai][1][m][n][j];
                        const float pv1 = dpp_shr1_old(r1p, xv), pv2 = dpp_shr2_old(r2p, xv), pg1 = dpp_shr1_old(q1p, xg), pg2 = dpp_shr2_old(q2p, xg);
                        const float cv = bvv[j] + wv0[j] * pv2 + wv1[j] * pv1 + wv2[j] * xv;
                        const float cg = bgv[j] + wg0[j] * pg2 + wg1[j] * pg1 + wg2[j] * xg;
                        hv[m][j] = cv * cg * frcp(1.0f + fexp(-cg));
                        if (m < 3) { r1p = dpp_ror1u(xv); r2p = dpp_ror2u(xv); q1p = dpp_ror1u(xg); q2p = dpp_ror2u(xg); }
                    }
                    __builtin_amdgcn_sched_barrier(0);
                }
#pragma unroll
                for (int m = 0; m < 4; ++m) {
                    u32x2 w; w.x = cvt_pk_bf16(hv[m][0], hv[m][1]); w.y = cvt_pk_bf16(hv[m][2], hv[m][3]);
                    *(u32x2*)(H + (size_t)(row0 + ai * HALF + m * 16) * DFF + ch0 + 4 * n) = w;
                }
            }
        }
    }
};

struct EpiHend {
    static constexpr bool PERM = false;
    float* Hout;
    __device__ __forceinline__ void operator()(Acc& acc, const Unit& u, int wr, int wc, int fr, int fq, LAS unsigned char*) const {
        const int row0 = u.pm * BM + wr * 64 + fr, col0 = wc * 32 + 4 * fq;
#pragma unroll
        for (int ai = 0; ai < 2; ++ai)
#pragma unroll
            for (int m = 0; m < 4; ++m)
#pragma unroll
                for (int n = 0; n < 2; ++n)
                    *(f32x4*)(Hout + (size_t)(row0 + ai * HALF + m * 16) * 128 + col0 + n * 16) = acc[ai][0][m][n];
    }
};

struct EpiSsmY {
    static constexpr bool PERM = true;
    const bf16_t* Ug; const float* Dskip; bf16_t* Yg;
    __device__ __forceinline__ void operator()(Acc& acc, const Unit& u, int wr, int wc, int fr, int fq, LAS unsigned char*) const {
        const int g = u.pm >> 2;
        const int rg0 = (u.pm & 3) * BM + wr * 64 + fr, col0 = u.pn * BM + wc * 32 + 8 * fq;
        const int co = col0 & 15;
        const f32x4 d0 = *(const f32x4*)(Dskip + g * 16 + co), d1 = *(const f32x4*)(Dskip + g * 16 + co + 4);
#pragma unroll
        for (int ai = 0; ai < 2; ++ai)
#pragma unroll
            for (int m = 0; m < 4; ++m) {
                const int rg = rg0 + ai * HALF + m * 16;
#pragma unroll
                for (int bj = 0; bj < 2; ++bj) {
                    const int col = col0 + bj * HALF;
                    const u32x4 uu = *(const u32x4*)(Ug + ((size_t)g * 1024 + rg) * 640 + col);
                    float y[8];
                    y[0] = acc[ai][bj][m][0][0] + d0[0] * bflo(uu.x); y[1] = acc[ai][bj][m][0][1] + d0[1] * bfhi(uu.x);
                    y[2] = acc[ai][bj][m][0][2] + d0[2] * bflo(uu.y); y[3] = acc[ai][bj][m][0][3] + d0[3] * bfhi(uu.y);
                    y[4] = acc[ai][bj][m][1][0] + d1[0] * bflo(uu.z); y[5] = acc[ai][bj][m][1][1] + d1[1] * bfhi(uu.z);
                    y[6] = acc[ai][bj][m][1][2] + d1[2] * bflo(uu.w); y[7] = acc[ai][bj][m][1][3] + d1[3] * bfhi(uu.w);
#pragma unroll
                    for (int j = 0; j < 8; ++j) { const float x = y[j]; const float k2 = 1.5957691216f * (x + 0.044715f * x * x * x); y[j] = x * frcp(1.0f + fexp(-k2)); }
                    u32x4 w; w.x = cvt_pk_bf16(y[0], y[1]); w.y = cvt_pk_bf16(y[2], y[3]); w.z = cvt_pk_bf16(y[4], y[5]); w.w = cvt_pk_bf16(y[6], y[7]);
                    const size_t tok = (size_t)rg * 32 + (col >> 4);
                    *(u32x4*)(Yg + tok * DM + g * 16 + co) = w;
                }
            }
    }
};

template <class Epi, class Sched>
__device__ __forceinline__ void gemm_phase(LAS unsigned char* lds, LAS unsigned char* xl, const int lda, const int ldb, const int K, const Sched& S, const Epi& E) {
    int tid_ = threadIdx.x; asm volatile("" : "+v"(tid_));
    const int tid = tid_, wid = __builtin_amdgcn_readfirstlane(tid >> 6), lane = tid & 63, wr = wid >> 2, wc = wid & 3, fr = lane & 15, fq = lane >> 4;
    const int nt = K / BK;
    unsigned voffA, voffB;
    { int R, C; stage_rc(tid * 16, R, C); const int Rb = Epi::PERM ? ((R & ~31) + perm32(R & 31)) : R;
      voffA = (unsigned)(R * lda + C) * 2u; voffB = (unsigned)(Rb * ldb + C) * 2u; }
    const size_t qstepA = (size_t)64 * lda * 2, qstepB = (size_t)64 * ldb * 2;
    const size_t kstep = (size_t)(BK * 2);
    const size_t hstepA = (size_t)HALF * lda * 2, hstepB = (size_t)HALF * ldb * 2;
    const unsigned ldsw = (unsigned)wid * 1024u;
    const int aoff = lds_byte(wr * 64 + fr, fq * 8), boff = lds_byte(wc * 32 + fr, fq * 8);
#define PG8_SA(b, h) (((b) * 2 + (h)) * HTB)
#define PG8_SB(b, h) ((4 + (b) * 2 + (h)) * HTB)
#define PG8_STAGE(bufoff, gbase, voff) do { _Pragma("unroll") for (int _i = 0; _i < 2; ++_i) \
        { const char* _gb = (const char*)(gbase) + (size_t)_i * q##voff; asm volatile("" : "+s"(_gb)); \
          __builtin_amdgcn_global_load_lds((const unsigned*)(_gb + (voff)), (LAS unsigned*)(lds + (bufoff) + ldsw + _i * 8192), 16, 0, 0); } } while (0)
#define qvoffA qstepA
#define qvoffB qstepB
#define PG8_LDA(dst, b, h) do { _Pragma("unroll") for (int m = 0; m < 4; ++m) _Pragma("unroll") for (int k = 0; k < 2; ++k) dst[m][k] = *(const LAS bf16x8*)(lds + PG8_SA(b, h) + aoff + m * 2048 + k * 1024); } while (0)
#define PG8_LDB(dst, b, h) do { _Pragma("unroll") for (int n = 0; n < 2; ++n) _Pragma("unroll") for (int k = 0; k < 2; ++k) dst[n][k] = *(const LAS bf16x8*)(lds + PG8_SB(b, h) + boff + n * 2048 + k * 1024); } while (0)
#define PG8_MMA(ai, bj, At, Bt) do { __builtin_amdgcn_s_setprio(1); _Pragma("unroll") for (int m = 0; m < 4; ++m) _Pragma("unroll") for (int n = 0; n < 2; ++n) _Pragma("unroll") for (int k = 0; k < 2; ++k) \
        acc[ai][bj][m][n] = __builtin_amdgcn_mfma_f32_16x16x32_bf16(Bt[n][k], At[m][k], acc[ai][bj][m][n], 0, 0, 0); __builtin_amdgcn_s_setprio(0); } while (0)
#define PG8_WAIT_V(n) asm volatile("s_waitcnt vmcnt(" #n ")" ::: "memory")
#define PG8_WAIT_L(n) asm volatile("s_waitcnt lgkmcnt(" #n ")" ::: "memory")
#define PG8_BAR __builtin_amdgcn_s_barrier()
#define PG8_SCHED __builtin_amdgcn_sched_barrier(0)
    Unit cur, nxt; int ui = 0;
    if (!S.next(0, cur)) return;
    Acc acc;
#pragma unroll
    for (int a = 0; a < 2; ++a)
#pragma unroll
        for (int b = 0; b < 2; ++b)
#pragma unroll
            for (int m = 0; m < 4; ++m)
#pragma unroll
                for (int n = 0; n < 2; ++n) acc[a][b][m][n] = (f32x4){0.f, 0.f, 0.f, 0.f};
    bf16x8 At[4][2], B0[2][2], B1[2][2];
    const char* cA = cur.a; const char* cB = cur.b;
    PG8_STAGE(PG8_SB(0, 0), cB, voffB); PG8_STAGE(PG8_SB(0, 1), cB + hstepB, voffB); PG8_STAGE(PG8_SA(0, 0), cA, voffA); PG8_STAGE(PG8_SA(0, 1), cA + hstepA, voffA);
    if (wr == 1) PG8_BAR;
    PG8_WAIT_V(2); PG8_BAR;
    PG8_STAGE(PG8_SB(1, 0), cB + kstep, voffB); PG8_STAGE(PG8_SA(1, 0), cA + kstep, voffA); PG8_STAGE(PG8_SB(1, 1), cB + hstepB + kstep, voffB);
    PG8_WAIT_V(6); PG8_BAR;
    for (;;) {
        const bool has_next = S.next(ui + 1, nxt);
        const char* nA = has_next ? nxt.a : cA; const char* nB = has_next ? nxt.b : cB;
        for (int t = 0; t < nt; t += 2) {
            const bool last = (t == nt - 2);
            const char* a1 = cA + (size_t)(t + 1) * kstep;
            const char* a2 = last ? nA : cA + (size_t)(t + 2) * kstep; const char* b2 = last ? nB : cB + (size_t)(t + 2) * kstep;
            const char* a3 = a2 + kstep; const char* b3 = b2 + kstep;
            PG8_LDB(B0, 0, 0); PG8_LDB(B1, 0, 1); PG8_SCHED; PG8_LDA(At, 0, 0); PG8_STAGE(PG8_SA(1, 1), a1 + hstepA, voffA);
            PG8_WAIT_V(8); PG8_WAIT_L(0); PG8_BAR; PG8_MMA(0, 0, At, B0); PG8_MMA(0, 1, At, B1); PG8_BAR; PG8_SCHED;
            PG8_LDA(At, 0, 1); PG8_STAGE(PG8_SB(0, 0), b2, voffB); PG8_STAGE(PG8_SB(0, 1), b2 + hstepB, voffB); PG8_STAGE(PG8_SA(0, 0), a2, voffA);
            PG8_WAIT_V(8); PG8_WAIT_L(0); PG8_BAR; PG8_MMA(1, 0, At, B0); PG8_MMA(1, 1, At, B1); PG8_BAR; PG8_SCHED;
            PG8_LDB(B0, 1, 0); PG8_LDB(B1, 1, 1); PG8_SCHED; PG8_LDA(At, 1, 0); PG8_STAGE(PG8_SA(0, 1), a2 + hstepA, voffA);
            PG8_WAIT_V(8); PG8_WAIT_L(0); PG8_BAR; PG8_MMA(0, 0, At, B0); PG8_MMA(0, 1, At, B1); PG8_BAR; PG8_SCHED;
            PG8_LDA(At, 1, 1); PG8_STAGE(PG8_SB(1, 0), b3, voffB); PG8_STAGE(PG8_SB(1, 1), b3 + hstepB, voffB); PG8_STAGE(PG8_SA(1, 0), a3, voffA);
            PG8_WAIT_V(8); PG8_WAIT_L(0); PG8_BAR; PG8_MMA(1, 0, At, B0); PG8_MMA(1, 1, At, B1); PG8_BAR; PG8_SCHED;
        }
        if (wr == 0) PG8_BAR;
        __builtin_amdgcn_sched_barrier(0); asm volatile("s_nop 15\n\ts_nop 15\n\ts_nop 15" ::: "memory"); __builtin_amdgcn_sched_barrier(0);
        { int t2 = threadIdx.x; asm volatile("" : "+v"(t2)); E(acc, cur, wr, wc, t2 & 15, (t2 >> 4) & 3, xl); }
        if (!has_next) break;
#pragma unroll
        for (int a = 0; a < 2; ++a)
#pragma unroll
            for (int b = 0; b < 2; ++b)
#pragma unroll
                for (int m = 0; m < 4; ++m)
#pragma unroll
                    for (int n = 0; n < 2; ++n) acc[a][b][m][n] = (f32x4){0.f, 0.f, 0.f, 0.f};
        cur = nxt; cA = nA; cB = nB; ++ui;
        if (wr == 1) PG8_BAR;
    }
    PG8_WAIT_V(0);
    PG8_BAR;
#undef PG8_SA
#undef PG8_SB
#undef PG8_STAGE
#undef qvoffA
#undef qvoffB
#undef PG8_LDA
#undef PG8_LDB
#undef PG8_MMA
#undef PG8_WAIT_V
#undef PG8_WAIT_L
#undef PG8_BAR
#undef PG8_SCHED
}
}

constexpr int RING_BYTES = 131072, XL_OFF = RING_BYTES, XBST_OFF = XL_OFF + 14336, LDS_BYTES = 147456;

struct TItem { const float* W; const float* gk; bf16_t* D; int N, ldt, drow0, k0, n0; };
__device__ __forceinline__ void titem_load(float (&v)[32], const TItem& t, int lane) {
#pragma unroll
    for (int i = 0; i < 32; ++i) { const int kk = 2 * i + (lane >> 5); v[i] = t.W[(size_t)(t.k0 + kk) * t.N + t.n0 + (lane & 31)]; }
}
__device__ __forceinline__ void titem_to_lds(const float (&v)[32], LAS float* scr, int lane) {
#pragma unroll
    for (int i = 0; i < 32; ++i) { const int kk = 2 * i + (lane >> 5); scr[kk * 33 + (lane & 31)] = v[i]; }
    LDS_WAIT(); asm volatile("" ::: "memory");
}
__device__ __forceinline__ void titem_store(const TItem& t, LAS float* scr, int lane) {
    const int c = lane & 7;
    f32x4 g0 = (f32x4){1.f, 1.f, 1.f, 1.f}, g1 = g0;
    if (t.gk) { g0 = *(const f32x4*)(t.gk + t.k0 + 8 * c); g1 = *(const f32x4*)(t.gk + t.k0 + 8 * c + 4); }
#pragma unroll
    for (int j = 0; j < 4; ++j) { const int n = (lane >> 3) + 8 * j; const LAS float* s = scr + (8 * c) * 33 + n;
        u32x4 o; o.x = cvt_pk_bf16(s[0 * 33] * g0[0], s[1 * 33] * g0[1]); o.y = cvt_pk_bf16(s[2 * 33] * g0[2], s[3 * 33] * g0[3]);
        o.z = cvt_pk_bf16(s[4 * 33] * g1[0], s[5 * 33] * g1[1]); o.w = cvt_pk_bf16(s[6 * 33] * g1[2], s[7 * 33] * g1[3]);
        *(u32x4*)(t.D + (size_t)(t.drow0 + n) * t.ldt + t.k0 + 8 * c) = o; }
    LDS_WAIT(); asm volatile("" ::: "memory");
}
__device__ __forceinline__ void rms_row_to_bf16(const float* xrow, const float* g, bf16_t* orow, int lane) {
    const f32x4* xr = (const f32x4*)xrow + lane; const f32x4* gr = (const f32x4*)g + lane;
    f32x4 v[4]; float s = 0.f;
#pragma unroll
    for (int j = 0; j < 4; ++j) { v[j] = xr[64 * j]; s += (v[j].x * v[j].x + v[j].y * v[j].y) + (v[j].z * v[j].z + v[j].w * v[j].w); }
    const float rstd = 1.f / sqrtf(wave_sum(s) * (1.f / DM) + EPS);
    u32x2* o8 = (u32x2*)orow + lane;
#pragma unroll
    for (int j = 0; j < 4; ++j) { const f32x4 gg = gr[64 * j]; u32x2 w; w.x = cvt_pk_bf16(v[j].x * rstd * gg.x, v[j].y * rstd * gg.y); w.y = cvt_pk_bf16(v[j].z * rstd * gg.z, v[j].w * rstd * gg.w); o8[64 * j] = w; }
}

__device__ __forceinline__ void rms_rows4_to_bf16(const float* xrow, const float* g, bf16_t* orow, int lane) {
    f32x4 v[4][4]; float s[4];
#pragma unroll
    for (int r = 0; r < 4; ++r)
#pragma unroll
        for (int j = 0; j < 4; ++j) v[r][j] = *((const f32x4*)(xrow + (size_t)r * DM) + lane + 64 * j);
#pragma unroll
    for (int r = 0; r < 4; ++r) { s[r] = 0.f;
#pragma unroll
        for (int j = 0; j < 4; ++j) s[r] += (v[r][j].x * v[r][j].x + v[r][j].y * v[r][j].y) + (v[r][j].z * v[r][j].z + v[r][j].w * v[r][j].w); }
#pragma unroll
    for (int r = 0; r < 4; ++r) s[r] = 1.f / sqrtf(wave_sum(s[r]) * (1.f / DM) + EPS);
#pragma unroll
    for (int j = 0; j < 4; ++j) { const f32x4 gg = *((const f32x4*)g + lane + 64 * j);
#pragma unroll
        for (int r = 0; r < 4; ++r) { u32x2 w; w.x = cvt_pk_bf16(v[r][j].x * s[r] * gg.x, v[r][j].y * s[r] * gg.y); w.y = cvt_pk_bf16(v[r][j].z * s[r] * gg.z, v[r][j].w * s[r] * gg.w);
            *((u32x2*)(orow + (size_t)r * DM) + lane + 64 * j) = w; } }
}

struct Args { const float* in[28]; float* out; unsigned char* ws; int ph_lo, ph_hi; };
typedef const __attribute__((address_space(4))) Args* KArgs;
__device__ __forceinline__ KArgs kargs() { KArgs p = (KArgs)__builtin_amdgcn_kernarg_segment_ptr(); asm volatile("" : "+s"(p)); return p; }

__device__ __forceinline__ void ssm_tables(KArgs ap, int g, LAS unsigned char* lds, bf16_t* Tg, bf16_t* Wend) {
    LAS float* Lre = (LAS float*)lds;
    LAS float* Lim = Lre + 33 * 64;
    LAS float* Bre = Lim + 33 * 64;
    LAS float* Bim = Bre + 1024;
    LAS float* Cre = Bim + 1024;
    LAS float* Cim = Cre + 1024;
    LAS float* Kern = Cim + 1024;
    const int tid = threadIdx.x;
    const float* lam_re = ap->in[12] + g * 64; const float* lam_im = ap->in[13] + g * 64;
    const float dt = expf(ap->in[14][g]);
    for (int idx = tid; idx < 33 * 64; idx += 512) {
        const int tau = idx >> 6, p = idx & 63;
        const float mag = expf((float)tau * (lam_re[p] * dt)); const float ang = (float)tau * (lam_im[p] * dt);
        Lre[idx] = mag * cosf(ang); Lim[idx] = mag * sinf(ang);
    }
    __syncthreads();
    for (int idx = tid; idx < 1024; idx += 512) {
        {
            const int p = idx >> 4;
            const float lr = lam_re[p], li = lam_im[p], lbr = Lre[64 + p], lbi = Lim[64 + p];
            const float nre = lbr - 1.0f, den = lr * lr + li * li;
            const float cr = (nre * lr + lbi * li) / den, ci = (lbi * lr - nre * li) / den;
            const float br = ap->in[15][(size_t)g * 1024 + idx], bi = ap->in[16][(size_t)g * 1024 + idx];
            Bre[idx] = cr * br - ci * bi; Bim[idx] = cr * bi + ci * br;
        }
        Cre[idx] = ap->in[17][(size_t)g * 1024 + idx]; Cim[idx] = ap->in[18][(size_t)g * 1024 + idx];
    }
    __syncthreads();
    {
        const int tau = tid >> 4, co = tid & 15; float kacc[16];
#pragma unroll
        for (int ci = 0; ci < 16; ++ci) kacc[ci] = 0.f;
        for (int p = 0; p < 64; ++p) {
            const float cr = Cre[co * 64 + p], cim = Cim[co * 64 + p], lr = Lre[tau * 64 + p], li = Lim[tau * 64 + p];
            const float gr = cr * lr - cim * li, gi = cr * li + cim * lr;
#pragma unroll
            for (int q = 0; q < 4; ++q) { const f32x4 br = *(const LAS f32x4*)(Bre + p * 16 + 4 * q), bi = *(const LAS f32x4*)(Bim + p * 16 + 4 * q);
#pragma unroll
                for (int e = 0; e < 4; ++e) kacc[4 * q + e] += gr * br[e] - gi * bi[e]; }
        }
#pragma unroll
        for (int ci = 0; ci < 16; ++ci) Kern[tid * 16 + ci] = kacc[ci];
    }
    __syncthreads();
    bf16_t* T = Tg + (size_t)g * 512 * 640;
    for (int idx = tid; idx < 512 * 80; idx += 512) {
        const int n = idx / 80, k8 = (idx % 80) * 8; const int t = n >> 4, co = n & 15;
        float v[8];
        if (k8 < 512) { const int s = k8 >> 4, ci = k8 & 15;
#pragma unroll
            for (int j = 0; j < 8; ++j) v[j] = (s <= t) ? Kern[((t - s) * 16 + co) * 16 + ci + j] : 0.f;
        } else { const int q = k8 - 512, im = q >> 6, p0 = q & 63;
#pragma unroll
            for (int j = 0; j < 8; ++j) { const int p = p0 + j; const float cr = Cre[co * 64 + p], cim = Cim[co * 64 + p], lr = Lre[(t + 1) * 64 + p], li = Lim[(t + 1) * 64 + p];
                v[j] = im ? -(cr * li + cim * lr) : (cr * lr - cim * li); }
        }
        u32x4 w; w.x = cvt_pk_bf16(v[0], v[1]); w.y = cvt_pk_bf16(v[2], v[3]); w.z = cvt_pk_bf16(v[4], v[5]); w.w = cvt_pk_bf16(v[6], v[7]);
        *(u32x4*)(T + (size_t)n * 640 + k8) = w;
    }
    bf16_t* We = Wend + (size_t)g * 256 * 512;
    for (int idx = tid; idx < 256 * 64; idx += 512) {
        const int j = idx >> 6, k8 = (idx & 63) * 8; float v[8];
        if (j < 128) { const int p = j & 63, im = j >> 6, s = k8 >> 4, ci = k8 & 15; const float lr = Lre[(31 - s) * 64 + p], li = Lim[(31 - s) * 64 + p];
#pragma unroll
            for (int e = 0; e < 8; ++e) { const float br = Bre[p * 16 + ci + e], bi = Bim[p * 16 + ci + e]; v[e] = im ? (lr * bi + li * br) : (lr * br - li * bi); }
        } else {
#pragma unroll
            for (int e = 0; e < 8; ++e) v[e] = 0.f;
        }
        u32x4 w; w.x = cvt_pk_bf16(v[0], v[1]); w.y = cvt_pk_bf16(v[2], v[3]); w.z = cvt_pk_bf16(v[4], v[5]); w.w = cvt_pk_bf16(v[6], v[7]);
        *(u32x4*)(We + (size_t)j * 512 + k8) = w;
    }
    __syncthreads();
}


template <int W> __device__ __forceinline__ u32x4 pool_item(const bf16_t* up, int t) {
    const int cnt = (t + 1 < W) ? t + 1 : W;
    u32x4 v[W];
#pragma unroll
    for (int i = 0; i < W; ++i) v[i] = (i < cnt) ? *(const u32x4*)(up - (size_t)i * 1536) : (u32x4){0u, 0u, 0u, 0u};
    float s[8];
#pragma unroll
    for (int j = 0; j < 8; ++j) s[j] = 0.f;
#pragma unroll
    for (int i = 0; i < W; ++i) { s[0] += bflo(v[i].x); s[1] += bfhi(v[i].x); s[2] += bflo(v[i].y); s[3] += bfhi(v[i].y); s[4] += bflo(v[i].z); s[5] += bfhi(v[i].z); s[6] += bflo(v[i].w); s[7] += bfhi(v[i].w); }
    const float inv = 1.0f / (float)cnt;
    u32x4 w; w.x = cvt_pk_bf16(s[0] * inv - bflo(v[0].x), s[1] * inv - bfhi(v[0].x)); w.y = cvt_pk_bf16(s[2] * inv - bflo(v[0].y), s[3] * inv - bfhi(v[0].y));
    w.z = cvt_pk_bf16(s[4] * inv - bflo(v[0].z), s[5] * inv - bfhi(v[0].z)); w.w = cvt_pk_bf16(s[6] * inv - bflo(v[0].w), s[7] * inv - bfhi(v[0].w));
    return w;
}

__device__ __forceinline__ void bf8_to_f(const u32x4 v, float (&f)[8]) { f[0] = bflo(v.x); f[1] = bfhi(v.x); f[2] = bflo(v.y); f[3] = bfhi(v.y); f[4] = bflo(v.z); f[5] = bfhi(v.z); f[6] = bflo(v.w); f[7] = bfhi(v.w); }
template <int W> __device__ __forceinline__ void pool_segment(const bf16_t* up, bf16_t* op, int t0) {
    float s[8];
#pragma unroll
    for (int j = 0; j < 8; ++j) s[j] = 0.f;
#pragma unroll
    for (int i = 1; i < W; ++i) {
        u32x4 v = (u32x4){0u, 0u, 0u, 0u};
        if (t0 - i >= 0) v = *(const u32x4*)(up - (size_t)i * 1536);
        float f[8]; bf8_to_f(v, f);
#pragma unroll
        for (int j = 0; j < 8; ++j) s[j] += f[j];
    }
#pragma unroll 4
    for (int r = 0; r < 32; ++r) {
        const int t = t0 + r;
        const u32x4 vc = *(const u32x4*)(up + (size_t)r * 1536);
        u32x4 vo = (u32x4){0u, 0u, 0u, 0u};
        if (t - (W - 1) >= 0) vo = *(const u32x4*)(up + (size_t)(r - (W - 1)) * 1536);
        float fc[8], fo[8]; bf8_to_f(vc, fc); bf8_to_f(vo, fo);
        const float inv = 1.0f / (float)((t + 1 < W) ? t + 1 : W);
        float o[8];
#pragma unroll
        for (int j = 0; j < 8; ++j) { s[j] += fc[j]; o[j] = s[j] * inv - fc[j]; s[j] -= fo[j]; }
        u32x4 w; w.x = cvt_pk_bf16(o[0], o[1]); w.y = cvt_pk_bf16(o[2], o[3]); w.z = cvt_pk_bf16(o[4], o[5]); w.w = cvt_pk_bf16(o[6], o[7]);
        *(u32x4*)(op + (size_t)r * DM) = w;
    }
}

__device__ __forceinline__ int crow(int r, int hi) { return (r & 3) + 8 * (r >> 2) + 4 * hi; }
__device__ __forceinline__ void sb_attn_task(const bf16_t* __restrict__ QKU, const bf16_t* __restrict__ VT, bf16_t* __restrict__ CAT, int b, int h, int qb, int lane) {
    const int r32 = lane & 31, hi = lane >> 5;
    const size_t tok0 = (size_t)b * SEQ; const int q0 = qb * 32;
    const bf16_t* qp = QKU + (tok0 + q0 + r32) * 1536 + h * 64 + 8 * hi;
    bf16x8 qf[4];
#pragma unroll
    for (int j = 0; j < 4; ++j) qf[j] = *(const bf16x8*)(qp + 16 * j);
    const bf16_t* kp = QKU + (tok0 + r32) * 1536 + 512 + h * 64 + 8 * hi;
    const bf16_t* vp = VT + (size_t)(h * 64 + r32) * VT_LD + tok0 + 4 * hi;
    f32x16 o0, o1;
#pragma unroll
    for (int r = 0; r < 16; ++r) { o0[r] = 0.f; o1[r] = 0.f; }
    float carry = 0.f;
    bf16x8 kf[4]; s16x4 va[2][4]; bf16x8 k1[4]; s16x4 v1[2][4];
#define SB_LOAD(KF, VA, K0) do { const int k0_ = (K0); \
        _Pragma("unroll") for (int j = 0; j < 4; ++j) KF[j] = *(const bf16x8*)(kp + (size_t)k0_ * 1536 + 16 * j); \
        _Pragma("unroll") for (int dh = 0; dh < 2; ++dh) _Pragma("unroll") for (int c = 0; c < 4; ++c) VA[dh][c] = *(const s16x4*)(vp + (size_t)dh * 32 * VT_LD + k0_ + 8 * c); } while (0)
    asm volatile("s_waitcnt vmcnt(0)" ::: "memory");
    SB_LOAD(kf, va, q0);
    SB_LOAD(k1, v1, qb > 0 ? q0 - 32 : q0);
    for (int kt = qb; kt >= 0; --kt) {
        bf16x8 kn[4]; s16x4 vn[2][4];
        SB_LOAD(kn, vn, kt >= 2 ? (kt - 2) * 32 : 0);
        f32x16 s;
#pragma unroll
        for (int r = 0; r < 16; ++r) s[r] = 0.f;
#pragma unroll
        for (int j = 0; j < 4; ++j) s = __builtin_amdgcn_mfma_f32_32x32x16_bf16(kf[j], qf[j], s, 0, 0, 0);
        const bool diag = (kt == qb);
        float sp[16], lb[16];
#pragma unroll
        for (int r = 0; r < 16; ++r) {
            const float z = s[r] * (0.125f * LOG2E);
            const float e = fexp2(-fabsf(z));
            float spv = fmaxf(z, 0.f) + flog2(1.0f + e);
            const bool valid = !diag || (crow(r, hi) < r32);
            spv = valid ? spv : 0.f;
            sp[r] = spv; lb[r] = valid ? (z - spv) : -1.0e30f;
        }
        float gs[4], pg[4];
#pragma unroll
        for (int g = 0; g < 4; ++g) { gs[g] = (sp[4 * g] + sp[4 * g + 1]) + (sp[4 * g + 2] + sp[4 * g + 3]); pg[g] = partner32(gs[g], hi); }
        float tap[4];
        tap[3] = 0.f; tap[2] = gs[3] + pg[3]; tap[1] = tap[2] + (gs[2] + pg[2]); tap[0] = tap[1] + (gs[1] + pg[1]);
        const float total = tap[0] + (gs[0] + pg[0]);
        float w[16];
#pragma unroll
        for (int g = 0; g < 4; ++g) {
            const float base = carry + tap[g] + (hi ? 0.f : pg[g]);
            const float a3 = base, a2 = a3 + sp[4 * g + 3], a1 = a2 + sp[4 * g + 2], a0 = a1 + sp[4 * g + 1];
            w[4 * g + 3] = fexp2(lb[4 * g + 3] - a3);
            w[4 * g + 2] = fexp2(lb[4 * g + 2] - a2);
            w[4 * g + 1] = fexp2(lb[4 * g + 1] - a1);
            w[4 * g + 0] = fexp2(lb[4 * g + 0] - a0);
        }
        carry += total;
        u32x4 p0, p1;
        p0.x = cvt_pk_bf16(w[0], w[1]); p0.y = cvt_pk_bf16(w[2], w[3]); p0.z = cvt_pk_bf16(w[4], w[5]); p0.w = cvt_pk_bf16(w[6], w[7]);
        p1.x = cvt_pk_bf16(w[8], w[9]); p1.y = cvt_pk_bf16(w[10], w[11]); p1.z = cvt_pk_bf16(w[12], w[13]); p1.w = cvt_pk_bf16(w[14], w[15]);
        const bf16x8 pb0 = __builtin_bit_cast(bf16x8, p0), pb1 = __builtin_bit_cast(bf16x8, p1);
#define VA8(dh, c) (bf16x8){va[dh][c][0], va[dh][c][1], va[dh][c][2], va[dh][c][3], va[dh][(c) + 1][0], va[dh][(c) + 1][1], va[dh][(c) + 1][2], va[dh][(c) + 1][3]}
        const bf16x8 a00 = VA8(0, 0), a02 = VA8(0, 2), a10 = VA8(1, 0), a12 = VA8(1, 2);
#undef VA8
        o0 = __builtin_amdgcn_mfma_f32_32x32x16_bf16(a00, pb0, o0, 0, 0, 0);
        o0 = __builtin_amdgcn_mfma_f32_32x32x16_bf16(a02, pb1, o0, 0, 0, 0);
        o1 = __builtin_amdgcn_mfma_f32_32x32x16_bf16(a10, pb0, o1, 0, 0, 0);
        o1 = __builtin_amdgcn_mfma_f32_32x32x16_bf16(a12, pb1, o1, 0, 0, 0);
        __builtin_amdgcn_sched_barrier(0);
        asm volatile("s_nop 15\n\ts_nop 15\n\ts_nop 15\n\ts_nop 15\n\ts_nop 15" ::: "memory");
        asm volatile("" :: "v"(a00), "v"(a02), "v"(a10), "v"(a12), "v"(pb0), "v"(pb1), "v"(kf[0]), "v"(kf[1]), "v"(kf[2]), "v"(kf[3]));
        __builtin_amdgcn_sched_barrier(0);
        if (__all(carry > 160.0f)) break;
#pragma unroll
        for (int j = 0; j < 4; ++j) { kf[j] = k1[j]; k1[j] = kn[j]; }
#pragma unroll
        for (int dh = 0; dh < 2; ++dh)
#pragma unroll
            for (int c = 0; c < 4; ++c) { va[dh][c] = v1[dh][c]; v1[dh][c] = vn[dh][c]; }
    }
#undef SB_LOAD
    bf16_t* op = CAT + (tok0 + q0 + r32) * DM + h * 64 + 4 * hi;
#pragma unroll
    for (int g = 0; g < 4; ++g) {
        u32x2 w0, w1;
        w0.x = cvt_pk_bf16(o0[4 * g], o0[4 * g + 1]); w0.y = cvt_pk_bf16(o0[4 * g + 2], o0[4 * g + 3]);
        w1.x = cvt_pk_bf16(o1[4 * g], o1[4 * g + 1]); w1.y = cvt_pk_bf16(o1[4 * g + 2], o1[4 * g + 3]);
        *(u32x2*)(op + 8 * g) = w0; *(u32x2*)(op + 32 + 8 * g) = w1;
    }
}


#define XB_TMO      128
#define XB_XCNT(j)  (256  + 64 * (j))
#define XB_XSUB(j)  (1280 + 64 * (j))
#define XB_XGEN(j)  (2304 + 64 * (j))
#define XB_TOP      3328
#define XB_TOPGEN   3392
#define XCD_BAR_WORDS 3456
#define XB_SPIN_CAP (1u << 22)
__device__ __forceinline__ unsigned xb_ld(unsigned* p)              { return __hip_atomic_load(p, __ATOMIC_RELAXED, __HIP_MEMORY_SCOPE_AGENT); }
__device__ __forceinline__ unsigned xb_add(unsigned* p, unsigned v) { return __hip_atomic_fetch_add(p, v, __ATOMIC_RELAXED, __HIP_MEMORY_SCOPE_AGENT); }
__device__ __forceinline__ unsigned xb_xcc_id() { return (unsigned)__builtin_amdgcn_s_getreg((3 << 11) | 20) & 0xFu; }
#define XB_SPIN(cond, bar) do { unsigned _sp = 0; while (cond) { __builtin_amdgcn_s_sleep(1); \
    if ((++_sp & 255u) == 0u) { if (xb_ld(&(bar)[XB_TMO])) break; if (_sp > XB_SPIN_CAP) { atomicAdd(&(bar)[XB_TMO], 1u); break; } } } } while (0)
__device__ __forceinline__ void xcd_barrier_complete(unsigned* bar, unsigned x, unsigned G, unsigned& nloc, unsigned& nx) {
    unsigned sum, cnt, mine, sp = 0u;
    for (;;) {
        sum = 0u; cnt = 0u; mine = 0u;
#pragma unroll
        for (unsigned j = 0; j < 16; ++j) { const unsigned c = xb_ld(&bar[XB_XCNT(j)]); sum += c; cnt += (c > 0u) ? 1u : 0u; mine = (j == x) ? c : mine; }
        if (sum == G) break;
        __builtin_amdgcn_s_sleep(1);
        if ((++sp & 255u) == 0u) { if (xb_ld(&bar[XB_TMO])) break; if (sp > XB_SPIN_CAP) { atomicAdd(&bar[XB_TMO], 1u); break; } }
    }
    nloc = mine > 0u ? mine : 1u; nx = cnt > 0u ? cnt : 1u;
}
__device__ __forceinline__ void xcd_barrier(unsigned* bar, volatile LAS unsigned* st, bool leader, unsigned G) {
    asm volatile("s_waitcnt vmcnt(0)" ::: "memory");
    __syncthreads();
    if (leader) {
        const unsigned x = xb_xcc_id();
        __builtin_amdgcn_s_waitcnt(0);
        unsigned nloc = st[0], nx = st[1];
        if (nloc == 0u) { xcd_barrier_complete(bar, x, G, nloc, nx); st[0] = nloc; st[1] = nx; }
        const unsigned old = xb_add(&bar[XB_XSUB(x)], 1u);
        const unsigned gen = old / nloc;
        if (old + 1u == (gen + 1u) * nloc) {
            __builtin_amdgcn_fence(__ATOMIC_RELEASE, "agent");
            asm volatile("s_waitcnt vmcnt(0)" ::: "memory");
            const unsigned og = xb_add(&bar[XB_TOP], 1u);
            const unsigned tg = og / nx;
            if (og + 1u == (tg + 1u) * nx) xb_add(&bar[XB_TOPGEN], 1u);
            else XB_SPIN(xb_ld(&bar[XB_TOPGEN]) == tg, bar);
            __builtin_amdgcn_fence(__ATOMIC_ACQUIRE, "agent");
            xb_add(&bar[XB_XGEN(x)], 1u);
            asm volatile("s_waitcnt vmcnt(0)" ::: "memory");
        } else {
            XB_SPIN(xb_ld(&bar[XB_XGEN(x)]) == gen, bar);
            __builtin_amdgcn_fence(__ATOMIC_ACQUIRE, "agent");
            asm volatile("s_waitcnt vmcnt(0)" ::: "memory");
        }
    }
    __syncthreads();
}

__global__ void __launch_bounds__(512) mega_fwd(Args a) {
    __builtin_assume(__builtin_amdgcn_workitem_id_y() == 0); __builtin_assume(__builtin_amdgcn_workitem_id_z() == 0);
    extern __shared__ __attribute__((aligned(16))) unsigned char lds_raw[];
    LAS unsigned char* lds = (LAS unsigned char*)lds_raw;
    LAS unsigned char* xl = lds + XL_OFF;
    cg::grid_group grid = cg::this_grid();
#if !MK_MULTI_LAUNCH
    {
        volatile LAS unsigned* st = (volatile LAS unsigned*)(lds + XBST_OFF);
        if (threadIdx.x == 0) { st[0] = 0u; st[1] = 0u; KArgs ap0 = kargs(); xb_add(&((unsigned*)ap0->ws)[XB_XCNT(xb_xcc_id())], 1u); }
        if (a.ph_lo < 0) grid.sync();
        __syncthreads();
    }
#endif
#if MK_MULTI_LAUNCH
    const int lo = a.ph_lo, hi = a.ph_hi;
    int ph = 0;
#endif
#define PH_VARS int tid = threadIdx.x; asm volatile("" : "+v"(tid)); const int lane = tid & 63, wave = __builtin_amdgcn_readfirstlane(tid >> 6); int G_ = gridDim.x, bid_ = blockIdx.x; asm volatile("" : "+s"(G_), "+s"(bid_)); const int G = G_, bid = bid_; \
    const int gw = bid * 8 + wave, NGW = G * 8, gt = bid * 512 + tid, NGT = G * 512; (void)lane; (void)gw; (void)NGW; (void)gt; (void)NGT; KArgs ap = kargs(); unsigned char* ws = ap->ws; float* X = ap->out; float* SSQ = (float*)(ws + WS_SSQ); bf16_t* XB = (bf16_t*)(ws + WS_XB); bf16_t* MEMN = (bf16_t*)(ws + WS_MEMN); (void)X; (void)SSQ; (void)XB; (void)MEMN;
#if MK_MULTI_LAUNCH
#define PHASE_ON (ph >= lo && ph < hi)
#define PHASE_END do { if (ph >= lo && ph + 1 < hi) grid.sync(); ++ph; } while (0)
#define LOCAL_SEAM PHASE_END
#else
#define PHASE_ON (true)
#define LOCAL_SEAM do { asm volatile("s_waitcnt vmcnt(0)" ::: "memory"); __syncthreads(); { int tl = threadIdx.x; asm volatile("" : "+v"(tl)); \
    if (tl == 0) { __builtin_amdgcn_fence(__ATOMIC_ACQUIRE, "agent"); asm volatile("s_waitcnt vmcnt(0)" ::: "memory"); } } __syncthreads(); } while (0)
#define PHASE_END do { KArgs apb = kargs(); int tb = threadIdx.x; asm volatile("" : "+v"(tb)); int Gb = gridDim.x; asm volatile("" : "+s"(Gb)); \
    xcd_barrier((unsigned*)apb->ws, (volatile LAS unsigned*)(lds + XBST_OFF), tb == 0, (unsigned)Gb); } while (0)
#endif

    if (PHASE_ON) { PH_VARS
        if (bid < 64) ssm_tables(ap, bid, lds, (bf16_t*)(ws + WS_TG), (bf16_t*)(ws + WS_WEND));
        LAS float* scr = (LAS float*)(lds + wave * 16384);
        const bool weighted = (G > 64);
        const int n_tw = weighted ? 64 * 8 : 0, n_nw = weighted ? (G - 64) * 8 : G * 8;
        const int spw = weighted ? 4 : 1, S = n_nw * spw + n_tw;
        const bool is_tw = weighted && bid < 64;
        const int slot0 = is_tw ? n_nw * spw + gw : (weighted ? (gw - 512) * 4 : gw), nslot = is_tw ? 1 : spw;
        if (!is_tw) {
            const int nb_ = weighted ? G - 64 : G, b_ = weighted ? bid - 64 : bid;
            for (int it = b_ + wave * nb_; it < 256; it += nb_ * 8) {
                const int g = it >> 6, cb = (it >> 2) & 15, nb = it & 3;
                const float* pw = ap->in[8] + (size_t)(g * 128 + cb * 8) * 128; const float* sc = ap->in[9] + g * 128;
                const float* wo = ap->in[10] + (size_t)(512 + g * 128) * 1024 + nb * 256 + lane * 4;
                f32x4 acc8[8];
#pragma unroll
                for (int j = 0; j < 8; ++j) acc8[j] = (f32x4){0.f, 0.f, 0.f, 0.f};
#pragma unroll 8
                for (int d = 0; d < 128; ++d) {
                    const f32x4 wv = *(const f32x4*)(wo + (size_t)d * 1024); const float sd = sc[d];
#pragma unroll
                    for (int j = 0; j < 8; ++j) acc8[j] += wv * (pw[j * 128 + d] * sd);
                }
                bf16_t* D = (bf16_t*)(ws + WS_WOUT) + (size_t)(nb * 256 + lane * 4) * 1024 + 512 + g * 128 + cb * 8;
#pragma unroll
                for (int e = 0; e < 4; ++e) {
                    u32x4 w; w.x = cvt_pk_bf16(acc8[0][e], acc8[1][e]); w.y = cvt_pk_bf16(acc8[2][e], acc8[3][e]); w.z = cvt_pk_bf16(acc8[4][e], acc8[5][e]); w.w = cvt_pk_bf16(acc8[6][e], acc8[7][e]);
                    *(u32x4*)(D + (size_t)e * 1024) = w;
                }
            }
        }
        {
            float tv[32]; TItem cur, nxt; bool have = false, have_next = false;
            int sl = 0, it = slot0;
            auto decode = [&](int item, TItem& t) -> bool {
                int r = item; const float* W = nullptr; const float* gk = nullptr; int N = 0; bf16_t* D = nullptr; int ldt = 0, mode = 0; bool found = false;
#define TJOB(Wp, Kk, Nn, Dp, Ld, Md, Gp) if (!found) { const int cnt = ((Kk) / 64) * ((Nn) / 32); if (r < cnt) { W = (Wp); N = (Nn); D = (bf16_t*)(Dp); ldt = (Ld); mode = (Md); gk = (Gp); found = true; } else r -= cnt; }
                TJOB(ap->in[7], 1024, 2048, ws + WS_WIN, 1024, 1, nullptr)
            TJOB(ap->in[10], 512, 1024, ws + WS_WOUT, 1024, 0, nullptr)
            TJOB(ap->in[11], 1024, 1024, ws + WS_WSSM, 1024, 0, ap->in[2] + 1024)
            TJOB(ap->in[20], 1024, 2048, ws + WS_WGLU, 1024, 2, nullptr)
#pragma unroll
            for (int l = 0; l < 2; ++l) {
                unsigned char* lb = ws + WS_LAYER + l * LAYER_STRIDE;
                TJOB(ap->in[22] + (size_t)l * 1024 * 2048, 1024, 2048, lb + LO_WKV, 1024, 0, nullptr)
                TJOB(ap->in[23] + (size_t)l * 1024 * 1024, 1024, 1024, lb + LO_WO, 1024, 0, nullptr)
                TJOB(ap->in[24] + (size_t)l * 1024 * DFF2, 1024, DFF2, lb + LO_WUP, 1024, 3, ap->in[4] + l * 1024)
                TJOB(ap->in[27] + (size_t)l * DFF * 1024, DFF, 1024, lb + LO_WDN, DFF, 0, nullptr)
            }
#undef TJOB
                if (!found) return false;
                const int nblk = N / 32, kb = r / nblk, nb = r % nblk, n0 = nb * 32;
                int drow0 = n0;
                if (mode == 1) drow0 = (n0 < 1024) ? n0 : (n0 < 1536 ? n0 + 512 : n0 - 512);
                else if (mode == 2) drow0 = (n0 < 1024) ? (256 * (n0 >> 7) + (n0 & 127)) : (256 * ((n0 - 1024) >> 7) + 128 + ((n0 - 1024) & 127));
                else if (mode == 3) drow0 = (n0 < DFF) ? (256 * (n0 >> 7) + (n0 & 127)) : (256 * ((n0 - DFF) >> 7) + 128 + ((n0 - DFF) & 127));
                t.W = W; t.gk = gk; t.D = D; t.N = N; t.ldt = ldt; t.drow0 = drow0; t.k0 = kb * 64; t.n0 = n0; return true;
            };
            auto advance = [&](TItem& t) -> bool {
                while (sl < nslot) { if (decode(it, t)) { it += S; return true; } ++sl; it = slot0 + sl; }
                return false;
            };
            have = advance(cur);
            if (have) titem_load(tv, cur, lane);
            while (have) {
                titem_to_lds(tv, scr, lane);
                have_next = advance(nxt);
                if (have_next) titem_load(tv, nxt, lane);
                titem_store(cur, scr, lane);
                cur = nxt; have = have_next;
            }
        }
        for (int it = gt; it < 2 * 1024 * 256; it += NGT) {
            const int l = it >> 18, e = it & 262143, k = e >> 8, n4 = (e & 255) * 4;
            const f32x4 w = *(const f32x4*)(ap->in[21] + (size_t)l * 1048576 + (size_t)k * 1024 + n4); const float gk = ap->in[3][l * 1024 + k];
            u32x2 o; o.x = cvt_pk_bf16(w[0] * gk, w[1] * gk); o.y = cvt_pk_bf16(w[2] * gk, w[3] * gk);
            *(u32x2*)((bf16_t*)(ws + WS_LAYER + l * LAYER_STRIDE + LO_WQ) + (size_t)k * 1024 + n4) = o;
        }
        for (int r = gw; r < MEMTOK / 4; r += NGW) rms_rows4_to_bf16(ap->in[1] + (size_t)r * 4 * DM, ap->in[5], MEMN + (size_t)r * 4 * DM, lane);
        for (int r = gw; r < MTOK / 4; r += NGW) rms_rows4_to_bf16(ap->in[0] + (size_t)r * 4 * DM, ap->in[2], XB + (size_t)r * 4 * DM, lane);
        __syncthreads();
    }
    PHASE_END;

    if (PHASE_ON) { PH_VARS
        bf16_t* WIN = (bf16_t*)(ws + WS_WIN);
        { pg8::SchedStd S; S.init(XB, 256 * 2048, WIN, 256 * 2048, 128, 6, G, bid);
          pg8::EpiStore E{(bf16_t*)(ws + WS_QKU), 1536, nullptr, 0, 1.0f, 0};
          pg8::gemm_phase(lds, xl, 1024, 1024, 1024, S, E); }
        { pg8::SchedStd S; S.init(WIN + (size_t)1536 * 1024, 256 * 2048, XB, 256 * 2048, 2, 128, G, bid);
          pg8::EpiStore E{(bf16_t*)(ws + WS_VT), VT_LD, nullptr, 0, 1.0f, 0};
          pg8::gemm_phase(lds, xl, 1024, 1024, 1024, S, E); }
        for (int j = 0; j < 4; ++j) {
            const int l = j >> 1, isv = j & 1;
            bf16_t* WKV = (bf16_t*)(ws + WS_LAYER + l * LAYER_STRIDE + LO_WKV);
            const int c = (bid + 64 * (j + 1)) % G;
            pg8::SchedStd S;
            S.init(MEMN, 256 * 2048, WKV + (size_t)isv * 1024 * 1024, 256 * 2048, 16, 4, G, c);
            pg8::EpiStore E{isv ? (bf16_t*)(ws + WS_MEMVT + l * MEMVT_STRIDE) : (bf16_t*)(ws + WS_MEMK + l * 8 * MiB), 1024, nullptr, 0, 1.0f, 0};
            pg8::gemm_phase(lds, xl, 1024, 1024, 1024, S, E);
        }
    }
    PHASE_END;

    if (PHASE_ON) { PH_VARS
        const bf16_t* QKU = (const bf16_t*)(ws + WS_QKU); bf16_t* CAT = (bf16_t*)(ws + WS_CAT);
        for (int it = gt; it < 64 * (MTOK / 32); it += NGT) {
            const int ch = it & 63, seg = it >> 6, g = ch >> 4;
            const bf16_t* up = QKU + (size_t)seg * 32 * 1536 + 1024 + ch * 8;
            bf16_t* op = CAT + (size_t)seg * 32 * DM + 512 + ch * 8;
            const int t0 = (seg * 32) & (SEQ - 1);
            if (g == 0) pool_segment<2>(up, op, t0); else if (g == 1) pool_segment<4>(up, op, t0); else if (g == 2) pool_segment<8>(up, op, t0); else pool_segment<16>(up, op, t0);
        }
        for (int task = gw; task < 128 * 64; task += NGW) {
            const int bh = task >> 6; int qb = task & 63; if ((bh >> 5) & 1) qb = 63 - qb;
            sb_attn_task(QKU, (const bf16_t*)(ws + WS_VT), CAT, bh >> 3, bh & 7, qb, lane);
        }
    }
    PHASE_END;

    if (PHASE_ON) { PH_VARS
        pg8::SchedStd S; S.init(ws + WS_CAT, 256 * 2048, ws + WS_WOUT, 256 * 2048, 128, 4, G, bid);
        pg8::EpiResid E{ap->in[0], XB, SSQ};
        pg8::gemm_phase(lds, xl, 1024, 1024, 1024, S, E);
        pg8::SchedG SG{(const char*)(ws + WS_MEMK), (const char*)(ws + WS_LAYER + LO_WQ), G, bid};
        pg8::EpiStore EG{(bf16_t*)(ws + WS_GT), 1024, nullptr, 0, 1.0f, 0};
        pg8::gemm_phase(lds, xl, 1024, 1024, 256, SG, EG);
    }
    PHASE_END;

#pragma nounroll
    for (int layer = 0; layer < 2; ++layer) {
        if (layer == 1) {
            if (PHASE_ON) { PH_VARS
                pg8::SchedStd S; S.init(XB, 256 * 2048, ws + WS_WSSM, 256 * 2048, 128, 4, G, bid);
                pg8::EpiStore E{(bf16_t*)(ws + WS_UG), 0, SSQ, 16, 1.0f, 1};
                pg8::gemm_phase(lds, xl, 1024, 1024, 1024, S, E);
            }
            PHASE_END;
            if (PHASE_ON) { PH_VARS
                pg8::SchedS2 S{(const char*)(ws + WS_UG), (const char*)(ws + WS_WEND), G, bid};
                pg8::EpiHend E{(float*)(ws + WS_HEND)};
                pg8::gemm_phase(lds, xl, 640, 512, 512, S, E);
            }
            PHASE_END;
            if (PHASE_ON) { PH_VARS
                bf16_t* UG = (bf16_t*)(ws + WS_UG); const float* HE = (const float*)(ws + WS_HEND);
                for (int it = gt; it < NBATCH * 64 * 64; it += NGT) {
                    const int p = it & 63, g = (it >> 6) & 63, b = it >> 12;
                    const float dt = expf(ap->in[14][g]);
                    const float mag = expf(32.0f * (ap->in[12][g * 64 + p] * dt)), ang = 32.0f * (ap->in[13][g * 64 + p] * dt);
                    const float lr = mag * cosf(ang), li = mag * sinf(ang);
                    float hr = 0.f, hi_ = 0.f;
                    for (int c0 = 0; c0 < 64; c0 += 8) {
                        const size_t row0 = (size_t)g * 1024 + b * 64 + c0;
                        float er[8], ei[8];
#pragma unroll
                        for (int j = 0; j < 8; ++j) { er[j] = HE[(row0 + j) * 128 + p]; ei[j] = HE[(row0 + j) * 128 + 64 + p]; }
#pragma unroll
                        for (int j = 0; j < 8; ++j) {
                            UG[(row0 + j) * 640 + 512 + p] = (bf16_t)(cvt_pk_bf16(hr, 0.f) & 0xffffu);
                            UG[(row0 + j) * 640 + 576 + p] = (bf16_t)(cvt_pk_bf16(hi_, 0.f) & 0xffffu);
                            const float nr = lr * hr - li * hi_ + er[j], ni = lr * hi_ + li * hr + ei[j];
                            hr = nr; hi_ = ni;
                        }
                    }
                }
            }
            PHASE_END;
            if (PHASE_ON) { PH_VARS
                pg8::SchedS4 S{(const char*)(ws + WS_UG), (const char*)(ws + WS_TG), G, bid};
                pg8::EpiSsmY E{(const bf16_t*)(ws + WS_UG), ap->in[19], (bf16_t*)(ws + WS_YG)};
                pg8::gemm_phase(lds, xl, 640, 640, 640, S, E);
            }
            PHASE_END;
            if (PHASE_ON) { PH_VARS
                pg8::SchedStd S; S.init(ws + WS_YG, 256 * 2048, ws + WS_WGLU, 256 * 2048, 128, 8, G, bid);
                pg8::EpiGlu E{XB, SSQ};
                pg8::gemm_phase(lds, xl, 1024, 1024, 1024, S, E);
            }
            PHASE_END;
        }
        if (PHASE_ON) { PH_VARS
            pg8::SchedXS2 S{(const char*)XB, (const char*)(ws + WS_GT + (size_t)layer * 32 * MiB), G, bid};
            pg8::EpiSoftmax E{(bf16_t*)(ws + WS_P), SSQ, layer == 0 ? 16 : 32, 0.0625f};
            pg8::gemm_phase(lds, xl, 1024, 1024, 1024, S, E);
        }
        if (PHASE_ON) { PH_VARS
            unsigned char* lb = ws + WS_LAYER + layer * LAYER_STRIDE;
            pg8::SchedVW S{(const char*)(lb + LO_WO), (const char*)(ws + WS_MEMVT + layer * MEMVT_STRIDE), G, bid};
            pg8::EpiStore E{(bf16_t*)(ws + WS_QX), 1024, nullptr, 0, 1.0f, 0};
            pg8::gemm_phase(lds, xl, 1024, 1024, 256, S, E);
        }
        PHASE_END;
        if (PHASE_ON) { PH_VARS
            pg8::SchedXOut S{(const char*)(ws + WS_P), (const char*)(ws + WS_QX), G, bid};
            pg8::EpiResid E{nullptr, XB, SSQ};
            pg8::gemm_phase(lds, xl, 1024, 1024, 1024, S, E);
        }
        PHASE_END;
        if (PHASE_ON) { PH_VARS
            unsigned char* lb = ws + WS_LAYER + layer * LAYER_STRIDE;
            pg8::SchedStd S; S.init(XB, 256 * 2048, lb + LO_WUP, 256 * 2048, 128, 22, G, bid);
            pg8::EpiUpConv E{(bf16_t*)(ws + WS_H), (bf16_t*)(ws + WS_HALO), SSQ, ap->in[25] + (size_t)layer * 3 * DFF2, ap->in[26] + (size_t)layer * DFF2};
            pg8::gemm_phase(lds, xl, 1024, 1024, 1024, S, E);
        }
        PHASE_END;
        if (PHASE_ON) { PH_VARS
            const bf16_t* HALO = (const bf16_t*)(ws + WS_HALO); bf16_t* H = (bf16_t*)(ws + WS_H);
            const float* cw = ap->in[25] + (size_t)layer * 3 * DFF2; const float* cb = ap->in[26] + (size_t)layer * DFF2;
            pg8::SchedStd S0; S0.init(ws + WS_H, 256u * DFF * 2, ws, 0u, 128, 4, G, bid);
            pg8::Unit uu;
            for (int ui = 0; S0.next(ui, uu); ++ui) {
                const int pm = uu.pm;
                if ((pm & 7) == 0) continue;
                for (int it = tid; it < 2 * 352; it += 512) {
                    const int chk = it % 352, rr = it / 352, c0 = chk * 8;
                    const bf16_t* cur = HALO + (size_t)(pm * 4 + rr) * DFF2;
                    const bf16_t* p1 = rr ? HALO + (size_t)(pm * 4) * DFF2 : HALO + (size_t)(pm * 4 - 1) * DFF2;
                    const bf16_t* p2 = rr ? HALO + (size_t)(pm * 4 - 1) * DFF2 : HALO + (size_t)(pm * 4 - 2) * DFF2;
                    float o[8];
                    const u32x4 av = *(const u32x4*)(cur + c0), ag = *(const u32x4*)(cur + DFF + c0);
                    const u32x4 a1 = *(const u32x4*)(p1 + c0), g1 = *(const u32x4*)(p1 + DFF + c0), a2 = *(const u32x4*)(p2 + c0), g2 = *(const u32x4*)(p2 + DFF + c0);
                    const float v0[8] = {bflo(av.x), bfhi(av.x), bflo(av.y), bfhi(av.y), bflo(av.z), bfhi(av.z), bflo(av.w), bfhi(av.w)};
                    const float g0[8] = {bflo(ag.x), bfhi(ag.x), bflo(ag.y), bfhi(ag.y), bflo(ag.z), bfhi(ag.z), bflo(ag.w), bfhi(ag.w)};
                    const float v1[8] = {bflo(a1.x), bfhi(a1.x), bflo(a1.y), bfhi(a1.y), bflo(a1.z), bfhi(a1.z), bflo(a1.w), bfhi(a1.w)};
                    const float gg1[8] = {bflo(g1.x), bfhi(g1.x), bflo(g1.y), bfhi(g1.y), bflo(g1.z), bfhi(g1.z), bflo(g1.w), bfhi(g1.w)};
                    const float v2[8] = {bflo(a2.x), bfhi(a2.x), bflo(a2.y), bfhi(a2.y), bflo(a2.z), bfhi(a2.z), bflo(a2.w), bfhi(a2.w)};
                    const float gg2[8] = {bflo(g2.x), bfhi(g2.x), bflo(g2.y), bfhi(g2.y), bflo(g2.z), bfhi(g2.z), bflo(g2.w), bfhi(g2.w)};
    #pragma unroll
                    for (int j = 0; j < 8; ++j) {
                        const int c = c0 + j;
                        const float cv = cb[c] + cw[c] * v2[j] + cw[DFF2 + c] * v1[j] + cw[2 * DFF2 + c] * v0[j];
                        const float cgt = cb[DFF + c] + cw[DFF + c] * gg2[j] + cw[DFF2 + DFF + c] * gg1[j] + cw[2 * DFF2 + DFF + c] * g0[j];
                        o[j] = cv * cgt * frcp(1.0f + fexp(-cgt));
                    }
                    u32x4 w; w.x = cvt_pk_bf16(o[0], o[1]); w.y = cvt_pk_bf16(o[2], o[3]); w.z = cvt_pk_bf16(o[4], o[5]); w.w = cvt_pk_bf16(o[6], o[7]);
                    *(u32x4*)(H + (size_t)(pm * 256 + rr) * DFF + c0) = w;
                }
            }
        }
        LOCAL_SEAM;
        if (PHASE_ON) { PH_VARS
            unsigned char* lb = ws + WS_LAYER + layer * LAYER_STRIDE;
            pg8::SchedStd S; S.init(ws + WS_H, 256u * DFF * 2, lb + LO_WDN, 256u * DFF * 2, 128, 4, G, bid);
            pg8::EpiResid E{nullptr, XB, SSQ};
            pg8::gemm_phase(lds, xl, DFF, DFF, DFF, S, E);
        }
        PHASE_END;
    }

    if (PHASE_ON) { PH_VARS
        for (int m4 = gw; m4 < MTOK / 4; m4 += NGW) {
            const f32x4* gr = (const f32x4*)ap->in[6] + lane;
            f32x4 v[4][4]; float sq[4];
#pragma unroll
            for (int r = 0; r < 4; ++r)
#pragma unroll
                for (int j = 0; j < 4; ++j) { const u32x2 o = *((const u32x2*)(XB + (size_t)(m4 * 4 + r) * DM) + lane + 64 * j); v[r][j] = (f32x4){bflo(o.x), bfhi(o.x), bflo(o.y), bfhi(o.y)}; }
#pragma unroll
            for (int r = 0; r < 4; ++r) { sq[r] = 0.f;
#pragma unroll
                for (int j = 0; j < 4; ++j) sq[r] += (v[r][j].x * v[r][j].x + v[r][j].y * v[r][j].y) + (v[r][j].z * v[r][j].z + v[r][j].w * v[r][j].w); }
#pragma unroll
            for (int r = 0; r < 4; ++r) sq[r] = 1.f / sqrtf(wave_sum(sq[r]) * (1.f / DM) + EPS);
#pragma unroll
            for (int j = 0; j < 4; ++j) { const f32x4 gg = gr[64 * j];
#pragma unroll
                for (int r = 0; r < 4; ++r) *((f32x4*)(X + (size_t)(m4 * 4 + r) * DM) + lane + 64 * j) = v[r][j] * sq[r] * gg; }
        }
    }
#undef PHASE_ON
#undef PHASE_END
}

constexpr int N_PHASES = 4 + 7 + 5 + 7 + 1;

extern "C" void kernel_launch(void* const* d_in, const int* in_sizes, int n_in, void* d_out, int out_size, void* d_ws, size_t ws_size, hipStream_t stream) {
    static int grid = 0;
    if (grid == 0) {
        if (n_in != 28 || in_sizes[0] != MTOK * DM || out_size != MTOK * DM || ws_size < WS_END) {
            fprintf(stderr, "kernel_launch: unexpected shapes (n_in %d, in0 %d, out %d, ws %zu); nothing launched\n", n_in, n_in > 0 ? in_sizes[0] : -1, out_size, ws_size); grid = -1; return; }
        int dev = 0, cus = 0, per_cu = 0;
        if (hipGetDevice(&dev) != hipSuccess || hipDeviceGetAttribute(&cus, hipDeviceAttributeMultiprocessorCount, dev) != hipSuccess) { grid = -1; return; }
        if (hipFuncSetAttribute((const void*)mega_fwd, hipFuncAttributeMaxDynamicSharedMemorySize, LDS_BYTES) != hipSuccess) { fprintf(stderr, "kernel_launch: hipFuncSetAttribute failed\n"); grid = -1; return; }
        if (hipOccupancyMaxActiveBlocksPerMultiprocessor(&per_cu, (const void*)mega_fwd, 512, LDS_BYTES) != hipSuccess || per_cu < 1) per_cu = 1;
        (void)hipGetLastError();
        grid = cus * per_cu;
    }
    if (grid < 0) return;
    Args a{};
    for (int i = 0; i < 28; ++i) a.in[i] = (const float*)d_in[i];
    a.out = (float*)d_out; a.ws = (unsigned char*)d_ws;
#if MK_MULTI_LAUNCH
    for (int p = 0; p < N_PHASES; ++p) {
        a.ph_lo = p; a.ph_hi = p + 1;
        hipLaunchKernelGGL(mega_fwd, dim3(grid), dim3(512), LDS_BYTES, stream, a);
    }
#else
    a.ph_lo = 0; a.ph_hi = N_PHASES;
    if (hipMemsetAsync(d_ws, 0, 16384, stream) != hipSuccess) { fprintf(stderr, "kernel_launch: memset of the barrier words failed\n"); return; }
    void* args[] = {&a};
    hipError_t e = hipLaunchCooperativeKernel((const void*)mega_fwd, dim3(grid), dim3(512), args, LDS_BYTES, stream);
    if (e != hipSuccess) fprintf(stderr, "cooperative launch failed: %s (grid %d)\n", hipGetErrorString(e), grid);
#endif
}
```

```cpp
#include <hip/hip_runtime.h>
#include <hip/hip_cooperative_groups.h>
#include <cstdio>
#include <cstdint>
namespace cg = cooperative_groups;

#ifndef MK_MULTI_LAUNCH
#define MK_MULTI_LAUNCH 0
#endif

#define LAS __attribute__((address_space(3)))
typedef unsigned short bf16_t;
typedef short bf16x8 __attribute__((ext_vector_type(8)));
typedef short s16x4 __attribute__((ext_vector_type(4)));
typedef float f32x4 __attribute__((ext_vector_type(4)));
typedef float f32x16 __attribute__((ext_vector_type(16)));
typedef unsigned u32x4 __attribute__((ext_vector_type(4)));
typedef unsigned u32x2 __attribute__((ext_vector_type(2)));

constexpr int MTOK = 32768, DM = 1024, SEQ = 2048, NBATCH = 16, DFF = 2816, DFF2 = 5632, MEMTOK = 4096;
constexpr int MHALF = 16384;
constexpr float EPS = 1e-6f;
constexpr float LOG2E = 1.4426950408889634f, LN2 = 0.6931471805599453f;

constexpr size_t MiB = 1u << 20;
constexpr size_t WS_SSQ = 1 * MiB;
constexpr size_t WS_WIN = 5 * MiB;
constexpr size_t WS_WOUT = 9 * MiB;
constexpr size_t WS_WSSM = 11 * MiB;
constexpr size_t WS_WGLU = 13 * MiB;
constexpr size_t WS_LAYER = 17 * MiB, LAYER_STRIDE = 25 * MiB;
constexpr size_t LO_WQ = 0, LO_WKV = 2 * MiB, LO_WO = 6 * MiB, LO_WUP = 8 * MiB, LO_WDN = 19 * MiB;
constexpr size_t WS_WEND = 67 * MiB;
constexpr size_t WS_TG = 83 * MiB;
constexpr size_t WS_MEMN = 123 * MiB;
constexpr size_t WS_MEMK = 131 * MiB;
constexpr size_t WS_MEMVT = 147 * MiB, MEMVT_STRIDE = 9 * MiB;
constexpr size_t WS_XB = 165 * MiB;
constexpr size_t WS_T = 229 * MiB;
constexpr size_t WS_QKU = WS_T, WS_VT = WS_T + 96 * MiB, WS_CAT = WS_T + 132 * MiB;
constexpr int VT_LD = MTOK + 128, MVT_LD = 4096 + 128;
constexpr size_t WS_QX = WS_T, WS_P = WS_T + 64 * MiB, WS_O = WS_T + 128 * MiB;
constexpr size_t WS_H = WS_T, WS_HALO = WS_T + 176 * MiB;
constexpr size_t WS_UG = WS_T, WS_HEND = WS_T + 80 * MiB, WS_YG = WS_T + 112 * MiB;
constexpr size_t WS_GT = 426 * MiB;
constexpr size_t WS_END = 512 * MiB;
static_assert(WS_H + (size_t)MTOK * DFF * 2 <= WS_HALO && WS_HALO + (size_t)128 * 4 * DFF2 * 2 <= WS_GT && WS_CAT + (size_t)MTOK * DM * 2 <= WS_GT && WS_GT + 64 * MiB <= WS_END, "ws map");

typedef float f32x2_t __attribute__((ext_vector_type(2))); typedef __bf16 bf16x2_t __attribute__((ext_vector_type(2)));
__device__ __forceinline__ unsigned cvt_pk_bf16(float lo, float hi) { f32x2_t v = {lo, hi}; bf16x2_t b = __builtin_convertvector(v, bf16x2_t); return __builtin_bit_cast(unsigned, b); }
__device__ __forceinline__ float bf2f(unsigned short b) { return __uint_as_float(((unsigned)b) << 16); }
__device__ __forceinline__ float bflo(unsigned w) { return __uint_as_float(w << 16); }
__device__ __forceinline__ float bfhi(unsigned w) { return __uint_as_float(w & 0xffff0000u); }
__device__ __forceinline__ float fexp2(float x) { return __builtin_amdgcn_exp2f(x); }
__device__ __forceinline__ float flog2(float x) { return __builtin_amdgcn_logf(x); }
__device__ __forceinline__ float fexp(float x) { return __builtin_amdgcn_exp2f(x * LOG2E); }
__device__ __forceinline__ float frcp(float x) { return __builtin_amdgcn_rcpf(x); }
template <int M> __device__ __forceinline__ float swz_xor(float v) { return __int_as_float(__builtin_amdgcn_ds_swizzle(__float_as_int(v), (M << 10) | 0x1f)); }
__device__ __forceinline__ float sum_x16(float v) { auto r = __builtin_amdgcn_permlane16_swap(__float_as_uint(v), __float_as_uint(v), false, false); return __uint_as_float(r[0]) + __uint_as_float(r[1]); }
__device__ __forceinline__ float sum_x32(float v) { auto r = __builtin_amdgcn_permlane32_swap(__float_as_uint(v), __float_as_uint(v), false, false); return __uint_as_float(r[0]) + __uint_as_float(r[1]); }
__device__ __forceinline__ float max_x16(float v) { auto r = __builtin_amdgcn_permlane16_swap(__float_as_uint(v), __float_as_uint(v), false, false); return fmaxf(__uint_as_float(r[0]), __uint_as_float(r[1])); }
__device__ __forceinline__ float max_x32(float v) { auto r = __builtin_amdgcn_permlane32_swap(__float_as_uint(v), __float_as_uint(v), false, false); return fmaxf(__uint_as_float(r[0]), __uint_as_float(r[1])); }
__device__ __forceinline__ float partner32(float v, int hi) { auto r = __builtin_amdgcn_permlane32_swap(__float_as_uint(v), __float_as_uint(v), false, false); return hi ? __uint_as_float(r[0]) : __uint_as_float(r[1]); }
__device__ __forceinline__ float wave_sum(float v) {
    v += swz_xor<1>(v); v += swz_xor<2>(v); v += swz_xor<4>(v); v += swz_xor<8>(v); v = sum_x16(v); v = sum_x32(v);
    return v;
}
#define LDS_WAIT() asm volatile("s_waitcnt lgkmcnt(0)" ::: "memory")

namespace pg8 {
constexpr int BM = 256, BK = 64, HALF = 128, HTB = HALF * BK * 2, STAGE_BYTES = 8 * HTB, NXCD = 8, WGM = 8;
__host__ __device__ __forceinline__ int lds_byte(int r, int c) { const int st = (r >> 4) * 2 + (c >> 5), rr = r & 15, cc = c & 31, ob = rr * 64 + cc * 2; return st * 1024 + (ob ^ (((ob >> 9) & 1) << 5)); }
__host__ __device__ __forceinline__ void stage_rc(int b, int& R, int& C) { const int st = b / 1024, sb = b % 1024, swz = sb ^ (((sb >> 9) & 1) << 5); R = (st >> 1) * 16 + swz / 64; C = (st & 1) * 32 + (swz % 64) / 2; }
__host__ __device__ __forceinline__ int perm32(int rho) { const int n = rho >> 4, i = rho & 15; return 8 * (i >> 2) + 4 * n + (i & 3); }

struct Unit { int pm, pn; const char* a; const char* b; };

struct SchedStd {
    const char* A; const char* B; unsigned sA, sB; int nM, nN, G, c;
    __device__ __forceinline__ void init(const void* A_, unsigned sA_, const void* B_, unsigned sB_, int nM_, int nN_, int G_, int c_) { A = (const char*)A_; B = (const char*)B_; sA = sA_; sB = sB_; nM = nM_; nN = nN_; G = G_; c = c_; }
    __device__ __forceinline__ bool next(int i, Unit& u) const {
        const int nwg = nM * nN; const long L = (long)i * G + c; if (L >= nwg) return false;
        int wgid = (int)L; { const int q = nwg / NXCD, r = nwg % NXCD, xcd = wgid % NXCD, off = wgid / NXCD; wgid = (xcd < r ? xcd * (q + 1) : r * (q + 1) + (xcd - r) * q) + off; }
        const int nig = WGM * nN, gid = wgid / nig, fm = gid * WGM, gsz = (nM - fm) < WGM ? (nM - fm) : WGM;
        u.pm = fm + ((wgid % nig) % gsz); u.pn = (wgid % nig) / gsz;
        u.a = A + (size_t)u.pm * sA; u.b = B + (size_t)u.pn * sB; return true;
    }
};
struct SchedXS {
    const char* A; const char* B; int G, c;
    __device__ __forceinline__ bool next(int i, Unit& u) const {
        const long L = (long)i * G + c; if (L >= 512) return false;
        u.pm = (int)(L >> 2); u.pn = (int)(L & 3);
        u.a = A + (size_t)u.pm * 256 * 2048 + u.pn * 512; u.b = B + (size_t)(u.pm >> 3) * 256 * 2048 + u.pn * 512; return true;
    }
};
struct SchedXQ {
    const char* A; const char* B; int G, c;
    __device__ __forceinline__ bool next(int i, Unit& u) const {
        const long L = (long)i * G + c; if (L >= 512) return false;
        u.pm = (int)(L >> 2); u.pn = (int)(L & 3);
        u.a = A + (size_t)u.pm * 256 * 2048; u.b = B + (size_t)u.pn * 256 * 2048; return true;
    }
};
struct SchedG {
    const char* MK; const char* WQ; int G, c;
    __device__ __forceinline__ bool next(int i, Unit& u) const {
        const long L = (long)i * G + c; if (L >= 512) return false;
        const int l = (int)(L >> 8), r = (int)(L & 255), b = r >> 4, h = (r >> 2) & 3, pn = r & 3;
        u.pm = l * 64 + b * 4 + h; u.pn = pn;
        u.a = MK + (size_t)l * 8 * 1048576 + (size_t)b * 256 * 2048 + h * 512; u.b = WQ + (size_t)l * LAYER_STRIDE + (size_t)pn * 256 * 2048 + h * 512; return true;
    }
};
struct SchedXS2 {
    const char* A; const char* B; int G, c;
    __device__ __forceinline__ bool next(int i, Unit& u) const {
        const long L = (long)i * G + c; if (L >= 512) return false;
        u.pm = (int)(L >> 2); u.pn = (int)(L & 3);
        u.a = A + (size_t)u.pm * 256 * 2048; u.b = B + (size_t)((u.pm >> 3) * 4 + u.pn) * 256 * 2048; return true;
    }
};
struct SchedVW {
    const char* WO; const char* MV; int G, c;
    __device__ __forceinline__ bool next(int i, Unit& u) const {
        const long L = (long)i * G + c; if (L >= 256) return false;
        const int b = (int)(L >> 4), pq = (int)(L >> 2) & 3, h = (int)L & 3;
        u.pm = b * 4 + pq; u.pn = h;
        u.a = WO + (size_t)pq * 256 * 2048 + h * 512; u.b = MV + (size_t)b * 256 * 2048 + h * 512; return true;
    }
};
struct SchedXOut {
    const char* A; const char* B; int G, c;
    __device__ __forceinline__ bool next(int i, Unit& u) const {
        const long L = (long)i * G + c; if (L >= 512) return false;
        u.pm = (int)(L >> 2); u.pn = (int)(L & 3);
        u.a = A + (size_t)u.pm * 256 * 2048; u.b = B + ((size_t)(u.pm >> 3) * 1024 + (size_t)u.pn * 256) * 2048; return true;
    }
};
struct SchedXO {
    const char* A; const char* B; int G, c;
    __device__ __forceinline__ bool next(int i, Unit& u) const {
        const long L = (long)i * G + c; if (L >= 512) return false;
        u.pm = (int)(L >> 2); u.pn = (int)(L & 3);
        u.a = A + (size_t)u.pm * 256 * 2048 + u.pn * 512; u.b = B + (size_t)u.pn * 256 * (MVT_LD * 2) + (size_t)(u.pm >> 3) * 512; return true;
    }
};
struct SchedS2 {
    const char* A; const char* B; int G, c;
    __device__ __forceinline__ bool next(int i, Unit& u) const {
        const long L = (long)i * G + c; if (L >= 256) return false;
        u.pm = (int)L; u.pn = 0;
        u.a = A + (size_t)L * 256 * 1280; u.b = B + (size_t)(L >> 2) * 256 * 1024; return true;
    }
};
struct SchedS4 {
    const char* A; const char* B; int G, c;
    __device__ __forceinline__ bool next(int i, Unit& u) const {
        const long L = (long)i * G + c; if (L >= 512) return false;
        u.pm = (int)(L >> 1); u.pn = (int)(L & 1);
        u.a = A + (size_t)u.pm * 256 * 1280; u.b = B + ((size_t)(L >> 3) * 512 + (size_t)u.pn * 256) * 1280; return true;
    }
};

typedef f32x4 Acc[2][2][4][2];

__device__ __forceinline__ float row_rstd(const float* ssq_row, int nslots) {
    float s = 0.f;
    const f32x4* p = (const f32x4*)ssq_row;
    for (int i = 0; i < nslots / 4; ++i) { const f32x4 v = p[i]; s += (v[0] + v[1]) + (v[2] + v[3]); }
    return 1.0f / sqrtf(s * (1.0f / DM) + EPS);
}

struct EpiStore {
    static constexpr bool PERM = true;
    bf16_t* O; int ldc; const float* ssq; int nslots; float cs; int mode;
    __device__ __forceinline__ void operator()(Acc& acc, const Unit& u, int wr, int wc, int fr, int fq, LAS unsigned char*) const {
        const int row0 = u.pm * BM + wr * 64 + fr, col0 = u.pn * BM + wc * 32 + 8 * fq;
#pragma unroll
        for (int ai = 0; ai < 2; ++ai)
#pragma unroll
            for (int m = 0; m < 4; ++m) {
                const int row = row0 + ai * HALF + m * 16;
                float sc = cs;
                if (ssq) sc *= row_rstd(ssq + (size_t)row * 32, nslots);
#pragma unroll
                for (int bj = 0; bj < 2; ++bj) {
                    const int col = col0 + bj * HALF;
                    const f32x4 v0 = acc[ai][bj][m][0] * sc, v1 = acc[ai][bj][m][1] * sc;
                    u32x4 w; w.x = cvt_pk_bf16(v0[0], v0[1]); w.y = cvt_pk_bf16(v0[2], v0[3]); w.z = cvt_pk_bf16(v1[0], v1[1]); w.w = cvt_pk_bf16(v1[2], v1[3]);
                    bf16_t* p = (mode == 0) ? O + (size_t)row * ldc + col
                                            : O + ((size_t)(col >> 4) * 1024 + (row >> 5)) * 640 + (row & 31) * 16 + (col & 15);
                    *(u32x4*)p = w;
                }
            }
    }
};

struct EpiResid {
    static constexpr bool PERM = false;
    const float* xf; bf16_t* xb; float* ssq;
    __device__ __forceinline__ void operator()(Acc& acc, const Unit& u, int wr, int wc, int fr, int fq, LAS unsigned char*) const {
        const int row0 = u.pm * BM + wr * 64 + fr, col0 = u.pn * BM + wc * 32 + 4 * fq;
#pragma unroll
        for (int ai = 0; ai < 2; ++ai)
#pragma unroll
            for (int m = 0; m < 4; ++m) {
                const int row = row0 + ai * HALF + m * 16; float q = 0.f;
#pragma unroll
                for (int bj = 0; bj < 2; ++bj)
#pragma unroll
                    for (int n = 0; n < 2; ++n) {
                        const int col = col0 + bj * HALF + n * 16; const size_t off = (size_t)row * DM + col;
                        f32x4 v;
                        if (xf) v = *(const f32x4*)(xf + off);
                        else { const u32x2 o = *(const u32x2*)(xb + off); v = (f32x4){bflo(o.x), bfhi(o.x), bflo(o.y), bfhi(o.y)}; }
                        v += acc[ai][bj][m][n];
                        q += (v[0] * v[0] + v[1] * v[1]) + (v[2] * v[2] + v[3] * v[3]);
                        u32x2 w; w.x = cvt_pk_bf16(v[0], v[1]); w.y = cvt_pk_bf16(v[2], v[3]);
                        *(u32x2*)(xb + off) = w;
                    }
                q = sum_x16(q); q = sum_x32(q);
                if (fq == 0) ssq[(size_t)row * 32 + u.pn * 4 + wc] = q;
            }
    }
};

struct EpiGlu {
    static constexpr bool PERM = false;
    bf16_t* xb; float* ssq;
    __device__ __forceinline__ void operator()(Acc& acc, const Unit& u, int wr, int wc, int fr, int fq, LAS unsigned char*) const {
        const int row0 = u.pm * BM + wr * 64 + fr, col0 = u.pn * HALF + wc * 32 + 4 * fq;
#pragma unroll
        for (int ai = 0; ai < 2; ++ai)
#pragma unroll
            for (int m = 0; m < 4; ++m) {
                const int row = row0 + ai * HALF + m * 16; float q = 0.f;
#pragma unroll
                for (int n = 0; n < 2; ++n) {
                    const int col = col0 + n * 16; const size_t off = (size_t)row * DM + col;
                    const f32x4 val = acc[ai][0][m][n], gt = acc[ai][1][m][n];
                    const u32x2 o = *(const u32x2*)(xb + off);
                    f32x4 v = (f32x4){bflo(o.x), bfhi(o.x), bflo(o.y), bfhi(o.y)};
#pragma unroll
                    for (int j = 0; j < 4; ++j) v[j] += val[j] * frcp(1.0f + fexp(-gt[j]));
                    q += (v[0] * v[0] + v[1] * v[1]) + (v[2] * v[2] + v[3] * v[3]);
                    u32x2 w; w.x = cvt_pk_bf16(v[0], v[1]); w.y = cvt_pk_bf16(v[2], v[3]);
                    *(u32x2*)(xb + off) = w;
                }
                q = sum_x16(q); q = sum_x32(q);
                if (fq == 0) ssq[(size_t)row * 32 + u.pn * 4 + wc] = q;
            }
    }
};

struct EpiSoftmax {
    static constexpr bool PERM = true;
    bf16_t* O; const float* ssq; int nslots; float cs;
    __device__ __forceinline__ void operator()(Acc& acc, const Unit& u, int wr, int wc, int fr, int fq, LAS unsigned char* xl) const {
        LAS float* tmax = (LAS float*)xl; LAS float* tsum = tmax + 1024;
#pragma unroll
        for (int ai = 0; ai < 2; ++ai)
#pragma unroll
            for (int m = 0; m < 4; ++m) {
                const float sc = cs * row_rstd(ssq + (size_t)(u.pm * BM + ai * HALF + wr * 64 + m * 16 + fr) * 32, nslots);
#pragma unroll
                for (int bj = 0; bj < 2; ++bj)
#pragma unroll
                    for (int n = 0; n < 2; ++n) acc[ai][bj][m][n] *= sc;
                float mx = -3.0e38f;
#pragma unroll
                for (int bj = 0; bj < 2; ++bj)
#pragma unroll
                    for (int n = 0; n < 2; ++n) { const f32x4 x = acc[ai][bj][m][n]; mx = fmaxf(mx, fmaxf(fmaxf(x[0], x[1]), fmaxf(x[2], x[3]))); }
                mx = max_x16(mx); mx = max_x32(mx);
                if (fq == 0) tmax[(ai * HALF + wr * 64 + m * 16 + fr) * 4 + wc] = mx;
            }
        LDS_WAIT(); __builtin_amdgcn_s_barrier(); asm volatile("" ::: "memory");
#pragma unroll
        for (int ai = 0; ai < 2; ++ai)
#pragma unroll
            for (int m = 0; m < 4; ++m) {
                const int r = ai * HALF + wr * 64 + m * 16 + fr;
                const f32x4 t = *(const LAS f32x4*)(tmax + r * 4);
                const float gm = fmaxf(fmaxf(t[0], t[1]), fmaxf(t[2], t[3])) * LOG2E; float s = 0.f;
#pragma unroll
                for (int bj = 0; bj < 2; ++bj)
#pragma unroll
                    for (int n = 0; n < 2; ++n) {
                        f32x4 x = acc[ai][bj][m][n];
#pragma unroll
                        for (int j = 0; j < 4; ++j) { x[j] = fexp2(x[j] * LOG2E - gm); s += x[j]; }
                        acc[ai][bj][m][n] = x;
                    }
                s = sum_x16(s); s = sum_x32(s);
                if (fq == 0) tsum[r * 4 + wc] = s;
            }
        LDS_WAIT(); __builtin_amdgcn_s_barrier(); asm volatile("" ::: "memory");
        const int row0 = u.pm * BM + wr * 64 + fr, col0 = u.pn * BM + wc * 32 + 8 * fq;
#pragma unroll
        for (int ai = 0; ai < 2; ++ai)
#pragma unroll
            for (int m = 0; m < 4; ++m) {
                const int r = ai * HALF + wr * 64 + m * 16 + fr;
                const f32x4 t = *(const LAS f32x4*)(tsum + r * 4);
                const float inv = 1.0f / ((t[0] + t[1]) + (t[2] + t[3]));
#pragma unroll
                for (int bj = 0; bj < 2; ++bj) {
                    const f32x4 v0 = acc[ai][bj][m][0] * inv, v1 = acc[ai][bj][m][1] * inv;
                    u32x4 w; w.x = cvt_pk_bf16(v0[0], v0[1]); w.y = cvt_pk_bf16(v0[2], v0[3]); w.z = cvt_pk_bf16(v1[0], v1[1]); w.w = cvt_pk_bf16(v1[2], v1[3]);
                    *(u32x4*)(O + (size_t)(row0 + ai * HALF + m * 16) * DM + col0 + bj * HALF) = w;
                }
            }
    }
};


__device__ __forceinline__ float dpp_ror1(float x) { return __int_as_float(__builtin_amdgcn_update_dpp(0, __float_as_int(x), 0x121, 0xf, 0xf, false)); }
__device__ __forceinline__ float dpp_ror2(float x) { return __int_as_float(__builtin_amdgcn_update_dpp(0, __float_as_int(x), 0x122, 0xf, 0xf, false)); }
__device__ __forceinline__ float dpp_ror1u(float x) { return __int_as_float(__builtin_amdgcn_mov_dpp(__float_as_int(x), 0x121, 0xf, 0xf, false)); }
__device__ __forceinline__ float dpp_ror2u(float x) { return __int_as_float(__builtin_amdgcn_mov_dpp(__float_as_int(x), 0x122, 0xf, 0xf, false)); }
__device__ __forceinline__ float dpp_shr1_old(float old, float x) { return __int_as_float(__builtin_amdgcn_update_dpp(__float_as_int(old), __float_as_int(x), 0x111, 0xf, 0xf, false)); }
__device__ __forceinline__ float dpp_shr2_old(float old, float x) { return __int_as_float(__builtin_amdgcn_update_dpp(__float_as_int(old), __float_as_int(x), 0x112, 0xf, 0xf, false)); }
struct EpiUpConv {
    static constexpr bool PERM = true;
    bf16_t* H; bf16_t* HALO; const float* ssq; const float* cw; const float* cb;
    __device__ __forceinline__ void operator()(Acc& acc, const Unit& u, int wr, int wc, int fr, int fq, LAS unsigned char* xl) const {
        LAS float* B = (LAS float*)xl;
        LAS float* Wl = B + 2048;
        LAS float* R = Wl + 1024;
        const int wid = wr * 4 + wc, lane = fq * 16 + fr, tid = wid * 64 + lane;
        const int row0 = u.pm * BM + wr * 64 + fr, colb = wc * 32 + 8 * fq, ch0 = u.pn * HALF + colb;
        {
#pragma unroll
            for (int i = 0; i < 2; ++i) { const int idx = tid + i * 512, t = idx >> 8, bj = (idx >> 7) & 1, chl = idx & 127;
                Wl[idx] = (t < 3) ? cw[t * DFF2 + bj * DFF + u.pn * HALF + chl] : cb[bj * DFF + u.pn * HALF + chl]; }
            if (lane < 32) R[wid * 32 + lane] = row_rstd(ssq + (size_t)(u.pm * BM + wid * 32 + lane) * 32, 16);
        }
        LDS_WAIT(); __builtin_amdgcn_s_barrier(); asm volatile("" ::: "memory");
#pragma unroll
        for (int ai = 0; ai < 2; ++ai)
#pragma unroll
            for (int m = 0; m < 4; ++m) {
                const float sc = R[ai * HALF + wr * 64 + m * 16 + fr];
#pragma unroll
                for (int bj = 0; bj < 2; ++bj)
#pragma unroll
                    for (int n = 0; n < 2; ++n) acc[ai][bj][m][n] *= sc;
            }
        if (fr >= 14) {
#pragma unroll
            for (int ai = 0; ai < 2; ++ai)
#pragma unroll
                for (int bj = 0; bj < 2; ++bj)
#pragma unroll
                    for (int n = 0; n < 2; ++n) *(LAS f32x4*)(B + ((ai * 2 + wr) * 2 + (fr - 14)) * 256 + bj * HALF + colb + 4 * n) = acc[ai][bj][3][n];
        }
        if (wr == 0 && fr < 2) {
#pragma unroll
            for (int bj = 0; bj < 2; ++bj) { const f32x4 v0 = acc[0][bj][0][0], v1 = acc[0][bj][0][1];
                u32x4 w; w.x = cvt_pk_bf16(v0[0], v0[1]); w.y = cvt_pk_bf16(v0[2], v0[3]); w.z = cvt_pk_bf16(v1[0], v1[1]); w.w = cvt_pk_bf16(v1[2], v1[3]);
                *(u32x4*)(HALO + (size_t)(u.pm * 4 + fr) * DFF2 + bj * DFF + ch0) = w; }
        }
        if (wr == 1 && fr >= 14) {
#pragma unroll
            for (int bj = 0; bj < 2; ++bj) { const f32x4 v0 = acc[1][bj][3][0], v1 = acc[1][bj][3][1];
                u32x4 w; w.x = cvt_pk_bf16(v0[0], v0[1]); w.y = cvt_pk_bf16(v0[2], v0[3]); w.z = cvt_pk_bf16(v1[0], v1[1]); w.w = cvt_pk_bf16(v1[2], v1[3]);
                *(u32x4*)(HALO + (size_t)(u.pm * 4 + 2 + (fr - 14)) * DFF2 + bj * DFF + ch0) = w; }
        }
        LDS_WAIT(); __builtin_amdgcn_s_barrier(); asm volatile("" ::: "memory");
#pragma unroll
        for (int ai = 0; ai < 2; ++ai) {
            const bool has = (wr == 1) || (ai == 1);
            const int sb = (wr == 1) ? (ai * 2) : 1;
#pragma unroll
            for (int n = 0; n < 2; ++n) {
                asm volatile("" ::: "memory");
                const int cl = colb + 4 * n;
                float hv[4][4];
                const f32x4 wv0 = *(const LAS f32x4*)(Wl + 0 * 128 + cl), wg0 = *(const LAS f32x4*)(Wl + 1 * 128 + cl);
                const f32x4 wv1 = *(const LAS f32x4*)(Wl + 2 * 128 + cl), wg1 = *(const LAS f32x4*)(Wl + 3 * 128 + cl);
                const f32x4 wv2 = *(const LAS f32x4*)(Wl + 4 * 128 + cl), wg2 = *(const LAS f32x4*)(Wl + 5 * 128 + cl);
                const f32x4 bvv = *(const LAS f32x4*)(Wl + 6 * 128 + cl), bgv = *(const LAS f32x4*)(Wl + 7 * 128 + cl);
                f32x4 b1v = (f32x4){0.f, 0.f, 0.f, 0.f}, b2v = b1v, b1g = b1v, b2g = b1v;
                if (has) {
                    b1v = *(const LAS f32x4*)(B + (sb * 2 + 1) * 256 + cl); b2v = *(const LAS f32x4*)(B + (sb * 2 + (fr & 1)) * 256 + cl);
                    b1g = *(const LAS f32x4*)(B + (sb * 2 + 1) * 256 + HALF + cl); b2g = *(const LAS f32x4*)(B + (sb * 2 + (fr & 1)) * 256 + HALF + cl);
                }
#pragma unroll
                for (int j = 0; j < 4; ++j) {
                    float r1p = b1v[j], r2p = b2v[j], q1p = b1g[j], q2p = b2g[j];
#pragma unroll
                    for (int m = 0; m < 4; ++m) {
                        const float xv = acc[ai][0][m][n][j], xg = acc[ai][1][m][n][j];
                        const float pv1 = dpp_shr1_old(r1p, xv), pv2 = dpp_shr2_old(r2p, xv), pg1 = dpp_shr1_old(q1p, xg), pg2 = dpp_shr2_old(q2p, xg);
                        const float cv = bvv[j] + wv0[j] * pv2 + wv1[j] * pv1 + wv2[j] * xv;
                        const float cg = bgv[j] + wg0[j] * pg2 + wg1[j] * pg1 + wg2[j] * xg;
                        hv[m][j] = cv * cg * frcp(1.0f + fexp(-cg));
                        if (m < 3) { r1p = dpp_ror1u(xv); r2p = dpp_ror2u(xv); q1p = dpp_ror1u(xg); q2p = dpp_ror2u(xg); }
                    }
                    __builtin_amdgcn_sched_barrier(0);
                }
#pragma unroll
                for (int m = 0; m < 4; ++m) {
                    u32x2 w; w.x = cvt_pk_bf16(hv[m][0], hv[m][1]); w.y = cvt_pk_bf16(hv[m][2], hv[m][3]);
                    *(u32x2*)(H + (size_t)(row0 + ai * HALF + m * 16) * DFF + ch0 + 4 * n) = w;
                }
            }
        }
    }
};

struct EpiHend {
    static constexpr bool PERM = false;
    float* Hout;
    __device__ __forceinline__ void operator()(Acc& acc, const Unit& u, int wr, int wc, int fr, int fq, LAS unsigned char*) const {
        const int row0 = u.pm * BM + wr * 64 + fr, col0 = wc * 32 + 4 * fq;
#pragma unroll
        for (int ai = 0; ai < 2; ++ai)
#pragma unroll
            for (int m = 0; m < 4; ++m)
#pragma unroll
                for (int n = 0; n < 2; ++n)
                    *(f32x4*)(Hout + (size_t)(row0 + ai * HALF + m * 16) * 128 + col0 + n * 16) = acc[ai][0][m][n];
    }
};

struct EpiSsmY {
    static constexpr bool PERM = true;
    const bf16_t* Ug; const float* Dskip; bf16_t* Yg;
    __device__ __forceinline__ void operator()(Acc& acc, const Unit& u, int wr, int wc, int fr, int fq, LAS unsigned char*) const {
        const int g = u.pm >> 2;
        const int rg0 = (u.pm & 3) * BM + wr * 64 + fr, col0 = u.pn * BM + wc * 32 + 8 * fq;
        const int co = col0 & 15;
        const f32x4 d0 = *(const f32x4*)(Dskip + g * 16 + co), d1 = *(const f32x4*)(Dskip + g * 16 + co + 4);
#pragma unroll
        for (int ai = 0; ai < 2; ++ai)
#pragma unroll
            for (int m = 0; m < 4; ++m) {
                const int rg = rg0 + ai * HALF + m * 16;
#pragma unroll
                for (int bj = 0; bj < 2; ++bj) {
                    const int col = col0 + bj * HALF;
                    const u32x4 uu = *(const u32x4*)(Ug + ((size_t)g * 1024 + rg) * 640 + col);
                    float y[8];
                    y[0] = acc[ai][bj][m][0][0] + d0[0] * bflo(uu.x); y[1] = acc[ai][bj][m][0][1] + d0[1] * bfhi(uu.x);
                    y[2] = acc[ai][bj][m][0][2] + d0[2] * bflo(uu.y); y[3] = acc[ai][bj][m][0][3] + d0[3] * bfhi(uu.y);
                    y[4] = acc[ai][bj][m][1][0] + d1[0] * bflo(uu.z); y[5] = acc[ai][bj][m][1][1] + d1[1] * bfhi(uu.z);
                    y[6] = acc[ai][bj][m][1][2] + d1[2] * bflo(uu.w); y[7] = acc[ai][bj][m][1][3] + d1[3] * bfhi(uu.w);
#pragma unroll
                    for (int j = 0; j < 8; ++j) { const float x = y[j]; const float k2 = 1.5957691216f * (x + 0.044715f * x * x * x); y[j] = x * frcp(1.0f + fexp(-k2)); }
                    u32x4 w; w.x = cvt_pk_bf16(y[0], y[1]); w.y = cvt_pk_bf16(y[2], y[3]); w.z = cvt_pk_bf16(y[4], y[5]); w.w = cvt_pk_bf16(y[6], y[7]);
                    const size_t tok = (size_t)rg * 32 + (col >> 4);
                    *(u32x4*)(Yg + tok * DM + g * 16 + co) = w;
                }
            }
    }
};

template <class Epi, class Sched>
__device__ __forceinline__ void gemm_phase(LAS unsigned char* lds, LAS unsigned char* xl, const int lda, const int ldb, const int K, const Sched& S, const Epi& E) {
    int tid_ = threadIdx.x; asm volatile("" : "+v"(tid_));
    const int tid = tid_, wid = __builtin_amdgcn_readfirstlane(tid >> 6), lane = tid & 63, wr = wid >> 2, wc = wid & 3, fr = lane & 15, fq = lane >> 4;
    const int nt = K / BK;
    unsigned voffA, voffB;
    { int R, C; stage_rc(tid * 16, R, C); const int Rb = Epi::PERM ? ((R & ~31) + perm32(R & 31)) : R;
      voffA = (unsigned)(R * lda + C) * 2u; voffB = (unsigned)(Rb * ldb + C) * 2u; }
    const size_t qstepA = (size_t)64 * lda * 2, qstepB = (size_t)64 * ldb * 2;
    const size_t kstep = (size_t)(BK * 2);
    const size_t hstepA = (size_t)HALF * lda * 2, hstepB = (size_t)HALF * ldb * 2;
    const unsigned ldsw = (unsigned)wid * 1024u;
    const int aoff = lds_byte(wr * 64 + fr, fq * 8), boff = lds_byte(wc * 32 + fr, fq * 8);
#define PG8_SA(b, h) (((b) * 2 + (h)) * HTB)
#define PG8_SB(b, h) ((4 + (b) * 2 + (h)) * HTB)
#define PG8_STAGE(bufoff, gbase, voff) do { _Pragma("unroll") for (int _i = 0; _i < 2; ++_i) \
        { const char* _gb = (const char*)(gbase) + (size_t)_i * q##voff; asm volatile("" : "+s"(_gb)); \
          __builtin_amdgcn_global_load_lds((const unsigned*)(_gb + (voff)), (LAS unsigned*)(lds + (bufoff) + ldsw + _i * 8192), 16, 0, 0); } } while (0)
#define qvoffA qstepA
#define qvoffB qstepB
#define PG8_LDA(dst, b, h) do { _Pragma("unroll") for (int m = 0; m < 4; ++m) _Pragma("unroll") for (int k = 0; k < 2; ++k) dst[m][k] = *(const LAS bf16x8*)(lds + PG8_SA(b, h) + aoff + m * 2048 + k * 1024); } while (0)
#define PG8_LDB(dst, b, h) do { _Pragma("unroll") for (int n = 0; n < 2; ++n) _Pragma("unroll") for (int k = 0; k < 2; ++k) dst[n][k] = *(const LAS bf16x8*)(lds + PG8_SB(b, h) + boff + n * 2048 + k * 1024); } while (0)
#define PG8_MMA(ai, bj, At, Bt) do { __builtin_amdgcn_s_setprio(1); _Pragma("unroll") for (int m = 0; m < 4; ++m) _Pragma("unroll") for (int n = 0; n < 2; ++n) _Pragma("unroll") for (int k = 0; k < 2; ++k) \
        acc[ai][bj][m][n] = __builtin_amdgcn_mfma_f32_16x16x32_bf16(Bt[n][k], At[m][k], acc[ai][bj][m][n], 0, 0, 0); __builtin_amdgcn_s_setprio(0); } while (0)
#define PG8_WAIT_V(n) asm volatile("s_waitcnt vmcnt(" #n ")" ::: "memory")
#define PG8_WAIT_L(n) asm volatile("s_waitcnt lgkmcnt(" #n ")" ::: "memory")
#define PG8_BAR __builtin_amdgcn_s_barrier()
#define PG8_SCHED __builtin_amdgcn_sched_barrier(0)
    Unit cur, nxt; int ui = 0;
    if (!S.next(0, cur)) return;
    Acc acc;
#pragma unroll
    for (int a = 0; a < 2; ++a)
#pragma unroll
        for (int b = 0; b < 2; ++b)
#pragma unroll
            for (int m = 0; m < 4; ++m)
#pragma unroll
                for (int n = 0; n < 2; ++n) acc[a][b][m][n] = (f32x4){0.f, 0.f, 0.f, 0.f};
    bf16x8 At[4][2], B0[2][2], B1[2][2];
    const char* cA = cur.a; const char* cB = cur.b;
    PG8_STAGE(PG8_SB(0, 0), cB, voffB); PG8_STAGE(PG8_SB(0, 1), cB + hstepB, voffB); PG8_STAGE(PG8_SA(0, 0), cA, voffA); PG8_STAGE(PG8_SA(0, 1), cA + hstepA, voffA);
    if (wr == 1) PG8_BAR;
    PG8_WAIT_V(2); PG8_BAR;
    PG8_STAGE(PG8_SB(1, 0), cB + kstep, voffB); PG8_STAGE(PG8_SA(1, 0), cA + kstep, voffA); PG8_STAGE(PG8_SB(1, 1), cB + hstepB + kstep, voffB);
    PG8_WAIT_V(6); PG8_BAR;
    for (;;) {
        const bool has_next = S.next(ui + 1, nxt);
        const char* nA = has_next ? nxt.a : cA; const char* nB = has_next ? nxt.b : cB;
        for (int t = 0; t < nt; t += 2) {
            const bool last = (t == nt - 2);
            const char* a1 = cA + (size_t)(t + 1) * kstep;
            const char* a2 = last ? nA : cA + (size_t)(t + 2) * kstep; const char* b2 = last ? nB : cB + (size_t)(t + 2) * kstep;
            const char* a3 = a2 + kstep; const char* b3 = b2 + kstep;
            PG8_LDB(B0, 0, 0); PG8_LDB(B1, 0, 1); PG8_SCHED; PG8_LDA(At, 0, 0); PG8_STAGE(PG8_SA(1, 1), a1 + hstepA, voffA);
            PG8_WAIT_V(8); PG8_WAIT_L(0); PG8_BAR; PG8_MMA(0, 0, At, B0); PG8_MMA(0, 1, At, B1); PG8_BAR; PG8_SCHED;
            PG8_LDA(At, 0, 1); PG8_STAGE(PG8_SB(0, 0), b2, voffB); PG8_STAGE(PG8_SB(0, 1), b2 + hstepB, voffB); PG8_STAGE(PG8_SA(0, 0), a2, voffA);
            PG8_WAIT_V(8); PG8_WAIT_L(0); PG8_BAR; PG8_MMA(1, 0, At, B0); PG8_MMA(1, 1, At, B1); PG8_BAR; PG8_SCHED;
            PG8_LDB(B0, 1, 0); PG8_LDB(B1, 1, 1); PG8_SCHED; PG8_LDA(At, 1, 0); PG8_STAGE(PG8_SA(0, 1), a2 + hstepA, voffA);
            PG8_WAIT_V(8); PG8_WAIT_L(0); PG8_BAR; PG8_MMA(0, 0, At, B0); PG8_MMA(0, 1, At, B1); PG8_BAR; PG8_SCHED;
            PG8_LDA(At, 1, 1); PG8_STAGE(PG8_SB(1, 0), b3, voffB); PG8_STAGE(PG8_SB(1, 1), b3 + hstepB, voffB); PG8_STAGE(PG8_SA(1, 0), a3, voffA);
            PG8_WAIT_V(8); PG8_WAIT_L(0); PG8_BAR; PG8_MMA(1, 0, At, B0); PG8_MMA(1, 1, At, B1); PG8_BAR; PG8_SCHED;
        }
        if (wr == 0) PG8_BAR;
        __builtin_amdgcn_sched_barrier(0); asm volatile("s_nop 15\n\ts_nop 15\n\ts_nop 15" ::: "memory"); __builtin_amdgcn_sched_barrier(0);
        { int t2 = threadIdx.x; asm volatile("" : "+v"(t2)); E(acc, cur, wr, wc, t2 & 15, (t2 >> 4) & 3, xl); }
        if (!has_next) break;
#pragma unroll
        for (int a = 0; a < 2; ++a)
#pragma unroll
            for (int b = 0; b < 2; ++b)
#pragma unroll
                for (int m = 0; m < 4; ++m)
#pragma unroll
                    for (int n = 0; n < 2; ++n) acc[a][b][m][n] = (f32x4){0.f, 0.f, 0.f, 0.f};
        cur = nxt; cA = nA; cB = nB; ++ui;
        if (wr == 1) PG8_BAR;
    }
    PG8_WAIT_V(0);
    PG8_BAR;
#undef PG8_SA
#undef PG8_SB
#undef PG8_STAGE
#undef qvoffA
#undef qvoffB
#undef PG8_LDA
#undef PG8_LDB
#undef PG8_MMA
#undef PG8_WAIT_V
#undef PG8_WAIT_L
#undef PG8_BAR
#undef PG8_SCHED
}
}

constexpr int RING_BYTES = 131072, XL_OFF = RING_BYTES, XBST_OFF = XL_OFF + 14336, LDS_BYTES = 147456;

struct TItem { const float* W; const float* gk; bf16_t* D; int N, ldt, drow0, k0, n0; };
__device__ __forceinline__ void titem_load(float (&v)[32], const TItem& t, int lane) {
#pragma unroll
    for (int i = 0; i < 32; ++i) { const int kk = 2 * i + (lane >> 5); v[i] = t.W[(size_t)(t.k0 + kk) * t.N + t.n0 + (lane & 31)]; }
}
__device__ __forceinline__ void titem_to_lds(const float (&v)[32], LAS float* scr, int lane) {
#pragma unroll
    for (int i = 0; i < 32; ++i) { const int kk = 2 * i + (lane >> 5); scr[kk * 33 + (lane & 31)] = v[i]; }
    LDS_WAIT(); asm volatile("" ::: "memory");
}
__device__ __forceinline__ void titem_store(const TItem& t, LAS float* scr, int lane) {
    const int c = lane & 7;
    f32x4 g0 = (f32x4){1.f, 1.f, 1.f, 1.f}, g1 = g0;
    if (t.gk) { g0 = *(const f32x4*)(t.gk + t.k0 + 8 * c); g1 = *(const f32x4*)(t.gk + t.k0 + 8 * c + 4); }
#pragma unroll
    for (int j = 0; j < 4; ++j) { const int n = (lane >> 3) + 8 * j; const LAS float* s = scr + (8 * c) * 33 + n;
        u32x4 o; o.x = cvt_pk_bf16(s[0 * 33] * g0[0], s[1 * 33] * g0[1]); o.y = cvt_pk_bf16(s[2 * 33] * g0[2], s[3 * 33] * g0[3]);
        o.z = cvt_pk_bf16(s[4 * 33] * g1[0], s[5 * 33] * g1[1]); o.w = cvt_pk_bf16(s[6 * 33] * g1[2], s[7 * 33] * g1[3]);
        *(u32x4*)(t.D + (size_t)(t.drow0 + n) * t.ldt + t.k0 + 8 * c) = o; }
    LDS_WAIT(); asm volatile("" ::: "memory");
}
__device__ __forceinline__ void rms_row_to_bf16(const float* xrow, const float* g, bf16_t* orow, int lane) {
    const f32x4* xr = (const f32x4*)xrow + lane; const f32x4* gr = (const f32x4*)g + lane;
    f32x4 v[4]; float s = 0.f;
#pragma unroll
    for (int j = 0; j < 4; ++j) { v[j] = xr[64 * j]; s += (v[j].x * v[j].x + v[j].y * v[j].y) + (v[j].z * v[j].z + v[j].w * v[j].w); }
    const float rstd = 1.f / sqrtf(wave_sum(s) * (1.f / DM) + EPS);
    u32x2* o8 = (u32x2*)orow + lane;
#pragma unroll
    for (int j = 0; j < 4; ++j) { const f32x4 gg = gr[64 * j]; u32x2 w; w.x = cvt_pk_bf16(v[j].x * rstd * gg.x, v[j].y * rstd * gg.y); w.y = cvt_pk_bf16(v[j].z * rstd * gg.z, v[j].w * rstd * gg.w); o8[64 * j] = w; }
}

__device__ __forceinline__ void rms_rows4_to_bf16(const float* xrow, const float* g, bf16_t* orow, int lane) {
    f32x4 v[4][4]; float s[4];
#pragma unroll
    for (int r = 0; r < 4; ++r)
#pragma unroll
        for (int j = 0; j < 4; ++j) v[r][j] = *((const f32x4*)(xrow + (size_t)r * DM) + lane + 64 * j);
#pragma unroll
    for (int r = 0; r < 4; ++r) { s[r] = 0.f;
#pragma unroll
        for (int j = 0; j < 4; ++j) s[r] += (v[r][j].x * v[r][j].x + v[r][j].y * v[r][j].y) + (v[r][j].z * v[r][j].z + v[r][j].w * v[r][j].w); }
#pragma unroll
    for (int r = 0; r < 4; ++r) s[r] = 1.f / sqrtf(wave_sum(s[r]) * (1.f / DM) + EPS);
#pragma unroll
    for (int j = 0; j < 4; ++j) { const f32x4 gg = *((const f32x4*)g + lane + 64 * j);
#pragma unroll
        for (int r = 0; r < 4; ++r) { u32x2 w; w.x = cvt_pk_bf16(v[r][j].x * s[r] * gg.x, v[r][j].y * s[r] * gg.y); w.y = cvt_pk_bf16(v[r][j].z * s[r] * gg.z, v[r][j].w * s[r] * gg.w);
            *((u32x2*)(orow + (size_t)r * DM) + lane + 64 * j) = w; } }
}

struct Args { const float* in[28]; float* out; unsigned char* ws; int ph_lo, ph_hi; };
typedef const __attribute__((address_space(4))) Args* KArgs;
__device__ __forceinline__ KArgs kargs() { KArgs p = (KArgs)__builtin_amdgcn_kernarg_segment_ptr(); asm volatile("" : "+s"(p)); return p; }

__device__ __forceinline__ void ssm_tables(KArgs ap, int g, LAS unsigned char* lds, bf16_t* Tg, bf16_t* Wend) {
    LAS float* Lre = (LAS float*)lds;
    LAS float* Lim = Lre + 33 * 64;
    LAS float* Bre = Lim + 33 * 64;
    LAS float* Bim = Bre + 1024;
    LAS float* Cre = Bim + 1024;
    LAS float* Cim = Cre + 1024;
    LAS float* Kern = Cim + 1024;
    const int tid = threadIdx.x;
    const float* lam_re = ap->in[12] + g * 64; const float* lam_im = ap->in[13] + g * 64;
    const float dt = expf(ap->in[14][g]);
    for (int idx = tid; idx < 33 * 64; idx += 512) {
        const int tau = idx >> 6, p = idx & 63;
        const float mag = expf((float)tau * (lam_re[p] * dt)); const float ang = (float)tau * (lam_im[p] * dt);
        Lre[idx] = mag * cosf(ang); Lim[idx] = mag * sinf(ang);
    }
    __syncthreads();
    for (int idx = tid; idx < 1024; idx += 512) {
        {
            const int p = idx >> 4;
            const float lr = lam_re[p], li = lam_im[p], lbr = Lre[64 + p], lbi = Lim[64 + p];
            const float nre = lbr - 1.0f, den = lr * lr + li * li;
            const float cr = (nre * lr + lbi * li) / den, ci = (lbi * lr - nre * li) / den;
            const float br = ap->in[15][(size_t)g * 1024 + idx], bi = ap->in[16][(size_t)g * 1024 + idx];
            Bre[idx] = cr * br - ci * bi; Bim[idx] = cr * bi + ci * br;
        }
        Cre[idx] = ap->in[17][(size_t)g * 1024 + idx]; Cim[idx] = ap->in[18][(size_t)g * 1024 + idx];
    }
    __syncthreads();
    {
        const int tau = tid >> 4, co = tid & 15; float kacc[16];
#pragma unroll
        for (int ci = 0; ci < 16; ++ci) kacc[ci] = 0.f;
        for (int p = 0; p < 64; ++p) {
            const float cr = Cre[co * 64 + p], cim = Cim[co * 64 + p], lr = Lre[tau * 64 + p], li = Lim[tau * 64 + p];
            const float gr = cr * lr - cim * li, gi = cr * li + cim * lr;
#pragma unroll
            for (int q = 0; q < 4; ++q) { const f32x4 br = *(const LAS f32x4*)(Bre + p * 16 + 4 * q), bi = *(const LAS f32x4*)(Bim + p * 16 + 4 * q);
#pragma unroll
                for (int e = 0; e < 4; ++e) kacc[4 * q + e] += gr * br[e] - gi * bi[e]; }
        }
#pragma unroll
        for (int ci = 0; ci < 16; ++ci) Kern[tid * 16 + ci] = kacc[ci];
    }
    __syncthreads();
    bf16_t* T = Tg + (size_t)g * 512 * 640;
    for (int idx = tid; idx < 512 * 80; idx += 512) {
        const int n = idx / 80, k8 = (idx % 80) * 8; const int t = n >> 4, co = n & 15;
        float v[8];
        if (k8 < 512) { const int s = k8 >> 4, ci = k8 & 15;
#pragma unroll
            for (int j = 0; j < 8; ++j) v[j] = (s <= t) ? Kern[((t - s) * 16 + co) * 16 + ci + j] : 0.f;
        } else { const int q = k8 - 512, im = q >> 6, p0 = q & 63;
#pragma unroll
            for (int j = 0; j < 8; ++j) { const int p = p0 + j; const float cr = Cre[co * 64 + p], cim = Cim[co * 64 + p], lr = Lre[(t + 1) * 64 + p], li = Lim[(t + 1) * 64 + p];
                v[j] = im ? -(cr * li + cim * lr) : (cr * lr - cim * li); }
        }
        u32x4 w; w.x = cvt_pk_bf16(v[0], v[1]); w.y = cvt_pk_bf16(v[2], v[3]); w.z = cvt_pk_bf16(v[4], v[5]); w.w = cvt_pk_bf16(v[6], v[7]);
        *(u32x4*)(T + (size_t)n * 640 + k8) = w;
    }
    bf16_t* We = Wend + (size_t)g * 256 * 512;
    for (int idx = tid; idx < 256 * 64; idx += 512) {
        const int j = idx >> 6, k8 = (idx & 63) * 8; float v[8];
        if (j < 128) { const int p = j & 63, im = j >> 6, s = k8 >> 4, ci = k8 & 15; const float lr = Lre[(31 - s) * 64 + p], li = Lim[(31 - s) * 64 + p];
#pragma unroll
            for (int e = 0; e < 8; ++e) { const float br = Bre[p * 16 + ci + e], bi = Bim[p * 16 + ci + e]; v[e] = im ? (lr * bi + li * br) : (lr * br - li * bi); }
        } else {
#pragma unroll
            for (int e = 0; e < 8; ++e) v[e] = 0.f;
        }
        u32x4 w; w.x = cvt_pk_bf16(v[0], v[1]); w.y = cvt_pk_bf16(v[2], v[3]); w.z = cvt_pk_bf16(v[4], v[5]); w.w = cvt_pk_bf16(v[6], v[7]);
        *(u32x4*)(We + (size_t)j * 512 + k8) = w;
    }
    __syncthreads();
}


template <int W> __device__ __forceinline__ u32x4 pool_item(const bf16_t* up, int t) {
    const int cnt = (t + 1 < W) ? t + 1 : W;
    u32x4 v[W];
#pragma unroll
    for (int i = 0; i < W; ++i) v[i] = (i < cnt) ? *(const u32x4*)(up - (size_t)i * 1536) : (u32x4){0u, 0u, 0u, 0u};
    float s[8];
#pragma unroll
    for (int j = 0; j < 8; ++j) s[j] = 0.f;
#pragma unroll
    for (int i = 0; i < W; ++i) { s[0] += bflo(v[i].x); s[1] += bfhi(v[i].x); s[2] += bflo(v[i].y); s[3] += bfhi(v[i].y); s[4] += bflo(v[i].z); s[5] += bfhi(v[i].z); s[6] += bflo(v[i].w); s[7] += bfhi(v[i].w); }
    const float inv = 1.0f / (float)cnt;
    u32x4 w; w.x = cvt_pk_bf16(s[0] * inv - bflo(v[0].x), s[1] * inv - bfhi(v[0].x)); w.y = cvt_pk_bf16(s[2] * inv - bflo(v[0].y), s[3] * inv - bfhi(v[0].y));
    w.z = cvt_pk_bf16(s[4] * inv - bflo(v[0].z), s[5] * inv - bfhi(v[0].z)); w.w = cvt_pk_bf16(s[6] * inv - bflo(v[0].w), s[7] * inv - bfhi(v[0].w));
    return w;
}

__device__ __forceinline__ void bf8_to_f(const u32x4 v, float (&f)[8]) { f[0] = bflo(v.x); f[1] = bfhi(v.x); f[2] = bflo(v.y); f[3] = bfhi(v.y); f[4] = bflo(v.z); f[5] = bfhi(v.z); f[6] = bflo(v.w); f[7] = bfhi(v.w); }
template <int W> __device__ __forceinline__ void pool_segment(const bf16_t* up, bf16_t* op, int t0) {
    float s[8];
#pragma unroll
    for (int j = 0; j < 8; ++j) s[j] = 0.f;
#pragma unroll
    for (int i = 1; i < W; ++i) {
        u32x4 v = (u32x4){0u, 0u, 0u, 0u};
        if (t0 - i >= 0) v = *(const u32x4*)(up - (size_t)i * 1536);
        float f[8]; bf8_to_f(v, f);
#pragma unroll
        for (int j = 0; j < 8; ++j) s[j] += f[j];
    }
#pragma unroll 4
    for (int r = 0; r < 32; ++r) {
        const int t = t0 + r;
        const u32x4 vc = *(const u32x4*)(up + (size_t)r * 1536);
        u32x4 vo = (u32x4){0u, 0u, 0u, 0u};
        if (t - (W - 1) >= 0) vo = *(const u32x4*)(up + (size_t)(r - (W - 1)) * 1536);
        float fc[8], fo[8]; bf8_to_f(vc, fc); bf8_to_f(vo, fo);
        const float inv = 1.0f / (float)((t + 1 < W) ? t + 1 : W);
        float o[8];
#pragma unroll
        for (int j = 0; j < 8; ++j) { s[j] += fc[j]; o[j] = s[j] * inv - fc[j]; s[j] -= fo[j]; }
        u32x4 w; w.x = cvt_pk_bf16(o[0], o[1]); w.y = cvt_pk_bf16(o[2], o[3]); w.z = cvt_pk_bf16(o[4], o[5]); w.w = cvt_pk_bf16(o[6], o[7]);
        *(u32x4*)(op + (size_t)r * DM) = w;
    }
}

__device__ __forceinline__ int crow(int r, int hi) { return (r & 3) + 8 * (r >> 2) + 4 * hi; }
__device__ __forceinline__ void sb_attn_task(const bf16_t* __restrict__ QKU, const bf16_t* __restrict__ VT, bf16_t* __restrict__ CAT, int b, int h, int qb, int lane) {
    const int r32 = lane & 31, hi = lane >> 5;
    const size_t tok0 = (size_t)b * SEQ; const int q0 = qb * 32;
    const bf16_t* qp = QKU + (tok0 + q0 + r32) * 1536 + h * 64 + 8 * hi;
    bf16x8 qf[4];
#pragma unroll
    for (int j = 0; j < 4; ++j) qf[j] = *(const bf16x8*)(qp + 16 * j);
    const bf16_t* kp = QKU + (tok0 + r32) * 1536 + 512 + h * 64 + 8 * hi;
    const bf16_t* vp = VT + (size_t)(h * 64 + r32) * VT_LD + tok0 + 4 * hi;
    f32x16 o0, o1;
#pragma unroll
    for (int r = 0; r < 16; ++r) { o0[r] = 0.f; o1[r] = 0.f; }
    float carry = 1.0f;
    bf16x8 kf[4]; s16x4 va[2][4]; bf16x8 k1[4]; s16x4 v1[2][4];
#define SB_LOAD(KF, VA, K0) do { const int k0_ = (K0); \
        _Pragma("unroll") for (int j = 0; j < 4; ++j) KF[j] = *(const bf16x8*)(kp + (size_t)k0_ * 1536 + 16 * j); \
        _Pragma("unroll") for (int dh = 0; dh < 2; ++dh) _Pragma("unroll") for (int c = 0; c < 4; ++c) VA[dh][c] = *(const s16x4*)(vp + (size_t)dh * 32 * VT_LD + k0_ + 8 * c); } while (0)
    asm volatile("s_waitcnt vmcnt(0)" ::: "memory");
    SB_LOAD(kf, va, q0);
    SB_LOAD(k1, v1, qb > 0 ? q0 - 32 : q0);
    for (int kt = qb; kt >= 0; --kt) {
        bf16x8 kn[4]; s16x4 vn[2][4];
        SB_LOAD(kn, vn, kt >= 2 ? (kt - 2) * 32 : 0);
        f32x16 s;
#pragma unroll
        for (int r = 0; r < 16; ++r) s[r] = 0.f;
#pragma unroll
        for (int j = 0; j < 4; ++j) s = __builtin_amdgcn_mfma_f32_32x32x16_bf16(kf[j], qf[j], s, 0, 0, 0);
        const bool diag = (kt == qb);
        float omb[16], bt[16];
#pragma unroll
        for (int r = 0; r < 16; ++r) {
            const float z2 = fminf(s[r] * (0.125f * LOG2E), 100.0f);
            const float e = fexp2(z2);
            const float ob = frcp(1.0f + e);
            const bool valid = !diag || (crow(r, hi) < r32);
            omb[r] = valid ? ob : 1.0f; bt[r] = valid ? e * ob : 0.0f;
        }
        float gp[4], pg[4];
#pragma unroll
        for (int g = 0; g < 4; ++g) { gp[g] = (omb[4 * g] * omb[4 * g + 1]) * (omb[4 * g + 2] * omb[4 * g + 3]); pg[g] = partner32(gp[g], hi); }
        float tp[4];
        tp[3] = 1.0f; tp[2] = gp[3] * pg[3]; tp[1] = tp[2] * (gp[2] * pg[2]); tp[0] = tp[1] * (gp[1] * pg[1]);
        const float total = tp[0] * (gp[0] * pg[0]);
        float w[16];
#pragma unroll
        for (int g = 0; g < 4; ++g) {
            const float base = carry * tp[g] * (hi ? 1.0f : pg[g]);
            const float a3 = base, a2 = a3 * omb[4 * g + 3], a1 = a2 * omb[4 * g + 2], a0 = a1 * omb[4 * g + 1];
            w[4 * g + 3] = bt[4 * g + 3] * a3;
            w[4 * g + 2] = bt[4 * g + 2] * a2;
            w[4 * g + 1] = bt[4 * g + 1] * a1;
            w[4 * g + 0] = bt[4 * g + 0] * a0;
        }
        carry *= total;
        u32x4 p0, p1;
        p0.x = cvt_pk_bf16(w[0], w[1]); p0.y = cvt_pk_bf16(w[2], w[3]); p0.z = cvt_pk_bf16(w[4], w[5]); p0.w = cvt_pk_bf16(w[6], w[7]);
        p1.x = cvt_pk_bf16(w[8], w[9]); p1.y = cvt_pk_bf16(w[10], w[11]); p1.z = cvt_pk_bf16(w[12], w[13]); p1.w = cvt_pk_bf16(w[14], w[15]);
        const bf16x8 pb0 = __builtin_bit_cast(bf16x8, p0), pb1 = __builtin_bit_cast(bf16x8, p1);
#define VA8(dh, c) (bf16x8){va[dh][c][0], va[dh][c][1], va[dh][c][2], va[dh][c][3], va[dh][(c) + 1][0], va[dh][(c) + 1][1], va[dh][(c) + 1][2], va[dh][(c) + 1][3]}
        const bf16x8 a00 = VA8(0, 0), a02 = VA8(0, 2), a10 = VA8(1, 0), a12 = VA8(1, 2);
#undef VA8
        o0 = __builtin_amdgcn_mfma_f32_32x32x16_bf16(a00, pb0, o0, 0, 0, 0);
        o0 = __builtin_amdgcn_mfma_f32_32x32x16_bf16(a02, pb1, o0, 0, 0, 0);
        o1 = __builtin_amdgcn_mfma_f32_32x32x16_bf16(a10, pb0, o1, 0, 0, 0);
        o1 = __builtin_amdgcn_mfma_f32_32x32x16_bf16(a12, pb1, o1, 0, 0, 0);
        __builtin_amdgcn_sched_barrier(0);
        asm volatile("s_nop 15\n\ts_nop 15\n\ts_nop 15\n\ts_nop 15\n\ts_nop 15" ::: "memory");
        asm volatile("" :: "v"(a00), "v"(a02), "v"(a10), "v"(a12), "v"(pb0), "v"(pb1), "v"(kf[0]), "v"(kf[1]), "v"(kf[2]), "v"(kf[3]));
        __builtin_amdgcn_sched_barrier(0);
        if (__all(carry == 0.0f)) break;
#pragma unroll
        for (int j = 0; j < 4; ++j) { kf[j] = k1[j]; k1[j] = kn[j]; }
#pragma unroll
        for (int dh = 0; dh < 2; ++dh)
#pragma unroll
            for (int c = 0; c < 4; ++c) { va[dh][c] = v1[dh][c]; v1[dh][c] = vn[dh][c]; }
    }
#undef SB_LOAD
    bf16_t* op = CAT + (tok0 + q0 + r32) * DM + h * 64 + 4 * hi;
#pragma unroll
    for (int g = 0; g < 4; ++g) {
        u32x2 w0, w1;
        w0.x = cvt_pk_bf16(o0[4 * g], o0[4 * g + 1]); w0.y = cvt_pk_bf16(o0[4 * g + 2], o0[4 * g + 3]);
        w1.x = cvt_pk_bf16(o1[4 * g], o1[4 * g + 1]); w1.y = cvt_pk_bf16(o1[4 * g + 2], o1[4 * g + 3]);
        *(u32x2*)(op + 8 * g) = w0; *(u32x2*)(op + 32 + 8 * g) = w1;
    }
}


#define XB_TMO      128
#define XB_XCNT(j)  (256  + 64 * (j))
#define XB_XSUB(j)  (1280 + 64 * (j))
#define XB_XGEN(j)  (2304 + 64 * (j))
#define XB_TOP      3328
#define XB_TOPGEN   3392
#define XCD_BAR_WORDS 3456
#define XB_SPIN_CAP (1u << 22)
__device__ __forceinline__ unsigned xb_ld(unsigned* p)              { return __hip_atomic_load(p, __ATOMIC_RELAXED, __HIP_MEMORY_SCOPE_AGENT); }
__device__ __forceinline__ unsigned xb_add(unsigned* p, unsigned v) { return __hip_atomic_fetch_add(p, v, __ATOMIC_RELAXED, __HIP_MEMORY_SCOPE_AGENT); }
__device__ __forceinline__ unsigned xb_xcc_id() { return (unsigned)__builtin_amdgcn_s_getreg((3 << 11) | 20) & 0xFu; }
#define XB_SPIN(cond, bar) do { unsigned _sp = 0; while (cond) { __builtin_amdgcn_s_sleep(1); \
    if ((++_sp & 255u) == 0u) { if (xb_ld(&(bar)[XB_TMO])) break; if (_sp > XB_SPIN_CAP) { atomicAdd(&(bar)[XB_TMO], 1u); break; } } } } while (0)
__device__ __forceinline__ void xcd_barrier_complete(unsigned* bar, unsigned x, unsigned G, unsigned& nloc, unsigned& nx) {
    unsigned sum, cnt, mine, sp = 0u;
    for (;;) {
        sum = 0u; cnt = 0u; mine = 0u;
#pragma unroll
        for (unsigned j = 0; j < 16; ++j) { const unsigned c = xb_ld(&bar[XB_XCNT(j)]); sum += c; cnt += (c > 0u) ? 1u : 0u; mine = (j == x) ? c : mine; }
        if (sum == G) break;
        __builtin_amdgcn_s_sleep(1);
        if ((++sp & 255u) == 0u) { if (xb_ld(&bar[XB_TMO])) break; if (sp > XB_SPIN_CAP) { atomicAdd(&bar[XB_TMO], 1u); break; } }
    }
    nloc = mine > 0u ? mine : 1u; nx = cnt > 0u ? cnt : 1u;
}
__device__ __forceinline__ void xcd_barrier(unsigned* bar, volatile LAS unsigned* st, bool leader, unsigned G) {
    asm volatile("s_waitcnt vmcnt(0)" ::: "memory");
    __syncthreads();
    if (leader) {
        const unsigned x = xb_xcc_id();
        __builtin_amdgcn_s_waitcnt(0);
        unsigned nloc = st[0], nx = st[1];
        if (nloc == 0u) { xcd_barrier_complete(bar, x, G, nloc, nx); st[0] = nloc; st[1] = nx; }
        const unsigned old = xb_add(&bar[XB_XSUB(x)], 1u);
        const unsigned gen = old / nloc;
        if (old + 1u == (gen + 1u) * nloc) {
            __builtin_amdgcn_fence(__ATOMIC_RELEASE, "agent");
            asm volatile("s_waitcnt vmcnt(0)" ::: "memory");
            const unsigned og = xb_add(&bar[XB_TOP], 1u);
            const unsigned tg = og / nx;
            if (og + 1u == (tg + 1u) * nx) xb_add(&bar[XB_TOPGEN], 1u);
            else XB_SPIN(xb_ld(&bar[XB_TOPGEN]) == tg, bar);
            __builtin_amdgcn_fence(__ATOMIC_ACQUIRE, "agent");
            xb_add(&bar[XB_XGEN(x)], 1u);
            asm volatile("s_waitcnt vmcnt(0)" ::: "memory");
        } else {
            XB_SPIN(xb_ld(&bar[XB_XGEN(x)]) == gen, bar);
            __builtin_amdgcn_fence(__ATOMIC_ACQUIRE, "agent");
            asm volatile("s_waitcnt vmcnt(0)" ::: "memory");
        }
    }
    __syncthreads();
}

__global__ void __launch_bounds__(512) mega_fwd(Args a) {
    __builtin_assume(__builtin_amdgcn_workitem_id_y() == 0); __builtin_assume(__builtin_amdgcn_workitem_id_z() == 0);
    extern __shared__ __attribute__((aligned(16))) unsigned char lds_raw[];
    LAS unsigned char* lds = (LAS unsigned char*)lds_raw;
    LAS unsigned char* xl = lds + XL_OFF;
    cg::grid_group grid = cg::this_grid();
#if !MK_MULTI_LAUNCH
    {
        volatile LAS unsigned* st = (volatile LAS unsigned*)(lds + XBST_OFF);
        if (threadIdx.x == 0) { st[0] = 0u; st[1] = 0u; KArgs ap0 = kargs(); xb_add(&((unsigned*)ap0->ws)[XB_XCNT(xb_xcc_id())], 1u); }
        if (a.ph_lo < 0) grid.sync();
        __syncthreads();
    }
#endif
#if MK_MULTI_LAUNCH
    const int lo = a.ph_lo, hi = a.ph_hi;
    int ph = 0;
#endif
#define PH_VARS int tid = threadIdx.x; asm volatile("" : "+v"(tid)); const int lane = tid & 63, wave = __builtin_amdgcn_readfirstlane(tid >> 6); int G_ = gridDim.x, bid_ = blockIdx.x; asm volatile("" : "+s"(G_), "+s"(bid_)); const int G = G_, bid = bid_; \
    const int gw = bid * 8 + wave, NGW = G * 8, gt = bid * 512 + tid, NGT = G * 512; (void)lane; (void)gw; (void)NGW; (void)gt; (void)NGT; KArgs ap = kargs(); unsigned char* ws = ap->ws; float* X = ap->out; float* SSQ = (float*)(ws + WS_SSQ); bf16_t* XB = (bf16_t*)(ws + WS_XB); bf16_t* MEMN = (bf16_t*)(ws + WS_MEMN); (void)X; (void)SSQ; (void)XB; (void)MEMN;
#if MK_MULTI_LAUNCH
#define PHASE_ON (ph >= lo && ph < hi)
#define PHASE_END do { if (ph >= lo && ph + 1 < hi) grid.sync(); ++ph; } while (0)
#define LOCAL_SEAM PHASE_END
#else
#define PHASE_ON (true)
#define LOCAL_SEAM do { asm volatile("s_waitcnt vmcnt(0)" ::: "memory"); __syncthreads(); { int tl = threadIdx.x; asm volatile("" : "+v"(tl)); \
    if (tl == 0) { __builtin_amdgcn_fence(__ATOMIC_ACQUIRE, "agent"); asm volatile("s_waitcnt vmcnt(0)" ::: "memory"); } } __syncthreads(); } while (0)
#define PHASE_END do { KArgs apb = kargs(); int tb = threadIdx.x; asm volatile("" : "+v"(tb)); int Gb = gridDim.x; asm volatile("" : "+s"(Gb)); \
    xcd_barrier((unsigned*)apb->ws, (volatile LAS unsigned*)(lds + XBST_OFF), tb == 0, (unsigned)Gb); } while (0)
#endif

    if (PHASE_ON) { PH_VARS
        if (bid < 64) ssm_tables(ap, bid, lds, (bf16_t*)(ws + WS_TG), (bf16_t*)(ws + WS_WEND));
        LAS float* scr = (LAS float*)(lds + wave * 16384);
        const bool weighted = (G > 64);
        const int n_tw = weighted ? 64 * 8 : 0, n_nw = weighted ? (G - 64) * 8 : G * 8;
        const int spw = weighted ? 4 : 1, S = n_nw * spw + n_tw;
        const bool is_tw = weighted && bid < 64;
        const int slot0 = is_tw ? n_nw * spw + gw : (weighted ? (gw - 512) * 4 : gw), nslot = is_tw ? 1 : spw;
        if (!is_tw) {
            const int nb_ = weighted ? G - 64 : G, b_ = weighted ? bid - 64 : bid;
            for (int it = b_ + wave * nb_; it < 256; it += nb_ * 8) {
                const int g = it >> 6, cb = (it >> 2) & 15, nb = it & 3;
                const float* pw = ap->in[8] + (size_t)(g * 128 + cb * 8) * 128; const float* sc = ap->in[9] + g * 128;
                const float* wo = ap->in[10] + (size_t)(512 + g * 128) * 1024 + nb * 256 + lane * 4;
                f32x4 acc8[8];
#pragma unroll
                for (int j = 0; j < 8; ++j) acc8[j] = (f32x4){0.f, 0.f, 0.f, 0.f};
#pragma unroll 8
                for (int d = 0; d < 128; ++d) {
                    const f32x4 wv = *(const f32x4*)(wo + (size_t)d * 1024); const float sd = sc[d];
#pragma unroll
                    for (int j = 0; j < 8; ++j) acc8[j] += wv * (pw[j * 128 + d] * sd);
                }
                bf16_t* D = (bf16_t*)(ws + WS_WOUT) + (size_t)(nb * 256 + lane * 4) * 1024 + 512 + g * 128 + cb * 8;
#pragma unroll
                for (int e = 0; e < 4; ++e) {
                    u32x4 w; w.x = cvt_pk_bf16(acc8[0][e], acc8[1][e]); w.y = cvt_pk_bf16(acc8[2][e], acc8[3][e]); w.z = cvt_pk_bf16(acc8[4][e], acc8[5][e]); w.w = cvt_pk_bf16(acc8[6][e], acc8[7][e]);
                    *(u32x4*)(D + (size_t)e * 1024) = w;
                }
            }
        }
        {
            float tv[32]; TItem cur, nxt; bool have = false, have_next = false;
            int sl = 0, it = slot0;
            auto decode = [&](int item, TItem& t) -> bool {
                int r = item; const float* W = nullptr; const float* gk = nullptr; int N = 0; bf16_t* D = nullptr; int ldt = 0, mode = 0; bool found = false;
#define TJOB(Wp, Kk, Nn, Dp, Ld, Md, Gp) if (!found) { const int cnt = ((Kk) / 64) * ((Nn) / 32); if (r < cnt) { W = (Wp); N = (Nn); D = (bf16_t*)(Dp); ldt = (Ld); mode = (Md); gk = (Gp); found = true; } else r -= cnt; }
                TJOB(ap->in[7], 1024, 2048, ws + WS_WIN, 1024, 1, nullptr)
            TJOB(ap->in[10], 512, 1024, ws + WS_WOUT, 1024, 0, nullptr)
            TJOB(ap->in[11], 1024, 1024, ws + WS_WSSM, 1024, 0, ap->in[2] + 1024)
            TJOB(ap->in[20], 1024, 2048, ws + WS_WGLU, 1024, 2, nullptr)
#pragma unroll
            for (int l = 0; l < 2; ++l) {
                unsigned char* lb = ws + WS_LAYER + l * LAYER_STRIDE;
                TJOB(ap->in[22] + (size_t)l * 1024 * 2048, 1024, 2048, lb + LO_WKV, 1024, 0, nullptr)
                TJOB(ap->in[23] + (size_t)l * 1024 * 1024, 1024, 1024, lb + LO_WO, 1024, 0, nullptr)
                TJOB(ap->in[24] + (size_t)l * 1024 * DFF2, 1024, DFF2, lb + LO_WUP, 1024, 3, ap->in[4] + l * 1024)
                TJOB(ap->in[27] + (size_t)l * DFF * 1024, DFF, 1024, lb + LO_WDN, DFF, 0, nullptr)
            }
#undef TJOB
                if (!found) return false;
                const int nblk = N / 32, kb = r / nblk, nb = r % nblk, n0 = nb * 32;
                int drow0 = n0;
                if (mode == 1) drow0 = (n0 < 1024) ? n0 : (n0 < 1536 ? n0 + 512 : n0 - 512);
                else if (mode == 2) drow0 = (n0 < 1024) ? (256 * (n0 >> 7) + (n0 & 127)) : (256 * ((n0 - 1024) >> 7) + 128 + ((n0 - 1024) & 127));
                else if (mode == 3) drow0 = (n0 < DFF) ? (256 * (n0 >> 7) + (n0 & 127)) : (256 * ((n0 - DFF) >> 7) + 128 + ((n0 - DFF) & 127));
                t.W = W; t.gk = gk; t.D = D; t.N = N; t.ldt = ldt; t.drow0 = drow0; t.k0 = kb * 64; t.n0 = n0; return true;
            };
            auto advance = [&](TItem& t) -> bool {
                while (sl < nslot) { if (decode(it, t)) { it += S; return true; } ++sl; it = slot0 + sl; }
                return false;
            };
            have = advance(cur);
            if (have) titem_load(tv, cur, lane);
            while (have) {
                titem_to_lds(tv, scr, lane);
                have_next = advance(nxt);
                if (have_next) titem_load(tv, nxt, lane);
                titem_store(cur, scr, lane);
                cur = nxt; have = have_next;
            }
        }
        for (int it = gt; it < 2 * 1024 * 256; it += NGT) {
            const int l = it >> 18, e = it & 262143, k = e >> 8, n4 = (e & 255) * 4;
            const f32x4 w = *(const f32x4*)(ap->in[21] + (size_t)l * 1048576 + (size_t)k * 1024 + n4); const float gk = ap->in[3][l * 1024 + k];
            u32x2 o; o.x = cvt_pk_bf16(w[0] * gk, w[1] * gk); o.y = cvt_pk_bf16(w[2] * gk, w[3] * gk);
            *(u32x2*)((bf16_t*)(ws + WS_LAYER + l * LAYER_STRIDE + LO_WQ) + (size_t)k * 1024 + n4) = o;
        }
        for (int r = gw; r < MEMTOK / 4; r += NGW) rms_rows4_to_bf16(ap->in[1] + (size_t)r * 4 * DM, ap->in[5], MEMN + (size_t)r * 4 * DM, lane);
        for (int r = gw; r < MTOK / 4; r += NGW) rms_rows4_to_bf16(ap->in[0] + (size_t)r * 4 * DM, ap->in[2], XB + (size_t)r * 4 * DM, lane);
        __syncthreads();
    }
    PHASE_END;

    if (PHASE_ON) { PH_VARS
        bf16_t* WIN = (bf16_t*)(ws + WS_WIN);
        { pg8::SchedStd S; S.init(XB, 256 * 2048, WIN, 256 * 2048, 128, 6, G, bid);
          pg8::EpiStore E{(bf16_t*)(ws + WS_QKU), 1536, nullptr, 0, 1.0f, 0};
          pg8::gemm_phase(lds, xl, 1024, 1024, 1024, S, E); }
        { pg8::SchedStd S; S.init(WIN + (size_t)1536 * 1024, 256 * 2048, XB, 256 * 2048, 2, 128, G, bid);
          pg8::EpiStore E{(bf16_t*)(ws + WS_VT), VT_LD, nullptr, 0, 1.0f, 0};
          pg8::gemm_phase(lds, xl, 1024, 1024, 1024, S, E); }
        for (int j = 0; j < 4; ++j) {
            const int l = j >> 1, isv = j & 1;
            bf16_t* WKV = (bf16_t*)(ws + WS_LAYER + l * LAYER_STRIDE + LO_WKV);
            const int c = (bid + 64 * (j + 1)) % G;
            pg8::SchedStd S;
            S.init(MEMN, 256 * 2048, WKV + (size_t)isv * 1024 * 1024, 256 * 2048, 16, 4, G, c);
            pg8::EpiStore E{isv ? (bf16_t*)(ws + WS_MEMVT + l * MEMVT_STRIDE) : (bf16_t*)(ws + WS_MEMK + l * 8 * MiB), 1024, nullptr, 0, 1.0f, 0};
            pg8::gemm_phase(lds, xl, 1024, 1024, 1024, S, E);
        }
    }
    PHASE_END;

    if (PHASE_ON) { PH_VARS
        const bf16_t* QKU = (const bf16_t*)(ws + WS_QKU); bf16_t* CAT = (bf16_t*)(ws + WS_CAT);
        for (int it = gt; it < 64 * (MTOK / 32); it += NGT) {
            const int ch = it & 63, seg = it >> 6, g = ch >> 4;
            const bf16_t* up = QKU + (size_t)seg * 32 * 1536 + 1024 + ch * 8;
            bf16_t* op = CAT + (size_t)seg * 32 * DM + 512 + ch * 8;
            const int t0 = (seg * 32) & (SEQ - 1);
            if (g == 0) pool_segment<2>(up, op, t0); else if (g == 1) pool_segment<4>(up, op, t0); else if (g == 2) pool_segment<8>(up, op, t0); else pool_segment<16>(up, op, t0);
        }
        for (int task = gw; task < 128 * 64; task += NGW) {
            const int bh = task >> 6; int qb = task & 63; if ((bh >> 5) & 1) qb = 63 - qb;
            sb_attn_task(QKU, (const bf16_t*)(ws + WS_VT), CAT, bh >> 3, bh & 7, qb, lane);
        }
    }
    PHASE_END;

    if (PHASE_ON) { PH_VARS
        pg8::SchedStd S; S.init(ws + WS_CAT, 256 * 2048, ws + WS_WOUT, 256 * 2048, 128, 4, G, bid);
        pg8::EpiResid E{ap->in[0], XB, SSQ};
        pg8::gemm_phase(lds, xl, 1024, 1024, 1024, S, E);
        pg8::SchedG SG{(const char*)(ws + WS_MEMK), (const char*)(ws + WS_LAYER + LO_WQ), G, bid};
        pg8::EpiStore EG{(bf16_t*)(ws + WS_GT), 1024, nullptr, 0, 1.0f, 0};
        pg8::gemm_phase(lds, xl, 1024, 1024, 256, SG, EG);
    }
    PHASE_END;

#pragma nounroll
    for (int layer = 0; layer < 2; ++layer) {
        if (layer == 1) {
            if (PHASE_ON) { PH_VARS
                pg8::SchedStd S; S.init(XB, 256 * 2048, ws + WS_WSSM, 256 * 2048, 128, 4, G, bid);
                pg8::EpiStore E{(bf16_t*)(ws + WS_UG), 0, SSQ, 16, 1.0f, 1};
                pg8::gemm_phase(lds, xl, 1024, 1024, 1024, S, E);
            }
            PHASE_END;
            if (PHASE_ON) { PH_VARS
                pg8::SchedS2 S{(const char*)(ws + WS_UG), (const char*)(ws + WS_WEND), G, bid};
                pg8::EpiHend E{(float*)(ws + WS_HEND)};
                pg8::gemm_phase(lds, xl, 640, 512, 512, S, E);
            }
            PHASE_END;
            if (PHASE_ON) { PH_VARS
                bf16_t* UG = (bf16_t*)(ws + WS_UG); const float* HE = (const float*)(ws + WS_HEND);
                for (int it = gt; it < NBATCH * 64 * 64; it += NGT) {
                    const int p = it & 63, g = (it >> 6) & 63, b = it >> 12;
                    const float dt = expf(ap->in[14][g]);
                    const float mag = expf(32.0f * (ap->in[12][g * 64 + p] * dt)), ang = 32.0f * (ap->in[13][g * 64 + p] * dt);
                    const float lr = mag * cosf(ang), li = mag * sinf(ang);
                    float hr = 0.f, hi_ = 0.f;
                    for (int c0 = 0; c0 < 64; c0 += 8) {
                        const size_t row0 = (size_t)g * 1024 + b * 64 + c0;
                        float er[8], ei[8];
#pragma unroll
                        for (int j = 0; j < 8; ++j) { er[j] = HE[(row0 + j) * 128 + p]; ei[j] = HE[(row0 + j) * 128 + 64 + p]; }
#pragma unroll
                        for (int j = 0; j < 8; ++j) {
                            UG[(row0 + j) * 640 + 512 + p] = (bf16_t)(cvt_pk_bf16(hr, 0.f) & 0xffffu);
                            UG[(row0 + j) * 640 + 576 + p] = (bf16_t)(cvt_pk_bf16(hi_, 0.f) & 0xffffu);
                            const float nr = lr * hr - li * hi_ + er[j], ni = lr * hi_ + li * hr + ei[j];
                            hr = nr; hi_ = ni;
                        }
                    }
                }
            }
            PHASE_END;
            if (PHASE_ON) { PH_VARS
                pg8::SchedS4 S{(const char*)(ws + WS_UG), (const char*)(ws + WS_TG), G, bid};
                pg8::EpiSsmY E{(const bf16_t*)(ws + WS_UG), ap->in[19], (bf16_t*)(ws + WS_YG)};
                pg8::gemm_phase(lds, xl, 640, 640, 640, S, E);
            }
            PHASE_END;
            if (PHASE_ON) { PH_VARS
                pg8::SchedStd S; S.init(ws + WS_YG, 256 * 2048, ws + WS_WGLU, 256 * 2048, 128, 8, G, bid);
                pg8::EpiGlu E{XB, SSQ};
                pg8::gemm_phase(lds, xl, 1024, 1024, 1024, S, E);
            }
            PHASE_END;
        }
        if (PHASE_ON) { PH_VARS
            pg8::SchedXS2 S{(const char*)XB, (const char*)(ws + WS_GT + (size_t)layer * 32 * MiB), G, bid};
            pg8::EpiSoftmax E{(bf16_t*)(ws + WS_P), SSQ, layer == 0 ? 16 : 32, 0.0625f};
            pg8::gemm_phase(lds, xl, 1024, 1024, 1024, S, E);
        }
        if (PHASE_ON) { PH_VARS
            unsigned char* lb = ws + WS_LAYER + layer * LAYER_STRIDE;
            pg8::SchedVW S{(const char*)(lb + LO_WO), (const char*)(ws + WS_MEMVT + layer * MEMVT_STRIDE), G, bid};
            pg8::EpiStore E{(bf16_t*)(ws + WS_QX), 1024, nullptr, 0, 1.0f, 0};
            pg8::gemm_phase(lds, xl, 1024, 1024, 256, S, E);
        }
        PHASE_END;
        if (PHASE_ON) { PH_VARS
            pg8::SchedXOut S{(const char*)(ws + WS_P), (const char*)(ws + WS_QX), G, bid};
            pg8::EpiResid E{nullptr, XB, SSQ};
            pg8::gemm_phase(lds, xl, 1024, 1024, 1024, S, E);
        }
        PHASE_END;
        if (PHASE_ON) { PH_VARS
            unsigned char* lb = ws + WS_LAYER + layer * LAYER_STRIDE;
            pg8::SchedStd S; S.init(XB, 256 * 2048, lb + LO_WUP, 256 * 2048, 128, 22, G, bid);
            pg8::EpiUpConv E{(bf16_t*)(ws + WS_H), (bf16_t*)(ws + WS_HALO), SSQ, ap->in[25] + (size_t)layer * 3 * DFF2, ap->in[26] + (size_t)layer * DFF2};
            pg8::gemm_phase(lds, xl, 1024, 1024, 1024, S, E);
        }
        PHASE_END;
        if (PHASE_ON) { PH_VARS
            const bf16_t* HALO = (const bf16_t*)(ws + WS_HALO); bf16_t* H = (bf16_t*)(ws + WS_H);
            const float* cw = ap->in[25] + (size_t)layer * 3 * DFF2; const float* cb = ap->in[26] + (size_t)layer * DFF2;
            pg8::SchedStd S0; S0.init(ws + WS_H, 256u * DFF * 2, ws, 0u, 128, 4, G, bid);
            pg8::Unit uu;
            for (int ui = 0; S0.next(ui, uu); ++ui) {
                const int pm = uu.pm;
                if ((pm & 7) == 0) continue;
                for (int it = tid; it < 2 * 352; it += 512) {
                    const int chk = it % 352, rr = it / 352, c0 = chk * 8;
                    const bf16_t* cur = HALO + (size_t)(pm * 4 + rr) * DFF2;
                    const bf16_t* p1 = rr ? HALO + (size_t)(pm * 4) * DFF2 : HALO + (size_t)(pm * 4 - 1) * DFF2;
                    const bf16_t* p2 = rr ? HALO + (size_t)(pm * 4 - 1) * DFF2 : HALO + (size_t)(pm * 4 - 2) * DFF2;
                    float o[8];
                    const u32x4 av = *(const u32x4*)(cur + c0), ag = *(const u32x4*)(cur + DFF + c0);
                    const u32x4 a1 = *(const u32x4*)(p1 + c0), g1 = *(const u32x4*)(p1 + DFF + c0), a2 = *(const u32x4*)(p2 + c0), g2 = *(const u32x4*)(p2 + DFF + c0);
                    const float v0[8] = {bflo(av.x), bfhi(av.x), bflo(av.y), bfhi(av.y), bflo(av.z), bfhi(av.z), bflo(av.w), bfhi(av.w)};
                    const float g0[8] = {bflo(ag.x), bfhi(ag.x), bflo(ag.y), bfhi(ag.y), bflo(ag.z), bfhi(ag.z), bflo(ag.w), bfhi(ag.w)};
                    const float v1[8] = {bflo(a1.x), bfhi(a1.x), bflo(a1.y), bfhi(a1.y), bflo(a1.z), bfhi(a1.z), bflo(a1.w), bfhi(a1.w)};
                    const float gg1[8] = {bflo(g1.x), bfhi(g1.x), bflo(g1.y), bfhi(g1.y), bflo(g1.z), bfhi(g1.z), bflo(g1.w), bfhi(g1.w)};
                    const float v2[8] = {bflo(a2.x), bfhi(a2.x), bflo(a2.y), bfhi(a2.y), bflo(a2.z), bfhi(a2.z), bflo(a2.w), bfhi(a2.w)};
                    const float gg2[8] = {bflo(g2.x), bfhi(g2.x), bflo(g2.y), bfhi(g2.y), bflo(g2.z), bfhi(g2.z), bflo(g2.w), bfhi(g2.w)};
    #pragma unroll
                    for (int j = 0; j < 8; ++j) {
                        const int c = c0 + j;
                        const float cv = cb[c] + cw[c] * v2[j] + cw[DFF2 + c] * v1[j] + cw[2 * DFF2 + c] * v0[j];
                        const float cgt = cb[DFF + c] + cw[DFF + c] * gg2[j] + cw[DFF2 + DFF + c] * gg1[j] + cw[2 * DFF2 + DFF + c] * g0[j];
                        o[j] = cv * cgt * frcp(1.0f + fexp(-cgt));
                    }
                    u32x4 w; w.x = cvt_pk_bf16(o[0], o[1]); w.y = cvt_pk_bf16(o[2], o[3]); w.z = cvt_pk_bf16(o[4], o[5]); w.w = cvt_pk_bf16(o[6], o[7]);
                    *(u32x4*)(H + (size_t)(pm * 256 + rr) * DFF + c0) = w;
                }
            }
        }
        LOCAL_SEAM;
        if (PHASE_ON) { PH_VARS
            unsigned char* lb = ws + WS_LAYER + layer * LAYER_STRIDE;
            pg8::SchedStd S; S.init(ws + WS_H, 256u * DFF * 2, lb + LO_WDN, 256u * DFF * 2, 128, 4, G, bid);
            pg8::EpiResid E{nullptr, XB, SSQ};
            pg8::gemm_phase(lds, xl, DFF, DFF, DFF, S, E);
        }
        PHASE_END;
    }

    if (PHASE_ON) { PH_VARS
        for (int m4 = gw; m4 < MTOK / 4; m4 += NGW) {
            const f32x4* gr = (const f32x4*)ap->in[6] + lane;
            f32x4 v[4][4]; float sq[4];
#pragma unroll
            for (int r = 0; r < 4; ++r)
#pragma unroll
                for (int j = 0; j < 4; ++j) { const u32x2 o = *((const u32x2*)(XB + (size_t)(m4 * 4 + r) * DM) + lane + 64 * j); v[r][j] = (f32x4){bflo(o.x), bfhi(o.x), bflo(o.y), bfhi(o.y)}; }
#pragma unroll
            for (int r = 0; r < 4; ++r) { sq[r] = 0.f;
#pragma unroll
                for (int j = 0; j < 4; ++j) sq[r] += (v[r][j].x * v[r][j].x + v[r][j].y * v[r][j].y) + (v[r][j].z * v[r][j].z + v[r][j].w * v[r][j].w); }
#pragma unroll
            for (int r = 0; r < 4; ++r) sq[r] = 1.f / sqrtf(wave_sum(sq[r]) * (1.f / DM) + EPS);
#pragma unroll
            for (int j = 0; j < 4; ++j) { const f32x4 gg = gr[64 * j];
#pragma unroll
                for (int r = 0; r < 4; ++r) *((f32x4*)(X + (size_t)(m4 * 4 + r) * DM) + lane + 64 * j) = v[r][j] * sq[r] * gg; }
        }
    }
#undef PHASE_ON
#undef PHASE_END
}

constexpr int N_PHASES = 4 + 7 + 5 + 7 + 1;

extern "C" void kernel_launch(void* const* d_in, const int* in_sizes, int n_in, void* d_out, int out_size, void* d_ws, size_t ws_size, hipStream_t stream) {
    static int grid = 0;
    if (grid == 0) {
        if (n_in != 28 || in_sizes[0] != MTOK * DM || out_size != MTOK * DM || ws_size < WS_END) {
            fprintf(stderr, "kernel_launch: unexpected shapes (n_in %d, in0 %d, out %d, ws %zu); nothing launched\n", n_in, n_in > 0 ? in_sizes[0] : -1, out_size, ws_size); grid = -1; return; }
        int dev = 0, cus = 0, per_cu = 0;
        if (hipGetDevice(&dev) != hipSuccess || hipDeviceGetAttribute(&cus, hipDeviceAttributeMultiprocessorCount, dev) != hipSuccess) { grid = -1; return; }
        if (hipFuncSetAttribute((const void*)mega_fwd, hipFuncAttributeMaxDynamicSharedMemorySize, LDS_BYTES) != hipSuccess) { fprintf(stderr, "kernel_launch: hipFuncSetAttribute failed\n"); grid = -1; return; }
        if (hipOccupancyMaxActiveBlocksPerMultiprocessor(&per_cu, (const void*)mega_fwd, 512, LDS_BYTES) != hipSuccess || per_cu < 1) per_cu = 1;
        (void)hipGetLastError();
        grid = cus * per_cu;
    }
    if (grid < 0) return;
    Args a{};
    for (int i = 0; i < 28; ++i) a.in[i] = (const float*)d_in[i];
    a.out = (float*)d_out; a.ws = (unsigned char*)d_ws;
#if MK_MULTI_LAUNCH
    for (int p = 0; p < N_PHASES; ++p) {
        a.ph_lo = p; a.ph_hi = p + 1;
        hipLaunchKernelGGL(mega_fwd, dim3(grid), dim3(512), LDS_BYTES, stream, a);
    }
#else
    a.ph_lo = 0; a.ph_hi = N_PHASES;
    if (hipMemsetAsync(d_ws, 0, 16384, stream) != hipSuccess) { fprintf(stderr, "kernel_launch: memset of the barrier words failed\n"); return; }
    void* args[] = {&a};
    hipError_t e = hipLaunchCooperativeKernel((const void*)mega_fwd, dim3(grid), dim3(512), args, LDS_BYTES, stream);
    if (e != hipSuccess) fprintf(stderr, "cooperative launch failed: %s (grid %d)\n", hipGetErrorString(e), grid);
#endif
}
```

```cpp
#include <hip/hip_runtime.h>
#include <hip/hip_cooperative_groups.h>
#include <cstdio>
#include <cstdint>
namespace cg = cooperative_groups;

#ifndef MK_MULTI_LAUNCH
#define MK_MULTI_LAUNCH 0
#endif

#define LAS __attribute__((address_space(3)))
typedef unsigned short bf16_t;
typedef short bf16x8 __attribute__((ext_vector_type(8)));
typedef short s16x4 __attribute__((ext_vector_type(4)));
typedef float f32x4 __attribute__((ext_vector_type(4)));
typedef float f32x16 __attribute__((ext_vector_type(16)));
typedef unsigned u32x4 __attribute__((ext_vector_type(4)));
typedef unsigned u32x2 __attribute__((ext_vector_type(2)));

constexpr int MTOK = 32768, DM = 1024, SEQ = 2048, NBATCH = 16, DFF = 2816, DFF2 = 5632, MEMTOK = 4096;
constexpr int MHALF = 16384;
constexpr float EPS = 1e-6f;
constexpr float LOG2E = 1.4426950408889634f, LN2 = 0.6931471805599453f;

constexpr size_t MiB = 1u << 20;
constexpr size_t WS_SSQ = 1 * MiB;
constexpr size_t WS_WIN = 5 * MiB;
constexpr size_t WS_WOUT = 9 * MiB;
constexpr size_t WS_WSSM = 11 * MiB;
constexpr size_t WS_WGLU = 13 * MiB;
constexpr size_t WS_LAYER = 17 * MiB, LAYER_STRIDE = 25 * MiB;
constexpr size_t LO_WQ = 0, LO_WKV = 2 * MiB, LO_WO = 6 * MiB, LO_WUP = 8 * MiB, LO_WDN = 19 * MiB;
constexpr size_t WS_WEND = 67 * MiB;
constexpr size_t WS_TG = 83 * MiB;
constexpr size_t WS_MEMN = 123 * MiB;
constexpr size_t WS_MEMK = 131 * MiB;
constexpr size_t WS_MEMVT = 147 * MiB, MEMVT_STRIDE = 9 * MiB;
constexpr size_t WS_XB = 165 * MiB;
constexpr size_t WS_T = 229 * MiB;
constexpr size_t WS_QKU = WS_T, WS_VT = WS_T + 96 * MiB, WS_CAT = WS_T + 132 * MiB;
constexpr int VT_LD = MTOK + 128, MVT_LD = 4096 + 128;
constexpr size_t WS_QX = WS_T, WS_P = WS_T + 64 * MiB, WS_O = WS_T + 128 * MiB;
constexpr size_t WS_H = WS_T, WS_HALO = WS_T + 176 * MiB;
constexpr size_t WS_UG = WS_T, WS_HEND = WS_T + 80 * MiB, WS_YG = WS_T + 112 * MiB;
constexpr size_t WS_GT = 426 * MiB;
constexpr size_t WS_END = 512 * MiB;
static_assert(WS_H + (size_t)MTOK * DFF * 2 <= WS_HALO && WS_HALO + (size_t)128 * 4 * DFF2 * 2 <= WS_GT && WS_CAT + (size_t)MTOK * DM * 2 <= WS_GT && WS_GT + 64 * MiB <= WS_END, "ws map");

typedef float f32x2_t __attribute__((ext_vector_type(2))); typedef __bf16 bf16x2_t __attribute__((ext_vector_type(2)));
__device__ __forceinline__ unsigned cvt_pk_bf16(float lo, float hi) { f32x2_t v = {lo, hi}; bf16x2_t b = __builtin_convertvector(v, bf16x2_t); return __builtin_bit_cast(unsigned, b); }
__device__ __forceinline__ float bf2f(unsigned short b) { return __uint_as_float(((unsigned)b) << 16); }
__device__ __forceinline__ float bflo(unsigned w) { return __uint_as_float(w << 16); }
__device__ __forceinline__ float bfhi(unsigned w) { return __uint_as_float(w & 0xffff0000u); }
__device__ __forceinline__ float fexp2(float x) { return __builtin_amdgcn_exp2f(x); }
__device__ __forceinline__ float flog2(float x) { return __builtin_amdgcn_logf(x); }
__device__ __forceinline__ float fexp(float x) { return __builtin_amdgcn_exp2f(x * LOG2E); }
__device__ __forceinline__ float frcp(float x) { return __builtin_amdgcn_rcpf(x); }
template <int M> __device__ __forceinline__ float swz_xor(float v) { return __int_as_float(__builtin_amdgcn_ds_swizzle(__float_as_int(v), (M << 10) | 0x1f)); }
__device__ __forceinline__ float sum_x16(float v) { auto r = __builtin_amdgcn_permlane16_swap(__float_as_uint(v), __float_as_uint(v), false, false); return __uint_as_float(r[0]) + __uint_as_float(r[1]); }
__device__ __forceinline__ float sum_x32(float v) { auto r = __builtin_amdgcn_permlane32_swap(__float_as_uint(v), __float_as_uint(v), false, false); return __uint_as_float(r[0]) + __uint_as_float(r[1]); }
__device__ __forceinline__ float max_x16(float v) { auto r = __builtin_amdgcn_permlane16_swap(__float_as_uint(v), __float_as_uint(v), false, false); return fmaxf(__uint_as_float(r[0]), __uint_as_float(r[1])); }
__device__ __forceinline__ float max_x32(float v) { auto r = __builtin_amdgcn_permlane32_swap(__float_as_uint(v), __float_as_uint(v), false, false); return fmaxf(__uint_as_float(r[0]), __uint_as_float(r[1])); }
__device__ __forceinline__ float partner32(float v, int hi) { auto r = __builtin_amdgcn_permlane32_swap(__float_as_uint(v), __float_as_uint(v), false, false); return hi ? __uint_as_float(r[0]) : __uint_as_float(r[1]); }
__device__ __forceinline__ float wave_sum(float v) {
    v += swz_xor<1>(v); v += swz_xor<2>(v); v += swz_xor<4>(v); v += swz_xor<8>(v); v = sum_x16(v); v = sum_x32(v);
    return v;
}
#define LDS_WAIT() asm volatile("s_waitcnt lgkmcnt(0)" ::: "memory")

namespace pg8 {
constexpr int BM = 256, BK = 64, HALF = 128, HTB = HALF * BK * 2, STAGE_BYTES = 8 * HTB, NXCD = 8, WGM = 8;
__host__ __device__ __forceinline__ int lds_byte(int r, int c) { const int st = (r >> 4) * 2 + (c >> 5), rr = r & 15, cc = c & 31, ob = rr * 64 + cc * 2; return st * 1024 + (ob ^ (((ob >> 9) & 1) << 5)); }
__host__ __device__ __forceinline__ void stage_rc(int b, int& R, int& C) { const int st = b / 1024, sb = b % 1024, swz = sb ^ (((sb >> 9) & 1) << 5); R = (st >> 1) * 16 + swz / 64; C = (st & 1) * 32 + (swz % 64) / 2; }
__host__ __device__ __forceinline__ int perm32(int rho) { const int n = rho >> 4, i = rho & 15; return 8 * (i >> 2) + 4 * n + (i & 3); }

struct Unit { int pm, pn; const char* a; const char* b; };

struct SchedStd {
    const char* A; const char* B; unsigned sA, sB; int nM, nN, G, c;
    __device__ __forceinline__ void init(const void* A_, unsigned sA_, const void* B_, unsigned sB_, int nM_, int nN_, int G_, int c_) { A = (const char*)A_; B = (const char*)B_; sA = sA_; sB = sB_; nM = nM_; nN = nN_; G = G_; c = c_; }
    __device__ __forceinline__ bool next(int i, Unit& u) const {
        const int nwg = nM * nN; const long L = (long)i * G + c; if (L >= nwg) return false;
        int wgid = (int)L; { const int q = nwg / NXCD, r = nwg % NXCD, xcd = wgid % NXCD, off = wgid / NXCD; wgid = (xcd < r ? xcd * (q + 1) : r * (q + 1) + (xcd - r) * q) + off; }
        const int nig = WGM * nN, gid = wgid / nig, fm = gid * WGM, gsz = (nM - fm) < WGM ? (nM - fm) : WGM;
        u.pm = fm + ((wgid % nig) % gsz); u.pn = (wgid % nig) / gsz;
        u.a = A + (size_t)u.pm * sA; u.b = B + (size_t)u.pn * sB; return true;
    }
};
struct SchedXS {
    const char* A; const char* B; int G, c;
    __device__ __forceinline__ bool next(int i, Unit& u) const {
        const long L = (long)i * G + c; if (L >= 512) return false;
        u.pm = (int)(L >> 2); u.pn = (int)(L & 3);
        u.a = A + (size_t)u.pm * 256 * 2048 + u.pn * 512; u.b = B + (size_t)(u.pm >> 3) * 256 * 2048 + u.pn * 512; return true;
    }
};
struct SchedXQ {
    const char* A; const char* B; int G, c;
    __device__ __forceinline__ bool next(int i, Unit& u) const {
        const long L = (long)i * G + c; if (L >= 512) return false;
        u.pm = (int)(L >> 2); u.pn = (int)(L & 3);
        u.a = A + (size_t)u.pm * 256 * 2048; u.b = B + (size_t)u.pn * 256 * 2048; return true;
    }
};
struct SchedG {
    const char* MK; const char* WQ; int G, c;
    __device__ __forceinline__ bool next(int i, Unit& u) const {
        const long L = (long)i * G + c; if (L >= 512) return false;
        const int l = (int)(L >> 8), r = (int)(L & 255), b = r >> 4, h = (r >> 2) & 3, pn = r & 3;
        u.pm = l * 64 + b * 4 + h; u.pn = pn;
        u.a = MK + (size_t)l * 8 * 1048576 + (size_t)b * 256 * 2048 + h * 512; u.b = WQ + (size_t)l * LAYER_STRIDE + (size_t)pn * 256 * 2048 + h * 512; return true;
    }
};
struct SchedXS2 {
    const char* A; const char* B; int G, c;
    __device__ __forceinline__ bool next(int i, Unit& u) const {
        const long L = (long)i * G + c; if (L >= 512) return false;
        u.pm = (int)(L >> 2); u.pn = (int)(L & 3);
        u.a = A + (size_t)u.pm * 256 * 2048; u.b = B + (size_t)((u.pm >> 3) * 4 + u.pn) * 256 * 2048; return true;
    }
};
struct SchedVW {
    const char* WO; const char* MV; int G, c;
    __device__ __forceinline__ bool next(int i, Unit& u) const {
        const long L = (long)i * G + c; if (L >= 256) return false;
        const int b = (int)(L >> 4), pq = (int)(L >> 2) & 3, h = (int)L & 3;
        u.pm = b * 4 + pq; u.pn = h;
        u.a = WO + (size_t)pq * 256 * 2048 + h * 512; u.b = MV + (size_t)b * 256 * 2048 + h * 512; return true;
    }
};
struct SchedXOut {
    const char* A; const char* B; int G, c;
    __device__ __forceinline__ bool next(int i, Unit& u) const {
        const long L = (long)i * G + c; if (L >= 512) return false;
        u.pm = (int)(L >> 2); u.pn = (int)(L & 3);
        u.a = A + (size_t)u.pm * 256 * 2048; u.b = B + ((size_t)(u.pm >> 3) * 1024 + (size_t)u.pn * 256) * 2048; return true;
    }
};
struct SchedXO {
    const char* A; const char* B; int G, c;
    __device__ __forceinline__ bool next(int i, Unit& u) const {
        const long L = (long)i * G + c; if (L >= 512) return false;
        u.pm = (int)(L >> 2); u.pn = (int)(L & 3);
        u.a = A + (size_t)u.pm * 256 * 2048 + u.pn * 512; u.b = B + (size_t)u.pn * 256 * (MVT_LD * 2) + (size_t)(u.pm >> 3) * 512; return true;
    }
};
struct SchedS2 {
    const char* A; const char* B; int G, c;
    __device__ __forceinline__ bool next(int i, Unit& u) const {
        const long L = (long)i * G + c; if (L >= 256) return false;
        u.pm = (int)L; u.pn = 0;
        u.a = A + (size_t)L * 256 * 1280; u.b = B + (size_t)(L >> 2) * 256 * 1024; return true;
    }
};
struct SchedS4 {
    const char* A; const char* B; int G, c;
    __device__ __forceinline__ bool next(int i, Unit& u) const {
        const long L = (long)i * G + c; if (L >= 512) return false;
        u.pm = (int)(L >> 1); u.pn = (int)(L & 1);
        u.a = A + (size_t)u.pm * 256 * 1280; u.b = B + ((size_t)(L >> 3) * 512 + (size_t)u.pn * 256) * 1280; return true;
    }
};

typedef f32x4 Acc[2][2][4][2];

__device__ __forceinline__ float row_rstd(const float* ssq_row, int nslots) {
    float s = 0.f;
    const f32x4* p = (const f32x4*)ssq_row;
    for (int i = 0; i < nslots / 4; ++i) { const f32x4 v = p[i]; s += (v[0] + v[1]) + (v[2] + v[3]); }
    return 1.0f / sqrtf(s * (1.0f / DM) + EPS);
}

struct EpiStore {
    static constexpr bool PERM = true;
    bf16_t* O; int ldc; const float* ssq; int nslots; float cs; int mode;
    __device__ __forceinline__ void operator()(Acc& acc, const Unit& u, int wr, int wc, int fr, int fq, LAS unsigned char*) const {
        const int row0 = u.pm * BM + wr * 64 + fr, col0 = u.pn * BM + wc * 32 + 8 * fq;
#pragma unroll
        for (int ai = 0; ai < 2; ++ai)
#pragma unroll
            for (int m = 0; m < 4; ++m) {
                const int row = row0 + ai * HALF + m * 16;
                float sc = cs;
                if (ssq) sc *= row_rstd(ssq + (size_t)row * 32, nslots);
#pragma unroll
                for (int bj = 0; bj < 2; ++bj) {
                    const int col = col0 + bj * HALF;
                    const f32x4 v0 = acc[ai][bj][m][0] * sc, v1 = acc[ai][bj][m][1] * sc;
                    u32x4 w; w.x = cvt_pk_bf16(v0[0], v0[1]); w.y = cvt_pk_bf16(v0[2], v0[3]); w.z = cvt_pk_bf16(v1[0], v1[1]); w.w = cvt_pk_bf16(v1[2], v1[3]);
                    bf16_t* p = (mode == 0) ? O + (size_t)row * ldc + col
                                            : O + ((size_t)(col >> 4) * 1024 + (row >> 5)) * 640 + (row & 31) * 16 + (col & 15);
                    *(u32x4*)p = w;
                }
            }
    }
};

struct EpiResid {
    static constexpr bool PERM = false;
    const float* xf; bf16_t* xb; float* ssq;
    __device__ __forceinline__ void operator()(Acc& acc, const Unit& u, int wr, int wc, int fr, int fq, LAS unsigned char*) const {
        const int row0 = u.pm * BM + wr * 64 + fr, col0 = u.pn * BM + wc * 32 + 4 * fq;
#pragma unroll
        for (int ai = 0; ai < 2; ++ai)
#pragma unroll
            for (int m = 0; m < 4; ++m) {
                const int row = row0 + ai * HALF + m * 16; float q = 0.f;
#pragma unroll
                for (int bj = 0; bj < 2; ++bj)
#pragma unroll
                    for (int n = 0; n < 2; ++n) {
                        const int col = col0 + bj * HALF + n * 16; const size_t off = (size_t)row * DM + col;
                        f32x4 v;
                        if (xf) v = *(const f32x4*)(xf + off);
                        else { const u32x2 o = *(const u32x2*)(xb + off); v = (f32x4){bflo(o.x), bfhi(o.x), bflo(o.y), bfhi(o.y)}; }
                        v += acc[ai][bj][m][n];
                        q += (v[0] * v[0] + v[1] * v[1]) + (v[2] * v[2] + v[3] * v[3]);
                        u32x2 w; w.x = cvt_pk_bf16(v[0], v[1]); w.y = cvt_pk_bf16(v[2], v[3]);
                        *(u32x2*)(xb + off) = w;
                    }
                q = sum_x16(q); q = sum_x32(q);
                if (fq == 0) ssq[(size_t)row * 32 + u.pn * 4 + wc] = q;
            }
    }
};

struct EpiGlu {
    static constexpr bool PERM = false;
    bf16_t* xb; float* ssq;
    __device__ __forceinline__ void operator()(Acc& acc, const Unit& u, int wr, int wc, int fr, int fq, LAS unsigned char*) const {
        const int row0 = u.pm * BM + wr * 64 + fr, col0 = u.pn * HALF + wc * 32 + 4 * fq;
#pragma unroll
        for (int ai = 0; ai < 2; ++ai)
#pragma unroll
            for (int m = 0; m < 4; ++m) {
                const int row = row0 + ai * HALF + m * 16; float q = 0.f;
#pragma unroll
                for (int n = 0; n < 2; ++n) {
                    const int col = col0 + n * 16; const size_t off = (size_t)row * DM + col;
                    const f32x4 val = acc[ai][0][m][n], gt = acc[ai][1][m][n];
                    const u32x2 o = *(const u32x2*)(xb + off);
                    f32x4 v = (f32x4){bflo(o.x), bfhi(o.x), bflo(o.y), bfhi(o.y)};
#pragma unroll
                    for (int j = 0; j < 4; ++j) v[j] += val[j] * frcp(1.0f + fexp(-gt[j]));
                    q += (v[0] * v[0] + v[1] * v[1]) + (v[2] * v[2] + v[3] * v[3]);
                    u32x2 w; w.x = cvt_pk_bf16(v[0], v[1]); w.y = cvt_pk_bf16(v[2], v[3]);
                    *(u32x2*)(xb + off) = w;
                }
                q = sum_x16(q); q = sum_x32(q);
                if (fq == 0) ssq[(size_t)row * 32 + u.pn * 4 + wc] = q;
            }
    }
};

struct EpiSoftmax {
    static constexpr bool PERM = true;
    bf16_t* O; const float* ssq; int nslots; float cs;
    __device__ __forceinline__ void operator()(Acc& acc, const Unit& u, int wr, int wc, int fr, int fq, LAS unsigned char* xl) const {
        LAS float* tmax = (LAS float*)xl; LAS float* tsum = tmax + 1024;
#pragma unroll
        for (int ai = 0; ai < 2; ++ai)
#pragma unroll
            for (int m = 0; m < 4; ++m) {
                const float sc = cs * row_rstd(ssq + (size_t)(u.pm * BM + ai * HALF + wr * 64 + m * 16 + fr) * 32, nslots);
#pragma unroll
                for (int bj = 0; bj < 2; ++bj)
#pragma unroll
                    for (int n = 0; n < 2; ++n) acc[ai][bj][m][n] *= sc;
                float mx = -3.0e38f;
#pragma unroll
                for (int bj = 0; bj < 2; ++bj)
#pragma unroll
                    for (int n = 0; n < 2; ++n) { const f32x4 x = acc[ai][bj][m][n]; mx = fmaxf(mx, fmaxf(fmaxf(x[0], x[1]), fmaxf(x[2], x[3]))); }
                mx = max_x16(mx); mx = max_x32(mx);
                if (fq == 0) tmax[(ai * HALF + wr * 64 + m * 16 + fr) * 4 + wc] = mx;
            }
        LDS_WAIT(); __builtin_amdgcn_s_barrier(); asm volatile("" ::: "memory");
#pragma unroll
        for (int ai = 0; ai < 2; ++ai)
#pragma unroll
            for (int m = 0; m < 4; ++m) {
                const int r = ai * HALF + wr * 64 + m * 16 + fr;
                const f32x4 t = *(const LAS f32x4*)(tmax + r * 4);
                const float gm = fmaxf(fmaxf(t[0], t[1]), fmaxf(t[2], t[3])) * LOG2E; float s = 0.f;
#pragma unroll
                for (int bj = 0; bj < 2; ++bj)
#pragma unroll
                    for (int n = 0; n < 2; ++n) {
                        f32x4 x = acc[ai][bj][m][n];
#pragma unroll
                        for (int j = 0; j < 4; ++j) { x[j] = fexp2(x[j] * LOG2E - gm); s += x[j]; }
                        acc[ai][bj][m][n] = x;
                    }
                s = sum_x16(s); s = sum_x32(s);
                if (fq == 0) tsum[r * 4 + wc] = s;
            }
        LDS_WAIT(); __builtin_amdgcn_s_barrier(); asm volatile("" ::: "memory");
        const int row0 = u.pm * BM + wr * 64 + fr, col0 = u.pn * BM + wc * 32 + 8 * fq;
#pragma unroll
        for (int ai = 0; ai < 2; ++ai)
#pragma unroll
            for (int m = 0; m < 4; ++m) {
                const int r = ai * HALF + wr * 64 + m * 16 + fr;
                const f32x4 t = *(const LAS f32x4*)(tsum + r * 4);
                const float inv = 1.0f / ((t[0] + t[1]) + (t[2] + t[3]));
#pragma unroll
                for (int bj = 0; bj < 2; ++bj) {
                    const f32x4 v0 = acc[ai][bj][m][0] * inv, v1 = acc[ai][bj][m][1] * inv;
                    u32x4 w; w.x = cvt_pk_bf16(v0[0], v0[1]); w.y = cvt_pk_bf16(v0[2], v0[3]); w.z = cvt_pk_bf16(v1[0], v1[1]); w.w = cvt_pk_bf16(v1[2], v1[3]);
                    *(u32x4*)(O + (size_t)(row0 + ai * HALF + m * 16) * DM + col0 + bj * HALF) = w;
                }
            }
    }
};


__device__ __forceinline__ float dpp_ror1(float x) { return __int_as_float(__builtin_amdgcn_update_dpp(0, __float_as_int(x), 0x121, 0xf, 0xf, false)); }
__device__ __forceinline__ float dpp_ror2(float x) { return __int_as_float(__builtin_amdgcn_update_dpp(0, __float_as_int(x), 0x122, 0xf, 0xf, false)); }
__device__ __forceinline__ float dpp_ror1u(float x) { return __int_as_float(__builtin_amdgcn_mov_dpp(__float_as_int(x), 0x121, 0xf, 0xf, false)); }
__device__ __forceinline__ float dpp_ror2u(float x) { return __int_as_float(__builtin_amdgcn_mov_dpp(__float_as_int(x), 0x122, 0xf, 0xf, false)); }
__device__ __forceinline__ float dpp_shr1_old(float old, float x) { return __int_as_float(__builtin_amdgcn_update_dpp(__float_as_int(old), __float_as_int(x), 0x111, 0xf, 0xf, false)); }
__device__ __forceinline__ float dpp_shr2_old(float old, float x) { return __int_as_float(__builtin_amdgcn_update_dpp(__float_as_int(old), __float_as_int(x), 0x112, 0xf, 0xf, false)); }
struct EpiUpConv {
    static constexpr bool PERM = true;
    bf16_t* H; bf16_t* HALO; const float* ssq; const float* cw; const float* cb;
    __device__ __forceinline__ void operator()(Acc& acc, const Unit& u, int wr, int wc, int fr, int fq, LAS unsigned char* xl) const {
        LAS float* B = (LAS float*)xl;
        LAS float* Wl = B + 2048;
        LAS float* R = Wl + 1024;
        const int wid = wr * 4 + wc, lane = fq * 16 + fr, tid = wid * 64 + lane;
        const int row0 = u.pm * BM + wr * 64 + fr, colb = wc * 32 + 8 * fq, ch0 = u.pn * HALF + colb;
        {
#pragma unroll
            for (int i = 0; i < 2; ++i) { const int idx = tid + i * 512, t = idx >> 8, bj = (idx >> 7) & 1, chl = idx & 127;
                Wl[idx] = (t < 3) ? cw[t * DFF2 + bj * DFF + u.pn * HALF + chl] : cb[bj * DFF + u.pn * HALF + chl]; }
            if (lane < 32) R[wid * 32 + lane] = row_rstd(ssq + (size_t)(u.pm * BM + wid * 32 + lane) * 32, 16);
        }
        LDS_WAIT(); __builtin_amdgcn_s_barrier(); asm volatile("" ::: "memory");
#pragma unroll
        for (int ai = 0; ai < 2; ++ai)
#pragma unroll
            for (int m = 0; m < 4; ++m) {
                const float sc = R[ai * HALF + wr * 64 + m * 16 + fr];
#pragma unroll
                for (int bj = 0; bj < 2; ++bj)
#pragma unroll
                    for (int n = 0; n < 2; ++n) acc[ai][bj][m][n] *= sc;
            }
        if (fr >= 14) {
#pragma unroll
            for (int ai = 0; ai < 2; ++ai)
#pragma unroll
                for (int bj = 0; bj < 2; ++bj)
#pragma unroll
                    for (int n = 0; n < 2; ++n) *(LAS f32x4*)(B + ((ai * 2 + wr) * 2 + (fr - 14)) * 256 + bj * HALF + colb + 4 * n) = acc[ai][bj][3][n];
        }
        if (wr == 0 && fr < 2) {
#pragma unroll
            for (int bj = 0; bj < 2; ++bj) { const f32x4 v0 = acc[0][bj][0][0], v1 = acc[0][bj][0][1];
                u32x4 w; w.x = cvt_pk_bf16(v0[0], v0[1]); w.y = cvt_pk_bf16(v0[2], v0[3]); w.z = cvt_pk_bf16(v1[0], v1[1]); w.w = cvt_pk_bf16(v1[2], v1[3]);
                *(u32x4*)(HALO + (size_t)(u.pm * 4 + fr) * DFF2 + bj * DFF + ch0) = w; }
        }
        if (wr == 1 && fr >= 14) {
#pragma unroll
            for (int bj = 0; bj < 2; ++bj) { const f32x4 v0 = acc[1][bj][3][0], v1 = acc[1][bj][3][1];
                u32x4 w; w.x = cvt_pk_bf16(v0[0], v0[1]); w.y = cvt_pk_bf16(v0[2], v0[3]); w.z = cvt_pk_bf16(v1[0], v1[1]); w.w = cvt_pk_bf16(v1[2], v1[3]);
                *(u32x4*)(HALO + (size_t)(u.pm * 4 + 2 + (fr - 14)) * DFF2 + bj * DFF + ch0) = w; }
        }
        LDS_WAIT(); __builtin_amdgcn_s_barrier(); asm volatile("" ::: "memory");
#pragma unroll
        for (int ai = 0; ai < 2; ++ai) {
            const bool has = (wr == 1) || (ai == 1);
            const int sb = (wr == 1) ? (ai * 2) : 1;
#pragma unroll
            for (int n = 0; n < 2; ++n) {
                asm volatile("" ::: "memory");
                const int cl = colb + 4 * n;
                float hv[4][4];
                const f32x4 wv0 = *(const LAS f32x4*)(Wl + 0 * 128 + cl), wg0 = *(const LAS f32x4*)(Wl + 1 * 128 + cl);
                const f32x4 wv1 = *(const LAS f32x4*)(Wl + 2 * 128 + cl), wg1 = *(const LAS f32x4*)(Wl + 3 * 128 + cl);
                const f32x4 wv2 = *(const LAS f32x4*)(Wl + 4 * 128 + cl), wg2 = *(const LAS f32x4*)(Wl + 5 * 128 + cl);
                const f32x4 bvv = *(const LAS f32x4*)(Wl + 6 * 128 + cl), bgv = *(const LAS f32x4*)(Wl + 7 * 128 + cl);
                f32x4 b1v = (f32x4){0.f, 0.f, 0.f, 0.f}, b2v = b1v, b1g = b1v, b2g = b1v;
                if (has) {
                    b1v = *(const LAS f32x4*)(B + (sb * 2 + 1) * 256 + cl); b2v = *(const LAS f32x4*)(B + (sb * 2 + (fr & 1)) * 256 + cl);
                    b1g = *(const LAS f32x4*)(B + (sb * 2 + 1) * 256 + HALF + cl); b2g = *(const LAS f32x4*)(B + (sb * 2 + (fr & 1)) * 256 + HALF + cl);
                }
#pragma unroll
                for (int j = 0; j < 4; ++j) {
                    float r1p = b1v[j], r2p = b2v[j], q1p = b1g[j], q2p = b2g[j];
#pragma unroll
                    for (int m = 0; m < 4; ++m) {
                        const float xv = acc[ai][0][m][n][j], xg = acc[ai][1][m][n][j];
                        const float pv1 = dpp_shr1_old(r1p, xv), pv2 = dpp_shr2_old(r2p, xv), pg1 = dpp_shr1_old(q1p, xg), pg2 = dpp_shr2_old(q2p, xg);
                        const float cv = bvv[j] + wv0[j] * pv2 + wv1[j] * pv1 + wv2[j] * xv;
                        const float cg = bgv[j] + wg0[j] * pg2 + wg1[j] * pg1 + wg2[j] * xg;
                        hv[m][j] = cv * cg * frcp(1.0f + fexp(-cg));
                        if (m < 3) { r1p = dpp_ror1u(xv); r2p = dpp_ror2u(xv); q1p = dpp_ror1u(xg); q2p = dpp_ror2u(xg); }
                    }
                    __builtin_amdgcn_sched_barrier(0);
                }
#pragma unroll
                for (int m = 0; m < 4; ++m) {
                    u32x2 w; w.x = cvt_pk_bf16(hv[m][0], hv[m][1]); w.y = cvt_pk_bf16(hv[m][2], hv[m][3]);
                    *(u32x2*)(H + (size_t)(row0 + ai * HALF + m * 16) * DFF + ch0 + 4 * n) = w;
                }
            }
        }
    }
};

struct EpiHend {
    static constexpr bool PERM = false;
    float* Hout;
    __device__ __forceinline__ void operator()(Acc& acc, const Unit& u, int wr, int wc, int fr, int fq, LAS unsigned char*) const {
        const int row0 = u.pm * BM + wr * 64 + fr, col0 = wc * 32 + 4 * fq;
#pragma unroll
        for (int ai = 0; ai < 2; ++ai)
#pragma unroll
            for (int m = 0; m < 4; ++m)
#pragma unroll
                for (int n = 0; n < 2; ++n)
                    *(f32x4*)(Hout + (size_t)(row0 + ai * HALF + m * 16) * 128 + col0 + n * 16) = acc[ai][0][m][n];
    }
};

struct EpiSsmY {
    static constexpr bool PERM = true;
    const bf16_t* Ug; const float* Dskip; bf16_t* Yg;
    __device__ __forceinline__ void operator()(Acc& acc, const Unit& u, int wr, int wc, int fr, int fq, LAS unsigned char*) const {
        const int g = u.pm >> 2;
        const int rg0 = (u.pm & 3) * BM + wr * 64 + fr, col0 = u.pn * BM + wc * 32 + 8 * fq;
        const int co = col0 & 15;
        const f32x4 d0 = *(const f32x4*)(Dskip + g * 16 + co), d1 = *(const f32x4*)(Dskip + g * 16 + co + 4);
#pragma unroll
        for (int ai = 0; ai < 2; ++ai)
#pragma unroll
            for (int m = 0; m < 4; ++m) {
                const int rg = rg0 + ai * HALF + m * 16;
#pragma unroll
                for (int bj = 0; bj < 2; ++bj) {
                    const int col = col0 + bj * HALF;
                    const u32x4 uu = *(const u32x4*)(Ug + ((size_t)g * 1024 + rg) * 640 + col);
                    float y[8];
                    y[0] = acc[ai][bj][m][0][0] + d0[0] * bflo(uu.x); y[1] = acc[ai][bj][m][0][1] + d0[1] * bfhi(uu.x);
                    y[2] = acc[ai][bj][m][0][2] + d0[2] * bflo(uu.y); y[3] = acc[ai][bj][m][0][3] + d0[3] * bfhi(uu.y);
                    y[4] = acc[ai][bj][m][1][0] + d1[0] * bflo(uu.z); y[5] = acc[ai][bj][m][1][1] + d1[1] * bfhi(uu.z);
                    y[6] = acc[ai][bj][m][1][2] + d1[2] * bflo(uu.w); y[7] = acc[ai][bj][m][1][3] + d1[3] * bfhi(uu.w);
#pragma unroll
                    for (int j = 0; j < 8; ++j) { const float x = y[j]; const float k2 = 1.5957691216f * (x + 0.044715f * x * x * x); y[j] = x * frcp(1.0f + fexp(-k2)); }
                    u32x4 w; w.x = cvt_pk_bf16(y[0], y[1]); w.y = cvt_pk_bf16(y[2], y[3]); w.z = cvt_pk_bf16(y[4], y[5]); w.w = cvt_pk_bf16(y[6], y[7]);
                    const size_t tok = (size_t)rg * 32 + (col >> 4);
                    *(u32x4*)(Yg + tok * DM + g * 16 + co) = w;
                }
            }
    }
};

template <class Epi, class Sched>
__device__ __forceinline__ void gemm_phase(LAS unsigned char* lds, LAS unsigned char* xl, const int lda, const int ldb, const int K, const Sched& S, const Epi& E) {
    int tid_ = threadIdx.x; asm volatile("" : "+v"(tid_));
    const int tid = tid_, wid = __builtin_amdgcn_readfirstlane(tid >> 6), lane = tid & 63, wr = wid >> 2, wc = wid & 3, fr = lane & 15, fq = lane >> 4;
    const int nt = K / BK;
    unsigned voffA, voffB;
    { int R, C; stage_rc(tid * 16, R, C); const int Rb = Epi::PERM ? ((R & ~31) + perm32(R & 31)) : R;
      voffA = (unsigned)(R * lda + C) * 2u; voffB = (unsigned)(Rb * ldb + C) * 2u; }
    const size_t qstepA = (size_t)64 * lda * 2, qstepB = (size_t)64 * ldb * 2;
    const size_t kstep = (size_t)(BK * 2);
    const size_t hstepA = (size_t)HALF * lda * 2, hstepB = (size_t)HALF * ldb * 2;
    const unsigned ldsw = (unsigned)wid * 1024u;
    const int aoff = lds_byte(wr * 64 + fr, fq * 8), boff = lds_byte(wc * 32 + fr, fq * 8);
#define PG8_SA(b, h) (((b) * 2 + (h)) * HTB)
#define PG8_SB(b, h) ((4 + (b) * 2 + (h)) * HTB)
#define PG8_STAGE(bufoff, gbase, voff) do { _Pragma("unroll") for (int _i = 0; _i < 2; ++_i) \
        { const char* _gb = (const char*)(gbase) + (size_t)_i * q##voff; asm volatile("" : "+s"(_gb)); \
          __builtin_amdgcn_global_load_lds((const unsigned*)(_gb + (voff)), (LAS unsigned*)(lds + (bufoff) + ldsw + _i * 8192), 16, 0, 0); } } while (0)
#define qvoffA qstepA
#define qvoffB qstepB
#define PG8_LDA(dst, b, h) do { _Pragma("unroll") for (int m = 0; m < 4; ++m) _Pragma("unroll") for (int k = 0; k < 2; ++k) dst[m][k] = *(const LAS bf16x8*)(lds + PG8_SA(b, h) + aoff + m * 2048 + k * 1024); } while (0)
#define PG8_LDB(dst, b, h) do { _Pragma("unroll") for (int n = 0; n < 2; ++n) _Pragma("unroll") for (int k = 0; k < 2; ++k) dst[n][k] = *(const LAS bf16x8*)(lds + PG8_SB(b, h) + boff + n * 2048 + k * 1024); } while (0)
#define PG8_MMA(ai, bj, At, Bt) do { __builtin_amdgcn_s_setprio(1); _Pragma("unroll") for (int m = 0; m < 4; ++m) _Pragma("unroll") for (int n = 0; n < 2; ++n) _Pragma("unroll") for (int k = 0; k < 2; ++k) \
        acc[ai][bj][m][n] = __builtin_amdgcn_mfma_f32_16x16x32_bf16(Bt[n][k], At[m][k], acc[ai][bj][m][n], 0, 0, 0); __builtin_amdgcn_s_setprio(0); } while (0)
#define PG8_WAIT_V(n) asm volatile("s_waitcnt vmcnt(" #n ")" ::: "memory")
#define PG8_WAIT_L(n) asm volatile("s_waitcnt lgkmcnt(" #n ")" ::: "memory")
#define PG8_BAR __builtin_amdgcn_s_barrier()
#define PG8_SCHED __builtin_amdgcn_sched_barrier(0)
    Unit cur, nxt; int ui = 0;
    if (!S.next(0, cur)) return;
    Acc acc;
#pragma unroll
    for (int a = 0; a < 2; ++a)
#pragma unroll
        for (int b = 0; b < 2; ++b)
#pragma unroll
            for (int m = 0; m < 4; ++m)
#pragma unroll
                for (int n = 0; n < 2; ++n) acc[a][b][m][n] = (f32x4){0.f, 0.f, 0.f, 0.f};
    bf16x8 At[4][2], B0[2][2], B1[2][2];
    const char* cA = cur.a; const char* cB = cur.b;
    PG8_STAGE(PG8_SB(0, 0), cB, voffB); PG8_STAGE(PG8_SB(0, 1), cB + hstepB, voffB); PG8_STAGE(PG8_SA(0, 0), cA, voffA); PG8_STAGE(PG8_SA(0, 1), cA + hstepA, voffA);
    if (wr == 1) PG8_BAR;
    PG8_WAIT_V(2); PG8_BAR;
    PG8_STAGE(PG8_SB(1, 0), cB + kstep, voffB); PG8_STAGE(PG8_SA(1, 0), cA + kstep, voffA); PG8_STAGE(PG8_SB(1, 1), cB + hstepB + kstep, voffB);
    PG8_WAIT_V(6); PG8_BAR;
    for (;;) {
        const bool has_next = S.next(ui + 1, nxt);
        const char* nA = has_next ? nxt.a : cA; const char* nB = has_next ? nxt.b : cB;
        for (int t = 0; t < nt; t += 2) {
            const bool last = (t == nt - 2);
            const char* a1 = cA + (size_t)(t + 1) * kstep;
            const char* a2 = last ? nA : cA + (size_t)(t + 2) * kstep; const char* b2 = last ? nB : cB + (size_t)(t + 2) * kstep;
            const char* a3 = a2 + kstep; const char* b3 = b2 + kstep;
            PG8_LDB(B0, 0, 0); PG8_LDB(B1, 0, 1); PG8_SCHED; PG8_LDA(At, 0, 0); PG8_STAGE(PG8_SA(1, 1), a1 + hstepA, voffA);
            PG8_WAIT_V(8); PG8_WAIT_L(0); PG8_BAR; PG8_MMA(0, 0, At, B0); PG8_MMA(0, 1, At, B1); PG8_BAR; PG8_SCHED;
            PG8_LDA(At, 0, 1); PG8_STAGE(PG8_SB(0, 0), b2, voffB); PG8_STAGE(PG8_SB(0, 1), b2 + hstepB, voffB); PG8_STAGE(PG8_SA(0, 0), a2, voffA);
            PG8_WAIT_V(8); PG8_WAIT_L(0); PG8_BAR; PG8_MMA(1, 0, At, B0); PG8_MMA(1, 1, At, B1); PG8_BAR; PG8_SCHED;
            PG8_LDB(B0, 1, 0); PG8_LDB(B1, 1, 1); PG8_SCHED; PG8_LDA(At, 1, 0); PG8_STAGE(PG8_SA(0, 1), a2 + hstepA, voffA);
            PG8_WAIT_V(8); PG8_WAIT_L(0); PG8_BAR; PG8_MMA(0, 0, At, B0); PG8_MMA(0, 1, At, B1); PG8_BAR; PG8_SCHED;
            PG8_LDA(At, 1, 1); PG8_STAGE(PG8_SB(1, 0), b3, voffB); PG8_STAGE(PG8_SB(1, 1), b3 + hstepB, voffB); PG8_STAGE(PG8_SA(1, 0), a3, voffA);
            PG8_WAIT_V(8); PG8_WAIT_L(0); PG8_BAR; PG8_MMA(1, 0, At, B0); PG8_MMA(1, 1, At, B1); PG8_BAR; PG8_SCHED;
        }
        if (wr == 0) PG8_BAR;
        __builtin_amdgcn_sched_barrier(0); asm volatile("s_nop 15\n\ts_nop 15\n\ts_nop 15" ::: "memory"); __builtin_amdgcn_sched_barrier(0);
        { int t2 = threadIdx.x; asm volatile("" : "+v"(t2)); E(acc, cur, wr, wc, t2 & 15, (t2 >> 4) & 3, xl); }
        if (!has_next) break;
#pragma unroll
        for (int a = 0; a < 2; ++a)
#pragma unroll
            for (int b = 0; b < 2; ++b)
#pragma unroll
                for (int m = 0; m < 4; ++m)
#pragma unroll
                    for (int n = 0; n < 2; ++n) acc[a][b][m][n] = (f32x4){0.f, 0.f, 0.f, 0.f};
        cur = nxt; cA = nA; cB = nB; ++ui;
        if (wr == 1) PG8_BAR;
    }
    PG8_WAIT_V(0);
    PG8_BAR;
#undef PG8_SA
#undef PG8_SB
#undef PG8_STAGE
#undef qvoffA
#undef qvoffB
#undef PG8_LDA
#undef PG8_LDB
#undef PG8_MMA
#undef PG8_WAIT_V
#undef PG8_WAIT_L
#undef PG8_BAR
#undef PG8_SCHED
}
}

constexpr int RING_BYTES = 131072, XL_OFF = RING_BYTES, XBST_OFF = XL_OFF + 14336, LDS_BYTES = 147456;

struct TItem { const float* W; const float* gk; bf16_t* D; int N, ldt, drow0, k0, n0; };
__device__ __forceinline__ void titem_load(float (&v)[32], const TItem& t, int lane) {
#pragma unroll
    for (int i = 0; i < 32; ++i) { const int kk = 2 * i + (lane >> 5); v[i] = t.W[(size_t)(t.k0 + kk) * t.N + t.n0 + (lane & 31)]; }
}
__device__ __forceinline__ void titem_to_lds(const float (&v)[32], LAS float* scr, int lane) {
#pragma unroll
    for (int i = 0; i < 32; ++i) { const int kk = 2 * i + (lane >> 5); scr[kk * 33 + (lane & 31)] = v[i]; }
    LDS_WAIT(); asm volatile("" ::: "memory");
}
__device__ __forceinline__ void titem_store(const TItem& t, LAS float* scr, int lane) {
    const int c = lane & 7;
    f32x4 g0 = (f32x4){1.f, 1.f, 1.f, 1.f}, g1 = g0;
    if (t.gk) { g0 = *(const f32x4*)(t.gk + t.k0 + 8 * c); g1 = *(const f32x4*)(t.gk + t.k0 + 8 * c + 4); }
#pragma unroll
    for (int j = 0; j < 4; ++j) { const int n = (lane >> 3) + 8 * j; const LAS float* s = scr + (8 * c) * 33 + n;
        u32x4 o; o.x = cvt_pk_bf16(s[0 * 33] * g0[0], s[1 * 33] * g0[1]); o.y = cvt_pk_bf16(s[2 * 33] * g0[2], s[3 * 33] * g0[3]);
        o.z = cvt_pk_bf16(s[4 * 33] * g1[0], s[5 * 33] * g1[1]); o.w = cvt_pk_bf16(s[6 * 33] * g1[2], s[7 * 33] * g1[3]);
        *(u32x4*)(t.D + (size_t)(t.drow0 + n) * t.ldt + t.k0 + 8 * c) = o; }
    LDS_WAIT(); asm volatile("" ::: "memory");
}
__device__ __forceinline__ void rms_row_to_bf16(const float* xrow, const float* g, bf16_t* orow, int lane) {
    const f32x4* xr = (const f32x4*)xrow + lane; const f32x4* gr = (const f32x4*)g + lane;
    f32x4 v[4]; float s = 0.f;
#pragma unroll
    for (int j = 0; j < 4; ++j) { v[j] = xr[64 * j]; s += (v[j].x * v[j].x + v[j].y * v[j].y) + (v[j].z * v[j].z + v[j].w * v[j].w); }
    const float rstd = 1.f / sqrtf(wave_sum(s) * (1.f / DM) + EPS);
    u32x2* o8 = (u32x2*)orow + lane;
#pragma unroll
    for (int j = 0; j < 4; ++j) { const f32x4 gg = gr[64 * j]; u32x2 w; w.x = cvt_pk_bf16(v[j].x * rstd * gg.x, v[j].y * rstd * gg.y); w.y = cvt_pk_bf16(v[j].z * rstd * gg.z, v[j].w * rstd * gg.w); o8[64 * j] = w; }
}

__device__ __forceinline__ void rms_rows4_to_bf16(const float* xrow, const float* g, bf16_t* orow, int lane) {
    f32x4 v[4][4]; float s[4];
#pragma unroll
    for (int r = 0; r < 4; ++r)
#pragma unroll
        for (int j = 0; j < 4; ++j) v[r][j] = *((const f32x4*)(xrow + (size_t)r * DM) + lane + 64 * j);
#pragma unroll
    for (int r = 0; r < 4; ++r) { s[r] = 0.f;
#pragma unroll
        for (int j = 0; j < 4; ++j) s[r] += (v[r][j].x * v[r][j].x + v[r][j].y * v[r][j].y) + (v[r][j].z * v[r][j].z + v[r][j].w * v[r][j].w); }
#pragma unroll
    for (int r = 0; r < 4; ++r) s[r] = 1.f / sqrtf(wave_sum(s[r]) * (1.f / DM) + EPS);
#pragma unroll
    for (int j = 0; j < 4; ++j) { const f32x4 gg = *((const f32x4*)g + lane + 64 * j);
#pragma unroll
        for (int r = 0; r < 4; ++r) { u32x2 w; w.x = cvt_pk_bf16(v[r][j].x * s[r] * gg.x, v[r][j].y * s[r] * gg.y); w.y = cvt_pk_bf16(v[r][j].z * s[r] * gg.z, v[r][j].w * s[r] * gg.w);
            *((u32x2*)(orow + (size_t)r * DM) + lane + 64 * j) = w; } }
}

struct Args { const float* in[28]; float* out; unsigned char* ws; int ph_lo, ph_hi; };
typedef const __attribute__((address_space(4))) Args* KArgs;
__device__ __forceinline__ KArgs kargs() { KArgs p = (KArgs)__builtin_amdgcn_kernarg_segment_ptr(); asm volatile("" : "+s"(p)); return p; }

__device__ __forceinline__ void ssm_tables(KArgs ap, int g, LAS unsigned char* lds, bf16_t* Tg, bf16_t* Wend) {
    LAS float* Lre = (LAS float*)lds;
    LAS float* Lim = Lre + 33 * 64;
    LAS float* Bre = Lim + 33 * 64;
    LAS float* Bim = Bre + 1024;
    LAS float* Cre = Bim + 1024;
    LAS float* Cim = Cre + 1024;
    LAS float* Kern = Cim + 1024;
    const int tid = threadIdx.x;
    const float* lam_re = ap->in[12] + g * 64; const float* lam_im = ap->in[13] + g * 64;
    const float dt = expf(ap->in[14][g]);
    for (int idx = tid; idx < 33 * 64; idx += 512) {
        const int tau = idx >> 6, p = idx & 63;
        const float mag = expf((float)tau * (lam_re[p] * dt)); const float ang = (float)tau * (lam_im[p] * dt);
        Lre[idx] = mag * cosf(ang); Lim[idx] = mag * sinf(ang);
    }
    __syncthreads();
    for (int idx = tid; idx < 1024; idx += 512) {
        {
            const int p = idx >> 4;
            const float lr = lam_re[p], li = lam_im[p], lbr = Lre[64 + p], lbi = Lim[64 + p];
            const float nre = lbr - 1.0f, den = lr * lr + li * li;
            const float cr = (nre * lr + lbi * li) / den, ci = (lbi * lr - nre * li) / den;
            const float br = ap->in[15][(size_t)g * 1024 + idx], bi = ap->in[16][(size_t)g * 1024 + idx];
            Bre[idx] = cr * br - ci * bi; Bim[idx] = cr * bi + ci * br;
        }
        Cre[idx] = ap->in[17][(size_t)g * 1024 + idx]; Cim[idx] = ap->in[18][(size_t)g * 1024 + idx];
    }
    __syncthreads();
    {
        const int tau = tid >> 4, co = tid & 15; float kacc[16];
#pragma unroll
        for (int ci = 0; ci < 16; ++ci) kacc[ci] = 0.f;
        for (int p = 0; p < 64; ++p) {
            const float cr = Cre[co * 64 + p], cim = Cim[co * 64 + p], lr = Lre[tau * 64 + p], li = Lim[tau * 64 + p];
            const float gr = cr * lr - cim * li, gi = cr * li + cim * lr;
#pragma unroll
            for (int q = 0; q < 4; ++q) { const f32x4 br = *(const LAS f32x4*)(Bre + p * 16 + 4 * q), bi = *(const LAS f32x4*)(Bim + p * 16 + 4 * q);
#pragma unroll
                for (int e = 0; e < 4; ++e) kacc[4 * q + e] += gr * br[e] - gi * bi[e]; }
        }
#pragma unroll
        for (int ci = 0; ci < 16; ++ci) Kern[tid * 16 + ci] = kacc[ci];
    }
    __syncthreads();
    bf16_t* T = Tg + (size_t)g * 512 * 640;
    for (int idx = tid; idx < 512 * 80; idx += 512) {
        const int n = idx / 80, k8 = (idx % 80) * 8; const int t = n >> 4, co = n & 15;
        float v[8];
        if (k8 < 512) { const int s = k8 >> 4, ci = k8 & 15;
#pragma unroll
            for (int j = 0; j < 8; ++j) v[j] = (s <= t) ? Kern[((t - s) * 16 + co) * 16 + ci + j] : 0.f;
        } else { const int q = k8 - 512, im = q >> 6, p0 = q & 63;
#pragma unroll
            for (int j = 0; j < 8; ++j) { const int p = p0 + j; const float cr = Cre[co * 64 + p], cim = Cim[co * 64 + p], lr = Lre[(t + 1) * 64 + p], li = Lim[(t + 1) * 64 + p];
                v[j] = im ? -(cr * li + cim * lr) : (cr * lr - cim * li); }
        }
        u32x4 w; w.x = cvt_pk_bf16(v[0], v[1]); w.y = cvt_pk_bf16(v[2], v[3]); w.z = cvt_pk_bf16(v[4], v[5]); w.w = cvt_pk_bf16(v[6], v[7]);
        *(u32x4*)(T + (size_t)n * 640 + k8) = w;
    }
    bf16_t* We = Wend + (size_t)g * 256 * 512;
    for (int idx = tid; idx < 256 * 64; idx += 512) {
        const int j = idx >> 6, k8 = (idx & 63) * 8; float v[8];
        if (j < 128) { const int p = j & 63, im = j >> 6, s = k8 >> 4, ci = k8 & 15; const float lr = Lre[(31 - s) * 64 + p], li = Lim[(31 - s) * 64 + p];
#pragma unroll
            for (int e = 0; e < 8; ++e) { const float br = Bre[p * 16 + ci + e], bi = Bim[p * 16 + ci + e]; v[e] = im ? (lr * bi + li * br) : (lr * br - li * bi); }
        } else {
#pragma unroll
            for (int e = 0; e < 8; ++e) v[e] = 0.f;
        }
        u32x4 w; w.x = cvt_pk_bf16(v[0], v[1]); w.y = cvt_pk_bf16(v[2], v[3]); w.z = cvt_pk_bf16(v[4], v[5]); w.w = cvt_pk_bf16(v[6], v[7]);
        *(u32x4*)(We + (size_t)j * 512 + k8) = w;
    }
    __syncthreads();
}


template <int W> __device__ __forceinline__ u32x4 pool_item(const bf16_t* up, int t) {
    const int cnt = (t + 1 < W) ? t + 1 : W;
    u32x4 v[W];
#pragma unroll
    for (int i = 0; i < W; ++i) v[i] = (i < cnt) ? *(const u32x4*)(up - (size_t)i * 1536) : (u32x4){0u, 0u, 0u, 0u};
    float s[8];
#pragma unroll
    for (int j = 0; j < 8; ++j) s[j] = 0.f;
#pragma unroll
    for (int i = 0; i < W; ++i) { s[0] += bflo(v[i].x); s[1] += bfhi(v[i].x); s[2] += bflo(v[i].y); s[3] += bfhi(v[i].y); s[4] += bflo(v[i].z); s[5] += bfhi(v[i].z); s[6] += bflo(v[i].w); s[7] += bfhi(v[i].w); }
    const float inv = 1.0f / (float)cnt;
    u32x4 w; w.x = cvt_pk_bf16(s[0] * inv - bflo(v[0].x), s[1] * inv - bfhi(v[0].x)); w.y = cvt_pk_bf16(s[2] * inv - bflo(v[0].y), s[3] * inv - bfhi(v[0].y));
    w.z = cvt_pk_bf16(s[4] * inv - bflo(v[0].z), s[5] * inv - bfhi(v[0].z)); w.w = cvt_pk_bf16(s[6] * inv - bflo(v[0].w), s[7] * inv - bfhi(v[0].w));
    return w;
}

__device__ __forceinline__ void bf8_to_f(const u32x4 v, float (&f)[8]) { f[0] = bflo(v.x); f[1] = bfhi(v.x); f[2] = bflo(v.y); f[3] = bfhi(v.y); f[4] = bflo(v.z); f[5] = bfhi(v.z); f[6] = bflo(v.w); f[7] = bfhi(v.w); }
template <int W> __device__ __forceinline__ void pool_segment(const bf16_t* up, bf16_t* op, int t0) {
    float s[8];
#pragma unroll
    for (int j = 0; j < 8; ++j) s[j] = 0.f;
#pragma unroll
    for (int i = 1; i < W; ++i) {
        u32x4 v = (u32x4){0u, 0u, 0u, 0u};
        if (t0 - i >= 0) v = *(const u32x4*)(up - (size_t)i * 1536);
        float f[8]; bf8_to_f(v, f);
#pragma unroll
        for (int j = 0; j < 8; ++j) s[j] += f[j];
    }
#pragma unroll 4
    for (int r = 0; r < 32; ++r) {
        const int t = t0 + r;
        const u32x4 vc = *(const u32x4*)(up + (size_t)r * 1536);
        u32x4 vo = (u32x4){0u, 0u, 0u, 0u};
        if (t - (W - 1) >= 0) vo = *(const u32x4*)(up + (size_t)(r - (W - 1)) * 1536);
        float fc[8], fo[8]; bf8_to_f(vc, fc); bf8_to_f(vo, fo);
        const float inv = 1.0f / (float)((t + 1 < W) ? t + 1 : W);
        float o[8];
#pragma unroll
        for (int j = 0; j < 8; ++j) { s[j] += fc[j]; o[j] = s[j] * inv - fc[j]; s[j] -= fo[j]; }
        u32x4 w; w.x = cvt_pk_bf16(o[0], o[1]); w.y = cvt_pk_bf16(o[2], o[3]); w.z = cvt_pk_bf16(o[4], o[5]); w.w = cvt_pk_bf16(o[6], o[7]);
        *(u32x4*)(op + (size_t)r * DM) = w;
    }
}

__device__ __forceinline__ int crow(int r, int hi) { return (r & 3) + 8 * (r >> 2) + 4 * hi; }
__device__ __forceinline__ void sb_attn_task(const bf16_t* __restrict__ QKU, const bf16_t* __restrict__ VT, bf16_t* __restrict__ CAT, int b, int h, int qb, int lane) {
    const int r32 = lane & 31, hi = lane >> 5;
    const size_t tok0 = (size_t)b * SEQ; const int q0 = qb * 32;
    const bf16_t* qp = QKU + (tok0 + q0 + r32) * 1536 + h * 64 + 8 * hi;
    bf16x8 qf[4];
#pragma unroll
    for (int j = 0; j < 4; ++j) qf[j] = *(const bf16x8*)(qp + 16 * j);
    const bf16_t* kp = QKU + (tok0 + r32) * 1536 + 512 + h * 64 + 8 * hi;
    const bf16_t* vp = VT + (size_t)(h * 64 + r32) * VT_LD + tok0 + 4 * hi;
    f32x16 o0, o1;
#pragma unroll
    for (int r = 0; r < 16; ++r) { o0[r] = 0.f; o1[r] = 0.f; }
    float carry = 1.0f;
    bf16x8 kf[4]; s16x4 va[2][4]; bf16x8 k1[4]; s16x4 v1[2][4];
#define SB_LOAD(KF, VA, K0) do { const int k0_ = (K0); \
        _Pragma("unroll") for (int j = 0; j < 4; ++j) KF[j] = *(const bf16x8*)(kp + (size_t)k0_ * 1536 + 16 * j); \
        _Pragma("unroll") for (int dh = 0; dh < 2; ++dh) _Pragma("unroll") for (int c = 0; c < 4; ++c) VA[dh][c] = *(const s16x4*)(vp + (size_t)dh * 32 * VT_LD + k0_ + 8 * c); } while (0)
    asm volatile("s_waitcnt vmcnt(0)" ::: "memory");
    SB_LOAD(kf, va, q0);
    SB_LOAD(k1, v1, qb > 0 ? q0 - 32 : q0);
    for (int kt = qb; kt >= 0; --kt) {
        bf16x8 kn[4]; s16x4 vn[2][4];
        SB_LOAD(kn, vn, kt >= 2 ? (kt - 2) * 32 : 0);
        f32x16 s;
#pragma unroll
        for (int r = 0; r < 16; ++r) s[r] = 0.f;
#pragma unroll
        for (int j = 0; j < 4; ++j) s = __builtin_amdgcn_mfma_f32_32x32x16_bf16(kf[j], qf[j], s, 0, 0, 0);
        const bool diag = (kt == qb);
        float omb[16], bt[16];
#pragma unroll
        for (int r = 0; r < 16; ++r) {
            const float z2 = fminf(s[r] * (0.125f * LOG2E), 100.0f);
            const float e = fexp2(z2);
            const float ob = frcp(1.0f + e);
            const bool valid = !diag || (crow(r, hi) < r32);
            omb[r] = valid ? ob : 1.0f; bt[r] = valid ? e * ob : 0.0f;
        }
        float gp[4], pg[4];
#pragma unroll
        for (int g = 0; g < 4; ++g) { gp[g] = (omb[4 * g] * omb[4 * g + 1]) * (omb[4 * g + 2] * omb[4 * g + 3]); pg[g] = partner32(gp[g], hi); }
        float tp[4];
        tp[3] = 1.0f; tp[2] = gp[3] * pg[3]; tp[1] = tp[2] * (gp[2] * pg[2]); tp[0] = tp[1] * (gp[1] * pg[1]);
        const float total = tp[0] * (gp[0] * pg[0]);
        float w[16];
#pragma unroll
        for (int g = 0; g < 4; ++g) {
            const float base = carry * tp[g] * (hi ? 1.0f : pg[g]);
            const float a3 = base, a2 = a3 * omb[4 * g + 3], a1 = a2 * omb[4 * g + 2], a0 = a1 * omb[4 * g + 1];
            w[4 * g + 3] = bt[4 * g + 3] * a3;
            w[4 * g + 2] = bt[4 * g + 2] * a2;
            w[4 * g + 1] = bt[4 * g + 1] * a1;
            w[4 * g + 0] = bt[4 * g + 0] * a0;
        }
        carry *= total;
        u32x4 p0, p1;
        p0.x = cvt_pk_bf16(w[0], w[1]); p0.y = cvt_pk_bf16(w[2], w[3]); p0.z = cvt_pk_bf16(w[4], w[5]); p0.w = cvt_pk_bf16(w[6], w[7]);
        p1.x = cvt_pk_bf16(w[8], w[9]); p1.y = cvt_pk_bf16(w[10], w[11]); p1.z = cvt_pk_bf16(w[12], w[13]); p1.w = cvt_pk_bf16(w[14], w[15]);
        const bf16x8 pb0 = __builtin_bit_cast(bf16x8, p0), pb1 = __builtin_bit_cast(bf16x8, p1);
#define VA8(dh, c) (bf16x8){va[dh][c][0], va[dh][c][1], va[dh][c][2], va[dh][c][3], va[dh][(c) + 1][0], va[dh][(c) + 1][1], va[dh][(c) + 1][2], va[dh][(c) + 1][3]}
        const bf16x8 a00 = VA8(0, 0), a02 = VA8(0, 2), a10 = VA8(1, 0), a12 = VA8(1, 2);
#undef VA8
        o0 = __builtin_amdgcn_mfma_f32_32x32x16_bf16(a00, pb0, o0, 0, 0, 0);
        o0 = __builtin_amdgcn_mfma_f32_32x32x16_bf16(a02, pb1, o0, 0, 0, 0);
        o1 = __builtin_amdgcn_mfma_f32_32x32x16_bf16(a10, pb0, o1, 0, 0, 0);
        o1 = __builtin_amdgcn_mfma_f32_32x32x16_bf16(a12, pb1, o1, 0, 0, 0);
        __builtin_amdgcn_sched_barrier(0);
        asm volatile("s_nop 15\n\ts_nop 15\n\ts_nop 15\n\ts_nop 15\n\ts_nop 15" ::: "memory");
        asm volatile("" :: "v"(a00), "v"(a02), "v"(a10), "v"(a12), "v"(pb0), "v"(pb1), "v"(kf[0]), "v"(kf[1]), "v"(kf[2]), "v"(kf[3]));
        __builtin_amdgcn_sched_barrier(0);
        if (__all(carry == 0.0f)) break;
#pragma unroll
        for (int j = 0; j < 4; ++j) { kf[j] = k1[j]; k1[j] = kn[j]; }
#pragma unroll
        for (int dh = 0; dh < 2; ++dh)
#pragma unroll
            for (int c = 0; c < 4; ++c) { va[dh][c] = v1[dh][c]; v1[dh][c] = vn[dh][c]; }
    }
#undef SB_LOAD
    bf16_t* op = CAT + (tok0 + q0 + r32) * DM + h * 64 + 4 * hi;
#pragma unroll
    for (int g = 0; g < 4; ++g) {
        u32x2 w0, w1;
        w0.x = cvt_pk_bf16(o0[4 * g], o0[4 * g + 1]); w0.y = cvt_pk_bf16(o0[4 * g + 2], o0[4 * g + 3]);
        w1.x = cvt_pk_bf16(o1[4 * g], o1[4 * g + 1]); w1.y = cvt_pk_bf16(o1[4 * g + 2], o1[4 * g + 3]);
        *(u32x2*)(op + 8 * g) = w0; *(u32x2*)(op + 32 + 8 * g) = w1;
    }
}


constexpr int SBK_PITCH = 144, SBV_PITCH = 80, SBK_BYTES = 32 * SBK_PITCH, SBV_BYTES = 64 * SBV_PITCH, SB_BUF = SBK_BYTES + SBV_BYTES;
__device__ __forceinline__ void sb_attn_block(const bf16_t* __restrict__ QKU, const bf16_t* __restrict__ VT, bf16_t* __restrict__ CAT, int b, int h, int qb0,
                                              LAS unsigned char* lds, int tid, int wave, int lane) {
    const int r32 = lane & 31, hi = lane >> 5;
    const size_t tok0 = (size_t)b * SEQ; const int qb = qb0 + wave, q0 = qb * 32;
    const bf16_t* qp = QKU + (tok0 + q0 + r32) * 1536 + h * 64 + 8 * hi;
    bf16x8 qf[4];
#pragma unroll
    for (int j = 0; j < 4; ++j) qf[j] = *(const bf16x8*)(qp + 16 * j);
    f32x16 o0, o1;
#pragma unroll
    for (int r = 0; r < 16; ++r) { o0[r] = 0.f; o1[r] = 0.f; }
    float carry = 1.0f; bool done = false;
    LAS unsigned* flg = (LAS unsigned*)(lds + 2 * SB_BUF);
    const bool isk = tid < 256; const int t2 = tid & 255;
    const bf16_t* gsrc = isk ? QKU + (tok0 + (t2 >> 3)) * 1536 + 512 + h * 64 + (t2 & 7) * 8
                             : VT + (size_t)(h * 64 + (t2 >> 2)) * VT_LD + tok0 + (t2 & 3) * 8;
    const size_t gstep = isk ? (size_t)32 * 1536 : (size_t)32;
    const int ldst = isk ? (t2 >> 3) * SBK_PITCH + (t2 & 7) * 16 : SBK_BYTES + (t2 >> 2) * SBV_PITCH + (t2 & 3) * 16;
    const int ktop = qb0 + 7;
    u32x4 stg = *(const u32x4*)(gsrc + (size_t)ktop * gstep);
    *(LAS u32x4*)(lds + (ktop & 1) * SB_BUF + ldst) = stg;
    __syncthreads();
    for (int kt = ktop; kt >= 0; --kt) {
        if (kt > 0) stg = *(const u32x4*)(gsrc + (size_t)(kt - 1) * gstep);
        LAS unsigned char* kb = lds + (kt & 1) * SB_BUF; LAS unsigned char* vb = kb + SBK_BYTES;
        if (kt <= qb && !done) {
            bf16x8 kf[4]; s16x4 va[2][4];
#pragma unroll
            for (int j = 0; j < 4; ++j) kf[j] = *(const LAS bf16x8*)(kb + r32 * SBK_PITCH + (16 * j + 8 * hi) * 2);
#pragma unroll
            for (int dh = 0; dh < 2; ++dh)
#pragma unroll
                for (int c = 0; c < 4; ++c) va[dh][c] = *(const LAS s16x4*)(vb + (dh * 32 + r32) * SBV_PITCH + (8 * c + 4 * hi) * 2);
            f32x16 s;
#pragma unroll
            for (int r = 0; r < 16; ++r) s[r] = 0.f;
#pragma unroll
            for (int j = 0; j < 4; ++j) s = __builtin_amdgcn_mfma_f32_32x32x16_bf16(kf[j], qf[j], s, 0, 0, 0);
            const bool diag = (kt == qb);
            float omb[16], bt[16];
#pragma unroll
            for (int r = 0; r < 16; ++r) {
                const float z2 = fminf(s[r] * (0.125f * LOG2E), 100.0f);
                const float e = fexp2(z2);
                const float ob = frcp(1.0f + e);
                const bool valid = !diag || (crow(r, hi) < r32);
                omb[r] = valid ? ob : 1.0f; bt[r] = valid ? e * ob : 0.0f;
            }
            float gp[4], pg[4];
#pragma unroll
            for (int g = 0; g < 4; ++g) { gp[g] = (omb[4 * g] * omb[4 * g + 1]) * (omb[4 * g + 2] * omb[4 * g + 3]); pg[g] = partner32(gp[g], hi); }
            float tp[4];
            tp[3] = 1.0f; tp[2] = gp[3] * pg[3]; tp[1] = tp[2] * (gp[2] * pg[2]); tp[0] = tp[1] * (gp[1] * pg[1]);
            const float total = tp[0] * (gp[0] * pg[0]);
            float w[16];
#pragma unroll
            for (int g = 0; g < 4; ++g) {
                const float base = carry * tp[g] * (hi ? 1.0f : pg[g]);
                const float a3 = base, a2 = a3 * omb[4 * g + 3], a1 = a2 * omb[4 * g + 2], a0 = a1 * omb[4 * g + 1];
                w[4 * g + 3] = bt[4 * g + 3] * a3; w[4 * g + 2] = bt[4 * g + 2] * a2; w[4 * g + 1] = bt[4 * g + 1] * a1; w[4 * g + 0] = bt[4 * g + 0] * a0;
            }
            carry *= total;
            u32x4 p0, p1;
            p0.x = cvt_pk_bf16(w[0], w[1]); p0.y = cvt_pk_bf16(w[2], w[3]); p0.z = cvt_pk_bf16(w[4], w[5]); p0.w = cvt_pk_bf16(w[6], w[7]);
            p1.x = cvt_pk_bf16(w[8], w[9]); p1.y = cvt_pk_bf16(w[10], w[11]); p1.z = cvt_pk_bf16(w[12], w[13]); p1.w = cvt_pk_bf16(w[14], w[15]);
            const bf16x8 pb0 = __builtin_bit_cast(bf16x8, p0), pb1 = __builtin_bit_cast(bf16x8, p1);
#define VA8(dh, c) (bf16x8){va[dh][c][0], va[dh][c][1], va[dh][c][2], va[dh][c][3], va[dh][(c) + 1][0], va[dh][(c) + 1][1], va[dh][(c) + 1][2], va[dh][(c) + 1][3]}
            const bf16x8 a00 = VA8(0, 0), a02 = VA8(0, 2), a10 = VA8(1, 0), a12 = VA8(1, 2);
#undef VA8
            o0 = __builtin_amdgcn_mfma_f32_32x32x16_bf16(a00, pb0, o0, 0, 0, 0);
            o0 = __builtin_amdgcn_mfma_f32_32x32x16_bf16(a02, pb1, o0, 0, 0, 0);
            o1 = __builtin_amdgcn_mfma_f32_32x32x16_bf16(a10, pb0, o1, 0, 0, 0);
            o1 = __builtin_amdgcn_mfma_f32_32x32x16_bf16(a12, pb1, o1, 0, 0, 0);
            __builtin_amdgcn_sched_barrier(0);
            asm volatile("s_nop 15\n\ts_nop 15\n\ts_nop 15\n\ts_nop 15\n\ts_nop 15" ::: "memory");
            asm volatile("" :: "v"(a00), "v"(a02), "v"(a10), "v"(a12), "v"(pb0), "v"(pb1), "v"(kf[0]), "v"(kf[1]), "v"(kf[2]), "v"(kf[3]));
            __builtin_amdgcn_sched_barrier(0);
            if (__all(carry == 0.0f) || kt == 0) done = true;
        }
        if (kt > 0) *(LAS u32x4*)(lds + ((kt - 1) & 1) * SB_BUF + ldst) = stg;
        if (lane == 0) flg[(kt & 1) * 8 + wave] = done ? 1u : 0u;
        __syncthreads();
        const u32x4 f0 = *(const LAS u32x4*)(flg + (kt & 1) * 8), f1 = *(const LAS u32x4*)(flg + (kt & 1) * 8 + 4);
        if ((f0.x & f0.y & f0.z & f0.w & f1.x & f1.y & f1.z & f1.w) != 0u) break;
    }
    bf16_t* op = CAT + (tok0 + q0 + r32) * DM + h * 64 + 4 * hi;
#pragma unroll
    for (int g = 0; g < 4; ++g) {
        u32x2 w0, w1;
        w0.x = cvt_pk_bf16(o0[4 * g], o0[4 * g + 1]); w0.y = cvt_pk_bf16(o0[4 * g + 2], o0[4 * g + 3]);
        w1.x = cvt_pk_bf16(o1[4 * g], o1[4 * g + 1]); w1.y = cvt_pk_bf16(o1[4 * g + 2], o1[4 * g + 3]);
        *(u32x2*)(op + 8 * g) = w0; *(u32x2*)(op + 32 + 8 * g) = w1;
    }
    __syncthreads();
}


#define XB_TMO      128
#define XB_XCNT(j)  (256  + 64 * (j))
#define XB_XSUB(j)  (1280 + 64 * (j))
#define XB_XGEN(j)  (2304 + 64 * (j))
#define XB_TOP      3328
#define XB_TOPGEN   3392
#define XCD_BAR_WORDS 3456
#define XB_SPIN_CAP (1u << 22)
__device__ __forceinline__ unsigned xb_ld(unsigned* p)              { return __hip_atomic_load(p, __ATOMIC_RELAXED, __HIP_MEMORY_SCOPE_AGENT); }
__device__ __forceinline__ unsigned xb_add(unsigned* p, unsigned v) { return __hip_atomic_fetch_add(p, v, __ATOMIC_RELAXED, __HIP_MEMORY_SCOPE_AGENT); }
__device__ __forceinline__ unsigned xb_xcc_id() { return (unsigned)__builtin_amdgcn_s_getreg((3 << 11) | 20) & 0xFu; }
#define XB_SPIN(cond, bar) do { unsigned _sp = 0; while (cond) { __builtin_amdgcn_s_sleep(1); \
    if ((++_sp & 255u) == 0u) { if (xb_ld(&(bar)[XB_TMO])) break; if (_sp > XB_SPIN_CAP) { atomicAdd(&(bar)[XB_TMO], 1u); break; } } } } while (0)
__device__ __forceinline__ void xcd_barrier_complete(unsigned* bar, unsigned x, unsigned G, unsigned& nloc, unsigned& nx) {
    unsigned sum, cnt, mine, sp = 0u;
    for (;;) {
        sum = 0u; cnt = 0u; mine = 0u;
#pragma unroll
        for (unsigned j = 0; j < 16; ++j) { const unsigned c = xb_ld(&bar[XB_XCNT(j)]); sum += c; cnt += (c > 0u) ? 1u : 0u; mine = (j == x) ? c : mine; }
        if (sum == G) break;
        __builtin_amdgcn_s_sleep(1);
        if ((++sp & 255u) == 0u) { if (xb_ld(&bar[XB_TMO])) break; if (sp > XB_SPIN_CAP) { atomicAdd(&bar[XB_TMO], 1u); break; } }
    }
    nloc = mine > 0u ? mine : 1u; nx = cnt > 0u ? cnt : 1u;
}
__device__ __forceinline__ void xcd_barrier(unsigned* bar, volatile LAS unsigned* st, bool leader, unsigned G) {
    asm volatile("s_waitcnt vmcnt(0)" ::: "memory");
    __syncthreads();
    if (leader) {
        const unsigned x = xb_xcc_id();
        __builtin_amdgcn_s_waitcnt(0);
        unsigned nloc = st[0], nx = st[1];
        if (nloc == 0u) { xcd_barrier_complete(bar, x, G, nloc, nx); st[0] = nloc; st[1] = nx; }
        const unsigned old = xb_add(&bar[XB_XSUB(x)], 1u);
        const unsigned gen = old / nloc;
        if (old + 1u == (gen + 1u) * nloc) {
            __builtin_amdgcn_fence(__ATOMIC_RELEASE, "agent");
            asm volatile("s_waitcnt vmcnt(0)" ::: "memory");
            const unsigned og = xb_add(&bar[XB_TOP], 1u);
            const unsigned tg = og / nx;
            if (og + 1u == (tg + 1u) * nx) xb_add(&bar[XB_TOPGEN], 1u);
            else XB_SPIN(xb_ld(&bar[XB_TOPGEN]) == tg, bar);
            __builtin_amdgcn_fence(__ATOMIC_ACQUIRE, "agent");
            xb_add(&bar[XB_XGEN(x)], 1u);
            asm volatile("s_waitcnt vmcnt(0)" ::: "memory");
        } else {
            XB_SPIN(xb_ld(&bar[XB_XGEN(x)]) == gen, bar);
            __builtin_amdgcn_fence(__ATOMIC_ACQUIRE, "agent");
            asm volatile("s_waitcnt vmcnt(0)" ::: "memory");
        }
    }
    __syncthreads();
}

__global__ void __launch_bounds__(512) mega_fwd(Args a) {
    __builtin_assume(__builtin_amdgcn_workitem_id_y() == 0); __builtin_assume(__builtin_amdgcn_workitem_id_z() == 0);
    extern __shared__ __attribute__((aligned(16))) unsigned char lds_raw[];
    LAS unsigned char* lds = (LAS unsigned char*)lds_raw;
    LAS unsigned char* xl = lds + XL_OFF;
    cg::grid_group grid = cg::this_grid();
#if !MK_MULTI_LAUNCH
    {
        volatile LAS unsigned* st = (volatile LAS unsigned*)(lds + XBST_OFF);
        if (threadIdx.x == 0) { st[0] = 0u; st[1] = 0u; KArgs ap0 = kargs(); xb_add(&((unsigned*)ap0->ws)[XB_XCNT(xb_xcc_id())], 1u); }
        if (a.ph_lo < 0) grid.sync();
        __syncthreads();
    }
#endif
#if MK_MULTI_LAUNCH
    const int lo = a.ph_lo, hi = a.ph_hi;
    int ph = 0;
#endif
#define PH_VARS int tid = threadIdx.x; asm volatile("" : "+v"(tid)); const int lane = tid & 63, wave = __builtin_amdgcn_readfirstlane(tid >> 6); int G_ = gridDim.x, bid_ = blockIdx.x; asm volatile("" : "+s"(G_), "+s"(bid_)); const int G = G_, bid = bid_; \
    const int gw = bid * 8 + wave, NGW = G * 8, gt = bid * 512 + tid, NGT = G * 512; (void)lane; (void)gw; (void)NGW; (void)gt; (void)NGT; KArgs ap = kargs(); unsigned char* ws = ap->ws; float* X = ap->out; float* SSQ = (float*)(ws + WS_SSQ); bf16_t* XB = (bf16_t*)(ws + WS_XB); bf16_t* MEMN = (bf16_t*)(ws + WS_MEMN); (void)X; (void)SSQ; (void)XB; (void)MEMN;
#if MK_MULTI_LAUNCH
#define PHASE_ON (ph >= lo && ph < hi)
#define PHASE_END do { if (ph >= lo && ph + 1 < hi) grid.sync(); ++ph; } while (0)
#define LOCAL_SEAM PHASE_END
#else
#define PHASE_ON (true)
#define LOCAL_SEAM do { asm volatile("s_waitcnt vmcnt(0)" ::: "memory"); __syncthreads(); { int tl = threadIdx.x; asm volatile("" : "+v"(tl)); \
    if (tl == 0) { __builtin_amdgcn_fence(__ATOMIC_ACQUIRE, "agent"); asm volatile("s_waitcnt vmcnt(0)" ::: "memory"); } } __syncthreads(); } while (0)
#define PHASE_END do { KArgs apb = kargs(); int tb = threadIdx.x; asm volatile("" : "+v"(tb)); int Gb = gridDim.x; asm volatile("" : "+s"(Gb)); \
    xcd_barrier((unsigned*)apb->ws, (volatile LAS unsigned*)(lds + XBST_OFF), tb == 0, (unsigned)Gb); } while (0)
#endif

    if (PHASE_ON) { PH_VARS
        if (bid < 64) ssm_tables(ap, bid, lds, (bf16_t*)(ws + WS_TG), (bf16_t*)(ws + WS_WEND));
        LAS float* scr = (LAS float*)(lds + wave * 16384);
        const bool weighted = (G > 64);
        const int n_tw = weighted ? 64 * 8 : 0, n_nw = weighted ? (G - 64) * 8 : G * 8;
        const int spw = weighted ? 4 : 1, S = n_nw * spw + n_tw;
        const bool is_tw = weighted && bid < 64;
        const int slot0 = is_tw ? n_nw * spw + gw : (weighted ? (gw - 512) * 4 : gw), nslot = is_tw ? 1 : spw;
        if (!is_tw) {
            const int nb_ = weighted ? G - 64 : G, b_ = weighted ? bid - 64 : bid;
            for (int it = b_ + wave * nb_; it < 256; it += nb_ * 8) {
                const int g = it >> 6, cb = (it >> 2) & 15, nb = it & 3;
                const float* pw = ap->in[8] + (size_t)(g * 128 + cb * 8) * 128; const float* sc = ap->in[9] + g * 128;
                const float* wo = ap->in[10] + (size_t)(512 + g * 128) * 1024 + nb * 256 + lane * 4;
                f32x4 acc8[8];
#pragma unroll
                for (int j = 0; j < 8; ++j) acc8[j] = (f32x4){0.f, 0.f, 0.f, 0.f};
#pragma unroll 8
                for (int d = 0; d < 128; ++d) {
                    const f32x4 wv = *(const f32x4*)(wo + (size_t)d * 1024); const float sd = sc[d];
#pragma unroll
                    for (int j = 0; j < 8; ++j) acc8[j] += wv * (pw[j * 128 + d] * sd);
                }
                bf16_t* D = (bf16_t*)(ws + WS_WOUT) + (size_t)(nb * 256 + lane * 4) * 1024 + 512 + g * 128 + cb * 8;
#pragma unroll
                for (int e = 0; e < 4; ++e) {
                    u32x4 w; w.x = cvt_pk_bf16(acc8[0][e], acc8[1][e]); w.y = cvt_pk_bf16(acc8[2][e], acc8[3][e]); w.z = cvt_pk_bf16(acc8[4][e], acc8[5][e]); w.w = cvt_pk_bf16(acc8[6][e], acc8[7][e]);
                    *(u32x4*)(D + (size_t)e * 1024) = w;
                }
            }
        }
        {
            float tv[32]; TItem cur, nxt; bool have = false, have_next = false;
            int sl = 0, it = slot0;
            auto decode = [&](int item, TItem& t) -> bool {
                int r = item; const float* W = nullptr; const float* gk = nullptr; int N = 0; bf16_t* D = nullptr; int ldt = 0, mode = 0; bool found = false;
#define TJOB(Wp, Kk, Nn, Dp, Ld, Md, Gp) if (!found) { const int cnt = ((Kk) / 64) * ((Nn) / 32); if (r < cnt) { W = (Wp); N = (Nn); D = (bf16_t*)(Dp); ldt = (Ld); mode = (Md); gk = (Gp); found = true; } else r -= cnt; }
                TJOB(ap->in[7], 1024, 2048, ws + WS_WIN, 1024, 1, nullptr)
            TJOB(ap->in[10], 512, 1024, ws + WS_WOUT, 1024, 0, nullptr)
            TJOB(ap->in[11], 1024, 1024, ws + WS_WSSM, 1024, 0, ap->in[2] + 1024)
            TJOB(ap->in[20], 1024, 2048, ws + WS_WGLU, 1024, 2, nullptr)
#pragma unroll
            for (int l = 0; l < 2; ++l) {
                unsigned char* lb = ws + WS_LAYER + l * LAYER_STRIDE;
                TJOB(ap->in[22] + (size_t)l * 1024 * 2048, 1024, 2048, lb + LO_WKV, 1024, 0, nullptr)
                TJOB(ap->in[23] + (size_t)l * 1024 * 1024, 1024, 1024, lb + LO_WO, 1024, 0, nullptr)
                TJOB(ap->in[24] + (size_t)l * 1024 * DFF2, 1024, DFF2, lb + LO_WUP, 1024, 3, ap->in[4] + l * 1024)
                TJOB(ap->in[27] + (size_t)l * DFF * 1024, DFF, 1024, lb + LO_WDN, DFF, 0, nullptr)
            }
#undef TJOB
                if (!found) return false;
                const int nblk = N / 32, kb = r / nblk, nb = r % nblk, n0 = nb * 32;
                int drow0 = n0;
                if (mode == 1) drow0 = (n0 < 1024) ? n0 : (n0 < 1536 ? n0 + 512 : n0 - 512);
                else if (mode == 2) drow0 = (n0 < 1024) ? (256 * (n0 >> 7) + (n0 & 127)) : (256 * ((n0 - 1024) >> 7) + 128 + ((n0 - 1024) & 127));
                else if (mode == 3) drow0 = (n0 < DFF) ? (256 * (n0 >> 7) + (n0 & 127)) : (256 * ((n0 - DFF) >> 7) + 128 + ((n0 - DFF) & 127));
                t.W = W; t.gk = gk; t.D = D; t.N = N; t.ldt = ldt; t.drow0 = drow0; t.k0 = kb * 64; t.n0 = n0; return true;
            };
            auto advance = [&](TItem& t) -> bool {
                while (sl < nslot) { if (decode(it, t)) { it += S; return true; } ++sl; it = slot0 + sl; }
                return false;
            };
            have = advance(cur);
            if (have) titem_load(tv, cur, lane);
            while (have) {
                titem_to_lds(tv, scr, lane);
                have_next = advance(nxt);
                if (have_next) titem_load(tv, nxt, lane);
                titem_store(cur, scr, lane);
                cur = nxt; have = have_next;
            }
        }
        for (int it = gt; it < 2 * 1024 * 256; it += NGT) {
            const int l = it >> 18, e = it & 262143, k = e >> 8, n4 = (e & 255) * 4;
            const f32x4 w = *(const f32x4*)(ap->in[21] + (size_t)l * 1048576 + (size_t)k * 1024 + n4); const float gk = ap->in[3][l * 1024 + k];
            u32x2 o; o.x = cvt_pk_bf16(w[0] * gk, w[1] * gk); o.y = cvt_pk_bf16(w[2] * gk, w[3] * gk);
            *(u32x2*)((bf16_t*)(ws + WS_LAYER + l * LAYER_STRIDE + LO_WQ) + (size_t)k * 1024 + n4) = o;
        }
        for (int r = gw; r < MEMTOK / 4; r += NGW) rms_rows4_to_bf16(ap->in[1] + (size_t)r * 4 * DM, ap->in[5], MEMN + (size_t)r * 4 * DM, lane);
        for (int r = gw; r < MTOK / 4; r += NGW) rms_rows4_to_bf16(ap->in[0] + (size_t)r * 4 * DM, ap->in[2], XB + (size_t)r * 4 * DM, lane);
        __syncthreads();
    }
    PHASE_END;

    if (PHASE_ON) { PH_VARS
        bf16_t* WIN = (bf16_t*)(ws + WS_WIN);
        { pg8::SchedStd S; S.init(XB, 256 * 2048, WIN, 256 * 2048, 128, 6, G, bid);
          pg8::EpiStore E{(bf16_t*)(ws + WS_QKU), 1536, nullptr, 0, 1.0f, 0};
          pg8::gemm_phase(lds, xl, 1024, 1024, 1024, S, E); }
        { pg8::SchedStd S; S.init(WIN + (size_t)1536 * 1024, 256 * 2048, XB, 256 * 2048, 2, 128, G, bid);
          pg8::EpiStore E{(bf16_t*)(ws + WS_VT), VT_LD, nullptr, 0, 1.0f, 0};
          pg8::gemm_phase(lds, xl, 1024, 1024, 1024, S, E); }
        for (int j = 0; j < 4; ++j) {
            const int l = j >> 1, isv = j & 1;
            bf16_t* WKV = (bf16_t*)(ws + WS_LAYER + l * LAYER_STRIDE + LO_WKV);
            const int c = (bid + 64 * (j + 1)) % G;
            pg8::SchedStd S;
            S.init(MEMN, 256 * 2048, WKV + (size_t)isv * 1024 * 1024, 256 * 2048, 16, 4, G, c);
            pg8::EpiStore E{isv ? (bf16_t*)(ws + WS_MEMVT + l * MEMVT_STRIDE) : (bf16_t*)(ws + WS_MEMK + l * 8 * MiB), 1024, nullptr, 0, 1.0f, 0};
            pg8::gemm_phase(lds, xl, 1024, 1024, 1024, S, E);
        }
    }
    PHASE_END;

    if (PHASE_ON) { PH_VARS
        const bf16_t* QKU = (const bf16_t*)(ws + WS_QKU); bf16_t* CAT = (bf16_t*)(ws + WS_CAT);
        for (int it = gt; it < 64 * (MTOK / 32); it += NGT) {
            const int ch = it & 63, seg = it >> 6, g = ch >> 4;
            const bf16_t* up = QKU + (size_t)seg * 32 * 1536 + 1024 + ch * 8;
            bf16_t* op = CAT + (size_t)seg * 32 * DM + 512 + ch * 8;
            const int t0 = (seg * 32) & (SEQ - 1);
            if (g == 0) pool_segment<2>(up, op, t0); else if (g == 1) pool_segment<4>(up, op, t0); else if (g == 2) pool_segment<8>(up, op, t0); else pool_segment<16>(up, op, t0);
        }
        for (int wt = bid; wt < 128 * 8; wt += G) {
            const int bh = wt >> 3, blk = wt & 7;
            sb_attn_block(QKU, (const bf16_t*)(ws + WS_VT), CAT, bh >> 3, bh & 7, blk * 8, lds, tid, wave, lane);
        }
    }
    PHASE_END;

    if (PHASE_ON) { PH_VARS
        pg8::SchedStd S; S.init(ws + WS_CAT, 256 * 2048, ws + WS_WOUT, 256 * 2048, 128, 4, G, bid);
        pg8::EpiResid E{ap->in[0], XB, SSQ};
        pg8::gemm_phase(lds, xl, 1024, 1024, 1024, S, E);
        pg8::SchedG SG{(const char*)(ws + WS_MEMK), (const char*)(ws + WS_LAYER + LO_WQ), G, bid};
        pg8::EpiStore EG{(bf16_t*)(ws + WS_GT), 1024, nullptr, 0, 1.0f, 0};
        pg8::gemm_phase(lds, xl, 1024, 1024, 256, SG, EG);
    }
    PHASE_END;

#pragma nounroll
    for (int layer = 0; layer < 2; ++layer) {
        if (layer == 1) {
            if (PHASE_ON) { PH_VARS
                pg8::SchedStd S; S.init(XB, 256 * 2048, ws + WS_WSSM, 256 * 2048, 128, 4, G, bid);
                pg8::EpiStore E{(bf16_t*)(ws + WS_UG), 0, SSQ, 16, 1.0f, 1};
                pg8::gemm_phase(lds, xl, 1024, 1024, 1024, S, E);
            }
            PHASE_END;
            if (PHASE_ON) { PH_VARS
                pg8::SchedS2 S{(const char*)(ws + WS_UG), (const char*)(ws + WS_WEND), G, bid};
                pg8::EpiHend E{(float*)(ws + WS_HEND)};
                pg8::gemm_phase(lds, xl, 640, 512, 512, S, E);
            }
            PHASE_END;
            if (PHASE_ON) { PH_VARS
                bf16_t* UG = (bf16_t*)(ws + WS_UG); const float* HE = (const float*)(ws + WS_HEND);
                for (int it = gt; it < NBATCH * 64 * 64; it += NGT) {
                    const int p = it & 63, g = (it >> 6) & 63, b = it >> 12;
                    const float dt = expf(ap->in[14][g]);
                    const float mag = expf(32.0f * (ap->in[12][g * 64 + p] * dt)), ang = 32.0f * (ap->in[13][g * 64 + p] * dt);
                    const float lr = mag * cosf(ang), li = mag * sinf(ang);
                    float hr = 0.f, hi_ = 0.f;
                    for (int c0 = 0; c0 < 64; c0 += 8) {
                        const size_t row0 = (size_t)g * 1024 + b * 64 + c0;
                        float er[8], ei[8];
#pragma unroll
                        for (int j = 0; j < 8; ++j) { er[j] = HE[(row0 + j) * 128 + p]; ei[j] = HE[(row0 + j) * 128 + 64 + p]; }
#pragma unroll
                        for (int j = 0; j < 8; ++j) {
                            UG[(row0 + j) * 640 + 512 + p] = (bf16_t)(cvt_pk_bf16(hr, 0.f) & 0xffffu);
                            UG[(row0 + j) * 640 + 576 + p] = (bf16_t)(cvt_pk_bf16(hi_, 0.f) & 0xffffu);
                            const float nr = lr * hr - li * hi_ + er[j], ni = lr * hi_ + li * hr + ei[j];
                            hr = nr; hi_ = ni;
                        }
                    }
                }
            }
            PHASE_END;
            if (PHASE_ON) { PH_VARS
                pg8::SchedS4 S{(const char*)(ws + WS_UG), (const char*)(ws + WS_TG), G, bid};
                pg8::EpiSsmY E{(const bf16_t*)(ws + WS_UG), ap->in[19], (bf16_t*)(ws + WS_YG)};
                pg8::gemm_phase(lds, xl, 640, 640, 640, S, E);
            }
            PHASE_END;
            if (PHASE_ON) { PH_VARS
                pg8::SchedStd S; S.init(ws + WS_YG, 256 * 2048, ws + WS_WGLU, 256 * 2048, 128, 8, G, bid);
                pg8::EpiGlu E{XB, SSQ};
                pg8::gemm_phase(lds, xl, 1024, 1024, 1024, S, E);
            }
            PHASE_END;
        }
        if (PHASE_ON) { PH_VARS
            pg8::SchedXS2 S{(const char*)XB, (const char*)(ws + WS_GT + (size_t)layer * 32 * MiB), G, bid};
            pg8::EpiSoftmax E{(bf16_t*)(ws + WS_P), SSQ, layer == 0 ? 16 : 32, 0.0625f};
            pg8::gemm_phase(lds, xl, 1024, 1024, 1024, S, E);
        }
        if (PHASE_ON) { PH_VARS
            unsigned char* lb = ws + WS_LAYER + layer * LAYER_STRIDE;
            pg8::SchedVW S{(const char*)(lb + LO_WO), (const char*)(ws + WS_MEMVT + layer * MEMVT_STRIDE), G, bid};
            pg8::EpiStore E{(bf16_t*)(ws + WS_QX), 1024, nullptr, 0, 1.0f, 0};
            pg8::gemm_phase(lds, xl, 1024, 1024, 256, S, E);
        }
        PHASE_END;
        if (PHASE_ON) { PH_VARS
            pg8::SchedXOut S{(const char*)(ws + WS_P), (const char*)(ws + WS_QX), G, bid};
            pg8::EpiResid E{nullptr, XB, SSQ};
            pg8::gemm_phase(lds, xl, 1024, 1024, 1024, S, E);
        }
        PHASE_END;
        if (PHASE_ON) { PH_VARS
            unsigned char* lb = ws + WS_LAYER + layer * LAYER_STRIDE;
            pg8::SchedStd S; S.init(XB, 256 * 2048, lb + LO_WUP, 256 * 2048, 128, 22, G, bid);
            pg8::EpiUpConv E{(bf16_t*)(ws + WS_H), (bf16_t*)(ws + WS_HALO), SSQ, ap->in[25] + (size_t)layer * 3 * DFF2, ap->in[26] + (size_t)layer * DFF2};
            pg8::gemm_phase(lds, xl, 1024, 1024, 1024, S, E);
        }
        PHASE_END;
        if (PHASE_ON) { PH_VARS
            const bf16_t* HALO = (const bf16_t*)(ws + WS_HALO); bf16_t* H = (bf16_t*)(ws + WS_H);
            const float* cw = ap->in[25] + (size_t)layer * 3 * DFF2; const float* cb = ap->in[26] + (size_t)layer * DFF2;
            pg8::SchedStd S0; S0.init(ws + WS_H, 256u * DFF * 2, ws, 0u, 128, 4, G, bid);
            pg8::Unit uu;
            for (int ui = 0; S0.next(ui, uu); ++ui) {
                const int pm = uu.pm;
                if ((pm & 7) == 0) continue;
                for (int it = tid; it < 2 * 352; it += 512) {
                    const int chk = it % 352, rr = it / 352, c0 = chk * 8;
                    const bf16_t* cur = HALO + (size_t)(pm * 4 + rr) * DFF2;
                    const bf16_t* p1 = rr ? HALO + (size_t)(pm * 4) * DFF2 : HALO + (size_t)(pm * 4 - 1) * DFF2;
                    const bf16_t* p2 = rr ? HALO + (size_t)(pm * 4 - 1) * DFF2 : HALO + (size_t)(pm * 4 - 2) * DFF2;
                    float o[8];
                    const u32x4 av = *(const u32x4*)(cur + c0), ag = *(const u32x4*)(cur + DFF + c0);
                    const u32x4 a1 = *(const u32x4*)(p1 + c0), g1 = *(const u32x4*)(p1 + DFF + c0), a2 = *(const u32x4*)(p2 + c0), g2 = *(const u32x4*)(p2 + DFF + c0);
                    const float v0[8] = {bflo(av.x), bfhi(av.x), bflo(av.y), bfhi(av.y), bflo(av.z), bfhi(av.z), bflo(av.w), bfhi(av.w)};
                    const float g0[8] = {bflo(ag.x), bfhi(ag.x), bflo(ag.y), bfhi(ag.y), bflo(ag.z), bfhi(ag.z), bflo(ag.w), bfhi(ag.w)};
                    const float v1[8] = {bflo(a1.x), bfhi(a1.x), bflo(a1.y), bfhi(a1.y), bflo(a1.z), bfhi(a1.z), bflo(a1.w), bfhi(a1.w)};
                    const float gg1[8] = {bflo(g1.x), bfhi(g1.x), bflo(g1.y), bfhi(g1.y), bflo(g1.z), bfhi(g1.z), bflo(g1.w), bfhi(g1.w)};
                    const float v2[8] = {bflo(a2.x), bfhi(a2.x), bflo(a2.y), bfhi(a2.y), bflo(a2.z), bfhi(a2.z), bflo(a2.w), bfhi(a2.w)};
                    const float gg2[8] = {bflo(g2.x), bfhi(g2.x), bflo(g2.y), bfhi(g2.y), bflo(g2.z), bfhi(g2.z), bflo(g2.w), bfhi(g2.w)};
    #pragma unroll
                    for (int j = 0; j < 8; ++j) {
                        const int c = c0 + j;
                        const float cv = cb[c] + cw[c] * v2[j] + cw[DFF2 + c] * v1[j] + cw[2 * DFF2 + c] * v0[j];
                        const float cgt = cb[DFF + c] + cw[DFF + c] * gg2[j] + cw[DFF2 + DFF + c] * gg1[j] + cw[2 * DFF2 + DFF + c] * g0[j];
                        o[j] = cv * cgt * frcp(1.0f + fexp(-cgt));
                    }
                    u32x4 w; w.x = cvt_pk_bf16(o[0], o[1]); w.y = cvt_pk_bf16(o[2], o[3]); w.z = cvt_pk_bf16(o[4], o[5]); w.w = cvt_pk_bf16(o[6], o[7]);
                    *(u32x4*)(H + (size_t)(pm * 256 + rr) * DFF + c0) = w;
                }
            }
        }
        LOCAL_SEAM;
        if (PHASE_ON) { PH_VARS
            unsigned char* lb = ws + WS_LAYER + layer * LAYER_STRIDE;
            pg8::SchedStd S; S.init(ws + WS_H, 256u * DFF * 2, lb + LO_WDN, 256u * DFF * 2, 128, 4, G, bid);
            pg8::EpiResid E{nullptr, XB, SSQ};
            pg8::gemm_phase(lds, xl, DFF, DFF, DFF, S, E);
        }
        PHASE_END;
    }

    if (PHASE_ON) { PH_VARS
        for (int m4 = gw; m4 < MTOK / 4; m4 += NGW) {
            const f32x4* gr = (const f32x4*)ap->in[6] + lane;
            f32x4 v[4][4]; float sq[4];
#pragma unroll
            for (int r = 0; r < 4; ++r)
#pragma unroll
                for (int j = 0; j < 4; ++j) { const u32x2 o = *((const u32x2*)(XB + (size_t)(m4 * 4 + r) * DM) + lane + 64 * j); v[r][j] = (f32x4){bflo(o.x), bfhi(o.x), bflo(o.y), bfhi(o.y)}; }
#pragma unroll
            for (int r = 0; r < 4; ++r) { sq[r] = 0.f;
#pragma unroll
                for (int j = 0; j < 4; ++j) sq[r] += (v[r][j].x * v[r][j].x + v[r][j].y * v[r][j].y) + (v[r][j].z * v[r][j].z + v[r][j].w * v[r][j].w); }
#pragma unroll
            for (int r = 0; r < 4; ++r) sq[r] = 1.f / sqrtf(wave_sum(sq[r]) * (1.f / DM) + EPS);
#pragma unroll
            for (int j = 0; j < 4; ++j) { const f32x4 gg = gr[64 * j];
#pragma unroll
                for (int r = 0; r < 4; ++r) *((f32x4*)(X + (size_t)(m4 * 4 + r) * DM) + lane + 64 * j) = v[r][j] * sq[r] * gg; }
        }
    }
#undef PHASE_ON
#undef PHASE_END
}

constexpr int N_PHASES = 4 + 7 + 5 + 7 + 1;

extern "C" void kernel_launch(void* const* d_in, const int* in_sizes, int n_in, void* d_out, int out_size, void* d_ws, size_t ws_size, hipStream_t stream) {
    static int grid = 0;
    if (grid == 0) {
        if (n_in != 28 || in_sizes[0] != MTOK * DM || out_size != MTOK * DM || ws_size < WS_END) {
            fprintf(stderr, "kernel_launch: unexpected shapes (n_in %d, in0 %d, out %d, ws %zu); nothing launched\n", n_in, n_in > 0 ? in_sizes[0] : -1, out_size, ws_size); grid = -1; return; }
        int dev = 0, cus = 0, per_cu = 0;
        if (hipGetDevice(&dev) != hipSuccess || hipDeviceGetAttribute(&cus, hipDeviceAttributeMultiprocessorCount, dev) != hipSuccess) { grid = -1; return; }
        if (hipFuncSetAttribute((const void*)mega_fwd, hipFuncAttributeMaxDynamicSharedMemorySize, LDS_BYTES) != hipSuccess) { fprintf(stderr, "kernel_launch: hipFuncSetAttribute failed\n"); grid = -1; return; }
        if (hipOccupancyMaxActiveBlocksPerMultiprocessor(&per_cu, (const void*)mega_fwd, 512, LDS_BYTES) != hipSuccess || per_cu < 1) per_cu = 1;
        (void)hipGetLastError();
        grid = cus * per_cu;
    }
    if (grid < 0) return;
    Args a{};
    for (int i = 0; i < 28; ++i) a.in[i] = (const float*)d_in[i];
    a.out = (float*)d_out; a.ws = (unsigned char*)d_ws;
#if MK_MULTI_LAUNCH
    for (int p = 0; p < N_PHASES; ++p) {
        a.ph_lo = p; a.ph_hi = p + 1;
        hipLaunchKernelGGL(mega_fwd, dim3(grid), dim3(512), LDS_BYTES, stream, a);
    }
#else
    a.ph_lo = 0; a.ph_hi = N_PHASES;
    if (hipMemsetAsync(d_ws, 0, 16384, stream) != hipSuccess) { fprintf(stderr, "kernel_launch: memset of the barrier words failed\n"); return; }
    void* args[] = {&a};
    hipError_t e = hipLaunchCooperativeKernel((const void*)mega_fwd, dim3(grid), dim3(512), args, LDS_BYTES, stream);
    if (e != hipSuccess) fprintf(stderr, "cooperative launch failed: %s (grid %d)\n", hipGetErrorString(e), grid);
#endif
}
```

```cpp
#include <hip/hip_runtime.h>
#include <hip/hip_cooperative_groups.h>
#include <cstdio>
#include <cstdint>
namespace cg = cooperative_groups;

#ifndef MK_MULTI_LAUNCH
#define MK_MULTI_LAUNCH 0
#endif

#define LAS __attribute__((address_space(3)))
typedef unsigned short bf16_t;
typedef short bf16x8 __attribute__((ext_vector_type(8)));
typedef short s16x4 __attribute__((ext_vector_type(4)));
typedef float f32x4 __attribute__((ext_vector_type(4)));
typedef float f32x16 __attribute__((ext_vector_type(16)));
typedef unsigned u32x4 __attribute__((ext_vector_type(4)));
typedef unsigned u32x2 __attribute__((ext_vector_type(2)));

constexpr int MTOK = 32768, DM = 1024, SEQ = 2048, NBATCH = 16, DFF = 2816, DFF2 = 5632, MEMTOK = 4096;
constexpr int MHALF = 16384;
constexpr float EPS = 1e-6f;
constexpr float LOG2E = 1.4426950408889634f, LN2 = 0.6931471805599453f;

constexpr size_t MiB = 1u << 20;
constexpr size_t WS_SSQ = 1 * MiB;
constexpr size_t WS_WIN = 5 * MiB;
constexpr size_t WS_WOUT = 9 * MiB;
constexpr size_t WS_WSSM = 11 * MiB;
constexpr size_t WS_WGLU = 13 * MiB;
constexpr size_t WS_LAYER = 17 * MiB, LAYER_STRIDE = 25 * MiB;
constexpr size_t LO_WQ = 0, LO_WKV = 2 * MiB, LO_WO = 6 * MiB, LO_WUP = 8 * MiB, LO_WDN = 19 * MiB;
constexpr size_t WS_WEND = 67 * MiB;
constexpr size_t WS_TG = 83 * MiB;
constexpr size_t WS_MEMN = 123 * MiB;
constexpr size_t WS_MEMK = 131 * MiB;
constexpr size_t WS_MEMVT = 147 * MiB, MEMVT_STRIDE = 9 * MiB;
constexpr size_t WS_XB = 165 * MiB;
constexpr size_t WS_T = 229 * MiB;
constexpr size_t WS_QKU = WS_T, WS_VT = WS_T + 96 * MiB, WS_CAT = WS_T + 132 * MiB;
constexpr int VT_LD = MTOK + 128, MVT_LD = 4096 + 128;
constexpr size_t WS_QX = WS_T, WS_P = WS_T + 64 * MiB, WS_O = WS_T + 128 * MiB;
constexpr size_t WS_H = WS_T, WS_HALO = WS_T + 176 * MiB;
constexpr size_t WS_UG = WS_T, WS_HEND = WS_T + 80 * MiB, WS_YG = WS_T + 112 * MiB;
constexpr size_t WS_GT = 426 * MiB;
constexpr size_t WS_END = 512 * MiB;
static_assert(WS_H + (size_t)MTOK * DFF * 2 <= WS_HALO && WS_HALO + (size_t)128 * 4 * DFF2 * 2 <= WS_GT && WS_CAT + (size_t)MTOK * DM * 2 <= WS_GT && WS_GT + 64 * MiB <= WS_END, "ws map");

typedef float f32x2_t __attribute__((ext_vector_type(2))); typedef __bf16 bf16x2_t __attribute__((ext_vector_type(2)));
__device__ __forceinline__ unsigned cvt_pk_bf16(float lo, float hi) { f32x2_t v = {lo, hi}; bf16x2_t b = __builtin_convertvector(v, bf16x2_t); return __builtin_bit_cast(unsigned, b); }
__device__ __forceinline__ float bf2f(unsigned short b) { return __uint_as_float(((unsigned)b) << 16); }
__device__ __forceinline__ float bflo(unsigned w) { return __uint_as_float(w << 16); }
__device__ __forceinline__ float bfhi(unsigned w) { return __uint_as_float(w & 0xffff0000u); }
__device__ __forceinline__ float fexp2(float x) { return __builtin_amdgcn_exp2f(x); }
__device__ __forceinline__ float flog2(float x) { return __builtin_amdgcn_logf(x); }
__device__ __forceinline__ float fexp(float x) { return __builtin_amdgcn_exp2f(x * LOG2E); }
__device__ __forceinline__ float frcp(float x) { return __builtin_amdgcn_rcpf(x); }
template <int M> __device__ __forceinline__ float swz_xor(float v) { return __int_as_float(__builtin_amdgcn_ds_swizzle(__float_as_int(v), (M << 10) | 0x1f)); }
__device__ __forceinline__ float sum_x16(float v) { auto r = __builtin_amdgcn_permlane16_swap(__float_as_uint(v), __float_as_uint(v), false, false); return __uint_as_float(r[0]) + __uint_as_float(r[1]); }
__device__ __forceinline__ float sum_x32(float v) { auto r = __builtin_amdgcn_permlane32_swap(__float_as_uint(v), __float_as_uint(v), false, false); return __uint_as_float(r[0]) + __uint_as_float(r[1]); }
__device__ __forceinline__ float max_x16(float v) { auto r = __builtin_amdgcn_permlane16_swap(__float_as_uint(v), __float_as_uint(v), false, false); return fmaxf(__uint_as_float(r[0]), __uint_as_float(r[1])); }
__device__ __forceinline__ float max_x32(float v) { auto r = __builtin_amdgcn_permlane32_swap(__float_as_uint(v), __float_as_uint(v), false, false); return fmaxf(__uint_as_float(r[0]), __uint_as_float(r[1])); }
__device__ __forceinline__ float partner32(float v, int hi) { auto r = __builtin_amdgcn_permlane32_swap(__float_as_uint(v), __float_as_uint(v), false, false); return hi ? __uint_as_float(r[0]) : __uint_as_float(r[1]); }
__device__ __forceinline__ float wave_sum(float v) {
    v += swz_xor<1>(v); v += swz_xor<2>(v); v += swz_xor<4>(v); v += swz_xor<8>(v); v = sum_x16(v); v = sum_x32(v);
    return v;
}
#define LDS_WAIT() asm volatile("s_waitcnt lgkmcnt(0)" ::: "memory")

namespace pg8 {
constexpr int BM = 256, BK = 64, HALF = 128, HTB = HALF * BK * 2, STAGE_BYTES = 8 * HTB, NXCD = 8, WGM = 8;
__host__ __device__ __forceinline__ int lds_byte(int r, int c) { const int st = (r >> 4) * 2 + (c >> 5), rr = r & 15, cc = c & 31, ob = rr * 64 + cc * 2; return st * 1024 + (ob ^ (((ob >> 9) & 1) << 5)); }
__host__ __device__ __forceinline__ void stage_rc(int b, int& R, int& C) { const int st = b / 1024, sb = b % 1024, swz = sb ^ (((sb >> 9) & 1) << 5); R = (st >> 1) * 16 + swz / 64; C = (st & 1) * 32 + (swz % 64) / 2; }
__host__ __device__ __forceinline__ int perm32(int rho) { const int n = rho >> 4, i = rho & 15; return 8 * (i >> 2) + 4 * n + (i & 3); }

struct Unit { int pm, pn; const char* a; const char* b; };

struct SchedStd {
    const char* A; const char* B; unsigned sA, sB; int nM, nN, G, c;
    __device__ __forceinline__ void init(const void* A_, unsigned sA_, const void* B_, unsigned sB_, int nM_, int nN_, int G_, int c_) { A = (const char*)A_; B = (const char*)B_; sA = sA_; sB = sB_; nM = nM_; nN = nN_; G = G_; c = c_; }
    __device__ __forceinline__ bool next(int i, Unit& u) const {
        const int nwg = nM * nN; const long L = (long)i * G + c; if (L >= nwg) return false;
        int wgid = (int)L; { const int q = nwg / NXCD, r = nwg % NXCD, xcd = wgid % NXCD, off = wgid / NXCD; wgid = (xcd < r ? xcd * (q + 1) : r * (q + 1) + (xcd - r) * q) + off; }
        const int nig = WGM * nN, gid = wgid / nig, fm = gid * WGM, gsz = (nM - fm) < WGM ? (nM - fm) : WGM;
        u.pm = fm + ((wgid % nig) % gsz); u.pn = (wgid % nig) / gsz;
        u.a = A + (size_t)u.pm * sA; u.b = B + (size_t)u.pn * sB; return true;
    }
};
struct SchedXS {
    const char* A; const char* B; int G, c;
    __device__ __forceinline__ bool next(int i, Unit& u) const {
        const long L = (long)i * G + c; if (L >= 512) return false;
        u.pm = (int)(L >> 2); u.pn = (int)(L & 3);
        u.a = A + (size_t)u.pm * 256 * 2048 + u.pn * 512; u.b = B + (size_t)(u.pm >> 3) * 256 * 2048 + u.pn * 512; return true;
    }
};
struct SchedXQ {
    const char* A; const char* B; int G, c;
    __device__ __forceinline__ bool next(int i, Unit& u) const {
        const long L = (long)i * G + c; if (L >= 512) return false;
        u.pm = (int)(L >> 2); u.pn = (int)(L & 3);
        u.a = A + (size_t)u.pm * 256 * 2048; u.b = B + (size_t)u.pn * 256 * 2048; return true;
    }
};
struct SchedG {
    const char* MK; const char* WQ; int G, c;
    __device__ __forceinline__ bool next(int i, Unit& u) const {
        const long L = (long)i * G + c; if (L >= 512) return false;
        const int l = (int)(L >> 8), r = (int)(L & 255), b = r >> 4, h = (r >> 2) & 3, pn = r & 3;
        u.pm = l * 64 + b * 4 + h; u.pn = pn;
        u.a = MK + (size_t)l * 8 * 1048576 + (size_t)b * 256 * 2048 + h * 512; u.b = WQ + (size_t)l * LAYER_STRIDE + (size_t)pn * 256 * 2048 + h * 512; return true;
    }
};
struct SchedXS2 {
    const char* A; const char* B; int G, c;
    __device__ __forceinline__ bool next(int i, Unit& u) const {
        const long L = (long)i * G + c; if (L >= 512) return false;
        u.pm = (int)(L >> 2); u.pn = (int)(L & 3);
        u.a = A + (size_t)u.pm * 256 * 2048; u.b = B + (size_t)((u.pm >> 3) * 4 + u.pn) * 256 * 2048; return true;
    }
};
struct SchedVW {
    const char* WO; const char* MV; int G, c;
    __device__ __forceinline__ bool next(int i, Unit& u) const {
        const long L = (long)i * G + c; if (L >= 256) return false;
        const int b = (int)(L >> 4), pq = (int)(L >> 2) & 3, h = (int)L & 3;
        u.pm = b * 4 + pq; u.pn = h;
        u.a = WO + (size_t)pq * 256 * 2048 + h * 512; u.b = MV + (size_t)b * 256 * 2048 + h * 512; return true;
    }
};
struct SchedXOut {
    const char* A; const char* B; int G, c;
    __device__ __forceinline__ bool next(int i, Unit& u) const {
        const long L = (long)i * G + c; if (L >= 512) return false;
        u.pm = (int)(L >> 2); u.pn = (int)(L & 3);
        u.a = A + (size_t)u.pm * 256 * 2048; u.b = B + ((size_t)(u.pm >> 3) * 1024 + (size_t)u.pn * 256) * 2048; return true;
    }
};
struct SchedXO {
    const char* A; const char* B; int G, c;
    __device__ __forceinline__ bool next(int i, Unit& u) const {
        const long L = (long)i * G + c; if (L >= 512) return false;
        u.pm = (int)(L >> 2); u.pn = (int)(L & 3);
        u.a = A + (size_t)u.pm * 256 * 2048 + u.pn * 512; u.b = B + (size_t)u.pn * 256 * (MVT_LD * 2) + (size_t)(u.pm >> 3) * 512; return true;
    }
};
struct SchedS2 {
    const char* A; const char* B; int G, c;
    __device__ __forceinline__ bool next(int i, Unit& u) const {
        const long L = (long)i * G + c; if (L >= 256) return false;
        u.pm = (int)L; u.pn = 0;
        u.a = A + (size_t)L * 256 * 1280; u.b = B + (size_t)(L >> 2) * 256 * 1024; return true;
    }
};
struct SchedS4 {
    const char* A; const char* B; int G, c;
    __device__ __forceinline__ bool next(int i, Unit& u) const {
        const long L = (long)i * G + c; if (L >= 512) return false;
        u.pm = (int)(L >> 1); u.pn = (int)(L & 1);
        u.a = A + (size_t)u.pm * 256 * 1280; u.b = B + ((size_t)(L >> 3) * 512 + (size_t)u.pn * 256) * 1280; return true;
    }
};

typedef f32x4 Acc[2][2][4][2];

__device__ __forceinline__ float row_rstd(const float* ssq_row, int nslots) {
    float s = 0.f;
    const f32x4* p = (const f32x4*)ssq_row;
    for (int i = 0; i < nslots / 4; ++i) { const f32x4 v = p[i]; s += (v[0] + v[1]) + (v[2] + v[3]); }
    return 1.0f / sqrtf(s * (1.0f / DM) + EPS);
}

struct EpiStore {
    static constexpr bool PERM = true;
    bf16_t* O; int ldc; const float* ssq; int nslots; float cs; int mode;
    __device__ __forceinline__ void operator()(Acc& acc, const Unit& u, int wr, int wc, int fr, int fq, LAS unsigned char*) const {
        const int row0 = u.pm * BM + wr * 64 + fr, col0 = u.pn * BM + wc * 32 + 8 * fq;
#pragma unroll
        for (int ai = 0; ai < 2; ++ai)
#pragma unroll
            for (int m = 0; m < 4; ++m) {
                const int row = row0 + ai * HALF + m * 16;
                float sc = cs;
                if (ssq) sc *= row_rstd(ssq + (size_t)row * 32, nslots);
#pragma unroll
                for (int bj = 0; bj < 2; ++bj) {
                    const int col = col0 + bj * HALF;
                    const f32x4 v0 = acc[ai][bj][m][0] * sc, v1 = acc[ai][bj][m][1] * sc;
                    u32x4 w; w.x = cvt_pk_bf16(v0[0], v0[1]); w.y = cvt_pk_bf16(v0[2], v0[3]); w.z = cvt_pk_bf16(v1[0], v1[1]); w.w = cvt_pk_bf16(v1[2], v1[3]);
                    bf16_t* p = (mode == 0) ? O + (size_t)row * ldc + col
                                            : O + ((size_t)(col >> 4) * 1024 + (row >> 5)) * 640 + (row & 31) * 16 + (col & 15);
                    *(u32x4*)p = w;
                }
            }
    }
};

struct EpiResid {
    static constexpr bool PERM = false;
    const float* xf; bf16_t* xb; float* ssq;
    __device__ __forceinline__ void operator()(Acc& acc, const Unit& u, int wr, int wc, int fr, int fq, LAS unsigned char*) const {
        const int row0 = u.pm * BM + wr * 64 + fr, col0 = u.pn * BM + wc * 32 + 4 * fq;
#pragma unroll
        for (int ai = 0; ai < 2; ++ai)
#pragma unroll
            for (int m = 0; m < 4; ++m) {
                const int row = row0 + ai * HALF + m * 16; float q = 0.f;
#pragma unroll
                for (int bj = 0; bj < 2; ++bj)
#pragma unroll
                    for (int n = 0; n < 2; ++n) {
                        const int col = col0 + bj * HALF + n * 16; const size_t off = (size_t)row * DM + col;
                        f32x4 v;
                        if (xf) v = *(const f32x4*)(xf + off);
                        else { const u32x2 o = *(const u32x2*)(xb + off); v = (f32x4){bflo(o.x), bfhi(o.x), bflo(o.y), bfhi(o.y)}; }
                        v += acc[ai][bj][m][n];
                        q += (v[0] * v[0] + v[1] * v[1]) + (v[2] * v[2] + v[3] * v[3]);
                        u32x2 w; w.x = cvt_pk_bf16(v[0], v[1]); w.y = cvt_pk_bf16(v[2], v[3]);
                        *(u32x2*)(xb + off) = w;
                    }
                q = sum_x16(q); q = sum_x32(q);
                if (fq == 0) ssq[(size_t)row * 32 + u.pn * 4 + wc] = q;
            }
    }
};

struct EpiGlu {
    static constexpr bool PERM = false;
    bf16_t* xb; float* ssq;
    __device__ __forceinline__ void operator()(Acc& acc, const Unit& u, int wr, int wc, int fr, int fq, LAS unsigned char*) const {
        const int row0 = u.pm * BM + wr * 64 + fr, col0 = u.pn * HALF + wc * 32 + 4 * fq;
#pragma unroll
        for (int ai = 0; ai < 2; ++ai)
#pragma unroll
            for (int m = 0; m < 4; ++m) {
                const int row = row0 + ai * HALF + m * 16; float q = 0.f;
#pragma unroll
                for (int n = 0; n < 2; ++n) {
                    const int col = col0 + n * 16; const size_t off = (size_t)row * DM + col;
                    const f32x4 val = acc[ai][0][m][n], gt = acc[ai][1][m][n];
                    const u32x2 o = *(const u32x2*)(xb + off);
                    f32x4 v = (f32x4){bflo(o.x), bfhi(o.x), bflo(o.y), bfhi(o.y)};
#pragma unroll
                    for (int j = 0; j < 4; ++j) v[j] += val[j] * frcp(1.0f + fexp(-gt[j]));
                    q += (v[0] * v[0] + v[1] * v[1]) + (v[2] * v[2] + v[3] * v[3]);
                    u32x2 w; w.x = cvt_pk_bf16(v[0], v[1]); w.y = cvt_pk_bf16(v[2], v[3]);
                    *(u32x2*)(xb + off) = w;
                }
                q = sum_x16(q); q = sum_x32(q);
                if (fq == 0) ssq[(size_t)row * 32 + u.pn * 4 + wc] = q;
            }
    }
};

struct EpiSoftmax {
    static constexpr bool PERM = true;
    bf16_t* O; const float* ssq; int nslots; float cs;
    __device__ __forceinline__ void operator()(Acc& acc, const Unit& u, int wr, int wc, int fr, int fq, LAS unsigned char* xl) const {
        LAS float* tmax = (LAS float*)xl; LAS float* tsum = tmax + 1024;
#pragma unroll
        for (int ai = 0; ai < 2; ++ai)
#pragma unroll
            for (int m = 0; m < 4; ++m) {
                const float sc = cs * row_rstd(ssq + (size_t)(u.pm * BM + ai * HALF + wr * 64 + m * 16 + fr) * 32, nslots);
#pragma unroll
                for (int bj = 0; bj < 2; ++bj)
#pragma unroll
                    for (int n = 0; n < 2; ++n) acc[ai][bj][m][n] *= sc;
                float mx = -3.0e38f;
#pragma unroll
                for (int bj = 0; bj < 2; ++bj)
#pragma unroll
                    for (int n = 0; n < 2; ++n) { const f32x4 x = acc[ai][bj][m][n]; mx = fmaxf(mx, fmaxf(fmaxf(x[0], x[1]), fmaxf(x[2], x[3]))); }
                mx = max_x16(mx); mx = max_x32(mx);
                if (fq == 0) tmax[(ai * HALF + wr * 64 + m * 16 + fr) * 4 + wc] = mx;
            }
        LDS_WAIT(); __builtin_amdgcn_s_barrier(); asm volatile("" ::: "memory");
#pragma unroll
        for (int ai = 0; ai < 2; ++ai)
#pragma unroll
            for (int m = 0; m < 4; ++m) {
                const int r = ai * HALF + wr * 64 + m * 16 + fr;
                const f32x4 t = *(const LAS f32x4*)(tmax + r * 4);
                const float gm = fmaxf(fmaxf(t[0], t[1]), fmaxf(t[2], t[3])) * LOG2E; float s = 0.f;
#pragma unroll
                for (int bj = 0; bj < 2; ++bj)
#pragma unroll
                    for (int n = 0; n < 2; ++n) {
                        f32x4 x = acc[ai][bj][m][n];
#pragma unroll
                        for (int j = 0; j < 4; ++j) { x[j] = fexp2(x[j] * LOG2E - gm); s += x[j]; }
                        acc[ai][bj][m][n] = x;
                    }
                s = sum_x16(s); s = sum_x32(s);
                if (fq == 0) tsum[r * 4 + wc] = s;
            }
        LDS_WAIT(); __builtin_amdgcn_s_barrier(); asm volatile("" ::: "memory");
        const int row0 = u.pm * BM + wr * 64 + fr, col0 = u.pn * BM + wc * 32 + 8 * fq;
#pragma unroll
        for (int ai = 0; ai < 2; ++ai)
#pragma unroll
            for (int m = 0; m < 4; ++m) {
                const int r = ai * HALF + wr * 64 + m * 16 + fr;
                const f32x4 t = *(const LAS f32x4*)(tsum + r * 4);
                const float inv = 1.0f / ((t[0] + t[1]) + (t[2] + t[3]));
#pragma unroll
                for (int bj = 0; bj < 2; ++bj) {
                    const f32x4 v0 = acc[ai][bj][m][0] * inv, v1 = acc[ai][bj][m][1] * inv;
                    u32x4 w; w.x = cvt_pk_bf16(v0[0], v0[1]); w.y = cvt_pk_bf16(v0[2], v0[3]); w.z = cvt_pk_bf16(v1[0], v1[1]); w.w = cvt_pk_bf16(v1[2], v1[3]);
                    *(u32x4*)(O + (size_t)(row0 + ai * HALF + m * 16) * DM + col0 + bj * HALF) = w;
                }
            }
    }
};


__device__ __forceinline__ float dpp_ror1(float x) { return __int_as_float(__builtin_amdgcn_update_dpp(0, __float_as_int(x), 0x121, 0xf, 0xf, false)); }
__device__ __forceinline__ float dpp_ror2(float x) { return __int_as_float(__builtin_amdgcn_update_dpp(0, __float_as_int(x), 0x122, 0xf, 0xf, false)); }
__device__ __forceinline__ float dpp_ror1u(float x) { return __int_as_float(__builtin_amdgcn_mov_dpp(__float_as_int(x), 0x121, 0xf, 0xf, false)); }
__device__ __forceinline__ float dpp_ror2u(float x) { return __int_as_float(__builtin_amdgcn_mov_dpp(__float_as_int(x), 0x122, 0xf, 0xf, false)); }
__device__ __forceinline__ float dpp_shr1_old(float old, float x) { return __int_as_float(__builtin_amdgcn_update_dpp(__float_as_int(old), __float_as_int(x), 0x111, 0xf, 0xf, false)); }
__device__ __forceinline__ float dpp_shr2_old(float old, float x) { return __int_as_float(__builtin_amdgcn_update_dpp(__float_as_int(old), __float_as_int(x), 0x112, 0xf, 0xf, false)); }
struct EpiUpConv {
    static constexpr bool PERM = true;
    bf16_t* H; bf16_t* HALO; const float* ssq; const float* cw; const float* cb;
    __device__ __forceinline__ void operator()(Acc& acc, const Unit& u, int wr, int wc, int fr, int fq, LAS unsigned char* xl) const {
        LAS float* B = (LAS float*)xl;
        LAS float* Wl = B + 2048;
        LAS float* R = Wl + 1024;
        const int wid = wr * 4 + wc, lane = fq * 16 + fr, tid = wid * 64 + lane;
        const int row0 = u.pm * BM + wr * 64 + fr, colb = wc * 32 + 8 * fq, ch0 = u.pn * HALF + colb;
        {
#pragma unroll
            for (int i = 0; i < 2; ++i) { const int idx = tid + i * 512, t = idx >> 8, bj = (idx >> 7) & 1, chl = idx & 127;
                Wl[idx] = (t < 3) ? cw[t * DFF2 + bj * DFF + u.pn * HALF + chl] : cb[bj * DFF + u.pn * HALF + chl]; }
            if (lane < 32) R[wid * 32 + lane] = row_rstd(ssq + (size_t)(u.pm * BM + wid * 32 + lane) * 32, 16);
        }
        LDS_WAIT(); __builtin_amdgcn_s_barrier(); asm volatile("" ::: "memory");
#pragma unroll
        for (int ai = 0; ai < 2; ++ai)
#pragma unroll
            for (int m = 0; m < 4; ++m) {
                const float sc = R[ai * HALF + wr * 64 + m * 16 + fr];
#pragma unroll
                for (int bj = 0; bj < 2; ++bj)
#pragma unroll
                    for (int n = 0; n < 2; ++n) acc[ai][bj][m][n] *= sc;
            }
        if (fr >= 14) {
#pragma unroll
            for (int ai = 0; ai < 2; ++ai)
#pragma unroll
                for (int bj = 0; bj < 2; ++bj)
#pragma unroll
                    for (int n = 0; n < 2; ++n) *(LAS f32x4*)(B + ((ai * 2 + wr) * 2 + (fr - 14)) * 256 + bj * HALF + colb + 4 * n) = acc[ai][bj][3][n];
        }
        if (wr == 0 && fr < 2) {
#pragma unroll
            for (int bj = 0; bj < 2; ++bj) { const f32x4 v0 = acc[0][bj][0][0], v1 = acc[0][bj][0][1];
                u32x4 w; w.x = cvt_pk_bf16(v0[0], v0[1]); w.y = cvt_pk_bf16(v0[2], v0[3]); w.z = cvt_pk_bf16(v1[0], v1[1]); w.w = cvt_pk_bf16(v1[2], v1[3]);
                *(u32x4*)(HALO + (size_t)(u.pm * 4 + fr) * DFF2 + bj * DFF + ch0) = w; }
        }
        if (wr == 1 && fr >= 14) {
#pragma unroll
            for (int bj = 0; bj < 2; ++bj) { const f32x4 v0 = acc[1][bj][3][0], v1 = acc[1][bj][3][1];
                u32x4 w; w.x = cvt_pk_bf16(v0[0], v0[1]); w.y = cvt_pk_bf16(v0[2], v0[3]); w.z = cvt_pk_bf16(v1[0], v1[1]); w.w = cvt_pk_bf16(v1[2], v1[3]);
                *(u32x4*)(HALO + (size_t)(u.pm * 4 + 2 + (fr - 14)) * DFF2 + bj * DFF + ch0) = w; }
        }
        LDS_WAIT(); __builtin_amdgcn_s_barrier(); asm volatile("" ::: "memory");
#pragma unroll
        for (int ai = 0; ai < 2; ++ai) {
            const bool has = (wr == 1) || (ai == 1);
            const int sb = (wr == 1) ? (ai * 2) : 1;
#pragma unroll
            for (int n = 0; n < 2; ++n) {
                asm volatile("" ::: "memory");
                const int cl = colb + 4 * n;
                float hv[4][4];
                const f32x4 wv0 = *(const LAS f32x4*)(Wl + 0 * 128 + cl), wg0 = *(const LAS f32x4*)(Wl + 1 * 128 + cl);
                const f32x4 wv1 = *(const LAS f32x4*)(Wl + 2 * 128 + cl), wg1 = *(const LAS f32x4*)(Wl + 3 * 128 + cl);
                const f32x4 wv2 = *(const LAS f32x4*)(Wl + 4 * 128 + cl), wg2 = *(const LAS f32x4*)(Wl + 5 * 128 + cl);
                const f32x4 bvv = *(const LAS f32x4*)(Wl + 6 * 128 + cl), bgv = *(const LAS f32x4*)(Wl + 7 * 128 + cl);
                f32x4 b1v = (f32x4){0.f, 0.f, 0.f, 0.f}, b2v = b1v, b1g = b1v, b2g = b1v;
                if (has) {
                    b1v = *(const LAS f32x4*)(B + (sb * 2 + 1) * 256 + cl); b2v = *(const LAS f32x4*)(B + (sb * 2 + (fr & 1)) * 256 + cl);
                    b1g = *(const LAS f32x4*)(B + (sb * 2 + 1) * 256 + HALF + cl); b2g = *(const LAS f32x4*)(B + (sb * 2 + (fr & 1)) * 256 + HALF + cl);
                }
#pragma unroll
                for (int j = 0; j < 4; ++j) {
                    float r1p = b1v[j], r2p = b2v[j], q1p = b1g[j], q2p = b2g[j];
#pragma unroll
                    for (int m = 0; m < 4; ++m) {
                        const float xv = acc[ai][0][m][n][j], xg = acc[ai][1][m][n][j];
                        const float pv1 = dpp_shr1_old(r1p, xv), pv2 = dpp_shr2_old(r2p, xv), pg1 = dpp_shr1_old(q1p, xg), pg2 = dpp_shr2_old(q2p, xg);
                        const float cv = bvv[j] + wv0[j] * pv2 + wv1[j] * pv1 + wv2[j] * xv;
                        const float cg = bgv[j] + wg0[j] * pg2 + wg1[j] * pg1 + wg2[j] * xg;
                        hv[m][j] = cv * cg * frcp(1.0f + fexp(-cg));
                        if (m < 3) { r1p = dpp_ror1u(xv); r2p = dpp_ror2u(xv); q1p = dpp_ror1u(xg); q2p = dpp_ror2u(xg); }
                    }
                    __builtin_amdgcn_sched_barrier(0);
                }
#pragma unroll
                for (int m = 0; m < 4; ++m) {
                    u32x2 w; w.x = cvt_pk_bf16(hv[m][0], hv[m][1]); w.y = cvt_pk_bf16(hv[m][2], hv[m][3]);
                    *(u32x2*)(H + (size_t)(row0 + ai * HALF + m * 16) * DFF + ch0 + 4 * n) = w;
                }
            }
        }
    }
};

struct EpiHend {
    static constexpr bool PERM = false;
    float* Hout;
    __device__ __forceinline__ void operator()(Acc& acc, const Unit& u, int wr, int wc, int fr, int fq, LAS unsigned char*) const {
        const int row0 = u.pm * BM + wr * 64 + fr, col0 = wc * 32 + 4 * fq;
#pragma unroll
        for (int ai = 0; ai < 2; ++ai)
#pragma unroll
            for (int m = 0; m < 4; ++m)
#pragma unroll
                for (int n = 0; n < 2; ++n)
                    *(f32x4*)(Hout + (size_t)(row0 + ai * HALF + m * 16) * 128 + col0 + n * 16) = acc[ai][0][m][n];
    }
};

struct EpiSsmY {
    static constexpr bool PERM = true;
    const bf16_t* Ug; const float* Dskip; bf16_t* Yg;
    __device__ __forceinline__ void operator()(Acc& acc, const Unit& u, int wr, int wc, int fr, int fq, LAS unsigned char*) const {
        const int g = u.pm >> 2;
        const int rg0 = (u.pm & 3) * BM + wr * 64 + fr, col0 = u.pn * BM + wc * 32 + 8 * fq;
        const int co = col0 & 15;
        const f32x4 d0 = *(const f32x4*)(Dskip + g * 16 + co), d1 = *(const f32x4*)(Dskip + g * 16 + co + 4);
#pragma unroll
        for (int ai = 0; ai < 2; ++ai)
#pragma unroll
            for (int m = 0; m < 4; ++m) {
                const int rg = rg0 + ai * HALF + m * 16;
#pragma unroll
                for (int bj = 0; bj < 2; ++bj) {
                    const int col = col0 + bj * HALF;
                    const u32x4 uu = *(const u32x4*)(Ug + ((size_t)g * 1024 + rg) * 640 + col);
                    float y[8];
                    y[0] = acc[ai][bj][m][0][0] + d0[0] * bflo(uu.x); y[1] = acc[ai][bj][m][0][1] + d0[1] * bfhi(uu.x);
                    y[2] = acc[ai][bj][m][0][2] + d0[2] * bflo(uu.y); y[3] = acc[ai][bj][m][0][3] + d0[3] * bfhi(uu.y);
                    y[4] = acc[ai][bj][m][1][0] + d1[0] * bflo(uu.z); y[5] = acc[ai][bj][m][1][1] + d1[1] * bfhi(uu.z);
                    y[6] = acc[ai][bj][m][1][2] + d1[2] * bflo(uu.w); y[7] = acc[ai][bj][m][1][3] + d1[3] * bfhi(uu.w);
#pragma unroll
                    for (int j = 0; j < 8; ++j) { const float x = y[j]; const float k2 = 1.5957691216f * (x + 0.044715f * x * x * x); y[j] = x * frcp(1.0f + fexp(-k2)); }
                    u32x4 w; w.x = cvt_pk_bf16(y[0], y[1]); w.y = cvt_pk_bf16(y[2], y[3]); w.z = cvt_pk_bf16(y[4], y[5]); w.w = cvt_pk_bf16(y[6], y[7]);
                    const size_t tok = (size_t)rg * 32 + (col >> 4);
                    *(u32x4*)(Yg + tok * DM + g * 16 + co) = w;
                }
            }
    }
};

template <class Epi, class Sched>
__device__ __forceinline__ void gemm_phase(LAS unsigned char* lds, LAS unsigned char* xl, const int lda, const int ldb, const int K, const Sched& S, const Epi& E) {
    int tid_ = threadIdx.x; asm volatile("" : "+v"(tid_));
    const int tid = tid_, wid = __builtin_amdgcn_readfirstlane(tid >> 6), lane = tid & 63, wr = wid >> 2, wc = wid & 3, fr = lane & 15, fq = lane >> 4;
    const int nt = K / BK;
    unsigned voffA, voffB;
    { int R, C; stage_rc(tid * 16, R, C); const int Rb = Epi::PERM ? ((R & ~31) + perm32(R & 31)) : R;
      voffA = (unsigned)(R * lda + C) * 2u; voffB = (unsigned)(Rb * ldb + C) * 2u; }
    const size_t qstepA = (size_t)64 * lda * 2, qstepB = (size_t)64 * ldb * 2;
    const size_t kstep = (size_t)(BK * 2);
    const size_t hstepA = (size_t)HALF * lda * 2, hstepB = (size_t)HALF * ldb * 2;
    const unsigned ldsw = (unsigned)wid * 1024u;
    const int aoff = lds_byte(wr * 64 + fr, fq * 8), boff = lds_byte(wc * 32 + fr, fq * 8);
#define PG8_SA(b, h) (((b) * 2 + (h)) * HTB)
#define PG8_SB(b, h) ((4 + (b) * 2 + (h)) * HTB)
#define PG8_STAGE(bufoff, gbase, voff) do { _Pragma("unroll") for (int _i = 0; _i < 2; ++_i) \
        { const char* _gb = (const char*)(gbase) + (size_t)_i * q##voff; asm volatile("" : "+s"(_gb)); \
          __builtin_amdgcn_global_load_lds((const unsigned*)(_gb + (voff)), (LAS unsigned*)(lds + (bufoff) + ldsw + _i * 8192), 16, 0, 0); } } while (0)
#define qvoffA qstepA
#define qvoffB qstepB
#define PG8_LDA(dst, b, h) do { _Pragma("unroll") for (int m = 0; m < 4; ++m) _Pragma("unroll") for (int k = 0; k < 2; ++k) dst[m][k] = *(const LAS bf16x8*)(lds + PG8_SA(b, h) + aoff + m * 2048 + k * 1024); } while (0)
#define PG8_LDB(dst, b, h) do { _Pragma("unroll") for (int n = 0; n < 2; ++n) _Pragma("unroll") for (int k = 0; k < 2; ++k) dst[n][k] = *(const LAS bf16x8*)(lds + PG8_SB(b, h) + boff + n * 2048 + k * 1024); } while (0)
#define PG8_MMA(ai, bj, At, Bt) do { __builtin_amdgcn_s_setprio(1); _Pragma("unroll") for (int m = 0; m < 4; ++m) _Pragma("unroll") for (int n = 0; n < 2; ++n) _Pragma("unroll") for (int k = 0; k < 2; ++k) \
        acc[ai][bj][m][n] = __builtin_amdgcn_mfma_f32_16x16x32_bf16(Bt[n][k], At[m][k], acc[ai][bj][m][n], 0, 0, 0); __builtin_amdgcn_s_setprio(0); } while (0)
#define PG8_WAIT_V(n) asm volatile("s_waitcnt vmcnt(" #n ")" ::: "memory")
#define PG8_WAIT_L(n) asm volatile("s_waitcnt lgkmcnt(" #n ")" ::: "memory")
#define PG8_BAR __builtin_amdgcn_s_barrier()
#define PG8_SCHED __builtin_amdgcn_sched_barrier(0)
    Unit cur, nxt; int ui = 0;
    if (!S.next(0, cur)) return;
    Acc acc;
#pragma unroll
    for (int a = 0; a < 2; ++a)
#pragma unroll
        for (int b = 0; b < 2; ++b)
#pragma unroll
            for (int m = 0; m < 4; ++m)
#pragma unroll
                for (int n = 0; n < 2; ++n) acc[a][b][m][n] = (f32x4){0.f, 0.f, 0.f, 0.f};
    bf16x8 At[4][2], B0[2][2], B1[2][2];
    const char* cA = cur.a; const char* cB = cur.b;
    PG8_STAGE(PG8_SB(0, 0), cB, voffB); PG8_STAGE(PG8_SB(0, 1), cB + hstepB, voffB); PG8_STAGE(PG8_SA(0, 0), cA, voffA); PG8_STAGE(PG8_SA(0, 1), cA + hstepA, voffA);
    if (wr == 1) PG8_BAR;
    PG8_WAIT_V(2); PG8_BAR;
    PG8_STAGE(PG8_SB(1, 0), cB + kstep, voffB); PG8_STAGE(PG8_SA(1, 0), cA + kstep, voffA); PG8_STAGE(PG8_SB(1, 1), cB + hstepB + kstep, voffB);
    PG8_WAIT_V(6); PG8_BAR;
    for (;;) {
        const bool has_next = S.next(ui + 1, nxt);
        const char* nA = has_next ? nxt.a : cA; const char* nB = has_next ? nxt.b : cB;
        for (int t = 0; t < nt; t += 2) {
            const bool last = (t == nt - 2);
            const char* a1 = cA + (size_t)(t + 1) * kstep;
            const char* a2 = last ? nA : cA + (size_t)(t + 2) * kstep; const char* b2 = last ? nB : cB + (size_t)(t + 2) * kstep;
            const char* a3 = a2 + kstep; const char* b3 = b2 + kstep;
            PG8_LDB(B0, 0, 0); PG8_LDB(B1, 0, 1); PG8_SCHED; PG8_LDA(At, 0, 0); PG8_STAGE(PG8_SA(1, 1), a1 + hstepA, voffA);
            PG8_WAIT_V(8); PG8_WAIT_L(0); PG8_BAR; PG8_MMA(0, 0, At, B0); PG8_MMA(0, 1, At, B1); PG8_BAR; PG8_SCHED;
            PG8_LDA(At, 0, 1); PG8_STAGE(PG8_SB(0, 0), b2, voffB); PG8_STAGE(PG8_SB(0, 1), b2 + hstepB, voffB); PG8_STAGE(PG8_SA(0, 0), a2, voffA);
            PG8_WAIT_V(8); PG8_WAIT_L(0); PG8_BAR; PG8_MMA(1, 0, At, B0); PG8_MMA(1, 1, At, B1); PG8_BAR; PG8_SCHED;
            PG8_LDB(B0, 1, 0); PG8_LDB(B1, 1, 1); PG8_SCHED; PG8_LDA(At, 1, 0); PG8_STAGE(PG8_SA(0, 1), a2 + hstepA, voffA);
            PG8_WAIT_V(8); PG8_WAIT_L(0); PG8_BAR; PG8_MMA(0, 0, At, B0); PG8_MMA(0, 1, At, B1); PG8_BAR; PG8_SCHED;
            PG8_LDA(At, 1, 1); PG8_STAGE(PG8_SB(1, 0), b3, voffB); PG8_STAGE(PG8_SB(1, 1), b3 + hstepB, voffB); PG8_STAGE(PG8_SA(1, 0), a3, voffA);
            PG8_WAIT_V(8); PG8_WAIT_L(0); PG8_BAR; PG8_MMA(1, 0, At, B0); PG8_MMA(1, 1, At, B1); PG8_BAR; PG8_SCHED;
        }
        if (wr == 0) PG8_BAR;
        __builtin_amdgcn_sched_barrier(0); asm volatile("s_nop 15\n\ts_nop 15\n\ts_nop 15" ::: "memory"); __builtin_amdgcn_sched_barrier(0);
        { int t2 = threadIdx.x; asm volatile("" : "+v"(t2)); E(acc, cur, wr, wc, t2 & 15, (t2 >> 4) & 3, xl); }
        if (!has_next) break;
#pragma unroll
        for (int a = 0; a < 2; ++a)
#pragma unroll
            for (int b = 0; b < 2; ++b)
#pragma unroll
                for (int m = 0; m < 4; ++m)
#pragma unroll
                    for (int n = 0; n < 2; ++n) acc[a][b][m][n] = (f32x4){0.f, 0.f, 0.f, 0.f};
        cur = nxt; cA = nA; cB = nB; ++ui;
        if (wr == 1) PG8_BAR;
    }
    PG8_WAIT_V(0);
    PG8_BAR;
#undef PG8_SA
#undef PG8_SB
#undef PG8_STAGE
#undef qvoffA
#undef qvoffB
#undef PG8_LDA
#undef PG8_LDB
#undef PG8_MMA
#undef PG8_WAIT_V
#undef PG8_WAIT_L
#undef PG8_BAR
#undef PG8_SCHED
}
}

constexpr int RING_BYTES = 131072, XL_OFF = RING_BYTES, XBST_OFF = XL_OFF + 14336, LDS_BYTES = 147456;

struct TItem { const float* W; const float* gk; bf16_t* D; int N, ldt, drow0, k0, n0; };
__device__ __forceinline__ void titem_load(float (&v)[32], const TItem& t, int lane) {
#pragma unroll
    for (int i = 0; i < 32; ++i) { const int kk = 2 * i + (lane >> 5); v[i] = t.W[(size_t)(t.k0 + kk) * t.N + t.n0 + (lane & 31)]; }
}
__device__ __forceinline__ void titem_to_lds(const float (&v)[32], LAS float* scr, int lane) {
#pragma unroll
    for (int i = 0; i < 32; ++i) { const int kk = 2 * i + (lane >> 5); scr[kk * 33 + (lane & 31)] = v[i]; }
    LDS_WAIT(); asm volatile("" ::: "memory");
}
__device__ __forceinline__ void titem_store(const TItem& t, LAS float* scr, int lane) {
    const int c = lane & 7;
    f32x4 g0 = (f32x4){1.f, 1.f, 1.f, 1.f}, g1 = g0;
    if (t.gk) { g0 = *(const f32x4*)(t.gk + t.k0 + 8 * c); g1 = *(const f32x4*)(t.gk + t.k0 + 8 * c + 4); }
#pragma unroll
    for (int j = 0; j < 4; ++j) { const int n = (lane >> 3) + 8 * j; const LAS float* s = scr + (8 * c) * 33 + n;
        u32x4 o; o.x = cvt_pk_bf16(s[0 * 33] * g0[0], s[1 * 33] * g0[1]); o.y = cvt_pk_bf16(s[2 * 33] * g0[2], s[3 * 33] * g0[3]);
        o.z = cvt_pk_bf16(s[4 * 33] * g1[0], s[5 * 33] * g1[1]); o.w = cvt_pk_bf16(s[6 * 33] * g1[2], s[7 * 33] * g1[3]);
        *(u32x4*)(t.D + (size_t)(t.drow0 + n) * t.ldt + t.k0 + 8 * c) = o; }
    LDS_WAIT(); asm volatile("" ::: "memory");
}
__device__ __forceinline__ void rms_row_to_bf16(const float* xrow, const float* g, bf16_t* orow, int lane) {
    const f32x4* xr = (const f32x4*)xrow + lane; const f32x4* gr = (const f32x4*)g + lane;
    f32x4 v[4]; float s = 0.f;
#pragma unroll
    for (int j = 0; j < 4; ++j) { v[j] = xr[64 * j]; s += (v[j].x * v[j].x + v[j].y * v[j].y) + (v[j].z * v[j].z + v[j].w * v[j].w); }
    const float rstd = 1.f / sqrtf(wave_sum(s) * (1.f / DM) + EPS);
    u32x2* o8 = (u32x2*)orow + lane;
#pragma unroll
    for (int j = 0; j < 4; ++j) { const f32x4 gg = gr[64 * j]; u32x2 w; w.x = cvt_pk_bf16(v[j].x * rstd * gg.x, v[j].y * rstd * gg.y); w.y = cvt_pk_bf16(v[j].z * rstd * gg.z, v[j].w * rstd * gg.w); o8[64 * j] = w; }
}

__device__ __forceinline__ void rms_rows4_to_bf16(const float* xrow, const float* g, bf16_t* orow, int lane) {
    f32x4 v[4][4]; float s[4];
#pragma unroll
    for (int r = 0; r < 4; ++r)
#pragma unroll
        for (int j = 0; j < 4; ++j) v[r][j] = *((const f32x4*)(xrow + (size_t)r * DM) + lane + 64 * j);
#pragma unroll
    for (int r = 0; r < 4; ++r) { s[r] = 0.f;
#pragma unroll
        for (int j = 0; j < 4; ++j) s[r] += (v[r][j].x * v[r][j].x + v[r][j].y * v[r][j].y) + (v[r][j].z * v[r][j].z + v[r][j].w * v[r][j].w); }
#pragma unroll
    for (int r = 0; r < 4; ++r) s[r] = 1.f / sqrtf(wave_sum(s[r]) * (1.f / DM) + EPS);
#pragma unroll
    for (int j = 0; j < 4; ++j) { const f32x4 gg = *((const f32x4*)g + lane + 64 * j);
#pragma unroll
        for (int r = 0; r < 4; ++r) { u32x2 w; w.x = cvt_pk_bf16(v[r][j].x * s[r] * gg.x, v[r][j].y * s[r] * gg.y); w.y = cvt_pk_bf16(v[r][j].z * s[r] * gg.z, v[r][j].w * s[r] * gg.w);
            *((u32x2*)(orow + (size_t)r * DM) + lane + 64 * j) = w; } }
}

struct Args { const float* in[28]; float* out; unsigned char* ws; int ph_lo, ph_hi; };
typedef const __attribute__((address_space(4))) Args* KArgs;
__device__ __forceinline__ KArgs kargs() { KArgs p = (KArgs)__builtin_amdgcn_kernarg_segment_ptr(); asm volatile("" : "+s"(p)); return p; }

__device__ __forceinline__ void ssm_tables(KArgs ap, int g, LAS unsigned char* lds, bf16_t* Tg, bf16_t* Wend) {
    LAS float* Lre = (LAS float*)lds;
    LAS float* Lim = Lre + 33 * 64;
    LAS float* Bre = Lim + 33 * 64;
    LAS float* Bim = Bre + 1024;
    LAS float* Cre = Bim + 1024;
    LAS float* Cim = Cre + 1024;
    LAS float* Kern = Cim + 1024;
    const int tid = threadIdx.x;
    const float* lam_re = ap->in[12] + g * 64; const float* lam_im = ap->in[13] + g * 64;
    const float dt = expf(ap->in[14][g]);
    for (int idx = tid; idx < 33 * 64; idx += 512) {
        const int tau = idx >> 6, p = idx & 63;
        const float mag = expf((float)tau * (lam_re[p] * dt)); const float ang = (float)tau * (lam_im[p] * dt);
        Lre[idx] = mag * cosf(ang); Lim[idx] = mag * sinf(ang);
    }
    __syncthreads();
    for (int idx = tid; idx < 1024; idx += 512) {
        {
            const int p = idx >> 4;
            const float lr = lam_re[p], li = lam_im[p], lbr = Lre[64 + p], lbi = Lim[64 + p];
            const float nre = lbr - 1.0f, den = lr * lr + li * li;
            const float cr = (nre * lr + lbi * li) / den, ci = (lbi * lr - nre * li) / den;
            const float br = ap->in[15][(size_t)g * 1024 + idx], bi = ap->in[16][(size_t)g * 1024 + idx];
            Bre[idx] = cr * br - ci * bi; Bim[idx] = cr * bi + ci * br;
        }
        Cre[idx] = ap->in[17][(size_t)g * 1024 + idx]; Cim[idx] = ap->in[18][(size_t)g * 1024 + idx];
    }
    __syncthreads();
    {
        const int tau = tid >> 4, co = tid & 15; float kacc[16];
#pragma unroll
        for (int ci = 0; ci < 16; ++ci) kacc[ci] = 0.f;
        for (int p = 0; p < 64; ++p) {
            const float cr = Cre[co * 64 + p], cim = Cim[co * 64 + p], lr = Lre[tau * 64 + p], li = Lim[tau * 64 + p];
            const float gr = cr * lr - cim * li, gi = cr * li + cim * lr;
#pragma unroll
            for (int q = 0; q < 4; ++q) { const f32x4 br = *(const LAS f32x4*)(Bre + p * 16 + 4 * q), bi = *(const LAS f32x4*)(Bim + p * 16 + 4 * q);
#pragma unroll
                for (int e = 0; e < 4; ++e) kacc[4 * q + e] += gr * br[e] - gi * bi[e]; }
        }
#pragma unroll
        for (int ci = 0; ci < 16; ++ci) Kern[tid * 16 + ci] = kacc[ci];
    }
    __syncthreads();
    bf16_t* T = Tg + (size_t)g * 512 * 640;
    for (int idx = tid; idx < 512 * 80; idx += 512) {
        const int n = idx / 80, k8 = (idx % 80) * 8; const int t = n >> 4, co = n & 15;
        float v[8];
        if (k8 < 512) { const int s = k8 >> 4, ci = k8 & 15;
#pragma unroll
            for (int j = 0; j < 8; ++j) v[j] = (s <= t) ? Kern[((t - s) * 16 + co) * 16 + ci + j] : 0.f;
        } else { const int q = k8 - 512, im = q >> 6, p0 = q & 63;
#pragma unroll
            for (int j = 0; j < 8; ++j) { const int p = p0 + j; const float cr = Cre[co * 64 + p], cim = Cim[co * 64 + p], lr = Lre[(t + 1) * 64 + p], li = Lim[(t + 1) * 64 + p];
                v[j] = im ? -(cr * li + cim * lr) : (cr * lr - cim * li); }
        }
        u32x4 w; w.x = cvt_pk_bf16(v[0], v[1]); w.y = cvt_pk_bf16(v[2], v[3]); w.z = cvt_pk_bf16(v[4], v[5]); w.w = cvt_pk_bf16(v[6], v[7]);
        *(u32x4*)(T + (size_t)n * 640 + k8) = w;
    }
    bf16_t* We = Wend + (size_t)g * 256 * 512;
    for (int idx = tid; idx < 256 * 64; idx += 512) {
        const int j = idx >> 6, k8 = (idx & 63) * 8; float v[8];
        if (j < 128) { const int p = j & 63, im = j >> 6, s = k8 >> 4, ci = k8 & 15; const float lr = Lre[(31 - s) * 64 + p], li = Lim[(31 - s) * 64 + p];
#pragma unroll
            for (int e = 0; e < 8; ++e) { const float br = Bre[p * 16 + ci + e], bi = Bim[p * 16 + ci + e]; v[e] = im ? (lr * bi + li * br) : (lr * br - li * bi); }
        } else {
#pragma unroll
            for (int e = 0; e < 8; ++e) v[e] = 0.f;
        }
        u32x4 w; w.x = cvt_pk_bf16(v[0], v[1]); w.y = cvt_pk_bf16(v[2], v[3]); w.z = cvt_pk_bf16(v[4], v[5]); w.w = cvt_pk_bf16(v[6], v[7]);
        *(u32x4*)(We + (size_t)j * 512 + k8) = w;
    }
    __syncthreads();
}


template <int W> __device__ __forceinline__ u32x4 pool_item(const bf16_t* up, int t) {
    const int cnt = (t + 1 < W) ? t + 1 : W;
    u32x4 v[W];
#pragma unroll
    for (int i = 0; i < W; ++i) v[i] = (i < cnt) ? *(const u32x4*)(up - (size_t)i * 1536) : (u32x4){0u, 0u, 0u, 0u};
    float s[8];
#pragma unroll
    for (int j = 0; j < 8; ++j) s[j] = 0.f;
#pragma unroll
    for (int i = 0; i < W; ++i) { s[0] += bflo(v[i].x); s[1] += bfhi(v[i].x); s[2] += bflo(v[i].y); s[3] += bfhi(v[i].y); s[4] += bflo(v[i].z); s[5] += bfhi(v[i].z); s[6] += bflo(v[i].w); s[7] += bfhi(v[i].w); }
    const float inv = 1.0f / (float)cnt;
    u32x4 w; w.x = cvt_pk_bf16(s[0] * inv - bflo(v[0].x), s[1] * inv - bfhi(v[0].x)); w.y = cvt_pk_bf16(s[2] * inv - bflo(v[0].y), s[3] * inv - bfhi(v[0].y));
    w.z = cvt_pk_bf16(s[4] * inv - bflo(v[0].z), s[5] * inv - bfhi(v[0].z)); w.w = cvt_pk_bf16(s[6] * inv - bflo(v[0].w), s[7] * inv - bfhi(v[0].w));
    return w;
}

__device__ __forceinline__ void bf8_to_f(const u32x4 v, float (&f)[8]) { f[0] = bflo(v.x); f[1] = bfhi(v.x); f[2] = bflo(v.y); f[3] = bfhi(v.y); f[4] = bflo(v.z); f[5] = bfhi(v.z); f[6] = bflo(v.w); f[7] = bfhi(v.w); }
template <int W> __device__ __forceinline__ void pool_segment(const bf16_t* up, bf16_t* op, int t0) {
    float s[8];
#pragma unroll
    for (int j = 0; j < 8; ++j) s[j] = 0.f;
#pragma unroll
    for (int i = 1; i < W; ++i) {
        u32x4 v = (u32x4){0u, 0u, 0u, 0u};
        if (t0 - i >= 0) v = *(const u32x4*)(up - (size_t)i * 1536);
        float f[8]; bf8_to_f(v, f);
#pragma unroll
        for (int j = 0; j < 8; ++j) s[j] += f[j];
    }
#pragma unroll 4
    for (int r = 0; r < 32; ++r) {
        const int t = t0 + r;
        const u32x4 vc = *(const u32x4*)(up + (size_t)r * 1536);
        u32x4 vo = (u32x4){0u, 0u, 0u, 0u};
        if (t - (W - 1) >= 0) vo = *(const u32x4*)(up + (size_t)(r - (W - 1)) * 1536);
        float fc[8], fo[8]; bf8_to_f(vc, fc); bf8_to_f(vo, fo);
        const float inv = 1.0f / (float)((t + 1 < W) ? t + 1 : W);
        float o[8];
#pragma unroll
        for (int j = 0; j < 8; ++j) { s[j] += fc[j]; o[j] = s[j] * inv - fc[j]; s[j] -= fo[j]; }
        u32x4 w; w.x = cvt_pk_bf16(o[0], o[1]); w.y = cvt_pk_bf16(o[2], o[3]); w.z = cvt_pk_bf16(o[4], o[5]); w.w = cvt_pk_bf16(o[6], o[7]);
        *(u32x4*)(op + (size_t)r * DM) = w;
    }
}

__device__ __forceinline__ int crow(int r, int hi) { return (r & 3) + 8 * (r >> 2) + 4 * hi; }
__device__ __forceinline__ void sb_attn_task(const bf16_t* __restrict__ QKU, const bf16_t* __restrict__ VT, bf16_t* __restrict__ CAT, int b, int h, int qb, int lane) {
    const int r32 = lane & 31, hi = lane >> 5;
    const size_t tok0 = (size_t)b * SEQ; const int q0 = qb * 32;
    const bf16_t* qp = QKU + (tok0 + q0 + r32) * 1536 + h * 64 + 8 * hi;
    bf16x8 qf[4];
#pragma unroll
    for (int j = 0; j < 4; ++j) qf[j] = *(const bf16x8*)(qp + 16 * j);
    const bf16_t* kp = QKU + (tok0 + r32) * 1536 + 512 + h * 64 + 8 * hi;
    const bf16_t* vp = VT + (size_t)(h * 64 + r32) * VT_LD + tok0 + 4 * hi;
    f32x16 o0, o1;
#pragma unroll
    for (int r = 0; r < 16; ++r) { o0[r] = 0.f; o1[r] = 0.f; }
    float carry = 1.0f;
    bf16x8 kf[4]; s16x4 va[2][4]; bf16x8 k1[4]; s16x4 v1[2][4];
#define SB_LOAD(KF, VA, K0) do { const int k0_ = (K0); \
        _Pragma("unroll") for (int j = 0; j < 4; ++j) KF[j] = *(const bf16x8*)(kp + (size_t)k0_ * 1536 + 16 * j); \
        _Pragma("unroll") for (int dh = 0; dh < 2; ++dh) _Pragma("unroll") for (int c = 0; c < 4; ++c) VA[dh][c] = *(const s16x4*)(vp + (size_t)dh * 32 * VT_LD + k0_ + 8 * c); } while (0)
    asm volatile("s_waitcnt vmcnt(0)" ::: "memory");
    SB_LOAD(kf, va, q0);
    SB_LOAD(k1, v1, qb > 0 ? q0 - 32 : q0);
    for (int kt = qb; kt >= 0; --kt) {
        bf16x8 kn[4]; s16x4 vn[2][4];
        SB_LOAD(kn, vn, kt >= 2 ? (kt - 2) * 32 : 0);
        f32x16 s;
#pragma unroll
        for (int r = 0; r < 16; ++r) s[r] = 0.f;
#pragma unroll
        for (int j = 0; j < 4; ++j) s = __builtin_amdgcn_mfma_f32_32x32x16_bf16(kf[j], qf[j], s, 0, 0, 0);
        const bool diag = (kt == qb);
        float omb[16], bt[16];
#pragma unroll
        for (int r = 0; r < 16; ++r) {
            const float z2 = fminf(s[r] * (0.125f * LOG2E), 100.0f);
            const float e = fexp2(z2);
            const float ob = frcp(1.0f + e);
            const bool valid = !diag || (crow(r, hi) < r32);
            omb[r] = valid ? ob : 1.0f; bt[r] = valid ? e * ob : 0.0f;
        }
        float gp[4], pg[4];
#pragma unroll
        for (int g = 0; g < 4; ++g) { gp[g] = (omb[4 * g] * omb[4 * g + 1]) * (omb[4 * g + 2] * omb[4 * g + 3]); pg[g] = partner32(gp[g], hi); }
        float tp[4];
        tp[3] = 1.0f; tp[2] = gp[3] * pg[3]; tp[1] = tp[2] * (gp[2] * pg[2]); tp[0] = tp[1] * (gp[1] * pg[1]);
        const float total = tp[0] * (gp[0] * pg[0]);
        float w[16];
#pragma unroll
        for (int g = 0; g < 4; ++g) {
            const float base = carry * tp[g] * (hi ? 1.0f : pg[g]);
            const float a3 = base, a2 = a3 * omb[4 * g + 3], a1 = a2 * omb[4 * g + 2], a0 = a1 * omb[4 * g + 1];
            w[4 * g + 3] = bt[4 * g + 3] * a3;
            w[4 * g + 2] = bt[4 * g + 2] * a2;
            w[4 * g + 1] = bt[4 * g + 1] * a1;
            w[4 * g + 0] = bt[4 * g + 0] * a0;
        }
        carry *= total;
        u32x4 p0, p1;
        p0.x = cvt_pk_bf16(w[0], w[1]); p0.y = cvt_pk_bf16(w[2], w[3]); p0.z = cvt_pk_bf16(w[4], w[5]); p0.w = cvt_pk_bf16(w[6], w[7]);
        p1.x = cvt_pk_bf16(w[8], w[9]); p1.y = cvt_pk_bf16(w[10], w[11]); p1.z = cvt_pk_bf16(w[12], w[13]); p1.w = cvt_pk_bf16(w[14], w[15]);
        const bf16x8 pb0 = __builtin_bit_cast(bf16x8, p0), pb1 = __builtin_bit_cast(bf16x8, p1);
#define VA8(dh, c) (bf16x8){va[dh][c][0], va[dh][c][1], va[dh][c][2], va[dh][c][3], va[dh][(c) + 1][0], va[dh][(c) + 1][1], va[dh][(c) + 1][2], va[dh][(c) + 1][3]}
        const bf16x8 a00 = VA8(0, 0), a02 = VA8(0, 2), a10 = VA8(1, 0), a12 = VA8(1, 2);
#undef VA8
        o0 = __builtin_amdgcn_mfma_f32_32x32x16_bf16(a00, pb0, o0, 0, 0, 0);
        o0 = __builtin_amdgcn_mfma_f32_32x32x16_bf16(a02, pb1, o0, 0, 0, 0);
        o1 = __builtin_amdgcn_mfma_f32_32x32x16_bf16(a10, pb0, o1, 0, 0, 0);
        o1 = __builtin_amdgcn_mfma_f32_32x32x16_bf16(a12, pb1, o1, 0, 0, 0);
        __builtin_amdgcn_sched_barrier(0);
        asm volatile("s_nop 15\n\ts_nop 15\n\ts_nop 15\n\ts_nop 15\n\ts_nop 15" ::: "memory");
        asm volatile("" :: "v"(a00), "v"(a02), "v"(a10), "v"(a12), "v"(pb0), "v"(pb1), "v"(kf[0]), "v"(kf[1]), "v"(kf[2]), "v"(kf[3]));
        __builtin_amdgcn_sched_barrier(0);
        if (__all(carry == 0.0f)) break;
#pragma unroll
        for (int j = 0; j < 4; ++j) { kf[j] = k1[j]; k1[j] = kn[j]; }
#pragma unroll
        for (int dh = 0; dh < 2; ++dh)
#pragma unroll
            for (int c = 0; c < 4; ++c) { va[dh][c] = v1[dh][c]; v1[dh][c] = vn[dh][c]; }
    }
#undef SB_LOAD
    bf16_t* op = CAT + (tok0 + q0 + r32) * DM + h * 64 + 4 * hi;
#pragma unroll
    for (int g = 0; g < 4; ++g) {
        u32x2 w0, w1;
        w0.x = cvt_pk_bf16(o0[4 * g], o0[4 * g + 1]); w0.y = cvt_pk_bf16(o0[4 * g + 2], o0[4 * g + 3]);
        w1.x = cvt_pk_bf16(o1[4 * g], o1[4 * g + 1]); w1.y = cvt_pk_bf16(o1[4 * g + 2], o1[4 * g + 3]);
        *(u32x2*)(op + 8 * g) = w0; *(u32x2*)(op + 32 + 8 * g) = w1;
    }
}


constexpr int SBK_PITCH = 144, SBV_PITCH = 80, SBK_BYTES = 32 * SBK_PITCH, SBV_BYTES = 64 * SBV_PITCH, SB_TILE = SBK_BYTES + SBV_BYTES, SB_WIN = 14;
static_assert(SB_WIN * SB_TILE <= XBST_OFF, "attention LDS window must stay below the grid barrier's LDS words");
__device__ __forceinline__ void sb_attn_block(const bf16_t* __restrict__ QKU, const bf16_t* __restrict__ VT, bf16_t* __restrict__ CAT, int b, int h, int qb0,
                                              LAS unsigned char* lds, int tid, int wave, int lane) {
    const int r32 = lane & 31, hi = lane >> 5;
    const size_t tok0 = (size_t)b * SEQ; const int qb = qb0 + wave, q0 = qb * 32;
    const int lo = (qb0 >= 6) ? qb0 - 6 : 0, ntile = qb0 + 8 - lo;
    {
        const bool isk = tid < 256; const int t2 = tid & 255;
        const bf16_t* gsrc = isk ? QKU + (tok0 + (t2 >> 3)) * 1536 + 512 + h * 64 + (t2 & 7) * 8
                                 : VT + (size_t)(h * 64 + (t2 >> 2)) * VT_LD + tok0 + (t2 & 3) * 8;
        const size_t gstep = isk ? (size_t)32 * 1536 : (size_t)32;
        const int ldst = isk ? (t2 >> 3) * SBK_PITCH + (t2 & 7) * 16 : SBK_BYTES + (t2 >> 2) * SBV_PITCH + (t2 & 3) * 16;
        u32x4 stg[SB_WIN];
#pragma unroll
        for (int i = 0; i < SB_WIN; ++i) if (i < ntile) stg[i] = *(const u32x4*)(gsrc + (size_t)(lo + i) * gstep);
#pragma unroll
        for (int i = 0; i < SB_WIN; ++i) if (i < ntile) *(LAS u32x4*)(lds + i * SB_TILE + ldst) = stg[i];
    }
    const bf16_t* qp = QKU + (tok0 + q0 + r32) * 1536 + h * 64 + 8 * hi;
    bf16x8 qf[4];
#pragma unroll
    for (int j = 0; j < 4; ++j) qf[j] = *(const bf16x8*)(qp + 16 * j);
    const bf16_t* kp = QKU + (tok0 + r32) * 1536 + 512 + h * 64 + 8 * hi;
    const bf16_t* vp = VT + (size_t)(h * 64 + r32) * VT_LD + tok0 + 4 * hi;
    f32x16 o0, o1;
#pragma unroll
    for (int r = 0; r < 16; ++r) { o0[r] = 0.f; o1[r] = 0.f; }
    float carry = 1.0f;
    __syncthreads();
    for (int kt = qb; kt >= 0; --kt) {
        bf16x8 kf[4]; s16x4 va[2][4];
        if (kt >= lo) {
            LAS unsigned char* kb = lds + (kt - lo) * SB_TILE; LAS unsigned char* vb = kb + SBK_BYTES;
#pragma unroll
            for (int j = 0; j < 4; ++j) kf[j] = *(const LAS bf16x8*)(kb + r32 * SBK_PITCH + (16 * j + 8 * hi) * 2);
#pragma unroll
            for (int dh = 0; dh < 2; ++dh)
#pragma unroll
                for (int c = 0; c < 4; ++c) va[dh][c] = *(const LAS s16x4*)(vb + (dh * 32 + r32) * SBV_PITCH + (8 * c + 4 * hi) * 2);
        } else {
            const int k0 = kt * 32;
#pragma unroll
            for (int j = 0; j < 4; ++j) kf[j] = *(const bf16x8*)(kp + (size_t)k0 * 1536 + 16 * j);
#pragma unroll
            for (int dh = 0; dh < 2; ++dh)
#pragma unroll
                for (int c = 0; c < 4; ++c) va[dh][c] = *(const s16x4*)(vp + (size_t)dh * 32 * VT_LD + k0 + 8 * c);
        }
        f32x16 s;
#pragma unroll
        for (int r = 0; r < 16; ++r) s[r] = 0.f;
#pragma unroll
        for (int j = 0; j < 4; ++j) s = __builtin_amdgcn_mfma_f32_32x32x16_bf16(kf[j], qf[j], s, 0, 0, 0);
        const bool diag = (kt == qb);
        float omb[16], bt[16];
#pragma unroll
        for (int r = 0; r < 16; ++r) {
            const float z2 = fminf(s[r] * (0.125f * LOG2E), 100.0f);
            const float e = fexp2(z2);
            const float ob = frcp(1.0f + e);
            const bool valid = !diag || (crow(r, hi) < r32);
            omb[r] = valid ? ob : 1.0f; bt[r] = valid ? e * ob : 0.0f;
        }
        float gp[4], pg[4];
#pragma unroll
        for (int g = 0; g < 4; ++g) { gp[g] = (omb[4 * g] * omb[4 * g + 1]) * (omb[4 * g + 2] * omb[4 * g + 3]); pg[g] = partner32(gp[g], hi); }
        float tp[4];
        tp[3] = 1.0f; tp[2] = gp[3] * pg[3]; tp[1] = tp[2] * (gp[2] * pg[2]); tp[0] = tp[1] * (gp[1] * pg[1]);
        const float total = tp[0] * (gp[0] * pg[0]);
        float w[16];
#pragma unroll
        for (int g = 0; g < 4; ++g) {
            const float base = carry * tp[g] * (hi ? 1.0f : pg[g]);
            const float a3 = base, a2 = a3 * omb[4 * g + 3], a1 = a2 * omb[4 * g + 2], a0 = a1 * omb[4 * g + 1];
            w[4 * g + 3] = bt[4 * g + 3] * a3; w[4 * g + 2] = bt[4 * g + 2] * a2; w[4 * g + 1] = bt[4 * g + 1] * a1; w[4 * g + 0] = bt[4 * g + 0] * a0;
        }
        carry *= total;
        u32x4 p0, p1;
        p0.x = cvt_pk_bf16(w[0], w[1]); p0.y = cvt_pk_bf16(w[2], w[3]); p0.z = cvt_pk_bf16(w[4], w[5]); p0.w = cvt_pk_bf16(w[6], w[7]);
        p1.x = cvt_pk_bf16(w[8], w[9]); p1.y = cvt_pk_bf16(w[10], w[11]); p1.z = cvt_pk_bf16(w[12], w[13]); p1.w = cvt_pk_bf16(w[14], w[15]);
        const bf16x8 pb0 = __builtin_bit_cast(bf16x8, p0), pb1 = __builtin_bit_cast(bf16x8, p1);
#define VA8(dh, c) (bf16x8){va[dh][c][0], va[dh][c][1], va[dh][c][2], va[dh][c][3], va[dh][(c) + 1][0], va[dh][(c) + 1][1], va[dh][(c) + 1][2], va[dh][(c) + 1][3]}
        const bf16x8 a00 = VA8(0, 0), a02 = VA8(0, 2), a10 = VA8(1, 0), a12 = VA8(1, 2);
#undef VA8
        o0 = __builtin_amdgcn_mfma_f32_32x32x16_bf16(a00, pb0, o0, 0, 0, 0);
        o0 = __builtin_amdgcn_mfma_f32_32x32x16_bf16(a02, pb1, o0, 0, 0, 0);
        o1 = __builtin_amdgcn_mfma_f32_32x32x16_bf16(a10, pb0, o1, 0, 0, 0);
        o1 = __builtin_amdgcn_mfma_f32_32x32x16_bf16(a12, pb1, o1, 0, 0, 0);
        __builtin_amdgcn_sched_barrier(0);
        asm volatile("s_nop 15\n\ts_nop 15\n\ts_nop 15\n\ts_nop 15\n\ts_nop 15" ::: "memory");
        asm volatile("" :: "v"(a00), "v"(a02), "v"(a10), "v"(a12), "v"(pb0), "v"(pb1), "v"(kf[0]), "v"(kf[1]), "v"(kf[2]), "v"(kf[3]));
        __builtin_amdgcn_sched_barrier(0);
        if (__all(carry == 0.0f)) break;
    }
    bf16_t* op = CAT + (tok0 + q0 + r32) * DM + h * 64 + 4 * hi;
#pragma unroll
    for (int g = 0; g < 4; ++g) {
        u32x2 w0, w1;
        w0.x = cvt_pk_bf16(o0[4 * g], o0[4 * g + 1]); w0.y = cvt_pk_bf16(o0[4 * g + 2], o0[4 * g + 3]);
        w1.x = cvt_pk_bf16(o1[4 * g], o1[4 * g + 1]); w1.y = cvt_pk_bf16(o1[4 * g + 2], o1[4 * g + 3]);
        *(u32x2*)(op + 8 * g) = w0; *(u32x2*)(op + 32 + 8 * g) = w1;
    }
    __syncthreads();
}

#define XB_TMO      128
#define XB_XCNT(j)  (256  + 64 * (j))
#define XB_XSUB(j)  (1280 + 64 * (j))
#define XB_XGEN(j)  (2304 + 64 * (j))
#define XB_TOP      3328
#define XB_TOPGEN   3392
#define XCD_BAR_WORDS 3456
#define XB_SPIN_CAP (1u << 22)
__device__ __forceinline__ unsigned xb_ld(unsigned* p)              { return __hip_atomic_load(p, __ATOMIC_RELAXED, __HIP_MEMORY_SCOPE_AGENT); }
__device__ __forceinline__ unsigned xb_add(unsigned* p, unsigned v) { return __hip_atomic_fetch_add(p, v, __ATOMIC_RELAXED, __HIP_MEMORY_SCOPE_AGENT); }
__device__ __forceinline__ unsigned xb_xcc_id() { return (unsigned)__builtin_amdgcn_s_getreg((3 << 11) | 20) & 0xFu; }
#define XB_SPIN(cond, bar) do { unsigned _sp = 0; while (cond) { __builtin_amdgcn_s_sleep(1); \
    if ((++_sp & 255u) == 0u) { if (xb_ld(&(bar)[XB_TMO])) break; if (_sp > XB_SPIN_CAP) { atomicAdd(&(bar)[XB_TMO], 1u); break; } } } } while (0)
__device__ __forceinline__ void xcd_barrier_complete(unsigned* bar, unsigned x, unsigned G, unsigned& nloc, unsigned& nx) {
    unsigned sum, cnt, mine, sp = 0u;
    for (;;) {
        sum = 0u; cnt = 0u; mine = 0u;
#pragma unroll
        for (unsigned j = 0; j < 16; ++j) { const unsigned c = xb_ld(&bar[XB_XCNT(j)]); sum += c; cnt += (c > 0u) ? 1u : 0u; mine = (j == x) ? c : mine; }
        if (sum == G) break;
        __builtin_amdgcn_s_sleep(1);
        if ((++sp & 255u) == 0u) { if (xb_ld(&bar[XB_TMO])) break; if (sp > XB_SPIN_CAP) { atomicAdd(&bar[XB_TMO], 1u); break; } }
    }
    nloc = mine > 0u ? mine : 1u; nx = cnt > 0u ? cnt : 1u;
}
__device__ __forceinline__ void xcd_barrier(unsigned* bar, volatile LAS unsigned* st, bool leader, unsigned G) {
    asm volatile("s_waitcnt vmcnt(0)" ::: "memory");
    __syncthreads();
    if (leader) {
        const unsigned x = xb_xcc_id();
        __builtin_amdgcn_s_waitcnt(0);
        unsigned nloc = st[0], nx = st[1];
        if (nloc == 0u) { xcd_barrier_complete(bar, x, G, nloc, nx); st[0] = nloc; st[1] = nx; }
        const unsigned old = xb_add(&bar[XB_XSUB(x)], 1u);
        const unsigned gen = old / nloc;
        if (old + 1u == (gen + 1u) * nloc) {
            __builtin_amdgcn_fence(__ATOMIC_RELEASE, "agent");
            asm volatile("s_waitcnt vmcnt(0)" ::: "memory");
            const unsigned og = xb_add(&bar[XB_TOP], 1u);
            const unsigned tg = og / nx;
            if (og + 1u == (tg + 1u) * nx) xb_add(&bar[XB_TOPGEN], 1u);
            else XB_SPIN(xb_ld(&bar[XB_TOPGEN]) == tg, bar);
            __builtin_amdgcn_fence(__ATOMIC_ACQUIRE, "agent");
            xb_add(&bar[XB_XGEN(x)], 1u);
            asm volatile("s_waitcnt vmcnt(0)" ::: "memory");
        } else {
            XB_SPIN(xb_ld(&bar[XB_XGEN(x)]) == gen, bar);
            __builtin_amdgcn_fence(__ATOMIC_ACQUIRE, "agent");
            asm volatile("s_waitcnt vmcnt(0)" ::: "memory");
        }
    }
    __syncthreads();
}

__global__ void __launch_bounds__(512) mega_fwd(Args a) {
    __builtin_assume(__builtin_amdgcn_workitem_id_y() == 0); __builtin_assume(__builtin_amdgcn_workitem_id_z() == 0);
    extern __shared__ __attribute__((aligned(16))) unsigned char lds_raw[];
    LAS unsigned char* lds = (LAS unsigned char*)lds_raw;
    LAS unsigned char* xl = lds + XL_OFF;
    cg::grid_group grid = cg::this_grid();
#if !MK_MULTI_LAUNCH
    {
        volatile LAS unsigned* st = (volatile LAS unsigned*)(lds + XBST_OFF);
        if (threadIdx.x == 0) { st[0] = 0u; st[1] = 0u; KArgs ap0 = kargs(); xb_add(&((unsigned*)ap0->ws)[XB_XCNT(xb_xcc_id())], 1u); }
        if (a.ph_lo < 0) grid.sync();
        __syncthreads();
    }
#endif
#if MK_MULTI_LAUNCH
    const int lo = a.ph_lo, hi = a.ph_hi;
    int ph = 0;
#endif
#define PH_VARS int tid = threadIdx.x; asm volatile("" : "+v"(tid)); const int lane = tid & 63, wave = __builtin_amdgcn_readfirstlane(tid >> 6); int G_ = gridDim.x, bid_ = blockIdx.x; asm volatile("" : "+s"(G_), "+s"(bid_)); const int G = G_, bid = bid_; \
    const int gw = bid * 8 + wave, NGW = G * 8, gt = bid * 512 + tid, NGT = G * 512; (void)lane; (void)gw; (void)NGW; (void)gt; (void)NGT; KArgs ap = kargs(); unsigned char* ws = ap->ws; float* X = ap->out; float* SSQ = (float*)(ws + WS_SSQ); bf16_t* XB = (bf16_t*)(ws + WS_XB); bf16_t* MEMN = (bf16_t*)(ws + WS_MEMN); (void)X; (void)SSQ; (void)XB; (void)MEMN;
#if MK_MULTI_LAUNCH
#define PHASE_ON (ph >= lo && ph < hi)
#define PHASE_END do { if (ph >= lo && ph + 1 < hi) grid.sync(); ++ph; } while (0)
#define LOCAL_SEAM PHASE_END
#else
#define PHASE_ON (true)
#define LOCAL_SEAM do { asm volatile("s_waitcnt vmcnt(0)" ::: "memory"); __syncthreads(); { int tl = threadIdx.x; asm volatile("" : "+v"(tl)); \
    if (tl == 0) { __builtin_amdgcn_fence(__ATOMIC_ACQUIRE, "agent"); asm volatile("s_waitcnt vmcnt(0)" ::: "memory"); } } __syncthreads(); } while (0)
#define PHASE_END do { KArgs apb = kargs(); int tb = threadIdx.x; asm volatile("" : "+v"(tb)); int Gb = gridDim.x; asm volatile("" : "+s"(Gb)); \
    xcd_barrier((unsigned*)apb->ws, (volatile LAS unsigned*)(lds + XBST_OFF), tb == 0, (unsigned)Gb); } while (0)
#endif

    if (PHASE_ON) { PH_VARS
        if (bid < 64) ssm_tables(ap, bid, lds, (bf16_t*)(ws + WS_TG), (bf16_t*)(ws + WS_WEND));
        LAS float* scr = (LAS float*)(lds + wave * 16384);
        const bool weighted = (G > 64);
        const int n_tw = weighted ? 64 * 8 : 0, n_nw = weighted ? (G - 64) * 8 : G * 8;
        const int spw = weighted ? 4 : 1, S = n_nw * spw + n_tw;
        const bool is_tw = weighted && bid < 64;
        const int slot0 = is_tw ? n_nw * spw + gw : (weighted ? (gw - 512) * 4 : gw), nslot = is_tw ? 1 : spw;
        if (!is_tw) {
            const int nb_ = weighted ? G - 64 : G, b_ = weighted ? bid - 64 : bid;
            for (int it = b_ + wave * nb_; it < 256; it += nb_ * 8) {
                const int g = it >> 6, cb = (it >> 2) & 15, nb = it & 3;
                const float* pw = ap->in[8] + (size_t)(g * 128 + cb * 8) * 128; const float* sc = ap->in[9] + g * 128;
                const float* wo = ap->in[10] + (size_t)(512 + g * 128) * 1024 + nb * 256 + lane * 4;
                f32x4 acc8[8];
#pragma unroll
                for (int j = 0; j < 8; ++j) acc8[j] = (f32x4){0.f, 0.f, 0.f, 0.f};
#pragma unroll 8
                for (int d = 0; d < 128; ++d) {
                    const f32x4 wv = *(const f32x4*)(wo + (size_t)d * 1024); const float sd = sc[d];
#pragma unroll
                    for (int j = 0; j < 8; ++j) acc8[j] += wv * (pw[j * 128 + d] * sd);
                }
                bf16_t* D = (bf16_t*)(ws + WS_WOUT) + (size_t)(nb * 256 + lane * 4) * 1024 + 512 + g * 128 + cb * 8;
#pragma unroll
                for (int e = 0; e < 4; ++e) {
                    u32x4 w; w.x = cvt_pk_bf16(acc8[0][e], acc8[1][e]); w.y = cvt_pk_bf16(acc8[2][e], acc8[3][e]); w.z = cvt_pk_bf16(acc8[4][e], acc8[5][e]); w.w = cvt_pk_bf16(acc8[6][e], acc8[7][e]);
                    *(u32x4*)(D + (size_t)e * 1024) = w;
                }
            }
        }
        {
            float tv[32]; TItem cur, nxt; bool have = false, have_next = false;
            int sl = 0, it = slot0;
            auto decode = [&](int item, TItem& t) -> bool {
                int r = item; const float* W = nullptr; const float* gk = nullptr; int N = 0; bf16_t* D = nullptr; int ldt = 0, mode = 0; bool found = false;
#define TJOB(Wp, Kk, Nn, Dp, Ld, Md, Gp) if (!found) { const int cnt = ((Kk) / 64) * ((Nn) / 32); if (r < cnt) { W = (Wp); N = (Nn); D = (bf16_t*)(Dp); ldt = (Ld); mode = (Md); gk = (Gp); found = true; } else r -= cnt; }
                TJOB(ap->in[7], 1024, 2048, ws + WS_WIN, 1024, 1, nullptr)
            TJOB(ap->in[10], 512, 1024, ws + WS_WOUT, 1024, 0, nullptr)
            TJOB(ap->in[11], 1024, 1024, ws + WS_WSSM, 1024, 0, ap->in[2] + 1024)
            TJOB(ap->in[20], 1024, 2048, ws + WS_WGLU, 1024, 2, nullptr)
#pragma unroll
            for (int l = 0; l < 2; ++l) {
                unsigned char* lb = ws + WS_LAYER + l * LAYER_STRIDE;
                TJOB(ap->in[22] + (size_t)l * 1024 * 2048, 1024, 2048, lb + LO_WKV, 1024, 0, nullptr)
                TJOB(ap->in[23] + (size_t)l * 1024 * 1024, 1024, 1024, lb + LO_WO, 1024, 0, nullptr)
                TJOB(ap->in[24] + (size_t)l * 1024 * DFF2, 1024, DFF2, lb + LO_WUP, 1024, 3, ap->in[4] + l * 1024)
                TJOB(ap->in[27] + (size_t)l * DFF * 1024, DFF, 1024, lb + LO_WDN, DFF, 0, nullptr)
            }
#undef TJOB
                if (!found) return false;
                const int nblk = N / 32, kb = r / nblk, nb = r % nblk, n0 = nb * 32;
                int drow0 = n0;
                if (mode == 1) drow0 = (n0 < 1024) ? n0 : (n0 < 1536 ? n0 + 512 : n0 - 512);
                else if (mode == 2) drow0 = (n0 < 1024) ? (256 * (n0 >> 7) + (n0 & 127)) : (256 * ((n0 - 1024) >> 7) + 128 + ((n0 - 1024) & 127));
                else if (mode == 3) drow0 = (n0 < DFF) ? (256 * (n0 >> 7) + (n0 & 127)) : (256 * ((n0 - DFF) >> 7) + 128 + ((n0 - DFF) & 127));
                t.W = W; t.gk = gk; t.D = D; t.N = N; t.ldt = ldt; t.drow0 = drow0; t.k0 = kb * 64; t.n0 = n0; return true;
            };
            auto advance = [&](TItem& t) -> bool {
                while (sl < nslot) { if (decode(it, t)) { it += S; return true; } ++sl; it = slot0 + sl; }
                return false;
            };
            have = advance(cur);
            if (have) titem_load(tv, cur, lane);
            while (have) {
                titem_to_lds(tv, scr, lane);
                have_next = advance(nxt);
                if (have_next) titem_load(tv, nxt, lane);
                titem_store(cur, scr, lane);
                cur = nxt; have = have_next;
            }
        }
        for (int it = gt; it < 2 * 1024 * 256; it += NGT) {
            const int l = it >> 18, e = it & 262143, k = e >> 8, n4 = (e & 255) * 4;
            const f32x4 w = *(const f32x4*)(ap->in[21] + (size_t)l * 1048576 + (size_t)k * 1024 + n4); const float gk = ap->in[3][l * 1024 + k];
            u32x2 o; o.x = cvt_pk_bf16(w[0] * gk, w[1] * gk); o.y = cvt_pk_bf16(w[2] * gk, w[3] * gk);
            *(u32x2*)((bf16_t*)(ws + WS_LAYER + l * LAYER_STRIDE + LO_WQ) + (size_t)k * 1024 + n4) = o;
        }
        for (int r = gw; r < MEMTOK / 4; r += NGW) rms_rows4_to_bf16(ap->in[1] + (size_t)r * 4 * DM, ap->in[5], MEMN + (size_t)r * 4 * DM, lane);
        for (int r = gw; r < MTOK / 4; r += NGW) rms_rows4_to_bf16(ap->in[0] + (size_t)r * 4 * DM, ap->in[2], XB + (size_t)r * 4 * DM, lane);
        __syncthreads();
    }
    PHASE_END;

    if (PHASE_ON) { PH_VARS
        bf16_t* WIN = (bf16_t*)(ws + WS_WIN);
        { pg8::SchedStd S; S.init(XB, 256 * 2048, WIN, 256 * 2048, 128, 6, G, bid);
          pg8::EpiStore E{(bf16_t*)(ws + WS_QKU), 1536, nullptr, 0, 1.0f, 0};
          pg8::gemm_phase(lds, xl, 1024, 1024, 1024, S, E); }
        { pg8::SchedStd S; S.init(WIN + (size_t)1536 * 1024, 256 * 2048, XB, 256 * 2048, 2, 128, G, bid);
          pg8::EpiStore E{(bf16_t*)(ws + WS_VT), VT_LD, nullptr, 0, 1.0f, 0};
          pg8::gemm_phase(lds, xl, 1024, 1024, 1024, S, E); }
        for (int j = 0; j < 4; ++j) {
            const int l = j >> 1, isv = j & 1;
            bf16_t* WKV = (bf16_t*)(ws + WS_LAYER + l * LAYER_STRIDE + LO_WKV);
            const int c = (bid + 64 * (j + 1)) % G;
            pg8::SchedStd S;
            S.init(MEMN, 256 * 2048, WKV + (size_t)isv * 1024 * 1024, 256 * 2048, 16, 4, G, c);
            pg8::EpiStore E{isv ? (bf16_t*)(ws + WS_MEMVT + l * MEMVT_STRIDE) : (bf16_t*)(ws + WS_MEMK + l * 8 * MiB), 1024, nullptr, 0, 1.0f, 0};
            pg8::gemm_phase(lds, xl, 1024, 1024, 1024, S, E);
        }
    }
    PHASE_END;

    if (PHASE_ON) { PH_VARS
        const bf16_t* QKU = (const bf16_t*)(ws + WS_QKU); bf16_t* CAT = (bf16_t*)(ws + WS_CAT);
        for (int it = gt; it < 64 * (MTOK / 32); it += NGT) {
            const int ch = it & 63, seg = it >> 6, g = ch >> 4;
            const bf16_t* up = QKU + (size_t)seg * 32 * 1536 + 1024 + ch * 8;
            bf16_t* op = CAT + (size_t)seg * 32 * DM + 512 + ch * 8;
            const int t0 = (seg * 32) & (SEQ - 1);
            if (g == 0) pool_segment<2>(up, op, t0); else if (g == 1) pool_segment<4>(up, op, t0); else if (g == 2) pool_segment<8>(up, op, t0); else pool_segment<16>(up, op, t0);
        }
        for (int wt = bid; wt < 128 * 8; wt += G) {
            const int bh = wt >> 3, blk = wt & 7;
            sb_attn_block(QKU, (const bf16_t*)(ws + WS_VT), CAT, bh >> 3, bh & 7, blk * 8, lds, tid, wave, lane);
        }
    }
    PHASE_END;

    if (PHASE_ON) { PH_VARS
        pg8::SchedStd S; S.init(ws + WS_CAT, 256 * 2048, ws + WS_WOUT, 256 * 2048, 128, 4, G, bid);
        pg8::EpiResid E{ap->in[0], XB, SSQ};
        pg8::gemm_phase(lds, xl, 1024, 1024, 1024, S, E);
        pg8::SchedG SG{(const char*)(ws + WS_MEMK), (const char*)(ws + WS_LAYER + LO_WQ), G, bid};
        pg8::EpiStore EG{(bf16_t*)(ws + WS_GT), 1024, nullptr, 0, 1.0f, 0};
        pg8::gemm_phase(lds, xl, 1024, 1024, 256, SG, EG);
    }
    PHASE_END;

#pragma nounroll
    for (int layer = 0; layer < 2; ++layer) {
        if (layer == 1) {
            if (PHASE_ON) { PH_VARS
                pg8::SchedStd S; S.init(XB, 256 * 2048, ws + WS_WSSM, 256 * 2048, 128, 4, G, bid);
                pg8::EpiStore E{(bf16_t*)(ws + WS_UG), 0, SSQ, 16, 1.0f, 1};
                pg8::gemm_phase(lds, xl, 1024, 1024, 1024, S, E);
            }
            PHASE_END;
            if (PHASE_ON) { PH_VARS
                pg8::SchedS2 S{(const char*)(ws + WS_UG), (const char*)(ws + WS_WEND), G, bid};
                pg8::EpiHend E{(float*)(ws + WS_HEND)};
                pg8::gemm_phase(lds, xl, 640, 512, 512, S, E);
            }
            PHASE_END;
            if (PHASE_ON) { PH_VARS
                bf16_t* UG = (bf16_t*)(ws + WS_UG); const float* HE = (const float*)(ws + WS_HEND);
                for (int it = gt; it < NBATCH * 64 * 64; it += NGT) {
                    const int p = it & 63, g = (it >> 6) & 63, b = it >> 12;
                    const float dt = expf(ap->in[14][g]);
                    const float mag = expf(32.0f * (ap->in[12][g * 64 + p] * dt)), ang = 32.0f * (ap->in[13][g * 64 + p] * dt);
                    const float lr = mag * cosf(ang), li = mag * sinf(ang);
                    float hr = 0.f, hi_ = 0.f;
                    for (int c0 = 0; c0 < 64; c0 += 8) {
                        const size_t row0 = (size_t)g * 1024 + b * 64 + c0;
                        float er[8], ei[8];
#pragma unroll
                        for (int j = 0; j < 8; ++j) { er[j] = HE[(row0 + j) * 128 + p]; ei[j] = HE[(row0 + j) * 128 + 64 + p]; }
#pragma unroll
                        for (int j = 0; j < 8; ++j) {
                            UG[(row0 + j) * 640 + 512 + p] = (bf16_t)(cvt_pk_bf16(hr, 0.f) & 0xffffu);
                            UG[(row0 + j) * 640 + 576 + p] = (bf16_t)(cvt_pk_bf16(hi_, 0.f) & 0xffffu);
                            const float nr = lr * hr - li * hi_ + er[j], ni = lr * hi_ + li * hr + ei[j];
                            hr = nr; hi_ = ni;
                        }
                    }
                }
            }
            PHASE_END;
            if (PHASE_ON) { PH_VARS
                pg8::SchedS4 S{(const char*)(ws + WS_UG), (const char*)(ws + WS_TG), G, bid};
                pg8::EpiSsmY E{(const bf16_t*)(ws + WS_UG), ap->in[19], (bf16_t*)(ws + WS_YG)};
                pg8::gemm_phase(lds, xl, 640, 640, 640, S, E);
            }
            PHASE_END;
            if (PHASE_ON) { PH_VARS
                pg8::SchedStd S; S.init(ws + WS_YG, 256 * 2048, ws + WS_WGLU, 256 * 2048, 128, 8, G, bid);
                pg8::EpiGlu E{XB, SSQ};
                pg8::gemm_phase(lds, xl, 1024, 1024, 1024, S, E);
            }
            PHASE_END;
        }
        if (PHASE_ON) { PH_VARS
            pg8::SchedXS2 S{(const char*)XB, (const char*)(ws + WS_GT + (size_t)layer * 32 * MiB), G, bid};
            pg8::EpiSoftmax E{(bf16_t*)(ws + WS_P), SSQ, layer == 0 ? 16 : 32, 0.0625f};
            pg8::gemm_phase(lds, xl, 1024, 1024, 1024, S, E);
        }
        if (PHASE_ON) { PH_VARS
            unsigned char* lb = ws + WS_LAYER + layer * LAYER_STRIDE;
            pg8::SchedVW S{(const char*)(lb + LO_WO), (const char*)(ws + WS_MEMVT + layer * MEMVT_STRIDE), G, bid};
            pg8::EpiStore E{(bf16_t*)(ws + WS_QX), 1024, nullptr, 0, 1.0f, 0};
            pg8::gemm_phase(lds, xl, 1024, 1024, 256, S, E);
        }
        PHASE_END;
        if (PHASE_ON) { PH_VARS
            pg8::SchedXOut S{(const char*)(ws + WS_P), (const char*)(ws + WS_QX), G, bid};
            pg8::EpiResid E{nullptr, XB, SSQ};
            pg8::gemm_phase(lds, xl, 1024, 1024, 1024, S, E);
        }
        PHASE_END;
        if (PHASE_ON) { PH_VARS
            unsigned char* lb = ws + WS_LAYER + layer * LAYER_STRIDE;
            pg8::SchedStd S; S.init(XB, 256 * 2048, lb + LO_WUP, 256 * 2048, 128, 22, G, bid);
            pg8::EpiUpConv E{(bf16_t*)(ws + WS_H), (bf16_t*)(ws + WS_HALO), SSQ, ap->in[25] + (size_t)layer * 3 * DFF2, ap->in[26] + (size_t)layer * DFF2};
            pg8::gemm_phase(lds, xl, 1024, 1024, 1024, S, E);
        }
        PHASE_END;
        if (PHASE_ON) { PH_VARS
            const bf16_t* HALO = (const bf16_t*)(ws + WS_HALO); bf16_t* H = (bf16_t*)(ws + WS_H);
            const float* cw = ap->in[25] + (size_t)layer * 3 * DFF2; const float* cb = ap->in[26] + (size_t)layer * DFF2;
            pg8::SchedStd S0; S0.init(ws + WS_H, 256u * DFF * 2, ws, 0u, 128, 4, G, bid);
            pg8::Unit uu;
            for (int ui = 0; S0.next(ui, uu); ++ui) {
                const int pm = uu.pm;
                if ((pm & 7) == 0) continue;
                for (int it = tid; it < 2 * 352; it += 512) {
                    const int chk = it % 352, rr = it / 352, c0 = chk * 8;
                    const bf16_t* cur = HALO + (size_t)(pm * 4 + rr) * DFF2;
                    const bf16_t* p1 = rr ? HALO + (size_t)(pm * 4) * DFF2 : HALO + (size_t)(pm * 4 - 1) * DFF2;
                    const bf16_t* p2 = rr ? HALO + (size_t)(pm * 4 - 1) * DFF2 : HALO + (size_t)(pm * 4 - 2) * DFF2;
                    float o[8];
                    const u32x4 av = *(const u32x4*)(cur + c0), ag = *(const u32x4*)(cur + DFF + c0);
                    const u32x4 a1 = *(const u32x4*)(p1 + c0), g1 = *(const u32x4*)(p1 + DFF + c0), a2 = *(const u32x4*)(p2 + c0), g2 = *(const u32x4*)(p2 + DFF + c0);
                    const float v0[8] = {bflo(av.x), bfhi(av.x), bflo(av.y), bfhi(av.y), bflo(av.z), bfhi(av.z), bflo(av.w), bfhi(av.w)};
                    const float g0[8] = {bflo(ag.x), bfhi(ag.x), bflo(ag.y), bfhi(ag.y), bflo(ag.z), bfhi(ag.z), bflo(ag.w), bfhi(ag.w)};
                    const float v1[8] = {bflo(a1.x), bfhi(a1.x), bflo(a1.y), bfhi(a1.y), bflo(a1.z), bfhi(a1.z), bflo(a1.w), bfhi(a1.w)};
                    const float gg1[8] = {bflo(g1.x), bfhi(g1.x), bflo(g1.y), bfhi(g1.y), bflo(g1.z), bfhi(g1.z), bflo(g1.w), bfhi(g1.w)};
                    const float v2[8] = {bflo(a2.x), bfhi(a2.x), bflo(a2.y), bfhi(a2.y), bflo(a2.z), bfhi(a2.z), bflo(a2.w), bfhi(a2.w)};
                    const float gg2[8] = {bflo(g2.x), bfhi(g2.x), bflo(g2.y), bfhi(g2.y), bflo(g2.z), bfhi(g2.z), bflo(g2.w), bfhi(g2.w)};
    #pragma unroll
                    for (int j = 0; j < 8; ++j) {
                        const int c = c0 + j;
                        const float cv = cb[c] + cw[c] * v2[j] + cw[DFF2 + c] * v1[j] + cw[2 * DFF2 + c] * v0[j];
                        const float cgt = cb[DFF + c] + cw[DFF + c] * gg2[j] + cw[DFF2 + DFF + c] * gg1[j] + cw[2 * DFF2 + DFF + c] * g0[j];
                        o[j] = cv * cgt * frcp(1.0f + fexp(-cgt));
                    }
                    u32x4 w; w.x = cvt_pk_bf16(o[0], o[1]); w.y = cvt_pk_bf16(o[2], o[3]); w.z = cvt_pk_bf16(o[4], o[5]); w.w = cvt_pk_bf16(o[6], o[7]);
                    *(u32x4*)(H + (size_t)(pm * 256 + rr) * DFF + c0) = w;
                }
            }
        }
        LOCAL_SEAM;
        if (PHASE_ON) { PH_VARS
            unsigned char* lb = ws + WS_LAYER + layer * LAYER_STRIDE;
            pg8::SchedStd S; S.init(ws + WS_H, 256u * DFF * 2, lb + LO_WDN, 256u * DFF * 2, 128, 4, G, bid);
            pg8::EpiResid E{nullptr, XB, SSQ};
            pg8::gemm_phase(lds, xl, DFF, DFF, DFF, S, E);
        }
        PHASE_END;
    }

    if (PHASE_ON) { PH_VARS
        for (int m4 = gw; m4 < MTOK / 4; m4 += NGW) {
            const f32x4* gr = (const f32x4*)ap->in[6] + lane;
            f32x4 v[4][4]; float sq[4];
#pragma unroll
            for (int r = 0; r < 4; ++r)
#pragma unroll
                for (int j = 0; j < 4; ++j) { const u32x2 o = *((const u32x2*)(XB + (size_t)(m4 * 4 + r) * DM) + lane + 64 * j); v[r][j] = (f32x4){bflo(o.x), bfhi(o.x), bflo(o.y), bfhi(o.y)}; }
#pragma unroll
            for (int r = 0; r < 4; ++r) { sq[r] = 0.f;
#pragma unroll
                for (int j = 0; j < 4; ++j) sq[r] += (v[r][j].x * v[r][j].x + v[r][j].y * v[r][j].y) + (v[r][j].z * v[r][j].z + v[r][j].w * v[r][j].w); }
#pragma unroll
            for (int r = 0; r < 4; ++r) sq[r] = 1.f / sqrtf(wave_sum(sq[r]) * (1.f / DM) + EPS);
#pragma unroll
            for (int j = 0; j < 4; ++j) { const f32x4 gg = gr[64 * j];
#pragma unroll
                for (int r = 0; r < 4; ++r) *((f32x4*)(X + (size_t)(m4 * 4 + r) * DM) + lane + 64 * j) = v[r][j] * sq[r] * gg; }
        }
    }
#undef PHASE_ON
#undef PHASE_END
}

constexpr int N_PHASES = 4 + 7 + 5 + 7 + 1;

extern "C" void kernel_launch(void* const* d_in, const int* in_sizes, int n_in, void* d_out, int out_size, void* d_ws, size_t ws_size, hipStream_t stream) {
    static int grid = 0;
    if (grid == 0) {
        if (n_in != 28 || in_sizes[0] != MTOK * DM || out_size != MTOK * DM || ws_size < WS_END) {
            fprintf(stderr, "kernel_launch: unexpected shapes (n_in %d, in0 %d, out %d, ws %zu); nothing launched\n", n_in, n_in > 0 ? in_sizes[0] : -1, out_size, ws_size); grid = -1; return; }
        int dev = 0, cus = 0, per_cu = 0;
        if (hipGetDevice(&dev) != hipSuccess || hipDeviceGetAttribute(&cus, hipDeviceAttributeMultiprocessorCount, dev) != hipSuccess) { grid = -1; return; }
        if (hipFuncSetAttribute((const void*)mega_fwd, hipFuncAttributeMaxDynamicSharedMemorySize, LDS_BYTES) != hipSuccess) { fprintf(stderr, "kernel_launch: hipFuncSetAttribute failed\n"); grid = -1; return; }
        if (hipOccupancyMaxActiveBlocksPerMultiprocessor(&per_cu, (const void*)mega_fwd, 512, LDS_BYTES) != hipSuccess || per_cu < 1) per_cu = 1;
        (void)hipGetLastError();
        grid = cus * per_cu;
    }
    if (grid < 0) return;
    Args a{};
    for (int i = 0; i < 28; ++i) a.in[i] = (const float*)d_in[i];
    a.out = (float*)d_out; a.ws = (unsigned char*)d_ws;
#if MK_MULTI_LAUNCH
    for (int p = 0; p < N_PHASES; ++p) {
        a.ph_lo = p; a.ph_hi = p + 1;
        hipLaunchKernelGGL(mega_fwd, dim3(grid), dim3(512), LDS_BYTES, stream, a);
    }
#else
    a.ph_lo = 0; a.ph_hi = N_PHASES;
    if (hipMemsetAsync(d_ws, 0, 16384, stream) != hipSuccess) { fprintf(stderr, "kernel_launch: memset of the barrier words failed\n"); return; }
    void* args[] = {&a};
    hipError_t e = hipLaunchCooperativeKernel((const void*)mega_fwd, dim3(grid), dim3(512), args, LDS_BYTES, stream);
    if (e != hipSuccess) fprintf(stderr, "cooperative launch failed: %s (grid %d)\n", hipGetErrorString(e), grid);
#endif
}
```

```cpp
#include <hip/hip_runtime.h>
#include <hip/hip_cooperative_groups.h>
#include <cstdio>
#include <cstdint>
namespace cg = cooperative_groups;

#ifndef MK_MULTI_LAUNCH
#define MK_MULTI_LAUNCH 0
#endif

#define LAS __attribute__((address_space(3)))
typedef unsigned short bf16_t;
typedef short bf16x8 __attribute__((ext_vector_type(8)));
typedef short s16x4 __attribute__((ext_vector_type(4)));
typedef float f32x4 __attribute__((ext_vector_type(4)));
typedef float f32x16 __attribute__((ext_vector_type(16)));
typedef unsigned u32x4 __attribute__((ext_vector_type(4)));
typedef unsigned u32x2 __attribute__((ext_vector_type(2)));

constexpr int MTOK = 32768, DM = 1024, SEQ = 2048, NBATCH = 16, DFF = 2816, DFF2 = 5632, MEMTOK = 4096;
constexpr int MHALF = 16384;
constexpr float EPS = 1e-6f;
constexpr float LOG2E = 1.4426950408889634f, LN2 = 0.6931471805599453f;

constexpr size_t MiB = 1u << 20;
constexpr size_t WS_SSQ = 1 * MiB;
constexpr size_t WS_WIN = 5 * MiB;
constexpr size_t WS_WOUT = 9 * MiB;
constexpr size_t WS_WSSM = 11 * MiB;
constexpr size_t WS_WGLU = 13 * MiB;
constexpr size_t WS_LAYER = 17 * MiB, LAYER_STRIDE = 25 * MiB;
constexpr size_t LO_WQ = 0, LO_WKV = 2 * MiB, LO_WO = 6 * MiB, LO_WUP = 8 * MiB, LO_WDN = 19 * MiB;
constexpr size_t WS_WEND = 67 * MiB;
constexpr size_t WS_TG = 83 * MiB;
constexpr size_t WS_MEMN = 123 * MiB;
constexpr size_t WS_MEMK = 131 * MiB;
constexpr size_t WS_MEMVT = 147 * MiB, MEMVT_STRIDE = 9 * MiB;
constexpr size_t WS_XB = 165 * MiB;
constexpr size_t WS_T = 229 * MiB;
constexpr size_t WS_QKU = WS_T, WS_VT = WS_T + 96 * MiB, WS_CAT = WS_T + 132 * MiB;
constexpr int VT_LD = MTOK + 128, MVT_LD = 4096 + 128;
constexpr size_t WS_QX = WS_T, WS_P = WS_T + 64 * MiB, WS_O = WS_T + 128 * MiB;
constexpr size_t WS_H = WS_T, WS_HALO = WS_T + 176 * MiB;
constexpr size_t WS_UG = WS_T, WS_HEND = WS_T + 80 * MiB, WS_YG = WS_T + 112 * MiB;
constexpr size_t WS_GT = 426 * MiB;
constexpr size_t WS_END = 512 * MiB;
static_assert(WS_H + (size_t)MTOK * DFF * 2 <= WS_HALO && WS_HALO + (size_t)128 * 4 * DFF2 * 2 <= WS_GT && WS_CAT + (size_t)MTOK * DM * 2 <= WS_GT && WS_GT + 64 * MiB <= WS_END, "ws map");

typedef float f32x2_t __attribute__((ext_vector_type(2))); typedef __bf16 bf16x2_t __attribute__((ext_vector_type(2)));
__device__ __forceinline__ unsigned cvt_pk_bf16(float lo, float hi) { f32x2_t v = {lo, hi}; bf16x2_t b = __builtin_convertvector(v, bf16x2_t); return __builtin_bit_cast(unsigned, b); }
__device__ __forceinline__ float bf2f(unsigned short b) { return __uint_as_float(((unsigned)b) << 16); }
__device__ __forceinline__ float bflo(unsigned w) { return __uint_as_float(w << 16); }
__device__ __forceinline__ float bfhi(unsigned w) { return __uint_as_float(w & 0xffff0000u); }
__device__ __forceinline__ float fexp2(float x) { return __builtin_amdgcn_exp2f(x); }
__device__ __forceinline__ float flog2(float x) { return __builtin_amdgcn_logf(x); }
__device__ __forceinline__ float fexp(float x) { return __builtin_amdgcn_exp2f(x * LOG2E); }
__device__ __forceinline__ float frcp(float x) { return __builtin_amdgcn_rcpf(x); }
template <int M> __device__ __forceinline__ float swz_xor(float v) { return __int_as_float(__builtin_amdgcn_ds_swizzle(__float_as_int(v), (M << 10) | 0x1f)); }
__device__ __forceinline__ float sum_x16(float v) { auto r = __builtin_amdgcn_permlane16_swap(__float_as_uint(v), __float_as_uint(v), false, false); return __uint_as_float(r[0]) + __uint_as_float(r[1]); }
__device__ __forceinline__ float sum_x32(float v) { auto r = __builtin_amdgcn_permlane32_swap(__float_as_uint(v), __float_as_uint(v), false, false); return __uint_as_float(r[0]) + __uint_as_float(r[1]); }
__device__ __forceinline__ float max_x16(float v) { auto r = __builtin_amdgcn_permlane16_swap(__float_as_uint(v), __float_as_uint(v), false, false); return fmaxf(__uint_as_float(r[0]), __uint_as_float(r[1])); }
__device__ __forceinline__ float max_x32(float v) { auto r = __builtin_amdgcn_permlane32_swap(__float_as_uint(v), __float_as_uint(v), false, false); return fmaxf(__uint_as_float(r[0]), __uint_as_float(r[1])); }
__device__ __forceinline__ float partner32(float v, int hi) { auto r = __builtin_amdgcn_permlane32_swap(__float_as_uint(v), __float_as_uint(v), false, false); return hi ? __uint_as_float(r[0]) : __uint_as_float(r[1]); }
__device__ __forceinline__ float wave_sum(float v) {
    v += swz_xor<1>(v); v += swz_xor<2>(v); v += swz_xor<4>(v); v += swz_xor<8>(v); v = sum_x16(v); v = sum_x32(v);
    return v;
}
#define LDS_WAIT() asm volatile("s_waitcnt lgkmcnt(0)" ::: "memory")

namespace pg8 {
constexpr int BM = 256, BK = 64, HALF = 128, HTB = HALF * BK * 2, STAGE_BYTES = 8 * HTB, NXCD = 8, WGM = 8;
__host__ __device__ __forceinline__ int lds_byte(int r, int c) { const int st = (r >> 4) * 2 + (c >> 5), rr = r & 15, cc = c & 31, ob = rr * 64 + cc * 2; return st * 1024 + (ob ^ (((ob >> 9) & 1) << 5)); }
__host__ __device__ __forceinline__ void stage_rc(int b, int& R, int& C) { const int st = b / 1024, sb = b % 1024, swz = sb ^ (((sb >> 9) & 1) << 5); R = (st >> 1) * 16 + swz / 64; C = (st & 1) * 32 + (swz % 64) / 2; }
__host__ __device__ __forceinline__ int perm32(int rho) { const int n = rho >> 4, i = rho & 15; return 8 * (i >> 2) + 4 * n + (i & 3); }

struct Unit { int pm, pn; const char* a; const char* b; };

struct SchedStd {
    const char* A; const char* B; unsigned sA, sB; int nM, nN, G, c;
    __device__ __forceinline__ void init(const void* A_, unsigned sA_, const void* B_, unsigned sB_, int nM_, int nN_, int G_, int c_) { A = (const char*)A_; B = (const char*)B_; sA = sA_; sB = sB_; nM = nM_; nN = nN_; G = G_; c = c_; }
    __device__ __forceinline__ bool next(int i, Unit& u) const {
        const int nwg = nM * nN; const long L = (long)i * G + c; if (L >= nwg) return false;
        int wgid = (int)L; { const int q = nwg / NXCD, r = nwg % NXCD, xcd = wgid % NXCD, off = wgid / NXCD; wgid = (xcd < r ? xcd * (q + 1) : r * (q + 1) + (xcd - r) * q) + off; }
        const int nig = WGM * nN, gid = wgid / nig, fm = gid * WGM, gsz = (nM - fm) < WGM ? (nM - fm) : WGM;
        u.pm = fm + ((wgid % nig) % gsz); u.pn = (wgid % nig) / gsz;
        u.a = A + (size_t)u.pm * sA; u.b = B + (size_t)u.pn * sB; return true;
    }
};
struct SchedXS {
    const char* A; const char* B; int G, c;
    __device__ __forceinline__ bool next(int i, Unit& u) const {
        const long L = (long)i * G + c; if (L >= 512) return false;
        u.pm = (int)(L >> 2); u.pn = (int)(L & 3);
        u.a = A + (size_t)u.pm * 256 * 2048 + u.pn * 512; u.b = B + (size_t)(u.pm >> 3) * 256 * 2048 + u.pn * 512; return true;
    }
};
struct SchedXQ {
    const char* A; const char* B; int G, c;
    __device__ __forceinline__ bool next(int i, Unit& u) const {
        const long L = (long)i * G + c; if (L >= 512) return false;
        u.pm = (int)(L >> 2); u.pn = (int)(L & 3);
        u.a = A + (size_t)u.pm * 256 * 2048; u.b = B + (size_t)u.pn * 256 * 2048; return true;
    }
};
struct SchedG {
    const char* MK; const char* WQ; int G, c;
    __device__ __forceinline__ bool next(int i, Unit& u) const {
        const long L = (long)i * G + c; if (L >= 512) return false;
        const int l = (int)(L >> 8), r = (int)(L & 255), b = r >> 4, h = (r >> 2) & 3, pn = r & 3;
        u.pm = l * 64 + b * 4 + h; u.pn = pn;
        u.a = MK + (size_t)l * 8 * 1048576 + (size_t)b * 256 * 2048 + h * 512; u.b = WQ + (size_t)l * LAYER_STRIDE + (size_t)pn * 256 * 2048 + h * 512; return true;
    }
};
struct SchedXS2 {
    const char* A; const char* B; int G, c;
    __device__ __forceinline__ bool next(int i, Unit& u) const {
        const long L = (long)i * G + c; if (L >= 512) return false;
        u.pm = (int)(L >> 2); u.pn = (int)(L & 3);
        u.a = A + (size_t)u.pm * 256 * 2048; u.b = B + (size_t)((u.pm >> 3) * 4 + u.pn) * 256 * 2048; return true;
    }
};
struct SchedVW {
    const char* WO; const char* MV; int G, c;
    __device__ __forceinline__ bool next(int i, Unit& u) const {
        const long L = (long)i * G + c; if (L >= 256) return false;
        const int b = (int)(L >> 4), pq = (int)(L >> 2) & 3, h = (int)L & 3;
        u.pm = b * 4 + pq; u.pn = h;
        u.a = WO + (size_t)pq * 256 * 2048 + h * 512; u.b = MV + (size_t)b * 256 * 2048 + h * 512; return true;
    }
};
struct SchedXOut {
    const char* A; const char* B; int G, c;
    __device__ __forceinline__ bool next(int i, Unit& u) const {
        const long L = (long)i * G + c; if (L >= 512) return false;
        u.pm = (int)(L >> 2); u.pn = (int)(L & 3);
        u.a = A + (size_t)u.pm * 256 * 2048; u.b = B + ((size_t)(u.pm >> 3) * 1024 + (size_t)u.pn * 256) * 2048; return true;
    }
};
struct SchedXO {
    const char* A; const char* B; int G, c;
    __device__ __forceinline__ bool next(int i, Unit& u) const {
        const long L = (long)i * G + c; if (L >= 512) return false;
        u.pm = (int)(L >> 2); u.pn = (int)(L & 3);
        u.a = A + (size_t)u.pm * 256 * 2048 + u.pn * 512; u.b = B + (size_t)u.pn * 256 * (MVT_LD * 2) + (size_t)(u.pm >> 3) * 512; return true;
    }
};
struct SchedS2 {
    const char* A; const char* B; int G, c;
    __device__ __forceinline__ bool next(int i, Unit& u) const {
        const long L = (long)i * G + c; if (L >= 256) return false;
        u.pm = (int)L; u.pn = 0;
        u.a = A + (size_t)L * 256 * 1280; u.b = B + (size_t)(L >> 2) * 256 * 1024; return true;
    }
};
struct SchedS4 {
    const char* A; const char* B; int G, c;
    __device__ __forceinline__ bool next(int i, Unit& u) const {
        const long L = (long)i * G + c; if (L >= 512) return false;
        u.pm = (int)(L >> 1); u.pn = (int)(L & 1);
        u.a = A + (size_t)u.pm * 256 * 1280; u.b = B + ((size_t)(L >> 3) * 512 + (size_t)u.pn * 256) * 1280; return true;
    }
};

typedef f32x4 Acc[2][2][4][2];

__device__ __forceinline__ float row_rstd(const float* ssq_row, int nslots) {
    float s = 0.f;
    const f32x4* p = (const f32x4*)ssq_row;
    for (int i = 0; i < nslots / 4; ++i) { const f32x4 v = p[i]; s += (v[0] + v[1]) + (v[2] + v[3]); }
    return 1.0f / sqrtf(s * (1.0f / DM) + EPS);
}

struct EpiStore {
    static constexpr bool PERM = true;
    bf16_t* O; int ldc; const float* ssq; int nslots; float cs; int mode;
    __device__ __forceinline__ void operator()(Acc& acc, const Unit& u, int wr, int wc, int fr, int fq, LAS unsigned char*) const {
        const int row0 = u.pm * BM + wr * 64 + fr, col0 = u.pn * BM + wc * 32 + 8 * fq;
#pragma unroll
        for (int ai = 0; ai < 2; ++ai)
#pragma unroll
            for (int m = 0; m < 4; ++m) {
                const int row = row0 + ai * HALF + m * 16;
                float sc = cs;
                if (ssq) sc *= row_rstd(ssq + (size_t)row * 32, nslots);
#pragma unroll
                for (int bj = 0; bj < 2; ++bj) {
                    const int col = col0 + bj * HALF;
                    const f32x4 v0 = acc[ai][bj][m][0] * sc, v1 = acc[ai][bj][m][1] * sc;
                    u32x4 w; w.x = cvt_pk_bf16(v0[0], v0[1]); w.y = cvt_pk_bf16(v0[2], v0[3]); w.z = cvt_pk_bf16(v1[0], v1[1]); w.w = cvt_pk_bf16(v1[2], v1[3]);
                    bf16_t* p = (mode == 0) ? O + (size_t)row * ldc + col
                                            : O + ((size_t)(col >> 4) * 1024 + (row >> 5)) * 640 + (row & 31) * 16 + (col & 15);
                    *(u32x4*)p = w;
                }
            }
    }
};

struct EpiResid {
    static constexpr bool PERM = true;
    const float* xf; bf16_t* xb; float* ssq;
    __device__ __forceinline__ void operator()(Acc& acc, const Unit& u, int wr, int wc, int fr, int fq, LAS unsigned char*) const {
        const int row0 = u.pm * BM + wr * 64 + fr, col0 = u.pn * BM + wc * 32 + 8 * fq;
#pragma unroll
        for (int ai = 0; ai < 2; ++ai)
#pragma unroll
            for (int m = 0; m < 4; ++m) {
                const int row = row0 + ai * HALF + m * 16; float q = 0.f;
#pragma unroll
                for (int bj = 0; bj < 2; ++bj) {
                    const int col = col0 + bj * HALF; const size_t off = (size_t)row * DM + col;
                    f32x4 v0, v1;
                    if (xf) { v0 = *(const f32x4*)(xf + off); v1 = *(const f32x4*)(xf + off + 4); }
                    else { const u32x4 o = *(const u32x4*)(xb + off); v0 = (f32x4){bflo(o.x), bfhi(o.x), bflo(o.y), bfhi(o.y)}; v1 = (f32x4){bflo(o.z), bfhi(o.z), bflo(o.w), bfhi(o.w)}; }
                    v0 += acc[ai][bj][m][0]; v1 += acc[ai][bj][m][1];
                    q += ((v0[0] * v0[0] + v0[1] * v0[1]) + (v0[2] * v0[2] + v0[3] * v0[3])) + ((v1[0] * v1[0] + v1[1] * v1[1]) + (v1[2] * v1[2] + v1[3] * v1[3]));
                    u32x4 w; w.x = cvt_pk_bf16(v0[0], v0[1]); w.y = cvt_pk_bf16(v0[2], v0[3]); w.z = cvt_pk_bf16(v1[0], v1[1]); w.w = cvt_pk_bf16(v1[2], v1[3]);
                    *(u32x4*)(xb + off) = w;
                }
                q = sum_x16(q); q = sum_x32(q);
                if (fq == 0) ssq[(size_t)row * 32 + u.pn * 4 + wc] = q;
            }
    }
};

struct EpiGlu {
    static constexpr bool PERM = true;
    bf16_t* xb; float* ssq;
    __device__ __forceinline__ void operator()(Acc& acc, const Unit& u, int wr, int wc, int fr, int fq, LAS unsigned char*) const {
        const int row0 = u.pm * BM + wr * 64 + fr, col0 = u.pn * HALF + wc * 32 + 8 * fq;
#pragma unroll
        for (int ai = 0; ai < 2; ++ai)
#pragma unroll
            for (int m = 0; m < 4; ++m) {
                const int row = row0 + ai * HALF + m * 16; const size_t off = (size_t)row * DM + col0;
                const u32x4 o = *(const u32x4*)(xb + off);
                float v[8] = {bflo(o.x), bfhi(o.x), bflo(o.y), bfhi(o.y), bflo(o.z), bfhi(o.z), bflo(o.w), bfhi(o.w)};
                float q = 0.f;
#pragma unroll
                for (int n = 0; n < 2; ++n) {
                    const f32x4 val = acc[ai][0][m][n], gt = acc[ai][1][m][n];
#pragma unroll
                    for (int j = 0; j < 4; ++j) { v[4 * n + j] += val[j] * frcp(1.0f + fexp(-gt[j])); q += v[4 * n + j] * v[4 * n + j]; }
                }
                u32x4 w; w.x = cvt_pk_bf16(v[0], v[1]); w.y = cvt_pk_bf16(v[2], v[3]); w.z = cvt_pk_bf16(v[4], v[5]); w.w = cvt_pk_bf16(v[6], v[7]);
                *(u32x4*)(xb + off) = w;
                q = sum_x16(q); q = sum_x32(q);
                if (fq == 0) ssq[(size_t)row * 32 + u.pn * 4 + wc] = q;
            }
    }
};

struct EpiSoftmax {
    static constexpr bool PERM = true;
    bf16_t* O; const float* ssq; int nslots; float cs;
    __device__ __forceinline__ void operator()(Acc& acc, const Unit& u, int wr, int wc, int fr, int fq, LAS unsigned char* xl) const {
        LAS float* tmax = (LAS float*)xl; LAS float* tsum = tmax + 1024;
#pragma unroll
        for (int ai = 0; ai < 2; ++ai)
#pragma unroll
            for (int m = 0; m < 4; ++m) {
                const float sc = cs * row_rstd(ssq + (size_t)(u.pm * BM + ai * HALF + wr * 64 + m * 16 + fr) * 32, nslots);
#pragma unroll
                for (int bj = 0; bj < 2; ++bj)
#pragma unroll
                    for (int n = 0; n < 2; ++n) acc[ai][bj][m][n] *= sc;
                float mx = -3.0e38f;
#pragma unroll
                for (int bj = 0; bj < 2; ++bj)
#pragma unroll
                    for (int n = 0; n < 2; ++n) { const f32x4 x = acc[ai][bj][m][n]; mx = fmaxf(mx, fmaxf(fmaxf(x[0], x[1]), fmaxf(x[2], x[3]))); }
                mx = max_x16(mx); mx = max_x32(mx);
                if (fq == 0) tmax[(ai * HALF + wr * 64 + m * 16 + fr) * 4 + wc] = mx;
            }
        LDS_WAIT(); __builtin_amdgcn_s_barrier(); asm volatile("" ::: "memory");
#pragma unroll
        for (int ai = 0; ai < 2; ++ai)
#pragma unroll
            for (int m = 0; m < 4; ++m) {
                const int r = ai * HALF + wr * 64 + m * 16 + fr;
                const f32x4 t = *(const LAS f32x4*)(tmax + r * 4);
                const float gm = fmaxf(fmaxf(t[0], t[1]), fmaxf(t[2], t[3])) * LOG2E; float s = 0.f;
#pragma unroll
                for (int bj = 0; bj < 2; ++bj)
#pragma unroll
                    for (int n = 0; n < 2; ++n) {
                        f32x4 x = acc[ai][bj][m][n];
#pragma unroll
                        for (int j = 0; j < 4; ++j) { x[j] = fexp2(x[j] * LOG2E - gm); s += x[j]; }
                        acc[ai][bj][m][n] = x;
                    }
                s = sum_x16(s); s = sum_x32(s);
                if (fq == 0) tsum[r * 4 + wc] = s;
            }
        LDS_WAIT(); __builtin_amdgcn_s_barrier(); asm volatile("" ::: "memory");
        const int row0 = u.pm * BM + wr * 64 + fr, col0 = u.pn * BM + wc * 32 + 8 * fq;
#pragma unroll
        for (int ai = 0; ai < 2; ++ai)
#pragma unroll
            for (int m = 0; m < 4; ++m) {
                const int r = ai * HALF + wr * 64 + m * 16 + fr;
                const f32x4 t = *(const LAS f32x4*)(tsum + r * 4);
                const float inv = 1.0f / ((t[0] + t[1]) + (t[2] + t[3]));
#pragma unroll
                for (int bj = 0; bj < 2; ++bj) {
                    const f32x4 v0 = acc[ai][bj][m][0] * inv, v1 = acc[ai][bj][m][1] * inv;
                    u32x4 w; w.x = cvt_pk_bf16(v0[0], v0[1]); w.y = cvt_pk_bf16(v0[2], v0[3]); w.z = cvt_pk_bf16(v1[0], v1[1]); w.w = cvt_pk_bf16(v1[2], v1[3]);
                    *(u32x4*)(O + (size_t)(row0 + ai * HALF + m * 16) * DM + col0 + bj * HALF) = w;
                }
            }
    }
};


__device__ __forceinline__ float dpp_ror1(float x) { return __int_as_float(__builtin_amdgcn_update_dpp(0, __float_as_int(x), 0x121, 0xf, 0xf, false)); }
__device__ __forceinline__ float dpp_ror2(float x) { return __int_as_float(__builtin_amdgcn_update_dpp(0, __float_as_int(x), 0x122, 0xf, 0xf, false)); }
__device__ __forceinline__ float dpp_ror1u(float x) { return __int_as_float(__builtin_amdgcn_mov_dpp(__float_as_int(x), 0x121, 0xf, 0xf, false)); }
__device__ __forceinline__ float dpp_ror2u(float x) { return __int_as_float(__builtin_amdgcn_mov_dpp(__float_as_int(x), 0x122, 0xf, 0xf, false)); }
__device__ __forceinline__ float dpp_shr1_old(float old, float x) { return __int_as_float(__builtin_amdgcn_update_dpp(__float_as_int(old), __float_as_int(x), 0x111, 0xf, 0xf, false)); }
__device__ __forceinline__ float dpp_shr2_old(float old, float x) { return __int_as_float(__builtin_amdgcn_update_dpp(__float_as_int(old), __float_as_int(x), 0x112, 0xf, 0xf, false)); }
struct EpiUpConv {
    static constexpr bool PERM = true;
    bf16_t* H; bf16_t* HALO; const float* ssq; const float* cw; const float* cb;
    __device__ __forceinline__ void operator()(Acc& acc, const Unit& u, int wr, int wc, int fr, int fq, LAS unsigned char* xl) const {
        LAS float* B = (LAS float*)xl;
        LAS float* Wl = B + 2048;
        LAS float* R = Wl + 1024;
        const int wid = wr * 4 + wc, lane = fq * 16 + fr, tid = wid * 64 + lane;
        const int row0 = u.pm * BM + wr * 64 + fr, colb = wc * 32 + 8 * fq, ch0 = u.pn * HALF + colb;
        {
#pragma unroll
            for (int i = 0; i < 2; ++i) { const int idx = tid + i * 512, t = idx >> 8, bj = (idx >> 7) & 1, chl = idx & 127;
                Wl[idx] = (t < 3) ? cw[t * DFF2 + bj * DFF + u.pn * HALF + chl] : cb[bj * DFF + u.pn * HALF + chl]; }
            if (lane < 32) R[wid * 32 + lane] = row_rstd(ssq + (size_t)(u.pm * BM + wid * 32 + lane) * 32, 16);
        }
        LDS_WAIT(); __builtin_amdgcn_s_barrier(); asm volatile("" ::: "memory");
#pragma unroll
        for (int ai = 0; ai < 2; ++ai)
#pragma unroll
            for (int m = 0; m < 4; ++m) {
                const float sc = R[ai * HALF + wr * 64 + m * 16 + fr];
#pragma unroll
                for (int bj = 0; bj < 2; ++bj)
#pragma unroll
                    for (int n = 0; n < 2; ++n) acc[ai][bj][m][n] *= sc;
            }
        if (fr >= 14) {
#pragma unroll
            for (int ai = 0; ai < 2; ++ai)
#pragma unroll
                for (int bj = 0; bj < 2; ++bj)
#pragma unroll
                    for (int n = 0; n < 2; ++n) *(LAS f32x4*)(B + ((ai * 2 + wr) * 2 + (fr - 14)) * 256 + bj * HALF + colb + 4 * n) = acc[ai][bj][3][n];
        }
        if (wr == 0 && fr < 2) {
#pragma unroll
            for (int bj = 0; bj < 2; ++bj) { const f32x4 v0 = acc[0][bj][0][0], v1 = acc[0][bj][0][1];
                u32x4 w; w.x = cvt_pk_bf16(v0[0], v0[1]); w.y = cvt_pk_bf16(v0[2], v0[3]); w.z = cvt_pk_bf16(v1[0], v1[1]); w.w = cvt_pk_bf16(v1[2], v1[3]);
                *(u32x4*)(HALO + (size_t)(u.pm * 4 + fr) * DFF2 + bj * DFF + ch0) = w; }
        }
        if (wr == 1 && fr >= 14) {
#pragma unroll
            for (int bj = 0; bj < 2; ++bj) { const f32x4 v0 = acc[1][bj][3][0], v1 = acc[1][bj][3][1];
                u32x4 w; w.x = cvt_pk_bf16(v0[0], v0[1]); w.y = cvt_pk_bf16(v0[2], v0[3]); w.z = cvt_pk_bf16(v1[0], v1[1]); w.w = cvt_pk_bf16(v1[2], v1[3]);
                *(u32x4*)(HALO + (size_t)(u.pm * 4 + 2 + (fr - 14)) * DFF2 + bj * DFF + ch0) = w; }
        }
        LDS_WAIT(); __builtin_amdgcn_s_barrier(); asm volatile("" ::: "memory");
#pragma unroll
        for (int ai = 0; ai < 2; ++ai) {
            const bool has = (wr == 1) || (ai == 1);
            const int sb = (wr == 1) ? (ai * 2) : 1;
#pragma unroll
            for (int n = 0; n < 2; ++n) {
                asm volatile("" ::: "memory");
                const int cl = colb + 4 * n;
                float hv[4][4];
                const f32x4 wv0 = *(const LAS f32x4*)(Wl + 0 * 128 + cl), wg0 = *(const LAS f32x4*)(Wl + 1 * 128 + cl);
                const f32x4 wv1 = *(const LAS f32x4*)(Wl + 2 * 128 + cl), wg1 = *(const LAS f32x4*)(Wl + 3 * 128 + cl);
                const f32x4 wv2 = *(const LAS f32x4*)(Wl + 4 * 128 + cl), wg2 = *(const LAS f32x4*)(Wl + 5 * 128 + cl);
                const f32x4 bvv = *(const LAS f32x4*)(Wl + 6 * 128 + cl), bgv = *(const LAS f32x4*)(Wl + 7 * 128 + cl);
                f32x4 b1v = (f32x4){0.f, 0.f, 0.f, 0.f}, b2v = b1v, b1g = b1v, b2g = b1v;
                if (has) {
                    b1v = *(const LAS f32x4*)(B + (sb * 2 + 1) * 256 + cl); b2v = *(const LAS f32x4*)(B + (sb * 2 + (fr & 1)) * 256 + cl);
                    b1g = *(const LAS f32x4*)(B + (sb * 2 + 1) * 256 + HALF + cl); b2g = *(const LAS f32x4*)(B + (sb * 2 + (fr & 1)) * 256 + HALF + cl);
                }
#pragma unroll
                for (int j = 0; j < 4; ++j) {
                    float r1p = b1v[j], r2p = b2v[j], q1p = b1g[j], q2p = b2g[j];
#pragma unroll
                    for (int m = 0; m < 4; ++m) {
                        const float xv = acc[ai][0][m][n][j], xg = acc[ai][1][m][n][j];
                        const float pv1 = dpp_shr1_old(r1p, xv), pv2 = dpp_shr2_old(r2p, xv), pg1 = dpp_shr1_old(q1p, xg), pg2 = dpp_shr2_old(q2p, xg);
                        const float cv = bvv[j] + wv0[j] * pv2 + wv1[j] * pv1 + wv2[j] * xv;
                        const float cg = bgv[j] + wg0[j] * pg2 + wg1[j] * pg1 + wg2[j] * xg;
                        hv[m][j] = cv * cg * frcp(1.0f + fexp(-cg));
                        if (m < 3) { r1p = dpp_ror1u(xv); r2p = dpp_ror2u(xv); q1p = dpp_ror1u(xg); q2p = dpp_ror2u(xg); }
                    }
                    __builtin_amdgcn_sched_barrier(0);
                }
#pragma unroll
                for (int m = 0; m < 4; ++m) {
                    u32x2 w; w.x = cvt_pk_bf16(hv[m][0], hv[m][1]); w.y = cvt_pk_bf16(hv[m][2], hv[m][3]);
                    *(u32x2*)(H + (size_t)(row0 + ai * HALF + m * 16) * DFF + ch0 + 4 * n) = w;
                }
            }
        }
    }
};

struct EpiHend {
    static constexpr bool PERM = false;
    float* Hout;
    __device__ __forceinline__ void operator()(Acc& acc, const Unit& u, int wr, int wc, int fr, int fq, LAS unsigned char*) const {
        const int row0 = u.pm * BM + wr * 64 + fr, col0 = wc * 32 + 4 * fq;
#pragma unroll
        for (int ai = 0; ai < 2; ++ai)
#pragma unroll
            for (int m = 0; m < 4; ++m)
#pragma unroll
                for (int n = 0; n < 2; ++n)
                    *(f32x4*)(Hout + (size_t)(row0 + ai * HALF + m * 16) * 128 + col0 + n * 16) = acc[ai][0][m][n];
    }
};

struct EpiSsmY {
    static constexpr bool PERM = true;
    const bf16_t* Ug; const float* Dskip; bf16_t* Yg;
    __device__ __forceinline__ void operator()(Acc& acc, const Unit& u, int wr, int wc, int fr, int fq, LAS unsigned char*) const {
        const int g = u.pm >> 2;
        const int rg0 = (u.pm & 3) * BM + wr * 64 + fr, col0 = u.pn * BM + wc * 32 + 8 * fq;
        const int co = col0 & 15;
        const f32x4 d0 = *(const f32x4*)(Dskip + g * 16 + co), d1 = *(const f32x4*)(Dskip + g * 16 + co + 4);
#pragma unroll
        for (int ai = 0; ai < 2; ++ai)
#pragma unroll
            for (int m = 0; m < 4; ++m) {
                const int rg = rg0 + ai * HALF + m * 16;
#pragma unroll
                for (int bj = 0; bj < 2; ++bj) {
                    const int col = col0 + bj * HALF;
                    const u32x4 uu = *(const u32x4*)(Ug + ((size_t)g * 1024 + rg) * 640 + col);
                    float y[8];
                    y[0] = acc[ai][bj][m][0][0] + d0[0] * bflo(uu.x); y[1] = acc[ai][bj][m][0][1] + d0[1] * bfhi(uu.x);
                    y[2] = acc[ai][bj][m][0][2] + d0[2] * bflo(uu.y); y[3] = acc[ai][bj][m][0][3] + d0[3] * bfhi(uu.y);
                    y[4] = acc[ai][bj][m][1][0] + d1[0] * bflo(uu.z); y[5] = acc[ai][bj][m][1][1] + d1[1] * bfhi(uu.z);
                    y[6] = acc[ai][bj][m][1][2] + d1[2] * bflo(uu.w); y[7] = acc[ai][bj][m][1][3] + d1[3] * bfhi(uu.w);
#pragma unroll
                    for (int j = 0; j < 8; ++j) { const float x = y[j]; const float k2 = 1.5957691216f * (x + 0.044715f * x * x * x); y[j] = x * frcp(1.0f + fexp(-k2)); }
                    u32x4 w; w.x = cvt_pk_bf16(y[0], y[1]); w.y = cvt_pk_bf16(y[2], y[3]); w.z = cvt_pk_bf16(y[4], y[5]); w.w = cvt_pk_bf16(y[6], y[7]);
                    const size_t tok = (size_t)rg * 32 + (col >> 4);
                    *(u32x4*)(Yg + tok * DM + g * 16 + co) = w;
                }
            }
    }
};

template <class Epi, class Sched>
__device__ __forceinline__ void gemm_phase(LAS unsigned char* lds, LAS unsigned char* xl, const int lda, const int ldb, const int K, const Sched& S, const Epi& E) {
    int tid_ = threadIdx.x; asm volatile("" : "+v"(tid_));
    const int tid = tid_, wid = __builtin_amdgcn_readfirstlane(tid >> 6), lane = tid & 63, wr = wid >> 2, wc = wid & 3, fr = lane & 15, fq = lane >> 4;
    const int nt = K / BK;
    unsigned voffA, voffB;
    { int R, C; stage_rc(tid * 16, R, C); const int Rb = Epi::PERM ? ((R & ~31) + perm32(R & 31)) : R;
      voffA = (unsigned)(R * lda + C) * 2u; voffB = (unsigned)(Rb * ldb + C) * 2u; }
    const size_t qstepA = (size_t)64 * lda * 2, qstepB = (size_t)64 * ldb * 2;
    const size_t kstep = (size_t)(BK * 2);
    const size_t hstepA = (size_t)HALF * lda * 2, hstepB = (size_t)HALF * ldb * 2;
    const unsigned ldsw = (unsigned)wid * 1024u;
    const int aoff = lds_byte(wr * 64 + fr, fq * 8), boff = lds_byte(wc * 32 + fr, fq * 8);
#define PG8_SA(b, h) (((b) * 2 + (h)) * HTB)
#define PG8_SB(b, h) ((4 + (b) * 2 + (h)) * HTB)
#define PG8_STAGE(bufoff, gbase, voff) do { _Pragma("unroll") for (int _i = 0; _i < 2; ++_i) \
        { const char* _gb = (const char*)(gbase) + (size_t)_i * q##voff; asm volatile("" : "+s"(_gb)); \
          __builtin_amdgcn_global_load_lds((const unsigned*)(_gb + (voff)), (LAS unsigned*)(lds + (bufoff) + ldsw + _i * 8192), 16, 0, 0); } } while (0)
#define qvoffA qstepA
#define qvoffB qstepB
#define PG8_LDA(dst, b, h) do { _Pragma("unroll") for (int m = 0; m < 4; ++m) _Pragma("unroll") for (int k = 0; k < 2; ++k) dst[m][k] = *(const LAS bf16x8*)(lds + PG8_SA(b, h) + aoff + m * 2048 + k * 1024); } while (0)
#define PG8_LDB(dst, b, h) do { _Pragma("unroll") for (int n = 0; n < 2; ++n) _Pragma("unroll") for (int k = 0; k < 2; ++k) dst[n][k] = *(const LAS bf16x8*)(lds + PG8_SB(b, h) + boff + n * 2048 + k * 1024); } while (0)
#define PG8_MMA(ai, bj, At, Bt) do { __builtin_amdgcn_s_setprio(1); _Pragma("unroll") for (int m = 0; m < 4; ++m) _Pragma("unroll") for (int n = 0; n < 2; ++n) _Pragma("unroll") for (int k = 0; k < 2; ++k) \
        acc[ai][bj][m][n] = __builtin_amdgcn_mfma_f32_16x16x32_bf16(Bt[n][k], At[m][k], acc[ai][bj][m][n], 0, 0, 0); __builtin_amdgcn_s_setprio(0); } while (0)
#define PG8_WAIT_V(n) asm volatile("s_waitcnt vmcnt(" #n ")" ::: "memory")
#define PG8_WAIT_L(n) asm volatile("s_waitcnt lgkmcnt(" #n ")" ::: "memory")
#define PG8_BAR __builtin_amdgcn_s_barrier()
#define PG8_SCHED __builtin_amdgcn_sched_barrier(0)
    Unit cur, nxt; int ui = 0;
    if (!S.next(0, cur)) return;
    Acc acc;
#pragma unroll
    for (int a = 0; a < 2; ++a)
#pragma unroll
        for (int b = 0; b < 2; ++b)
#pragma unroll
            for (int m = 0; m < 4; ++m)
#pragma unroll
                for (int n = 0; n < 2; ++n) acc[a][b][m][n] = (f32x4){0.f, 0.f, 0.f, 0.f};
    bf16x8 At[4][2], B0[2][2], B1[2][2];
    const char* cA = cur.a; const char* cB = cur.b;
    PG8_STAGE(PG8_SB(0, 0), cB, voffB); PG8_STAGE(PG8_SB(0, 1), cB + hstepB, voffB); PG8_STAGE(PG8_SA(0, 0), cA, voffA); PG8_STAGE(PG8_SA(0, 1), cA + hstepA, voffA);
    if (wr == 1) PG8_BAR;
    PG8_WAIT_V(2); PG8_BAR;
    PG8_STAGE(PG8_SB(1, 0), cB + kstep, voffB); PG8_STAGE(PG8_SA(1, 0), cA + kstep, voffA); PG8_STAGE(PG8_SB(1, 1), cB + hstepB + kstep, voffB);
    PG8_WAIT_V(6); PG8_BAR;
    for (;;) {
        const bool has_next = S.next(ui + 1, nxt);
        const char* nA = has_next ? nxt.a : cA; const char* nB = has_next ? nxt.b : cB;
        for (int t = 0; t < nt; t += 2) {
            const bool last = (t == nt - 2);
            const char* a1 = cA + (size_t)(t + 1) * kstep;
            const char* a2 = last ? nA : cA + (size_t)(t + 2) * kstep; const char* b2 = last ? nB : cB + (size_t)(t + 2) * kstep;
            const char* a3 = a2 + kstep; const char* b3 = b2 + kstep;
            PG8_LDB(B0, 0, 0); PG8_LDB(B1, 0, 1); PG8_SCHED; PG8_LDA(At, 0, 0); PG8_STAGE(PG8_SA(1, 1), a1 + hstepA, voffA);
            PG8_WAIT_V(8); PG8_WAIT_L(0); PG8_BAR; PG8_MMA(0, 0, At, B0); PG8_MMA(0, 1, At, B1); PG8_BAR; PG8_SCHED;
            PG8_LDA(At, 0, 1); PG8_STAGE(PG8_SB(0, 0), b2, voffB); PG8_STAGE(PG8_SB(0, 1), b2 + hstepB, voffB); PG8_STAGE(PG8_SA(0, 0), a2, voffA);
            PG8_WAIT_V(8); PG8_WAIT_L(0); PG8_BAR; PG8_MMA(1, 0, At, B0); PG8_MMA(1, 1, At, B1); PG8_BAR; PG8_SCHED;
            PG8_LDB(B0, 1, 0); PG8_LDB(B1, 1, 1); PG8_SCHED; PG8_LDA(At, 1, 0); PG8_STAGE(PG8_SA(0, 1), a2 + hstepA, voffA);
            PG8_WAIT_V(8); PG8_WAIT_L(0); PG8_BAR; PG8_MMA(0, 0, At, B0); PG8_MMA(0, 1, At, B1); PG8_BAR; PG8_SCHED;
            PG8_LDA(At, 1, 1); PG8_STAGE(PG8_SB(1, 0), b3, voffB); PG8_STAGE(PG8_SB(1, 1), b3 + hstepB, voffB); PG8_STAGE(PG8_SA(1, 0), a3, voffA);
            PG8_WAIT_V(8); PG8_WAIT_L(0); PG8_BAR; PG8_MMA(1, 0, At, B0); PG8_MMA(1, 1, At, B1); PG8_BAR; PG8_SCHED;
        }
        if (wr == 0) PG8_BAR;
        __builtin_amdgcn_sched_barrier(0); asm volatile("s_nop 15\n\ts_nop 15\n\ts_nop 15" ::: "memory"); __builtin_amdgcn_sched_barrier(0);
        { int t2 = threadIdx.x; asm volatile("" : "+v"(t2)); E(acc, cur, wr, wc, t2 & 15, (t2 >> 4) & 3, xl); }
        if (!has_next) break;
#pragma unroll
        for (int a = 0; a < 2; ++a)
#pragma unroll
            for (int b = 0; b < 2; ++b)
#pragma unroll
                for (int m = 0; m < 4; ++m)
#pragma unroll
                    for (int n = 0; n < 2; ++n) acc[a][b][m][n] = (f32x4){0.f, 0.f, 0.f, 0.f};
        cur = nxt; cA = nA; cB = nB; ++ui;
        if (wr == 1) PG8_BAR;
    }
    PG8_WAIT_V(0);
    PG8_BAR;
#undef PG8_SA
#undef PG8_SB
#undef PG8_STAGE
#undef qvoffA
#undef qvoffB
#undef PG8_LDA
#undef PG8_LDB
#undef PG8_MMA
#undef PG8_WAIT_V
#undef PG8_WAIT_L
#undef PG8_BAR
#undef PG8_SCHED
}
}

constexpr int RING_BYTES = 131072, XL_OFF = RING_BYTES, XBST_OFF = XL_OFF + 14336, LDS_BYTES = 147456;

struct TItem { const float* W; const float* gk; bf16_t* D; int N, ldt, drow0, k0, n0; };
__device__ __forceinline__ void titem_load(float (&v)[32], const TItem& t, int lane) {
#pragma unroll
    for (int i = 0; i < 32; ++i) { const int kk = 2 * i + (lane >> 5); v[i] = t.W[(size_t)(t.k0 + kk) * t.N + t.n0 + (lane & 31)]; }
}
__device__ __forceinline__ void titem_to_lds(const float (&v)[32], LAS float* scr, int lane) {
#pragma unroll
    for (int i = 0; i < 32; ++i) { const int kk = 2 * i + (lane >> 5); scr[kk * 33 + (lane & 31)] = v[i]; }
    LDS_WAIT(); asm volatile("" ::: "memory");
}
__device__ __forceinline__ void titem_store(const TItem& t, LAS float* scr, int lane) {
    const int c = lane & 7;
    f32x4 g0 = (f32x4){1.f, 1.f, 1.f, 1.f}, g1 = g0;
    if (t.gk) { g0 = *(const f32x4*)(t.gk + t.k0 + 8 * c); g1 = *(const f32x4*)(t.gk + t.k0 + 8 * c + 4); }
#pragma unroll
    for (int j = 0; j < 4; ++j) { const int n = (lane >> 3) + 8 * j; const LAS float* s = scr + (8 * c) * 33 + n;
        u32x4 o; o.x = cvt_pk_bf16(s[0 * 33] * g0[0], s[1 * 33] * g0[1]); o.y = cvt_pk_bf16(s[2 * 33] * g0[2], s[3 * 33] * g0[3]);
        o.z = cvt_pk_bf16(s[4 * 33] * g1[0], s[5 * 33] * g1[1]); o.w = cvt_pk_bf16(s[6 * 33] * g1[2], s[7 * 33] * g1[3]);
        *(u32x4*)(t.D + (size_t)(t.drow0 + n) * t.ldt + t.k0 + 8 * c) = o; }
    LDS_WAIT(); asm volatile("" ::: "memory");
}
__device__ __forceinline__ void rms_row_to_bf16(const float* xrow, const float* g, bf16_t* orow, int lane) {
    const f32x4* xr = (const f32x4*)xrow + lane; const f32x4* gr = (const f32x4*)g + lane;
    f32x4 v[4]; float s = 0.f;
#pragma unroll
    for (int j = 0; j < 4; ++j) { v[j] = xr[64 * j]; s += (v[j].x * v[j].x + v[j].y * v[j].y) + (v[j].z * v[j].z + v[j].w * v[j].w); }
    const float rstd = 1.f / sqrtf(wave_sum(s) * (1.f / DM) + EPS);
    u32x2* o8 = (u32x2*)orow + lane;
#pragma unroll
    for (int j = 0; j < 4; ++j) { const f32x4 gg = gr[64 * j]; u32x2 w; w.x = cvt_pk_bf16(v[j].x * rstd * gg.x, v[j].y * rstd * gg.y); w.y = cvt_pk_bf16(v[j].z * rstd * gg.z, v[j].w * rstd * gg.w); o8[64 * j] = w; }
}

__device__ __forceinline__ void rms_rows4_to_bf16(const float* xrow, const float* g, bf16_t* orow, int lane) {
    f32x4 v[4][4]; float s[4];
#pragma unroll
    for (int r = 0; r < 4; ++r)
#pragma unroll
        for (int j = 0; j < 4; ++j) v[r][j] = *((const f32x4*)(xrow + (size_t)r * DM) + lane + 64 * j);
#pragma unroll
    for (int r = 0; r < 4; ++r) { s[r] = 0.f;
#pragma unroll
        for (int j = 0; j < 4; ++j) s[r] += (v[r][j].x * v[r][j].x + v[r][j].y * v[r][j].y) + (v[r][j].z * v[r][j].z + v[r][j].w * v[r][j].w); }
#pragma unroll
    for (int r = 0; r < 4; ++r) s[r] = 1.f / sqrtf(wave_sum(s[r]) * (1.f / DM) + EPS);
#pragma unroll
    for (int j = 0; j < 4; ++j) { const f32x4 gg = *((const f32x4*)g + lane + 64 * j);
#pragma unroll
        for (int r = 0; r < 4; ++r) { u32x2 w; w.x = cvt_pk_bf16(v[r][j].x * s[r] * gg.x, v[r][j].y * s[r] * gg.y); w.y = cvt_pk_bf16(v[r][j].z * s[r] * gg.z, v[r][j].w * s[r] * gg.w);
            *((u32x2*)(orow + (size_t)r * DM) + lane + 64 * j) = w; } }
}

struct Args { const float* in[28]; float* out; unsigned char* ws; int ph_lo, ph_hi; };
typedef const __attribute__((address_space(4))) Args* KArgs;
__device__ __forceinline__ KArgs kargs() { KArgs p = (KArgs)__builtin_amdgcn_kernarg_segment_ptr(); asm volatile("" : "+s"(p)); return p; }

__device__ __forceinline__ void ssm_tables(KArgs ap, int g, LAS unsigned char* lds, bf16_t* Tg, bf16_t* Wend) {
    LAS float* Lre = (LAS float*)lds;
    LAS float* Lim = Lre + 33 * 64;
    LAS float* Bre = Lim + 33 * 64;
    LAS float* Bim = Bre + 1024;
    LAS float* Cre = Bim + 1024;
    LAS float* Cim = Cre + 1024;
    LAS float* Kern = Cim + 1024;
    const int tid = threadIdx.x;
    const float* lam_re = ap->in[12] + g * 64; const float* lam_im = ap->in[13] + g * 64;
    const float dt = expf(ap->in[14][g]);
    for (int idx = tid; idx < 33 * 64; idx += 512) {
        const int tau = idx >> 6, p = idx & 63;
        const float mag = expf((float)tau * (lam_re[p] * dt)); const float ang = (float)tau * (lam_im[p] * dt);
        Lre[idx] = mag * cosf(ang); Lim[idx] = mag * sinf(ang);
    }
    __syncthreads();
    for (int idx = tid; idx < 1024; idx += 512) {
        {
            const int p = idx >> 4;
            const float lr = lam_re[p], li = lam_im[p], lbr = Lre[64 + p], lbi = Lim[64 + p];
            const float nre = lbr - 1.0f, den = lr * lr + li * li;
            const float cr = (nre * lr + lbi * li) / den, ci = (lbi * lr - nre * li) / den;
            const float br = ap->in[15][(size_t)g * 1024 + idx], bi = ap->in[16][(size_t)g * 1024 + idx];
            Bre[idx] = cr * br - ci * bi; Bim[idx] = cr * bi + ci * br;
        }
        Cre[idx] = ap->in[17][(size_t)g * 1024 + idx]; Cim[idx] = ap->in[18][(size_t)g * 1024 + idx];
    }
    __syncthreads();
    {
        const int tau = tid >> 4, co = tid & 15; float kacc[16];
#pragma unroll
        for (int ci = 0; ci < 16; ++ci) kacc[ci] = 0.f;
        for (int p = 0; p < 64; ++p) {
            const float cr = Cre[co * 64 + p], cim = Cim[co * 64 + p], lr = Lre[tau * 64 + p], li = Lim[tau * 64 + p];
            const float gr = cr * lr - cim * li, gi = cr * li + cim * lr;
#pragma unroll
            for (int q = 0; q < 4; ++q) { const f32x4 br = *(const LAS f32x4*)(Bre + p * 16 + 4 * q), bi = *(const LAS f32x4*)(Bim + p * 16 + 4 * q);
#pragma unroll
                for (int e = 0; e < 4; ++e) kacc[4 * q + e] += gr * br[e] - gi * bi[e]; }
        }
#pragma unroll
        for (int ci = 0; ci < 16; ++ci) Kern[tid * 16 + ci] = kacc[ci];
    }
    __syncthreads();
    bf16_t* T = Tg + (size_t)g * 512 * 640;
    for (int idx = tid; idx < 512 * 80; idx += 512) {
        const int n = idx / 80, k8 = (idx % 80) * 8; const int t = n >> 4, co = n & 15;
        float v[8];
        if (k8 < 512) { const int s = k8 >> 4, ci = k8 & 15;
#pragma unroll
            for (int j = 0; j < 8; ++j) v[j] = (s <= t) ? Kern[((t - s) * 16 + co) * 16 + ci + j] : 0.f;
        } else { const int q = k8 - 512, im = q >> 6, p0 = q & 63;
#pragma unroll
            for (int j = 0; j < 8; ++j) { const int p = p0 + j; const float cr = Cre[co * 64 + p], cim = Cim[co * 64 + p], lr = Lre[(t + 1) * 64 + p], li = Lim[(t + 1) * 64 + p];
                v[j] = im ? -(cr * li + cim * lr) : (cr * lr - cim * li); }
        }
        u32x4 w; w.x = cvt_pk_bf16(v[0], v[1]); w.y = cvt_pk_bf16(v[2], v[3]); w.z = cvt_pk_bf16(v[4], v[5]); w.w = cvt_pk_bf16(v[6], v[7]);
        *(u32x4*)(T + (size_t)n * 640 + k8) = w;
    }
    bf16_t* We = Wend + (size_t)g * 256 * 512;
    for (int idx = tid; idx < 256 * 64; idx += 512) {
        const int j = idx >> 6, k8 = (idx & 63) * 8; float v[8];
        if (j < 128) { const int p = j & 63, im = j >> 6, s = k8 >> 4, ci = k8 & 15; const float lr = Lre[(31 - s) * 64 + p], li = Lim[(31 - s) * 64 + p];
#pragma unroll
            for (int e = 0; e < 8; ++e) { const float br = Bre[p * 16 + ci + e], bi = Bim[p * 16 + ci + e]; v[e] = im ? (lr * bi + li * br) : (lr * br - li * bi); }
        } else {
#pragma unroll
            for (int e = 0; e < 8; ++e) v[e] = 0.f;
        }
        u32x4 w; w.x = cvt_pk_bf16(v[0], v[1]); w.y = cvt_pk_bf16(v[2], v[3]); w.z = cvt_pk_bf16(v[4], v[5]); w.w = cvt_pk_bf16(v[6], v[7]);
        *(u32x4*)(We + (size_t)j * 512 + k8) = w;
    }
    __syncthreads();
}


template <int W> __device__ __forceinline__ u32x4 pool_item(const bf16_t* up, int t) {
    const int cnt = (t + 1 < W) ? t + 1 : W;
    u32x4 v[W];
#pragma unroll
    for (int i = 0; i < W; ++i) v[i] = (i < cnt) ? *(const u32x4*)(up - (size_t)i * 1536) : (u32x4){0u, 0u, 0u, 0u};
    float s[8];
#pragma unroll
    for (int j = 0; j < 8; ++j) s[j] = 0.f;
#pragma unroll
    for (int i = 0; i < W; ++i) { s[0] += bflo(v[i].x); s[1] += bfhi(v[i].x); s[2] += bflo(v[i].y); s[3] += bfhi(v[i].y); s[4] += bflo(v[i].z); s[5] += bfhi(v[i].z); s[6] += bflo(v[i].w); s[7] += bfhi(v[i].w); }
    const float inv = 1.0f / (float)cnt;
    u32x4 w; w.x = cvt_pk_bf16(s[0] * inv - bflo(v[0].x), s[1] * inv - bfhi(v[0].x)); w.y = cvt_pk_bf16(s[2] * inv - bflo(v[0].y), s[3] * inv - bfhi(v[0].y));
    w.z = cvt_pk_bf16(s[4] * inv - bflo(v[0].z), s[5] * inv - bfhi(v[0].z)); w.w = cvt_pk_bf16(s[6] * inv - bflo(v[0].w), s[7] * inv - bfhi(v[0].w));
    return w;
}

__device__ __forceinline__ void bf8_to_f(const u32x4 v, float (&f)[8]) { f[0] = bflo(v.x); f[1] = bfhi(v.x); f[2] = bflo(v.y); f[3] = bfhi(v.y); f[4] = bflo(v.z); f[5] = bfhi(v.z); f[6] = bflo(v.w); f[7] = bfhi(v.w); }
template <int W> __device__ __forceinline__ void pool_segment(const bf16_t* up, bf16_t* op, int t0) {
    float s[8];
#pragma unroll
    for (int j = 0; j < 8; ++j) s[j] = 0.f;
#pragma unroll
    for (int i = 1; i < W; ++i) {
        u32x4 v = (u32x4){0u, 0u, 0u, 0u};
        if (t0 - i >= 0) v = *(const u32x4*)(up - (size_t)i * 1536);
        float f[8]; bf8_to_f(v, f);
#pragma unroll
        for (int j = 0; j < 8; ++j) s[j] += f[j];
    }
#pragma unroll 4
    for (int r = 0; r < 32; ++r) {
        const int t = t0 + r;
        const u32x4 vc = *(const u32x4*)(up + (size_t)r * 1536);
        u32x4 vo = (u32x4){0u, 0u, 0u, 0u};
        if (t - (W - 1) >= 0) vo = *(const u32x4*)(up + (size_t)(r - (W - 1)) * 1536);
        float fc[8], fo[8]; bf8_to_f(vc, fc); bf8_to_f(vo, fo);
        const float inv = 1.0f / (float)((t + 1 < W) ? t + 1 : W);
        float o[8];
#pragma unroll
        for (int j = 0; j < 8; ++j) { s[j] += fc[j]; o[j] = s[j] * inv - fc[j]; s[j] -= fo[j]; }
        u32x4 w; w.x = cvt_pk_bf16(o[0], o[1]); w.y = cvt_pk_bf16(o[2], o[3]); w.z = cvt_pk_bf16(o[4], o[5]); w.w = cvt_pk_bf16(o[6], o[7]);
        *(u32x4*)(op + (size_t)r * DM) = w;
    }
}

__device__ __forceinline__ int crow(int r, int hi) { return (r & 3) + 8 * (r >> 2) + 4 * hi; }
__device__ __forceinline__ void sb_attn_task(const bf16_t* __restrict__ QKU, const bf16_t* __restrict__ VT, bf16_t* __restrict__ CAT, int b, int h, int qb, int lane) {
    const int r32 = lane & 31, hi = lane >> 5;
    const size_t tok0 = (size_t)b * SEQ; const int q0 = qb * 32;
    const bf16_t* qp = QKU + (tok0 + q0 + r32) * 1536 + h * 64 + 8 * hi;
    bf16x8 qf[4];
#pragma unroll
    for (int j = 0; j < 4; ++j) qf[j] = *(const bf16x8*)(qp + 16 * j);
    const bf16_t* kp = QKU + (tok0 + r32) * 1536 + 512 + h * 64 + 8 * hi;
    const bf16_t* vp = VT + (size_t)(h * 64 + r32) * VT_LD + tok0 + 4 * hi;
    f32x16 o0, o1;
#pragma unroll
    for (int r = 0; r < 16; ++r) { o0[r] = 0.f; o1[r] = 0.f; }
    float carry = 1.0f;
    bf16x8 kf[4]; s16x4 va[2][4]; bf16x8 k1[4]; s16x4 v1[2][4];
#define SB_LOAD(KF, VA, K0) do { const int k0_ = (K0); \
        _Pragma("unroll") for (int j = 0; j < 4; ++j) KF[j] = *(const bf16x8*)(kp + (size_t)k0_ * 1536 + 16 * j); \
        _Pragma("unroll") for (int dh = 0; dh < 2; ++dh) _Pragma("unroll") for (int c = 0; c < 4; ++c) VA[dh][c] = *(const s16x4*)(vp + (size_t)dh * 32 * VT_LD + k0_ + 8 * c); } while (0)
    asm volatile("s_waitcnt vmcnt(0)" ::: "memory");
    SB_LOAD(kf, va, q0);
    SB_LOAD(k1, v1, qb > 0 ? q0 - 32 : q0);
    for (int kt = qb; kt >= 0; --kt) {
        bf16x8 kn[4]; s16x4 vn[2][4];
        SB_LOAD(kn, vn, kt >= 2 ? (kt - 2) * 32 : 0);
        f32x16 s;
#pragma unroll
        for (int r = 0; r < 16; ++r) s[r] = 0.f;
#pragma unroll
        for (int j = 0; j < 4; ++j) s = __builtin_amdgcn_mfma_f32_32x32x16_bf16(kf[j], qf[j], s, 0, 0, 0);
        const bool diag = (kt == qb);
        float omb[16], bt[16];
#pragma unroll
        for (int r = 0; r < 16; ++r) {
            const float z2 = fminf(s[r] * (0.125f * LOG2E), 100.0f);
            const float e = fexp2(z2);
            const float ob = frcp(1.0f + e);
            const bool valid = !diag || (crow(r, hi) < r32);
            omb[r] = valid ? ob : 1.0f; bt[r] = valid ? e * ob : 0.0f;
        }
        float gp[4], pg[4];
#pragma unroll
        for (int g = 0; g < 4; ++g) { gp[g] = (omb[4 * g] * omb[4 * g + 1]) * (omb[4 * g + 2] * omb[4 * g + 3]); pg[g] = partner32(gp[g], hi); }
        float tp[4];
        tp[3] = 1.0f; tp[2] = gp[3] * pg[3]; tp[1] = tp[2] * (gp[2] * pg[2]); tp[0] = tp[1] * (gp[1] * pg[1]);
        const float total = tp[0] * (gp[0] * pg[0]);
        float w[16];
#pragma unroll
        for (int g = 0; g < 4; ++g) {
            const float base = carry * tp[g] * (hi ? 1.0f : pg[g]);
            const float a3 = base, a2 = a3 * omb[4 * g + 3], a1 = a2 * omb[4 * g + 2], a0 = a1 * omb[4 * g + 1];
            w[4 * g + 3] = bt[4 * g + 3] * a3;
            w[4 * g + 2] = bt[4 * g + 2] * a2;
            w[4 * g + 1] = bt[4 * g + 1] * a1;
            w[4 * g + 0] = bt[4 * g + 0] * a0;
        }
        carry *= total;
        u32x4 p0, p1;
        p0.x = cvt_pk_bf16(w[0], w[1]); p0.y = cvt_pk_bf16(w[2], w[3]); p0.z = cvt_pk_bf16(w[4], w[5]); p0.w = cvt_pk_bf16(w[6], w[7]);
        p1.x = cvt_pk_bf16(w[8], w[9]); p1.y = cvt_pk_bf16(w[10], w[11]); p1.z = cvt_pk_bf16(w[12], w[13]); p1.w = cvt_pk_bf16(w[14], w[15]);
        const bf16x8 pb0 = __builtin_bit_cast(bf16x8, p0), pb1 = __builtin_bit_cast(bf16x8, p1);
#define VA8(dh, c) (bf16x8){va[dh][c][0], va[dh][c][1], va[dh][c][2], va[dh][c][3], va[dh][(c) + 1][0], va[dh][(c) + 1][1], va[dh][(c) + 1][2], va[dh][(c) + 1][3]}
        const bf16x8 a00 = VA8(0, 0), a02 = VA8(0, 2), a10 = VA8(1, 0), a12 = VA8(1, 2);
#undef VA8
        o0 = __builtin_amdgcn_mfma_f32_32x32x16_bf16(a00, pb0, o0, 0, 0, 0);
        o0 = __builtin_amdgcn_mfma_f32_32x32x16_bf16(a02, pb1, o0, 0, 0, 0);
        o1 = __builtin_amdgcn_mfma_f32_32x32x16_bf16(a10, pb0, o1, 0, 0, 0);
        o1 = __builtin_amdgcn_mfma_f32_32x32x16_bf16(a12, pb1, o1, 0, 0, 0);
        __builtin_amdgcn_sched_barrier(0);
        asm volatile("s_nop 15\n\ts_nop 15\n\ts_nop 15\n\ts_nop 15\n\ts_nop 15" ::: "memory");
        asm volatile("" :: "v"(a00), "v"(a02), "v"(a10), "v"(a12), "v"(pb0), "v"(pb1), "v"(kf[0]), "v"(kf[1]), "v"(kf[2]), "v"(kf[3]));
        __builtin_amdgcn_sched_barrier(0);
        if (__all(carry == 0.0f)) break;
#pragma unroll
        for (int j = 0; j < 4; ++j) { kf[j] = k1[j]; k1[j] = kn[j]; }
#pragma unroll
        for (int dh = 0; dh < 2; ++dh)
#pragma unroll
            for (int c = 0; c < 4; ++c) { va[dh][c] = v1[dh][c]; v1[dh][c] = vn[dh][c]; }
    }
#undef SB_LOAD
    bf16_t* op = CAT + (tok0 + q0 + r32) * DM + h * 64 + 4 * hi;
#pragma unroll
    for (int g = 0; g < 4; ++g) {
        u32x2 w0, w1;
        w0.x = cvt_pk_bf16(o0[4 * g], o0[4 * g + 1]); w0.y = cvt_pk_bf16(o0[4 * g + 2], o0[4 * g + 3]);
        w1.x = cvt_pk_bf16(o1[4 * g], o1[4 * g + 1]); w1.y = cvt_pk_bf16(o1[4 * g + 2], o1[4 * g + 3]);
        *(u32x2*)(op + 8 * g) = w0; *(u32x2*)(op + 32 + 8 * g) = w1;
    }
}


constexpr int SBK_PITCH = 144, SBV_PITCH = 80, SBK_BYTES = 32 * SBK_PITCH, SBV_BYTES = 64 * SBV_PITCH, SB_TILE = SBK_BYTES + SBV_BYTES, SB_WIN = 14;
static_assert(SB_WIN * SB_TILE <= XBST_OFF, "attention LDS window must stay below the grid barrier's LDS words");
__device__ __forceinline__ void sb_attn_block(const bf16_t* __restrict__ QKU, const bf16_t* __restrict__ VT, bf16_t* __restrict__ CAT, int b, int h, int qb0,
                                              LAS unsigned char* lds, int tid, int wave, int lane) {
    const int r32 = lane & 31, hi = lane >> 5;
    const size_t tok0 = (size_t)b * SEQ; const int qb = qb0 + wave, q0 = qb * 32;
    const int lo = (qb0 >= 6) ? qb0 - 6 : 0, ntile = qb0 + 8 - lo;
    {
        const bool isk = tid < 256; const int t2 = tid & 255;
        const bf16_t* gsrc = isk ? QKU + (tok0 + (t2 >> 3)) * 1536 + 512 + h * 64 + (t2 & 7) * 8
                                 : VT + (size_t)(h * 64 + (t2 >> 2)) * VT_LD + tok0 + (t2 & 3) * 8;
        const size_t gstep = isk ? (size_t)32 * 1536 : (size_t)32;
        const int ldst = isk ? (t2 >> 3) * SBK_PITCH + (t2 & 7) * 16 : SBK_BYTES + (t2 >> 2) * SBV_PITCH + (t2 & 3) * 16;
        u32x4 stg[SB_WIN];
#pragma unroll
        for (int i = 0; i < SB_WIN; ++i) if (i < ntile) stg[i] = *(const u32x4*)(gsrc + (size_t)(lo + i) * gstep);
#pragma unroll
        for (int i = 0; i < SB_WIN; ++i) if (i < ntile) *(LAS u32x4*)(lds + i * SB_TILE + ldst) = stg[i];
    }
    const bf16_t* qp = QKU + (tok0 + q0 + r32) * 1536 + h * 64 + 8 * hi;
    bf16x8 qf[4];
#pragma unroll
    for (int j = 0; j < 4; ++j) qf[j] = *(const bf16x8*)(qp + 16 * j);
    const bf16_t* kp = QKU + (tok0 + r32) * 1536 + 512 + h * 64 + 8 * hi;
    const bf16_t* vp = VT + (size_t)(h * 64 + r32) * VT_LD + tok0 + 4 * hi;
    f32x16 o0, o1;
#pragma unroll
    for (int r = 0; r < 16; ++r) { o0[r] = 0.f; o1[r] = 0.f; }
    float carry = 1.0f;
    __syncthreads();
    for (int kt = qb; kt >= 0; --kt) {
        bf16x8 kf[4]; s16x4 va[2][4];
        if (kt >= lo) {
            LAS unsigned char* kb = lds + (kt - lo) * SB_TILE; LAS unsigned char* vb = kb + SBK_BYTES;
#pragma unroll
            for (int j = 0; j < 4; ++j) kf[j] = *(const LAS bf16x8*)(kb + r32 * SBK_PITCH + (16 * j + 8 * hi) * 2);
#pragma unroll
            for (int dh = 0; dh < 2; ++dh)
#pragma unroll
                for (int c = 0; c < 4; ++c) va[dh][c] = *(const LAS s16x4*)(vb + (dh * 32 + r32) * SBV_PITCH + (8 * c + 4 * hi) * 2);
        } else {
            const int k0 = kt * 32;
#pragma unroll
            for (int j = 0; j < 4; ++j) kf[j] = *(const bf16x8*)(kp + (size_t)k0 * 1536 + 16 * j);
#pragma unroll
            for (int dh = 0; dh < 2; ++dh)
#pragma unroll
                for (int c = 0; c < 4; ++c) va[dh][c] = *(const s16x4*)(vp + (size_t)dh * 32 * VT_LD + k0 + 8 * c);
        }
        f32x16 s;
#pragma unroll
        for (int r = 0; r < 16; ++r) s[r] = 0.f;
#pragma unroll
        for (int j = 0; j < 4; ++j) s = __builtin_amdgcn_mfma_f32_32x32x16_bf16(kf[j], qf[j], s, 0, 0, 0);
        const bool diag = (kt == qb);
        float omb[16], bt[16];
#pragma unroll
        for (int r = 0; r < 16; ++r) {
            const float z2 = fminf(s[r] * (0.125f * LOG2E), 100.0f);
            const float e = fexp2(z2);
            const float ob = frcp(1.0f + e);
            const bool valid = !diag || (crow(r, hi) < r32);
            omb[r] = valid ? ob : 1.0f; bt[r] = valid ? e * ob : 0.0f;
        }
        float gp[4], pg[4];
#pragma unroll
        for (int g = 0; g < 4; ++g) { gp[g] = (omb[4 * g] * omb[4 * g + 1]) * (omb[4 * g + 2] * omb[4 * g + 3]); pg[g] = partner32(gp[g], hi); }
        float tp[4];
        tp[3] = 1.0f; tp[2] = gp[3] * pg[3]; tp[1] = tp[2] * (gp[2] * pg[2]); tp[0] = tp[1] * (gp[1] * pg[1]);
        const float total = tp[0] * (gp[0] * pg[0]);
        float w[16];
#pragma unroll
        for (int g = 0; g < 4; ++g) {
            const float base = carry * tp[g] * (hi ? 1.0f : pg[g]);
            const float a3 = base, a2 = a3 * omb[4 * g + 3], a1 = a2 * omb[4 * g + 2], a0 = a1 * omb[4 * g + 1];
            w[4 * g + 3] = bt[4 * g + 3] * a3; w[4 * g + 2] = bt[4 * g + 2] * a2; w[4 * g + 1] = bt[4 * g + 1] * a1; w[4 * g + 0] = bt[4 * g + 0] * a0;
        }
        carry *= total;
        u32x4 p0, p1;
        p0.x = cvt_pk_bf16(w[0], w[1]); p0.y = cvt_pk_bf16(w[2], w[3]); p0.z = cvt_pk_bf16(w[4], w[5]); p0.w = cvt_pk_bf16(w[6], w[7]);
        p1.x = cvt_pk_bf16(w[8], w[9]); p1.y = cvt_pk_bf16(w[10], w[11]); p1.z = cvt_pk_bf16(w[12], w[13]); p1.w = cvt_pk_bf16(w[14], w[15]);
        const bf16x8 pb0 = __builtin_bit_cast(bf16x8, p0), pb1 = __builtin_bit_cast(bf16x8, p1);
#define VA8(dh, c) (bf16x8){va[dh][c][0], va[dh][c][1], va[dh][c][2], va[dh][c][3], va[dh][(c) + 1][0], va[dh][(c) + 1][1], va[dh][(c) + 1][2], va[dh][(c) + 1][3]}
        const bf16x8 a00 = VA8(0, 0), a02 = VA8(0, 2), a10 = VA8(1, 0), a12 = VA8(1, 2);
#undef VA8
        o0 = __builtin_amdgcn_mfma_f32_32x32x16_bf16(a00, pb0, o0, 0, 0, 0);
        o0 = __builtin_amdgcn_mfma_f32_32x32x16_bf16(a02, pb1, o0, 0, 0, 0);
        o1 = __builtin_amdgcn_mfma_f32_32x32x16_bf16(a10, pb0, o1, 0, 0, 0);
        o1 = __builtin_amdgcn_mfma_f32_32x32x16_bf16(a12, pb1, o1, 0, 0, 0);
        __builtin_amdgcn_sched_barrier(0);
        asm volatile("s_nop 15\n\ts_nop 15\n\ts_nop 15\n\ts_nop 15\n\ts_nop 15" ::: "memory");
        asm volatile("" :: "v"(a00), "v"(a02), "v"(a10), "v"(a12), "v"(pb0), "v"(pb1), "v"(kf[0]), "v"(kf[1]), "v"(kf[2]), "v"(kf[3]));
        __builtin_amdgcn_sched_barrier(0);
        if (__all(carry == 0.0f)) break;
    }
    bf16_t* op = CAT + (tok0 + q0 + r32) * DM + h * 64 + 4 * hi;
#pragma unroll
    for (int g = 0; g < 4; ++g) {
        u32x2 w0, w1;
        w0.x = cvt_pk_bf16(o0[4 * g], o0[4 * g + 1]); w0.y = cvt_pk_bf16(o0[4 * g + 2], o0[4 * g + 3]);
        w1.x = cvt_pk_bf16(o1[4 * g], o1[4 * g + 1]); w1.y = cvt_pk_bf16(o1[4 * g + 2], o1[4 * g + 3]);
        *(u32x2*)(op + 8 * g) = w0; *(u32x2*)(op + 32 + 8 * g) = w1;
    }
    __syncthreads();
}

#define XB_TMO      128
#define XB_XCNT(j)  (256  + 64 * (j))
#define XB_XSUB(j)  (1280 + 64 * (j))
#define XB_XGEN(j)  (2304 + 64 * (j))
#define XB_TOP      3328
#define XB_TOPGEN   3392
#define XCD_BAR_WORDS 3456
#define XB_SPIN_CAP (1u << 22)
__device__ __forceinline__ unsigned xb_ld(unsigned* p)              { return __hip_atomic_load(p, __ATOMIC_RELAXED, __HIP_MEMORY_SCOPE_AGENT); }
__device__ __forceinline__ unsigned xb_add(unsigned* p, unsigned v) { return __hip_atomic_fetch_add(p, v, __ATOMIC_RELAXED, __HIP_MEMORY_SCOPE_AGENT); }
__device__ __forceinline__ unsigned xb_xcc_id() { return (unsigned)__builtin_amdgcn_s_getreg((3 << 11) | 20) & 0xFu; }
#define XB_SPIN(cond, bar) do { unsigned _sp = 0; while (cond) { __builtin_amdgcn_s_sleep(1); \
    if ((++_sp & 255u) == 0u) { if (xb_ld(&(bar)[XB_TMO])) break; if (_sp > XB_SPIN_CAP) { atomicAdd(&(bar)[XB_TMO], 1u); break; } } } } while (0)
__device__ __forceinline__ void xcd_barrier_complete(unsigned* bar, unsigned x, unsigned G, unsigned& nloc, unsigned& nx) {
    unsigned sum, cnt, mine, sp = 0u;
    for (;;) {
        sum = 0u; cnt = 0u; mine = 0u;
#pragma unroll
        for (unsigned j = 0; j < 16; ++j) { const unsigned c = xb_ld(&bar[XB_XCNT(j)]); sum += c; cnt += (c > 0u) ? 1u : 0u; mine = (j == x) ? c : mine; }
        if (sum == G) break;
        __builtin_amdgcn_s_sleep(1);
        if ((++sp & 255u) == 0u) { if (xb_ld(&bar[XB_TMO])) break; if (sp > XB_SPIN_CAP) { atomicAdd(&bar[XB_TMO], 1u); break; } }
    }
    nloc = mine > 0u ? mine : 1u; nx = cnt > 0u ? cnt : 1u;
}
__device__ __forceinline__ void xcd_barrier(unsigned* bar, volatile LAS unsigned* st, bool leader, unsigned G) {
    asm volatile("s_waitcnt vmcnt(0)" ::: "memory");
    __syncthreads();
    if (leader) {
        const unsigned x = xb_xcc_id();
        __builtin_amdgcn_s_waitcnt(0);
        unsigned nloc = st[0], nx = st[1];
        if (nloc == 0u) { xcd_barrier_complete(bar, x, G, nloc, nx); st[0] = nloc; st[1] = nx; }
        const unsigned old = xb_add(&bar[XB_XSUB(x)], 1u);
        const unsigned gen = old / nloc;
        if (old + 1u == (gen + 1u) * nloc) {
            __builtin_amdgcn_fence(__ATOMIC_RELEASE, "agent");
            asm volatile("s_waitcnt vmcnt(0)" ::: "memory");
            const unsigned og = xb_add(&bar[XB_TOP], 1u);
            const unsigned tg = og / nx;
            if (og + 1u == (tg + 1u) * nx) xb_add(&bar[XB_TOPGEN], 1u);
            else XB_SPIN(xb_ld(&bar[XB_TOPGEN]) == tg, bar);
            __builtin_amdgcn_fence(__ATOMIC_ACQUIRE, "agent");
            xb_add(&bar[XB_XGEN(x)], 1u);
            asm volatile("s_waitcnt vmcnt(0)" ::: "memory");
        } else {
            XB_SPIN(xb_ld(&bar[XB_XGEN(x)]) == gen, bar);
            __builtin_amdgcn_fence(__ATOMIC_ACQUIRE, "agent");
            asm volatile("s_waitcnt vmcnt(0)" ::: "memory");
        }
    }
    __syncthreads();
}

__global__ void __launch_bounds__(512) mega_fwd(Args a) {
    __builtin_assume(__builtin_amdgcn_workitem_id_y() == 0); __builtin_assume(__builtin_amdgcn_workitem_id_z() == 0);
    extern __shared__ __attribute__((aligned(16))) unsigned char lds_raw[];
    LAS unsigned char* lds = (LAS unsigned char*)lds_raw;
    LAS unsigned char* xl = lds + XL_OFF;
    cg::grid_group grid = cg::this_grid();
#if !MK_MULTI_LAUNCH
    {
        volatile LAS unsigned* st = (volatile LAS unsigned*)(lds + XBST_OFF);
        if (threadIdx.x == 0) { st[0] = 0u; st[1] = 0u; KArgs ap0 = kargs(); xb_add(&((unsigned*)ap0->ws)[XB_XCNT(xb_xcc_id())], 1u); }
        if (a.ph_lo < 0) grid.sync();
        __syncthreads();
    }
#endif
#if MK_MULTI_LAUNCH
    const int lo = a.ph_lo, hi = a.ph_hi;
    int ph = 0;
#endif
#define PH_VARS int tid = threadIdx.x; asm volatile("" : "+v"(tid)); const int lane = tid & 63, wave = __builtin_amdgcn_readfirstlane(tid >> 6); int G_ = gridDim.x, bid_ = blockIdx.x; asm volatile("" : "+s"(G_), "+s"(bid_)); const int G = G_, bid = bid_; \
    const int gw = bid * 8 + wave, NGW = G * 8, gt = bid * 512 + tid, NGT = G * 512; (void)lane; (void)gw; (void)NGW; (void)gt; (void)NGT; KArgs ap = kargs(); unsigned char* ws = ap->ws; float* X = ap->out; float* SSQ = (float*)(ws + WS_SSQ); bf16_t* XB = (bf16_t*)(ws + WS_XB); bf16_t* MEMN = (bf16_t*)(ws + WS_MEMN); (void)X; (void)SSQ; (void)XB; (void)MEMN;
#if MK_MULTI_LAUNCH
#define PHASE_ON (ph >= lo && ph < hi)
#define PHASE_END do { if (ph >= lo && ph + 1 < hi) grid.sync(); ++ph; } while (0)
#define LOCAL_SEAM PHASE_END
#else
#define PHASE_ON (true)
#define LOCAL_SEAM do { asm volatile("s_waitcnt vmcnt(0)" ::: "memory"); __syncthreads(); { int tl = threadIdx.x; asm volatile("" : "+v"(tl)); \
    if (tl == 0) { __builtin_amdgcn_fence(__ATOMIC_ACQUIRE, "agent"); asm volatile("s_waitcnt vmcnt(0)" ::: "memory"); } } __syncthreads(); } while (0)
#define PHASE_END do { KArgs apb = kargs(); int tb = threadIdx.x; asm volatile("" : "+v"(tb)); int Gb = gridDim.x; asm volatile("" : "+s"(Gb)); \
    xcd_barrier((unsigned*)apb->ws, (volatile LAS unsigned*)(lds + XBST_OFF), tb == 0, (unsigned)Gb); } while (0)
#endif

    if (PHASE_ON) { PH_VARS
        if (bid < 64) ssm_tables(ap, bid, lds, (bf16_t*)(ws + WS_TG), (bf16_t*)(ws + WS_WEND));
        LAS float* scr = (LAS float*)(lds + wave * 16384);
        const bool weighted = (G > 64);
        const int n_tw = weighted ? 64 * 8 : 0, n_nw = weighted ? (G - 64) * 8 : G * 8;
        const int spw = weighted ? 4 : 1, S = n_nw * spw + n_tw;
        const bool is_tw = weighted && bid < 64;
        const int slot0 = is_tw ? n_nw * spw + gw : (weighted ? (gw - 512) * 4 : gw), nslot = is_tw ? 1 : spw;
        if (!is_tw) {
            const int nb_ = weighted ? G - 64 : G, b_ = weighted ? bid - 64 : bid;
            for (int it = b_ + wave * nb_; it < 256; it += nb_ * 8) {
                const int g = it >> 6, cb = (it >> 2) & 15, nb = it & 3;
                const float* pw = ap->in[8] + (size_t)(g * 128 + cb * 8) * 128; const float* sc = ap->in[9] + g * 128;
                const float* wo = ap->in[10] + (size_t)(512 + g * 128) * 1024 + nb * 256 + lane * 4;
                f32x4 acc8[8];
#pragma unroll
                for (int j = 0; j < 8; ++j) acc8[j] = (f32x4){0.f, 0.f, 0.f, 0.f};
#pragma unroll 8
                for (int d = 0; d < 128; ++d) {
                    const f32x4 wv = *(const f32x4*)(wo + (size_t)d * 1024); const float sd = sc[d];
#pragma unroll
                    for (int j = 0; j < 8; ++j) acc8[j] += wv * (pw[j * 128 + d] * sd);
                }
                bf16_t* D = (bf16_t*)(ws + WS_WOUT) + (size_t)(nb * 256 + lane * 4) * 1024 + 512 + g * 128 + cb * 8;
#pragma unroll
                for (int e = 0; e < 4; ++e) {
                    u32x4 w; w.x = cvt_pk_bf16(acc8[0][e], acc8[1][e]); w.y = cvt_pk_bf16(acc8[2][e], acc8[3][e]); w.z = cvt_pk_bf16(acc8[4][e], acc8[5][e]); w.w = cvt_pk_bf16(acc8[6][e], acc8[7][e]);
                    *(u32x4*)(D + (size_t)e * 1024) = w;
                }
            }
        }
        {
            float tv[32]; TItem cur, nxt; bool have = false, have_next = false;
            int sl = 0, it = slot0;
            auto decode = [&](int item, TItem& t) -> bool {
                int r = item; const float* W = nullptr; const float* gk = nullptr; int N = 0; bf16_t* D = nullptr; int ldt = 0, mode = 0; bool found = false;
#define TJOB(Wp, Kk, Nn, Dp, Ld, Md, Gp) if (!found) { const int cnt = ((Kk) / 64) * ((Nn) / 32); if (r < cnt) { W = (Wp); N = (Nn); D = (bf16_t*)(Dp); ldt = (Ld); mode = (Md); gk = (Gp); found = true; } else r -= cnt; }
                TJOB(ap->in[7], 1024, 2048, ws + WS_WIN, 1024, 1, nullptr)
            TJOB(ap->in[10], 512, 1024, ws + WS_WOUT, 1024, 0, nullptr)
            TJOB(ap->in[11], 1024, 1024, ws + WS_WSSM, 1024, 0, ap->in[2] + 1024)
            TJOB(ap->in[20], 1024, 2048, ws + WS_WGLU, 1024, 2, nullptr)
#pragma unroll
            for (int l = 0; l < 2; ++l) {
                unsigned char* lb = ws + WS_LAYER + l * LAYER_STRIDE;
                TJOB(ap->in[22] + (size_t)l * 1024 * 2048, 1024, 2048, lb + LO_WKV, 1024, 0, nullptr)
                TJOB(ap->in[23] + (size_t)l * 1024 * 1024, 1024, 1024, lb + LO_WO, 1024, 0, nullptr)
                TJOB(ap->in[24] + (size_t)l * 1024 * DFF2, 1024, DFF2, lb + LO_WUP, 1024, 3, ap->in[4] + l * 1024)
                TJOB(ap->in[27] + (size_t)l * DFF * 1024, DFF, 1024, lb + LO_WDN, DFF, 0, nullptr)
            }
#undef TJOB
                if (!found) return false;
                const int nblk = N / 32, kb = r / nblk, nb = r % nblk, n0 = nb * 32;
                int drow0 = n0;
                if (mode == 1) drow0 = (n0 < 1024) ? n0 : (n0 < 1536 ? n0 + 512 : n0 - 512);
                else if (mode == 2) drow0 = (n0 < 1024) ? (256 * (n0 >> 7) + (n0 & 127)) : (256 * ((n0 - 1024) >> 7) + 128 + ((n0 - 1024) & 127));
                else if (mode == 3) drow0 = (n0 < DFF) ? (256 * (n0 >> 7) + (n0 & 127)) : (256 * ((n0 - DFF) >> 7) + 128 + ((n0 - DFF) & 127));
                t.W = W; t.gk = gk; t.D = D; t.N = N; t.ldt = ldt; t.drow0 = drow0; t.k0 = kb * 64; t.n0 = n0; return true;
            };
            auto advance = [&](TItem& t) -> bool {
                while (sl < nslot) { if (decode(it, t)) { it += S; return true; } ++sl; it = slot0 + sl; }
                return false;
            };
            have = advance(cur);
            if (have) titem_load(tv, cur, lane);
            while (have) {
                titem_to_lds(tv, scr, lane);
                have_next = advance(nxt);
                if (have_next) titem_load(tv, nxt, lane);
                titem_store(cur, scr, lane);
                cur = nxt; have = have_next;
            }
        }
        for (int it = gt; it < 2 * 1024 * 256; it += NGT) {
            const int l = it >> 18, e = it & 262143, k = e >> 8, n4 = (e & 255) * 4;
            const f32x4 w = *(const f32x4*)(ap->in[21] + (size_t)l * 1048576 + (size_t)k * 1024 + n4); const float gk = ap->in[3][l * 1024 + k];
            u32x2 o; o.x = cvt_pk_bf16(w[0] * gk, w[1] * gk); o.y = cvt_pk_bf16(w[2] * gk, w[3] * gk);
            *(u32x2*)((bf16_t*)(ws + WS_LAYER + l * LAYER_STRIDE + LO_WQ) + (size_t)k * 1024 + n4) = o;
        }
        for (int r = gw; r < MEMTOK / 4; r += NGW) rms_rows4_to_bf16(ap->in[1] + (size_t)r * 4 * DM, ap->in[5], MEMN + (size_t)r * 4 * DM, lane);
        for (int r = gw; r < MTOK / 4; r += NGW) rms_rows4_to_bf16(ap->in[0] + (size_t)r * 4 * DM, ap->in[2], XB + (size_t)r * 4 * DM, lane);
        __syncthreads();
    }
    PHASE_END;

    if (PHASE_ON) { PH_VARS
        bf16_t* WIN = (bf16_t*)(ws + WS_WIN);
        { pg8::SchedStd S; S.init(XB, 256 * 2048, WIN, 256 * 2048, 128, 6, G, bid);
          pg8::EpiStore E{(bf16_t*)(ws + WS_QKU), 1536, nullptr, 0, 1.0f, 0};
          pg8::gemm_phase(lds, xl, 1024, 1024, 1024, S, E); }
        { pg8::SchedStd S; S.init(WIN + (size_t)1536 * 1024, 256 * 2048, XB, 256 * 2048, 2, 128, G, bid);
          pg8::EpiStore E{(bf16_t*)(ws + WS_VT), VT_LD, nullptr, 0, 1.0f, 0};
          pg8::gemm_phase(lds, xl, 1024, 1024, 1024, S, E); }
        for (int j = 0; j < 4; ++j) {
            const int l = j >> 1, isv = j & 1;
            bf16_t* WKV = (bf16_t*)(ws + WS_LAYER + l * LAYER_STRIDE + LO_WKV);
            const int c = (bid + 64 * (j + 1)) % G;
            pg8::SchedStd S;
            S.init(MEMN, 256 * 2048, WKV + (size_t)isv * 1024 * 1024, 256 * 2048, 16, 4, G, c);
            pg8::EpiStore E{isv ? (bf16_t*)(ws + WS_MEMVT + l * MEMVT_STRIDE) : (bf16_t*)(ws + WS_MEMK + l * 8 * MiB), 1024, nullptr, 0, 1.0f, 0};
            pg8::gemm_phase(lds, xl, 1024, 1024, 1024, S, E);
        }
    }
    PHASE_END;

    if (PHASE_ON) { PH_VARS
        const bf16_t* QKU = (const bf16_t*)(ws + WS_QKU); bf16_t* CAT = (bf16_t*)(ws + WS_CAT);
        for (int it = gt; it < 64 * (MTOK / 32); it += NGT) {
            const int ch = it & 63, seg = it >> 6, g = ch >> 4;
            const bf16_t* up = QKU + (size_t)seg * 32 * 1536 + 1024 + ch * 8;
            bf16_t* op = CAT + (size_t)seg * 32 * DM + 512 + ch * 8;
            const int t0 = (seg * 32) & (SEQ - 1);
            if (g == 0) pool_segment<2>(up, op, t0); else if (g == 1) pool_segment<4>(up, op, t0); else if (g == 2) pool_segment<8>(up, op, t0); else pool_segment<16>(up, op, t0);
        }
        for (int wt = bid; wt < 128 * 8; wt += G) {
            const int bh = wt >> 3, blk = wt & 7;
            sb_attn_block(QKU, (const bf16_t*)(ws + WS_VT), CAT, bh >> 3, bh & 7, blk * 8, lds, tid, wave, lane);
        }
    }
    PHASE_END;

    if (PHASE_ON) { PH_VARS
        pg8::SchedStd S; S.init(ws + WS_CAT, 256 * 2048, ws + WS_WOUT, 256 * 2048, 128, 4, G, bid);
        pg8::EpiResid E{ap->in[0], XB, SSQ};
        pg8::gemm_phase(lds, xl, 1024, 1024, 1024, S, E);
        pg8::SchedG SG{(const char*)(ws + WS_MEMK), (const char*)(ws + WS_LAYER + LO_WQ), G, bid};
        pg8::EpiStore EG{(bf16_t*)(ws + WS_GT), 1024, nullptr, 0, 1.0f, 0};
        pg8::gemm_phase(lds, xl, 1024, 1024, 256, SG, EG);
    }
    PHASE_END;

#pragma nounroll
    for (int layer = 0; layer < 2; ++layer) {
        if (layer == 1) {
            if (PHASE_ON) { PH_VARS
                pg8::SchedStd S; S.init(XB, 256 * 2048, ws + WS_WSSM, 256 * 2048, 128, 4, G, bid);
                pg8::EpiStore E{(bf16_t*)(ws + WS_UG), 0, SSQ, 16, 1.0f, 1};
                pg8::gemm_phase(lds, xl, 1024, 1024, 1024, S, E);
            }
            PHASE_END;
            if (PHASE_ON) { PH_VARS
                pg8::SchedS2 S{(const char*)(ws + WS_UG), (const char*)(ws + WS_WEND), G, bid};
                pg8::EpiHend E{(float*)(ws + WS_HEND)};
                pg8::gemm_phase(lds, xl, 640, 512, 512, S, E);
            }
            PHASE_END;
            if (PHASE_ON) { PH_VARS
                bf16_t* UG = (bf16_t*)(ws + WS_UG); const float* HE = (const float*)(ws + WS_HEND);
                for (int it = gt; it < NBATCH * 64 * 64; it += NGT) {
                    const int p = it & 63, g = (it >> 6) & 63, b = it >> 12;
                    const float dt = expf(ap->in[14][g]);
                    const float mag = expf(32.0f * (ap->in[12][g * 64 + p] * dt)), ang = 32.0f * (ap->in[13][g * 64 + p] * dt);
                    const float lr = mag * cosf(ang), li = mag * sinf(ang);
                    float hr = 0.f, hi_ = 0.f;
                    for (int c0 = 0; c0 < 64; c0 += 8) {
                        const size_t row0 = (size_t)g * 1024 + b * 64 + c0;
                        float er[8], ei[8];
#pragma unroll
                        for (int j = 0; j < 8; ++j) { er[j] = HE[(row0 + j) * 128 + p]; ei[j] = HE[(row0 + j) * 128 + 64 + p]; }
#pragma unroll
                        for (int j = 0; j < 8; ++j) {
                            UG[(row0 + j) * 640 + 512 + p] = (bf16_t)(cvt_pk_bf16(hr, 0.f) & 0xffffu);
                            UG[(row0 + j) * 640 + 576 + p] = (bf16_t)(cvt_pk_bf16(hi_, 0.f) & 0xffffu);
                            const float nr = lr * hr - li * hi_ + er[j], ni = lr * hi_ + li * hr + ei[j];
                            hr = nr; hi_ = ni;
                        }
                    }
                }
            }
            PHASE_END;
            if (PHASE_ON) { PH_VARS
                pg8::SchedS4 S{(const char*)(ws + WS_UG), (const char*)(ws + WS_TG), G, bid};
                pg8::EpiSsmY E{(const bf16_t*)(ws + WS_UG), ap->in[19], (bf16_t*)(ws + WS_YG)};
                pg8::gemm_phase(lds, xl, 640, 640, 640, S, E);
            }
            PHASE_END;
            if (PHASE_ON) { PH_VARS
                pg8::SchedStd S; S.init(ws + WS_YG, 256 * 2048, ws + WS_WGLU, 256 * 2048, 128, 8, G, bid);
                pg8::EpiGlu E{XB, SSQ};
                pg8::gemm_phase(lds, xl, 1024, 1024, 1024, S, E);
            }
            PHASE_END;
        }
        if (PHASE_ON) { PH_VARS
            pg8::SchedXS2 S{(const char*)XB, (const char*)(ws + WS_GT + (size_t)layer * 32 * MiB), G, bid};
            pg8::EpiSoftmax E{(bf16_t*)(ws + WS_P), SSQ, layer == 0 ? 16 : 32, 0.0625f};
            pg8::gemm_phase(lds, xl, 1024, 1024, 1024, S, E);
        }
        if (PHASE_ON) { PH_VARS
            unsigned char* lb = ws + WS_LAYER + layer * LAYER_STRIDE;
            pg8::SchedVW S{(const char*)(lb + LO_WO), (const char*)(ws + WS_MEMVT + layer * MEMVT_STRIDE), G, bid};
            pg8::EpiStore E{(bf16_t*)(ws + WS_QX), 1024, nullptr, 0, 1.0f, 0};
            pg8::gemm_phase(lds, xl, 1024, 1024, 256, S, E);
        }
        PHASE_END;
        if (PHASE_ON) { PH_VARS
            pg8::SchedXOut S{(const char*)(ws + WS_P), (const char*)(ws + WS_QX), G, bid};
            pg8::EpiResid E{nullptr, XB, SSQ};
            pg8::gemm_phase(lds, xl, 1024, 1024, 1024, S, E);
        }
        PHASE_END;
        if (PHASE_ON) { PH_VARS
            unsigned char* lb = ws + WS_LAYER + layer * LAYER_STRIDE;
            pg8::SchedStd S; S.init(XB, 256 * 2048, lb + LO_WUP, 256 * 2048, 128, 22, G, bid);
            pg8::EpiUpConv E{(bf16_t*)(ws + WS_H), (bf16_t*)(ws + WS_HALO), SSQ, ap->in[25] + (size_t)layer * 3 * DFF2, ap->in[26] + (size_t)layer * DFF2};
            pg8::gemm_phase(lds, xl, 1024, 1024, 1024, S, E);
        }
        PHASE_END;
        if (PHASE_ON) { PH_VARS
            const bf16_t* HALO = (const bf16_t*)(ws + WS_HALO); bf16_t* H = (bf16_t*)(ws + WS_H);
            const float* cw = ap->in[25] + (size_t)layer * 3 * DFF2; const float* cb = ap->in[26] + (size_t)layer * DFF2;
            pg8::SchedStd S0; S0.init(ws + WS_H, 256u * DFF * 2, ws, 0u, 128, 4, G, bid);
            pg8::Unit uu;
            for (int ui = 0; S0.next(ui, uu); ++ui) {
                const int pm = uu.pm;
                if ((pm & 7) == 0) continue;
                for (int it = tid; it < 2 * 352; it += 512) {
                    const int chk = it % 352, rr = it / 352, c0 = chk * 8;
                    const bf16_t* cur = HALO + (size_t)(pm * 4 + rr) * DFF2;
                    const bf16_t* p1 = rr ? HALO + (size_t)(pm * 4) * DFF2 : HALO + (size_t)(pm * 4 - 1) * DFF2;
                    const bf16_t* p2 = rr ? HALO + (size_t)(pm * 4 - 1) * DFF2 : HALO + (size_t)(pm * 4 - 2) * DFF2;
                    float o[8];
                    const u32x4 av = *(const u32x4*)(cur + c0), ag = *(const u32x4*)(cur + DFF + c0);
                    const u32x4 a1 = *(const u32x4*)(p1 + c0), g1 = *(const u32x4*)(p1 + DFF + c0), a2 = *(const u32x4*)(p2 + c0), g2 = *(const u32x4*)(p2 + DFF + c0);
                    const float v0[8] = {bflo(av.x), bfhi(av.x), bflo(av.y), bfhi(av.y), bflo(av.z), bfhi(av.z), bflo(av.w), bfhi(av.w)};
                    const float g0[8] = {bflo(ag.x), bfhi(ag.x), bflo(ag.y), bfhi(ag.y), bflo(ag.z), bfhi(ag.z), bflo(ag.w), bfhi(ag.w)};
                    const float v1[8] = {bflo(a1.x), bfhi(a1.x), bflo(a1.y), bfhi(a1.y), bflo(a1.z), bfhi(a1.z), bflo(a1.w), bfhi(a1.w)};
                    const float gg1[8] = {bflo(g1.x), bfhi(g1.x), bflo(g1.y), bfhi(g1.y), bflo(g1.z), bfhi(g1.z), bflo(g1.w), bfhi(g1.w)};
                    const float v2[8] = {bflo(a2.x), bfhi(a2.x), bflo(a2.y), bfhi(a2.y), bflo(a2.z), bfhi(a2.z), bflo(a2.w), bfhi(a2.w)};
                    const float gg2[8] = {bflo(g2.x), bfhi(g2.x), bflo(g2.y), bfhi(g2.y), bflo(g2.z), bfhi(g2.z), bflo(g2.w), bfhi(g2.w)};
    #pragma unroll
                    for (int j = 0; j < 8; ++j) {
                        const int c = c0 + j;
                        const float cv = cb[c] + cw[c] * v2[j] + cw[DFF2 + c] * v1[j] + cw[2 * DFF2 + c] * v0[j];
                        const float cgt = cb[DFF + c] + cw[DFF + c] * gg2[j] + cw[DFF2 + DFF + c] * gg1[j] + cw[2 * DFF2 + DFF + c] * g0[j];
                        o[j] = cv * cgt * frcp(1.0f + fexp(-cgt));
                    }
                    u32x4 w; w.x = cvt_pk_bf16(o[0], o[1]); w.y = cvt_pk_bf16(o[2], o[3]); w.z = cvt_pk_bf16(o[4], o[5]); w.w = cvt_pk_bf16(o[6], o[7]);
                    *(u32x4*)(H + (size_t)(pm * 256 + rr) * DFF + c0) = w;
                }
            }
        }
        LOCAL_SEAM;
        if (PHASE_ON) { PH_VARS
            unsigned char* lb = ws + WS_LAYER + layer * LAYER_STRIDE;
            pg8::SchedStd S; S.init(ws + WS_H, 256u * DFF * 2, lb + LO_WDN, 256u * DFF * 2, 128, 4, G, bid);
            pg8::EpiResid E{nullptr, XB, SSQ};
            pg8::gemm_phase(lds, xl, DFF, DFF, DFF, S, E);
        }
        PHASE_END;
    }

    if (PHASE_ON) { PH_VARS
        for (int m4 = gw; m4 < MTOK / 4; m4 += NGW) {
            const f32x4* gr = (const f32x4*)ap->in[6] + lane;
            f32x4 v[4][4]; float sq[4];
#pragma unroll
            for (int r = 0; r < 4; ++r)
#pragma unroll
                for (int j = 0; j < 4; ++j) { const u32x2 o = *((const u32x2*)(XB + (size_t)(m4 * 4 + r) * DM) + lane + 64 * j); v[r][j] = (f32x4){bflo(o.x), bfhi(o.x), bflo(o.y), bfhi(o.y)}; }
#pragma unroll
            for (int r = 0; r < 4; ++r) { sq[r] = 0.f;
#pragma unroll
                for (int j = 0; j < 4; ++j) sq[r] += (v[r][j].x * v[r][j].x + v[r][j].y * v[r][j].y) + (v[r][j].z * v[r][j].z + v[r][j].w * v[r][j].w); }
#pragma unroll
            for (int r = 0; r < 4; ++r) sq[r] = 1.f / sqrtf(wave_sum(sq[r]) * (1.f / DM) + EPS);
#pragma unroll
            for (int j = 0; j < 4; ++j) { const f32x4 gg = gr[64 * j];
#pragma unroll
                for (int r = 0; r < 4; ++r) *((f32x4*)(X + (size_t)(m4 * 4 + r) * DM) + lane + 64 * j) = v[r][j] * sq[r] * gg; }
        }
    }
#undef PHASE_ON
#undef PHASE_END
}

constexpr int N_PHASES = 4 + 7 + 5 + 7 + 1;

extern "C" void kernel_launch(void* const* d_in, const int* in_sizes, int n_in, void* d_out, int out_size, void* d_ws, size_t ws_size, hipStream_t stream) {
    static int grid = 0;
    if (grid == 0) {
        if (n_in != 28 || in_sizes[0] != MTOK * DM || out_size != MTOK * DM || ws_size < WS_END) {
            fprintf(stderr, "kernel_launch: unexpected shapes (n_in %d, in0 %d, out %d, ws %zu); nothing launched\n", n_in, n_in > 0 ? in_sizes[0] : -1, out_size, ws_size); grid = -1; return; }
        int dev = 0, cus = 0, per_cu = 0;
        if (hipGetDevice(&dev) != hipSuccess || hipDeviceGetAttribute(&cus, hipDeviceAttributeMultiprocessorCount, dev) != hipSuccess) { grid = -1; return; }
        if (hipFuncSetAttribute((const void*)mega_fwd, hipFuncAttributeMaxDynamicSharedMemorySize, LDS_BYTES) != hipSuccess) { fprintf(stderr, "kernel_launch: hipFuncSetAttribute failed\n"); grid = -1; return; }
        if (hipOccupancyMaxActiveBlocksPerMultiprocessor(&per_cu, (const void*)mega_fwd, 512, LDS_BYTES) != hipSuccess || per_cu < 1) per_cu = 1;
        (void)hipGetLastError();
        grid = cus * per_cu;
    }
    if (grid < 0) return;
    Args a{};
    for (int i = 0; i < 28; ++i) a.in[i] = (const float*)d_in[i];
    a.out = (float*)d_out; a.ws = (unsigned char*)d_ws;
#if MK_MULTI_LAUNCH
    for (int p = 0; p < N_PHASES; ++p) {
        a.ph_lo = p; a.ph_hi = p + 1;
        hipLaunchKernelGGL(mega_fwd, dim3(grid), dim3(512), LDS_BYTES, stream, a);
    }
#else
    a.ph_lo = 0; a.ph_hi = N_PHASES;
    if (hipMemsetAsync(d_ws, 0, 16384, stream) != hipSuccess) { fprintf(stderr, "kernel_launch: memset of the barrier words failed\n"); return; }
    void* args[] = {&a};
    hipError_t e = hipLaunchCooperativeKernel((const void*)mega_fwd, dim3(grid), dim3(512), args, LDS_BYTES, stream);
    if (e != hipSuccess) fprintf(stderr, "cooperative launch failed: %s (grid %d)\n", hipGetErrorString(e), grid);
#endif
}
```

```cpp
#include <hip/hip_runtime.h>
#include <hip/hip_cooperative_groups.h>
#include <cstdio>
#include <cstdint>
namespace cg = cooperative_groups;

#ifndef MK_MULTI_LAUNCH
#define MK_MULTI_LAUNCH 0
#endif

#define LAS __attribute__((address_space(3)))
typedef unsigned short bf16_t;
typedef short bf16x8 __attribute__((ext_vector_type(8)));
typedef short s16x4 __attribute__((ext_vector_type(4)));
typedef float f32x4 __attribute__((ext_vector_type(4)));
typedef float f32x16 __attribute__((ext_vector_type(16)));
typedef unsigned u32x4 __attribute__((ext_vector_type(4)));
typedef unsigned u32x2 __attribute__((ext_vector_type(2)));

constexpr int MTOK = 32768, DM = 1024, SEQ = 2048, NBATCH = 16, DFF = 2816, DFF2 = 5632, MEMTOK = 4096;
constexpr int MHALF = 16384;
constexpr float EPS = 1e-6f;
constexpr float LOG2E = 1.4426950408889634f, LN2 = 0.6931471805599453f;

constexpr size_t MiB = 1u << 20;
constexpr size_t WS_SSQ = 1 * MiB;
constexpr size_t WS_WIN = 5 * MiB;
constexpr size_t WS_WOUT = 9 * MiB;
constexpr size_t WS_WSSM = 11 * MiB;
constexpr size_t WS_WGLU = 13 * MiB;
constexpr size_t WS_LAYER = 17 * MiB, LAYER_STRIDE = 25 * MiB;
constexpr size_t LO_WQ = 0, LO_WKV = 2 * MiB, LO_WO = 6 * MiB, LO_WUP = 8 * MiB, LO_WDN = 19 * MiB;
constexpr size_t WS_WEND = 67 * MiB;
constexpr size_t WS_TG = 83 * MiB;
constexpr size_t WS_MEMN = 123 * MiB;
constexpr size_t WS_MEMK = 131 * MiB;
constexpr size_t WS_MEMVT = 147 * MiB, MEMVT_STRIDE = 9 * MiB;
constexpr size_t WS_XB = 165 * MiB;
constexpr size_t WS_T = 229 * MiB;
constexpr size_t WS_QKU = WS_T, WS_VT = WS_T + 96 * MiB, WS_CAT = WS_T + 132 * MiB;
constexpr int VT_LD = MTOK + 128, MVT_LD = 4096 + 128;
constexpr size_t WS_QX = WS_T, WS_P = WS_T + 64 * MiB, WS_O = WS_T + 128 * MiB;
constexpr size_t WS_H = WS_T, WS_HALO = WS_T + 176 * MiB;
constexpr size_t WS_UG = WS_T, WS_HEND = WS_T + 80 * MiB, WS_YG = WS_T + 112 * MiB;
constexpr size_t WS_GT = 426 * MiB;
constexpr size_t WS_END = 512 * MiB;
static_assert(WS_H + (size_t)MTOK * DFF * 2 <= WS_HALO && WS_HALO + (size_t)128 * 4 * DFF2 * 2 <= WS_GT && WS_CAT + (size_t)MTOK * DM * 2 <= WS_GT && WS_GT + 64 * MiB <= WS_END, "ws map");

typedef float f32x2_t __attribute__((ext_vector_type(2))); typedef __bf16 bf16x2_t __attribute__((ext_vector_type(2)));
__device__ __forceinline__ unsigned cvt_pk_bf16(float lo, float hi) { f32x2_t v = {lo, hi}; bf16x2_t b = __builtin_convertvector(v, bf16x2_t); return __builtin_bit_cast(unsigned, b); }
__device__ __forceinline__ float bf2f(unsigned short b) { return __uint_as_float(((unsigned)b) << 16); }
__device__ __forceinline__ float bflo(unsigned w) { return __uint_as_float(w << 16); }
__device__ __forceinline__ float bfhi(unsigned w) { return __uint_as_float(w & 0xffff0000u); }
__device__ __forceinline__ float fexp2(float x) { return __builtin_amdgcn_exp2f(x); }
__device__ __forceinline__ float flog2(float x) { return __builtin_amdgcn_logf(x); }
__device__ __forceinline__ float fexp(float x) { return __builtin_amdgcn_exp2f(x * LOG2E); }
__device__ __forceinline__ float frcp(float x) { return __builtin_amdgcn_rcpf(x); }
template <int M> __device__ __forceinline__ float swz_xor(float v) { return __int_as_float(__builtin_amdgcn_ds_swizzle(__float_as_int(v), (M << 10) | 0x1f)); }
__device__ __forceinline__ float sum_x16(float v) { auto r = __builtin_amdgcn_permlane16_swap(__float_as_uint(v), __float_as_uint(v), false, false); return __uint_as_float(r[0]) + __uint_as_float(r[1]); }
__device__ __forceinline__ float sum_x32(float v) { auto r = __builtin_amdgcn_permlane32_swap(__float_as_uint(v), __float_as_uint(v), false, false); return __uint_as_float(r[0]) + __uint_as_float(r[1]); }
__device__ __forceinline__ float max_x16(float v) { auto r = __builtin_amdgcn_permlane16_swap(__float_as_uint(v), __float_as_uint(v), false, false); return fmaxf(__uint_as_float(r[0]), __uint_as_float(r[1])); }
__device__ __forceinline__ float max_x32(float v) { auto r = __builtin_amdgcn_permlane32_swap(__float_as_uint(v), __float_as_uint(v), false, false); return fmaxf(__uint_as_float(r[0]), __uint_as_float(r[1])); }
__device__ __forceinline__ float partner32(float v, int hi) { auto r = __builtin_amdgcn_permlane32_swap(__float_as_uint(v), __float_as_uint(v), false, false); return hi ? __uint_as_float(r[0]) : __uint_as_float(r[1]); }
__device__ __forceinline__ float wave_sum(float v) {
    v += swz_xor<1>(v); v += swz_xor<2>(v); v += swz_xor<4>(v); v += swz_xor<8>(v); v = sum_x16(v); v = sum_x32(v);
    return v;
}
#define LDS_WAIT() asm volatile("s_waitcnt lgkmcnt(0)" ::: "memory")

namespace pg8 {
constexpr int BM = 256, BK = 64, HALF = 128, HTB = HALF * BK * 2, STAGE_BYTES = 8 * HTB, NXCD = 8, WGM = 8;
__host__ __device__ __forceinline__ int lds_byte(int r, int c) { const int st = (r >> 4) * 2 + (c >> 5), rr = r & 15, cc = c & 31, ob = rr * 64 + cc * 2; return st * 1024 + (ob ^ (((ob >> 9) & 1) << 5)); }
__host__ __device__ __forceinline__ void stage_rc(int b, int& R, int& C) { const int st = b / 1024, sb = b % 1024, swz = sb ^ (((sb >> 9) & 1) << 5); R = (st >> 1) * 16 + swz / 64; C = (st & 1) * 32 + (swz % 64) / 2; }
__host__ __device__ __forceinline__ int perm32(int rho) { const int n = rho >> 4, i = rho & 15; return 8 * (i >> 2) + 4 * n + (i & 3); }

struct Unit { int pm, pn; const char* a; const char* b; };

struct SchedStd {
    const char* A; const char* B; unsigned sA, sB; int nM, nN, G, c;
    __device__ __forceinline__ void init(const void* A_, unsigned sA_, const void* B_, unsigned sB_, int nM_, int nN_, int G_, int c_) { A = (const char*)A_; B = (const char*)B_; sA = sA_; sB = sB_; nM = nM_; nN = nN_; G = G_; c = c_; }
    __device__ __forceinline__ bool next(int i, Unit& u) const {
        const int nwg = nM * nN; const long L = (long)i * G + c; if (L >= nwg) return false;
        int wgid = (int)L; { const int q = nwg / NXCD, r = nwg % NXCD, xcd = wgid % NXCD, off = wgid / NXCD; wgid = (xcd < r ? xcd * (q + 1) : r * (q + 1) + (xcd - r) * q) + off; }
        const int nig = WGM * nN, gid = wgid / nig, fm = gid * WGM, gsz = (nM - fm) < WGM ? (nM - fm) : WGM;
        u.pm = fm + ((wgid % nig) % gsz); u.pn = (wgid % nig) / gsz;
        u.a = A + (size_t)u.pm * sA; u.b = B + (size_t)u.pn * sB; return true;
    }
};
struct SchedXS {
    const char* A; const char* B; int G, c;
    __device__ __forceinline__ bool next(int i, Unit& u) const {
        const long L = (long)i * G + c; if (L >= 512) return false;
        u.pm = (int)(L >> 2); u.pn = (int)(L & 3);
        u.a = A + (size_t)u.pm * 256 * 2048 + u.pn * 512; u.b = B + (size_t)(u.pm >> 3) * 256 * 2048 + u.pn * 512; return true;
    }
};
struct SchedXQ {
    const char* A; const char* B; int G, c;
    __device__ __forceinline__ bool next(int i, Unit& u) const {
        const long L = (long)i * G + c; if (L >= 512) return false;
        u.pm = (int)(L >> 2); u.pn = (int)(L & 3);
        u.a = A + (size_t)u.pm * 256 * 2048; u.b = B + (size_t)u.pn * 256 * 2048; return true;
    }
};
struct SchedG {
    const char* MK; const char* WQ; int G, c;
    __device__ __forceinline__ bool next(int i, Unit& u) const {
        const long L = (long)i * G + c; if (L >= 512) return false;
        const int l = (int)(L >> 8), r = (int)(L & 255), b = r >> 4, h = (r >> 2) & 3, pn = r & 3;
        u.pm = l * 64 + b * 4 + h; u.pn = pn;
        u.a = MK + (size_t)l * 8 * 1048576 + (size_t)b * 256 * 2048 + h * 512; u.b = WQ + (size_t)l * LAYER_STRIDE + (size_t)pn * 256 * 2048 + h * 512; return true;
    }
};
struct SchedXS2 {
    const char* A; const char* B; int G, c;
    __device__ __forceinline__ bool next(int i, Unit& u) const {
        const long L = (long)i * G + c; if (L >= 512) return false;
        u.pm = (int)(L >> 2); u.pn = (int)(L & 3);
        u.a = A + (size_t)u.pm * 256 * 2048; u.b = B + (size_t)((u.pm >> 3) * 4 + u.pn) * 256 * 2048; return true;
    }
};
struct SchedVW {
    const char* WO; const char* MV; int G, c;
    __device__ __forceinline__ bool next(int i, Unit& u) const {
        const long L = (long)i * G + c; if (L >= 256) return false;
        const int b = (int)(L >> 4), pq = (int)(L >> 2) & 3, h = (int)L & 3;
        u.pm = b * 4 + pq; u.pn = h;
        u.a = WO + (size_t)pq * 256 * 2048 + h * 512; u.b = MV + (size_t)b * 256 * 2048 + h * 512; return true;
    }
};
struct SchedXOut {
    const char* A; const char* B; int G, c;
    __device__ __forceinline__ bool next(int i, Unit& u) const {
        const long L = (long)i * G + c; if (L >= 512) return false;
        u.pm = (int)(L >> 2); u.pn = (int)(L & 3);
        u.a = A + (size_t)u.pm * 256 * 2048; u.b = B + ((size_t)(u.pm >> 3) * 1024 + (size_t)u.pn * 256) * 2048; return true;
    }
};
struct SchedXO {
    const char* A; const char* B; int G, c;
    __device__ __forceinline__ bool next(int i, Unit& u) const {
        const long L = (long)i * G + c; if (L >= 512) return false;
        u.pm = (int)(L >> 2); u.pn = (int)(L & 3);
        u.a = A + (size_t)u.pm * 256 * 2048 + u.pn * 512; u.b = B + (size_t)u.pn * 256 * (MVT_LD * 2) + (size_t)(u.pm >> 3) * 512; return true;
    }
};
struct SchedS2 {
    const char* A; const char* B; int G, c;
    __device__ __forceinline__ bool next(int i, Unit& u) const {
        const long L = (long)i * G + c; if (L >= 256) return false;
        u.pm = (int)L; u.pn = 0;
        u.a = A + (size_t)L * 256 * 1280; u.b = B + (size_t)(L >> 2) * 256 * 1024; return true;
    }
};
struct SchedS4 {
    const char* A; const char* B; int G, c;
    __device__ __forceinline__ bool next(int i, Unit& u) const {
        const long L = (long)i * G + c; if (L >= 512) return false;
        u.pm = (int)(L >> 1); u.pn = (int)(L & 1);
        u.a = A + (size_t)u.pm * 256 * 1280; u.b = B + ((size_t)(L >> 3) * 512 + (size_t)u.pn * 256) * 1280; return true;
    }
};

typedef f32x4 Acc[2][2][4][2];

__device__ __forceinline__ float row_rstd(const float* ssq_row, int nslots) {
    float s = 0.f;
    const f32x4* p = (const f32x4*)ssq_row;
    for (int i = 0; i < nslots / 4; ++i) { const f32x4 v = p[i]; s += (v[0] + v[1]) + (v[2] + v[3]); }
    return 1.0f / sqrtf(s * (1.0f / DM) + EPS);
}

struct EpiStore {
    static constexpr bool PERM = true;
    bf16_t* O; int ldc; const float* ssq; int nslots; float cs; int mode;
    __device__ __forceinline__ void operator()(Acc& acc, const Unit& u, int wr, int wc, int fr, int fq, LAS unsigned char* xl) const {
        const int row0 = u.pm * BM + wr * 64 + fr, col0 = u.pn * BM + wc * 32 + 8 * fq;
        LAS float* R = (LAS float*)xl;
        if (ssq) {
            const int wid = wr * 4 + wc, lane = fq * 16 + fr;
            if (lane < 32) R[wid * 32 + lane] = row_rstd(ssq + (size_t)(u.pm * BM + wid * 32 + lane) * 32, nslots);
            LDS_WAIT(); __builtin_amdgcn_s_barrier(); asm volatile("" ::: "memory");
        }
#pragma unroll
        for (int ai = 0; ai < 2; ++ai)
#pragma unroll
            for (int m = 0; m < 4; ++m) {
                const int row = row0 + ai * HALF + m * 16;
                float sc = cs;
                if (ssq) sc *= R[ai * HALF + wr * 64 + m * 16 + fr];
#pragma unroll
                for (int bj = 0; bj < 2; ++bj) {
                    const int col = col0 + bj * HALF;
                    const f32x4 v0 = acc[ai][bj][m][0] * sc, v1 = acc[ai][bj][m][1] * sc;
                    u32x4 w; w.x = cvt_pk_bf16(v0[0], v0[1]); w.y = cvt_pk_bf16(v0[2], v0[3]); w.z = cvt_pk_bf16(v1[0], v1[1]); w.w = cvt_pk_bf16(v1[2], v1[3]);
                    bf16_t* p = (mode == 0) ? O + (size_t)row * ldc + col
                                            : O + ((size_t)(col >> 4) * 1024 + (row >> 5)) * 640 + (row & 31) * 16 + (col & 15);
                    *(u32x4*)p = w;
                }
            }
    }
};

struct EpiResid {
    static constexpr bool PERM = true;
    const float* xf; bf16_t* xb; float* ssq;
    __device__ __forceinline__ void operator()(Acc& acc, const Unit& u, int wr, int wc, int fr, int fq, LAS unsigned char*) const {
        const int row0 = u.pm * BM + wr * 64 + fr, col0 = u.pn * BM + wc * 32 + 8 * fq;
#pragma unroll
        for (int ai = 0; ai < 2; ++ai)
#pragma unroll
            for (int m = 0; m < 4; ++m) {
                const int row = row0 + ai * HALF + m * 16; float q = 0.f;
#pragma unroll
                for (int bj = 0; bj < 2; ++bj) {
                    const int col = col0 + bj * HALF; const size_t off = (size_t)row * DM + col;
                    f32x4 v0, v1;
                    if (xf) { v0 = *(const f32x4*)(xf + off); v1 = *(const f32x4*)(xf + off + 4); }
                    else { const u32x4 o = *(const u32x4*)(xb + off); v0 = (f32x4){bflo(o.x), bfhi(o.x), bflo(o.y), bfhi(o.y)}; v1 = (f32x4){bflo(o.z), bfhi(o.z), bflo(o.w), bfhi(o.w)}; }
                    v0 += acc[ai][bj][m][0]; v1 += acc[ai][bj][m][1];
                    q += ((v0[0] * v0[0] + v0[1] * v0[1]) + (v0[2] * v0[2] + v0[3] * v0[3])) + ((v1[0] * v1[0] + v1[1] * v1[1]) + (v1[2] * v1[2] + v1[3] * v1[3]));
                    u32x4 w; w.x = cvt_pk_bf16(v0[0], v0[1]); w.y = cvt_pk_bf16(v0[2], v0[3]); w.z = cvt_pk_bf16(v1[0], v1[1]); w.w = cvt_pk_bf16(v1[2], v1[3]);
                    *(u32x4*)(xb + off) = w;
                }
                q = sum_x16(q); q = sum_x32(q);
                if (fq == 0) ssq[(size_t)row * 32 + u.pn * 4 + wc] = q;
            }
    }
};

struct EpiGlu {
    static constexpr bool PERM = true;
    bf16_t* xb; float* ssq;
    __device__ __forceinline__ void operator()(Acc& acc, const Unit& u, int wr, int wc, int fr, int fq, LAS unsigned char*) const {
        const int row0 = u.pm * BM + wr * 64 + fr, col0 = u.pn * HALF + wc * 32 + 8 * fq;
#pragma unroll
        for (int ai = 0; ai < 2; ++ai)
#pragma unroll
            for (int m = 0; m < 4; ++m) {
                const int row = row0 + ai * HALF + m * 16; const size_t off = (size_t)row * DM + col0;
                const u32x4 o = *(const u32x4*)(xb + off);
                float v[8] = {bflo(o.x), bfhi(o.x), bflo(o.y), bfhi(o.y), bflo(o.z), bfhi(o.z), bflo(o.w), bfhi(o.w)};
                float q = 0.f;
#pragma unroll
                for (int n = 0; n < 2; ++n) {
                    const f32x4 val = acc[ai][0][m][n], gt = acc[ai][1][m][n];
#pragma unroll
                    for (int j = 0; j < 4; ++j) { v[4 * n + j] += val[j] * frcp(1.0f + fexp(-gt[j])); q += v[4 * n + j] * v[4 * n + j]; }
                }
                u32x4 w; w.x = cvt_pk_bf16(v[0], v[1]); w.y = cvt_pk_bf16(v[2], v[3]); w.z = cvt_pk_bf16(v[4], v[5]); w.w = cvt_pk_bf16(v[6], v[7]);
                *(u32x4*)(xb + off) = w;
                q = sum_x16(q); q = sum_x32(q);
                if (fq == 0) ssq[(size_t)row * 32 + u.pn * 4 + wc] = q;
            }
    }
};

struct EpiSoftmax {
    static constexpr bool PERM = true;
    bf16_t* O; const float* ssq; int nslots; float cs;
    __device__ __forceinline__ void operator()(Acc& acc, const Unit& u, int wr, int wc, int fr, int fq, LAS unsigned char* xl) const {
        LAS float* tmax = (LAS float*)xl; LAS float* tsum = tmax + 1024; LAS float* R = tsum + 1024;
        { const int wid = wr * 4 + wc, lane = fq * 16 + fr;
          if (lane < 32) R[wid * 32 + lane] = row_rstd(ssq + (size_t)(u.pm * BM + wid * 32 + lane) * 32, nslots); }
        LDS_WAIT(); __builtin_amdgcn_s_barrier(); asm volatile("" ::: "memory");
#pragma unroll
        for (int ai = 0; ai < 2; ++ai)
#pragma unroll
            for (int m = 0; m < 4; ++m) {
                const float sc = cs * R[ai * HALF + wr * 64 + m * 16 + fr];
#pragma unroll
                for (int bj = 0; bj < 2; ++bj)
#pragma unroll
                    for (int n = 0; n < 2; ++n) acc[ai][bj][m][n] *= sc;
                float mx = -3.0e38f;
#pragma unroll
                for (int bj = 0; bj < 2; ++bj)
#pragma unroll
                    for (int n = 0; n < 2; ++n) { const f32x4 x = acc[ai][bj][m][n]; mx = fmaxf(mx, fmaxf(fmaxf(x[0], x[1]), fmaxf(x[2], x[3]))); }
                mx = max_x16(mx); mx = max_x32(mx);
                if (fq == 0) tmax[(ai * HALF + wr * 64 + m * 16 + fr) * 4 + wc] = mx;
            }
        LDS_WAIT(); __builtin_amdgcn_s_barrier(); asm volatile("" ::: "memory");
#pragma unroll
        for (int ai = 0; ai < 2; ++ai)
#pragma unroll
            for (int m = 0; m < 4; ++m) {
                const int r = ai * HALF + wr * 64 + m * 16 + fr;
                const f32x4 t = *(const LAS f32x4*)(tmax + r * 4);
                const float gm = fmaxf(fmaxf(t[0], t[1]), fmaxf(t[2], t[3])) * LOG2E; float s = 0.f;
#pragma unroll
                for (int bj = 0; bj < 2; ++bj)
#pragma unroll
                    for (int n = 0; n < 2; ++n) {
                        f32x4 x = acc[ai][bj][m][n];
#pragma unroll
                        for (int j = 0; j < 4; ++j) { x[j] = fexp2(x[j] * LOG2E - gm); s += x[j]; }
                        acc[ai][bj][m][n] = x;
                    }
                s = sum_x16(s); s = sum_x32(s);
                if (fq == 0) tsum[r * 4 + wc] = s;
            }
        LDS_WAIT(); __builtin_amdgcn_s_barrier(); asm volatile("" ::: "memory");
        const int row0 = u.pm * BM + wr * 64 + fr, col0 = u.pn * BM + wc * 32 + 8 * fq;
#pragma unroll
        for (int ai = 0; ai < 2; ++ai)
#pragma unroll
            for (int m = 0; m < 4; ++m) {
                const int r = ai * HALF + wr * 64 + m * 16 + fr;
                const f32x4 t = *(const LAS f32x4*)(tsum + r * 4);
                const float inv = 1.0f / ((t[0] + t[1]) + (t[2] + t[3]));
#pragma unroll
                for (int bj = 0; bj < 2; ++bj) {
                    const f32x4 v0 = acc[ai][bj][m][0] * inv, v1 = acc[ai][bj][m][1] * inv;
                    u32x4 w; w.x = cvt_pk_bf16(v0[0], v0[1]); w.y = cvt_pk_bf16(v0[2], v0[3]); w.z = cvt_pk_bf16(v1[0], v1[1]); w.w = cvt_pk_bf16(v1[2], v1[3]);
                    *(u32x4*)(O + (size_t)(row0 + ai * HALF + m * 16) * DM + col0 + bj * HALF) = w;
                }
            }
    }
};


__device__ __forceinline__ float dpp_ror1(float x) { return __int_as_float(__builtin_amdgcn_update_dpp(0, __float_as_int(x), 0x121, 0xf, 0xf, false)); }
__device__ __forceinline__ float dpp_ror2(float x) { return __int_as_float(__builtin_amdgcn_update_dpp(0, __float_as_int(x), 0x122, 0xf, 0xf, false)); }
__device__ __forceinline__ float dpp_ror1u(float x) { return __int_as_float(__builtin_amdgcn_mov_dpp(__float_as_int(x), 0x121, 0xf, 0xf, false)); }
__device__ __forceinline__ float dpp_ror2u(float x) { return __int_as_float(__builtin_amdgcn_mov_dpp(__float_as_int(x), 0x122, 0xf, 0xf, false)); }
__device__ __forceinline__ float dpp_shr1_old(float old, float x) { return __int_as_float(__builtin_amdgcn_update_dpp(__float_as_int(old), __float_as_int(x), 0x111, 0xf, 0xf, false)); }
__device__ __forceinline__ float dpp_shr2_old(float old, float x) { return __int_as_float(__builtin_amdgcn_update_dpp(__float_as_int(old), __float_as_int(x), 0x112, 0xf, 0xf, false)); }
struct EpiUpConv {
    static constexpr bool PERM = true;
    bf16_t* H; bf16_t* HALO; const float* ssq; const float* cw; const float* cb;
    __device__ __forceinline__ void operator()(Acc& acc, const Unit& u, int wr, int wc, int fr, int fq, LAS unsigned char* xl) const {
        LAS float* B = (LAS float*)xl;
        LAS float* Wl = B + 2048;
        LAS float* R = Wl + 1024;
        const int wid = wr * 4 + wc, lane = fq * 16 + fr, tid = wid * 64 + lane;
        const int row0 = u.pm * BM + wr * 64 + fr, colb = wc * 32 + 8 * fq, ch0 = u.pn * HALF + colb;
        {
#pragma unroll
            for (int i = 0; i < 2; ++i) { const int idx = tid + i * 512, t = idx >> 8, bj = (idx >> 7) & 1, chl = idx & 127;
                Wl[idx] = (t < 3) ? cw[t * DFF2 + bj * DFF + u.pn * HALF + chl] : cb[bj * DFF + u.pn * HALF + chl]; }
            if (lane < 32) R[wid * 32 + lane] = row_rstd(ssq + (size_t)(u.pm * BM + wid * 32 + lane) * 32, 16);
        }
        LDS_WAIT(); __builtin_amdgcn_s_barrier(); asm volatile("" ::: "memory");
#pragma unroll
        for (int ai = 0; ai < 2; ++ai)
#pragma unroll
            for (int m = 0; m < 4; ++m) {
                const float sc = R[ai * HALF + wr * 64 + m * 16 + fr];
#pragma unroll
                for (int bj = 0; bj < 2; ++bj)
#pragma unroll
                    for (int n = 0; n < 2; ++n) acc[ai][bj][m][n] *= sc;
            }
        if (fr >= 14) {
#pragma unroll
            for (int ai = 0; ai < 2; ++ai)
#pragma unroll
                for (int bj = 0; bj < 2; ++bj)
#pragma unroll
                    for (int n = 0; n < 2; ++n) *(LAS f32x4*)(B + ((ai * 2 + wr) * 2 + (fr - 14)) * 256 + bj * HALF + colb + 4 * n) = acc[ai][bj][3][n];
        }
        if (wr == 0 && fr < 2) {
#pragma unroll
            for (int bj = 0; bj < 2; ++bj) { const f32x4 v0 = acc[0][bj][0][0], v1 = acc[0][bj][0][1];
                u32x4 w; w.x = cvt_pk_bf16(v0[0], v0[1]); w.y = cvt_pk_bf16(v0[2], v0[3]); w.z = cvt_pk_bf16(v1[0], v1[1]); w.w = cvt_pk_bf16(v1[2], v1[3]);
                *(u32x4*)(HALO + (size_t)(u.pm * 4 + fr) * DFF2 + bj * DFF + ch0) = w; }
        }
        if (wr == 1 && fr >= 14) {
#pragma unroll
            for (int bj = 0; bj < 2; ++bj) { const f32x4 v0 = acc[1][bj][3][0], v1 = acc[1][bj][3][1];
                u32x4 w; w.x = cvt_pk_bf16(v0[0], v0[1]); w.y = cvt_pk_bf16(v0[2], v0[3]); w.z = cvt_pk_bf16(v1[0], v1[1]); w.w = cvt_pk_bf16(v1[2], v1[3]);
                *(u32x4*)(HALO + (size_t)(u.pm * 4 + 2 + (fr - 14)) * DFF2 + bj * DFF + ch0) = w; }
        }
        LDS_WAIT(); __builtin_amdgcn_s_barrier(); asm volatile("" ::: "memory");
#pragma unroll
        for (int ai = 0; ai < 2; ++ai) {
            const bool has = (wr == 1) || (ai == 1);
            const int sb = (wr == 1) ? (ai * 2) : 1;
#pragma unroll
            for (int n = 0; n < 2; ++n) {
                asm volatile("" ::: "memory");
                const int cl = colb + 4 * n;
                float hv[4][4];
                const f32x4 wv0 = *(const LAS f32x4*)(Wl + 0 * 128 + cl), wg0 = *(const LAS f32x4*)(Wl + 1 * 128 + cl);
                const f32x4 wv1 = *(const LAS f32x4*)(Wl + 2 * 128 + cl), wg1 = *(const LAS f32x4*)(Wl + 3 * 128 + cl);
                const f32x4 wv2 = *(const LAS f32x4*)(Wl + 4 * 128 + cl), wg2 = *(const LAS f32x4*)(Wl + 5 * 128 + cl);
                const f32x4 bvv = *(const LAS f32x4*)(Wl + 6 * 128 + cl), bgv = *(const LAS f32x4*)(Wl + 7 * 128 + cl);
                f32x4 b1v = (f32x4){0.f, 0.f, 0.f, 0.f}, b2v = b1v, b1g = b1v, b2g = b1v;
                if (has) {
                    b1v = *(const LAS f32x4*)(B + (sb * 2 + 1) * 256 + cl); b2v = *(const LAS f32x4*)(B + (sb * 2 + (fr & 1)) * 256 + cl);
                    b1g = *(const LAS f32x4*)(B + (sb * 2 + 1) * 256 + HALF + cl); b2g = *(const LAS f32x4*)(B + (sb * 2 + (fr & 1)) * 256 + HALF + cl);
                }
#pragma unroll
                for (int j = 0; j < 4; ++j) {
                    float r1p = b1v[j], r2p = b2v[j], q1p = b1g[j], q2p = b2g[j];
#pragma unroll
                    for (int m = 0; m < 4; ++m) {
                        const float xv = acc[ai][0][m][n][j], xg = acc[ai][1][m][n][j];
                        const float pv1 = dpp_shr1_old(r1p, xv), pv2 = dpp_shr2_old(r2p, xv), pg1 = dpp_shr1_old(q1p, xg), pg2 = dpp_shr2_old(q2p, xg);
                        const float cv = bvv[j] + wv0[j] * pv2 + wv1[j] * pv1 + wv2[j] * xv;
                        const float cg = bgv[j] + wg0[j] * pg2 + wg1[j] * pg1 + wg2[j] * xg;
                        hv[m][j] = cv * cg * frcp(1.0f + fexp(-cg));
                        if (m < 3) { r1p = dpp_ror1u(xv); r2p = dpp_ror2u(xv); q1p = dpp_ror1u(xg); q2p = dpp_ror2u(xg); }
                    }
                    __builtin_amdgcn_sched_barrier(0);
                }
#pragma unroll
                for (int m = 0; m < 4; ++m) {
                    u32x2 w; w.x = cvt_pk_bf16(hv[m][0], hv[m][1]); w.y = cvt_pk_bf16(hv[m][2], hv[m][3]);
                    *(u32x2*)(H + (size_t)(row0 + ai * HALF + m * 16) * DFF + ch0 + 4 * n) = w;
                }
            }
        }
    }
};

struct EpiHend {
    static constexpr bool PERM = false;
    float* Hout;
    __device__ __forceinline__ void operator()(Acc& acc, const Unit& u, int wr, int wc, int fr, int fq, LAS unsigned char*) const {
        const int row0 = u.pm * BM + wr * 64 + fr, col0 = wc * 32 + 4 * fq;
#pragma unroll
        for (int ai = 0; ai < 2; ++ai)
#pragma unroll
            for (int m = 0; m < 4; ++m)
#pragma unroll
                for (int n = 0; n < 2; ++n)
                    *(f32x4*)(Hout + (size_t)(row0 + ai * HALF + m * 16) * 128 + col0 + n * 16) = acc[ai][0][m][n];
    }
};

struct EpiSsmY {
    static constexpr bool PERM = true;
    const bf16_t* Ug; const float* Dskip; bf16_t* Yg;
    __device__ __forceinline__ void operator()(Acc& acc, const Unit& u, int wr, int wc, int fr, int fq, LAS unsigned char*) const {
        const int g = u.pm >> 2;
        const int rg0 = (u.pm & 3) * BM + wr * 64 + fr, col0 = u.pn * BM + wc * 32 + 8 * fq;
        const int co = col0 & 15;
        const f32x4 d0 = *(const f32x4*)(Dskip + g * 16 + co), d1 = *(const f32x4*)(Dskip + g * 16 + co + 4);
#pragma unroll
        for (int ai = 0; ai < 2; ++ai)
#pragma unroll
            for (int m = 0; m < 4; ++m) {
                const int rg = rg0 + ai * HALF + m * 16;
#pragma unroll
                for (int bj = 0; bj < 2; ++bj) {
                    const int col = col0 + bj * HALF;
                    const u32x4 uu = *(const u32x4*)(Ug + ((size_t)g * 1024 + rg) * 640 + col);
                    float y[8];
                    y[0] = acc[ai][bj][m][0][0] + d0[0] * bflo(uu.x); y[1] = acc[ai][bj][m][0][1] + d0[1] * bfhi(uu.x);
                    y[2] = acc[ai][bj][m][0][2] + d0[2] * bflo(uu.y); y[3] = acc[ai][bj][m][0][3] + d0[3] * bfhi(uu.y);
                    y[4] = acc[ai][bj][m][1][0] + d1[0] * bflo(uu.z); y[5] = acc[ai][bj][m][1][1] + d1[1] * bfhi(uu.z);
                    y[6] = acc[ai][bj][m][1][2] + d1[2] * bflo(uu.w); y[7] = acc[ai][bj][m][1][3] + d1[3] * bfhi(uu.w);
#pragma unroll
                    for (int j = 0; j < 8; ++j) { const float x = y[j]; const float k2 = 1.5957691216f * (x + 0.044715f * x * x * x); y[j] = x * frcp(1.0f + fexp(-k2)); }
                    u32x4 w; w.x = cvt_pk_bf16(y[0], y[1]); w.y = cvt_pk_bf16(y[2], y[3]); w.z = cvt_pk_bf16(y[4], y[5]); w.w = cvt_pk_bf16(y[6], y[7]);
                    const size_t tok = (size_t)rg * 32 + (col >> 4);
                    *(u32x4*)(Yg + tok * DM + g * 16 + co) = w;
                }
            }
    }
};

template <class Epi, class Sched>
__device__ __forceinline__ void gemm_phase(LAS unsigned char* lds, LAS unsigned char* xl, const int lda, const int ldb, const int K, const Sched& S, const Epi& E) {
    int tid_ = threadIdx.x; asm volatile("" : "+v"(tid_));
    const int tid = tid_, wid = __builtin_amdgcn_readfirstlane(tid >> 6), lane = tid & 63, wr = wid >> 2, wc = wid & 3, fr = lane & 15, fq = lane >> 4;
    const int nt = K / BK;
    unsigned voffA, voffB;
    { int R, C; stage_rc(tid * 16, R, C); const int Rb = Epi::PERM ? ((R & ~31) + perm32(R & 31)) : R;
      voffA = (unsigned)(R * lda + C) * 2u; voffB = (unsigned)(Rb * ldb + C) * 2u; }
    const size_t qstepA = (size_t)64 * lda * 2, qstepB = (size_t)64 * ldb * 2;
    const size_t kstep = (size_t)(BK * 2);
    const size_t hstepA = (size_t)HALF * lda * 2, hstepB = (size_t)HALF * ldb * 2;
    const unsigned ldsw = (unsigned)wid * 1024u;
    const int aoff = lds_byte(wr * 64 + fr, fq * 8), boff = lds_byte(wc * 32 + fr, fq * 8);
#define PG8_SA(b, h) (((b) * 2 + (h)) * HTB)
#define PG8_SB(b, h) ((4 + (b) * 2 + (h)) * HTB)
#define PG8_STAGE(bufoff, gbase, voff) do { _Pragma("unroll") for (int _i = 0; _i < 2; ++_i) \
        { const char* _gb = (const char*)(gbase) + (size_t)_i * q##voff; asm volatile("" : "+s"(_gb)); \
          __builtin_amdgcn_global_load_lds((const unsigned*)(_gb + (voff)), (LAS unsigned*)(lds + (bufoff) + ldsw + _i * 8192), 16, 0, 0); } } while (0)
#define qvoffA qstepA
#define qvoffB qstepB
#define PG8_LDA(dst, b, h) do { _Pragma("unroll") for (int m = 0; m < 4; ++m) _Pragma("unroll") for (int k = 0; k < 2; ++k) dst[m][k] = *(const LAS bf16x8*)(lds + PG8_SA(b, h) + aoff + m * 2048 + k * 1024); } while (0)
#define PG8_LDB(dst, b, h) do { _Pragma("unroll") for (int n = 0; n < 2; ++n) _Pragma("unroll") for (int k = 0; k < 2; ++k) dst[n][k] = *(const LAS bf16x8*)(lds + PG8_SB(b, h) + boff + n * 2048 + k * 1024); } while (0)
#define PG8_MMA(ai, bj, At, Bt) do { __builtin_amdgcn_s_setprio(1); _Pragma("unroll") for (int m = 0; m < 4; ++m) _Pragma("unroll") for (int n = 0; n < 2; ++n) _Pragma("unroll") for (int k = 0; k < 2; ++k) \
        acc[ai][bj][m][n] = __builtin_amdgcn_mfma_f32_16x16x32_bf16(Bt[n][k], At[m][k], acc[ai][bj][m][n], 0, 0, 0); __builtin_amdgcn_s_setprio(0); } while (0)
#define PG8_WAIT_V(n) asm volatile("s_waitcnt vmcnt(" #n ")" ::: "memory")
#define PG8_WAIT_L(n) asm volatile("s_waitcnt lgkmcnt(" #n ")" ::: "memory")
#define PG8_BAR __builtin_amdgcn_s_barrier()
#define PG8_SCHED __builtin_amdgcn_sched_barrier(0)
    Unit cur, nxt; int ui = 0;
    if (!S.next(0, cur)) return;
    Acc acc;
#pragma unroll
    for (int a = 0; a < 2; ++a)
#pragma unroll
        for (int b = 0; b < 2; ++b)
#pragma unroll
            for (int m = 0; m < 4; ++m)
#pragma unroll
                for (int n = 0; n < 2; ++n) acc[a][b][m][n] = (f32x4){0.f, 0.f, 0.f, 0.f};
    bf16x8 At[4][2], B0[2][2], B1[2][2];
    const char* cA = cur.a; const char* cB = cur.b;
    PG8_STAGE(PG8_SB(0, 0), cB, voffB); PG8_STAGE(PG8_SB(0, 1), cB + hstepB, voffB); PG8_STAGE(PG8_SA(0, 0), cA, voffA); PG8_STAGE(PG8_SA(0, 1), cA + hstepA, voffA);
    if (wr == 1) PG8_BAR;
    PG8_WAIT_V(2); PG8_BAR;
    PG8_STAGE(PG8_SB(1, 0), cB + kstep, voffB); PG8_STAGE(PG8_SA(1, 0), cA + kstep, voffA); PG8_STAGE(PG8_SB(1, 1), cB + hstepB + kstep, voffB);
    PG8_WAIT_V(6); PG8_BAR;
    for (;;) {
        const bool has_next = S.next(ui + 1, nxt);
        const char* nA = has_next ? nxt.a : cA; const char* nB = has_next ? nxt.b : cB;
        for (int t = 0; t < nt; t += 2) {
            const bool last = (t == nt - 2);
            const char* a1 = cA + (size_t)(t + 1) * kstep;
            const char* a2 = last ? nA : cA + (size_t)(t + 2) * kstep; const char* b2 = last ? nB : cB + (size_t)(t + 2) * kstep;
            const char* a3 = a2 + kstep; const char* b3 = b2 + kstep;
            PG8_LDB(B0, 0, 0); PG8_LDB(B1, 0, 1); PG8_SCHED; PG8_LDA(At, 0, 0); PG8_STAGE(PG8_SA(1, 1), a1 + hstepA, voffA);
            PG8_WAIT_V(8); PG8_WAIT_L(0); PG8_BAR; PG8_MMA(0, 0, At, B0); PG8_MMA(0, 1, At, B1); PG8_BAR; PG8_SCHED;
            PG8_LDA(At, 0, 1); PG8_STAGE(PG8_SB(0, 0), b2, voffB); PG8_STAGE(PG8_SB(0, 1), b2 + hstepB, voffB); PG8_STAGE(PG8_SA(0, 0), a2, voffA);
            PG8_WAIT_V(8); PG8_WAIT_L(0); PG8_BAR; PG8_MMA(1, 0, At, B0); PG8_MMA(1, 1, At, B1); PG8_BAR; PG8_SCHED;
            PG8_LDB(B0, 1, 0); PG8_LDB(B1, 1, 1); PG8_SCHED; PG8_LDA(At, 1, 0); PG8_STAGE(PG8_SA(0, 1), a2 + hstepA, voffA);
            PG8_WAIT_V(8); PG8_WAIT_L(0); PG8_BAR; PG8_MMA(0, 0, At, B0); PG8_MMA(0, 1, At, B1); PG8_BAR; PG8_SCHED;
            PG8_LDA(At, 1, 1); PG8_STAGE(PG8_SB(1, 0), b3, voffB); PG8_STAGE(PG8_SB(1, 1), b3 + hstepB, voffB); PG8_STAGE(PG8_SA(1, 0), a3, voffA);
            PG8_WAIT_V(8); PG8_WAIT_L(0); PG8_BAR; PG8_MMA(1, 0, At, B0); PG8_MMA(1, 1, At, B1); PG8_BAR; PG8_SCHED;
        }
        if (wr == 0) PG8_BAR;
        __builtin_amdgcn_sched_barrier(0); asm volatile("s_nop 15\n\ts_nop 15\n\ts_nop 15" ::: "memory"); __builtin_amdgcn_sched_barrier(0);
        { int t2 = threadIdx.x; asm volatile("" : "+v"(t2)); E(acc, cur, wr, wc, t2 & 15, (t2 >> 4) & 3, xl); }
        if (!has_next) break;
#pragma unroll
        for (int a = 0; a < 2; ++a)
#pragma unroll
            for (int b = 0; b < 2; ++b)
#pragma unroll
                for (int m = 0; m < 4; ++m)
#pragma unroll
                    for (int n = 0; n < 2; ++n) acc[a][b][m][n] = (f32x4){0.f, 0.f, 0.f, 0.f};
        cur = nxt; cA = nA; cB = nB; ++ui;
        if (wr == 1) PG8_BAR;
    }
    PG8_WAIT_V(0);
    PG8_BAR;
#undef PG8_SA
#undef PG8_SB
#undef PG8_STAGE
#undef qvoffA
#undef qvoffB
#undef PG8_LDA
#undef PG8_LDB
#undef PG8_MMA
#undef PG8_WAIT_V
#undef PG8_WAIT_L
#undef PG8_BAR
#undef PG8_SCHED
}
}

constexpr int RING_BYTES = 131072, XL_OFF = RING_BYTES, XBST_OFF = XL_OFF + 14336, LDS_BYTES = 147456;

struct TItem { const float* W; const float* gk; bf16_t* D; int N, ldt, drow0, k0, n0; };
__device__ __forceinline__ void titem_load(float (&v)[32], const TItem& t, int lane) {
#pragma unroll
    for (int i = 0; i < 32; ++i) { const int kk = 2 * i + (lane >> 5); v[i] = t.W[(size_t)(t.k0 + kk) * t.N + t.n0 + (lane & 31)]; }
}
__device__ __forceinline__ void titem_to_lds(const float (&v)[32], LAS float* scr, int lane) {
#pragma unroll
    for (int i = 0; i < 32; ++i) { const int kk = 2 * i + (lane >> 5); scr[kk * 33 + (lane & 31)] = v[i]; }
    LDS_WAIT(); asm volatile("" ::: "memory");
}
__device__ __forceinline__ void titem_store(const TItem& t, LAS float* scr, int lane) {
    const int c = lane & 7;
    f32x4 g0 = (f32x4){1.f, 1.f, 1.f, 1.f}, g1 = g0;
    if (t.gk) { g0 = *(const f32x4*)(t.gk + t.k0 + 8 * c); g1 = *(const f32x4*)(t.gk + t.k0 + 8 * c + 4); }
#pragma unroll
    for (int j = 0; j < 4; ++j) { const int n = (lane >> 3) + 8 * j; const LAS float* s = scr + (8 * c) * 33 + n;
        u32x4 o; o.x = cvt_pk_bf16(s[0 * 33] * g0[0], s[1 * 33] * g0[1]); o.y = cvt_pk_bf16(s[2 * 33] * g0[2], s[3 * 33] * g0[3]);
        o.z = cvt_pk_bf16(s[4 * 33] * g1[0], s[5 * 33] * g1[1]); o.w = cvt_pk_bf16(s[6 * 33] * g1[2], s[7 * 33] * g1[3]);
        *(u32x4*)(t.D + (size_t)(t.drow0 + n) * t.ldt + t.k0 + 8 * c) = o; }
    LDS_WAIT(); asm volatile("" ::: "memory");
}
__device__ __forceinline__ void rms_row_to_bf16(const float* xrow, const float* g, bf16_t* orow, int lane) {
    const f32x4* xr = (const f32x4*)xrow + lane; const f32x4* gr = (const f32x4*)g + lane;
    f32x4 v[4]; float s = 0.f;
#pragma unroll
    for (int j = 0; j < 4; ++j) { v[j] = xr[64 * j]; s += (v[j].x * v[j].x + v[j].y * v[j].y) + (v[j].z * v[j].z + v[j].w * v[j].w); }
    const float rstd = 1.f / sqrtf(wave_sum(s) * (1.f / DM) + EPS);
    u32x2* o8 = (u32x2*)orow + lane;
#pragma unroll
    for (int j = 0; j < 4; ++j) { const f32x4 gg = gr[64 * j]; u32x2 w; w.x = cvt_pk_bf16(v[j].x * rstd * gg.x, v[j].y * rstd * gg.y); w.y = cvt_pk_bf16(v[j].z * rstd * gg.z, v[j].w * rstd * gg.w); o8[64 * j] = w; }
}

__device__ __forceinline__ void rms_rows4_to_bf16(const float* xrow, const float* g, bf16_t* orow, int lane) {
    f32x4 v[4][4]; float s[4];
#pragma unroll
    for (int r = 0; r < 4; ++r)
#pragma unroll
        for (int j = 0; j < 4; ++j) v[r][j] = *((const f32x4*)(xrow + (size_t)r * DM) + lane + 64 * j);
#pragma unroll
    for (int r = 0; r < 4; ++r) { s[r] = 0.f;
#pragma unroll
        for (int j = 0; j < 4; ++j) s[r] += (v[r][j].x * v[r][j].x + v[r][j].y * v[r][j].y) + (v[r][j].z * v[r][j].z + v[r][j].w * v[r][j].w); }
#pragma unroll
    for (int r = 0; r < 4; ++r) s[r] = 1.f / sqrtf(wave_sum(s[r]) * (1.f / DM) + EPS);
#pragma unroll
    for (int j = 0; j < 4; ++j) { const f32x4 gg = *((const f32x4*)g + lane + 64 * j);
#pragma unroll
        for (int r = 0; r < 4; ++r) { u32x2 w; w.x = cvt_pk_bf16(v[r][j].x * s[r] * gg.x, v[r][j].y * s[r] * gg.y); w.y = cvt_pk_bf16(v[r][j].z * s[r] * gg.z, v[r][j].w * s[r] * gg.w);
            *((u32x2*)(orow + (size_t)r * DM) + lane + 64 * j) = w; } }
}

struct Args { const float* in[28]; float* out; unsigned char* ws; int ph_lo, ph_hi; };
typedef const __attribute__((address_space(4))) Args* KArgs;
__device__ __forceinline__ KArgs kargs() { KArgs p = (KArgs)__builtin_amdgcn_kernarg_segment_ptr(); asm volatile("" : "+s"(p)); return p; }

__device__ __forceinline__ void ssm_tables(KArgs ap, int g, LAS unsigned char* lds, bf16_t* Tg, bf16_t* Wend) {
    LAS float* Lre = (LAS float*)lds;
    LAS float* Lim = Lre + 33 * 64;
    LAS float* Bre = Lim + 33 * 64;
    LAS float* Bim = Bre + 1024;
    LAS float* Cre = Bim + 1024;
    LAS float* Cim = Cre + 1024;
    LAS float* Kern = Cim + 1024;
    const int tid = threadIdx.x;
    const float* lam_re = ap->in[12] + g * 64; const float* lam_im = ap->in[13] + g * 64;
    const float dt = expf(ap->in[14][g]);
    for (int idx = tid; idx < 33 * 64; idx += 512) {
        const int tau = idx >> 6, p = idx & 63;
        const float mag = expf((float)tau * (lam_re[p] * dt)); const float ang = (float)tau * (lam_im[p] * dt);
        Lre[idx] = mag * cosf(ang); Lim[idx] = mag * sinf(ang);
    }
    __syncthreads();
    for (int idx = tid; idx < 1024; idx += 512) {
        {
            const int p = idx >> 4;
            const float lr = lam_re[p], li = lam_im[p], lbr = Lre[64 + p], lbi = Lim[64 + p];
            const float nre = lbr - 1.0f, den = lr * lr + li * li;
            const float cr = (nre * lr + lbi * li) / den, ci = (lbi * lr - nre * li) / den;
            const float br = ap->in[15][(size_t)g * 1024 + idx], bi = ap->in[16][(size_t)g * 1024 + idx];
            Bre[idx] = cr * br - ci * bi; Bim[idx] = cr * bi + ci * br;
        }
        Cre[idx] = ap->in[17][(size_t)g * 1024 + idx]; Cim[idx] = ap->in[18][(size_t)g * 1024 + idx];
    }
    __syncthreads();
    {
        const int tau = tid >> 4, co = tid & 15; float kacc[16];
#pragma unroll
        for (int ci = 0; ci < 16; ++ci) kacc[ci] = 0.f;
        for (int p = 0; p < 64; ++p) {
            const float cr = Cre[co * 64 + p], cim = Cim[co * 64 + p], lr = Lre[tau * 64 + p], li = Lim[tau * 64 + p];
            const float gr = cr * lr - cim * li, gi = cr * li + cim * lr;
#pragma unroll
            for (int q = 0; q < 4; ++q) { const f32x4 br = *(const LAS f32x4*)(Bre + p * 16 + 4 * q), bi = *(const LAS f32x4*)(Bim + p * 16 + 4 * q);
#pragma unroll
                for (int e = 0; e < 4; ++e) kacc[4 * q + e] += gr * br[e] - gi * bi[e]; }
        }
#pragma unroll
        for (int ci = 0; ci < 16; ++ci) Kern[tid * 16 + ci] = kacc[ci];
    }
    __syncthreads();
    bf16_t* T = Tg + (size_t)g * 512 * 640;
    for (int idx = tid; idx < 512 * 80; idx += 512) {
        const int n = idx / 80, k8 = (idx % 80) * 8; const int t = n >> 4, co = n & 15;
        float v[8];
        if (k8 < 512) { const int s = k8 >> 4, ci = k8 & 15;
#pragma unroll
            for (int j = 0; j < 8; ++j) v[j] = (s <= t) ? Kern[((t - s) * 16 + co) * 16 + ci + j] : 0.f;
        } else { const int q = k8 - 512, im = q >> 6, p0 = q & 63;
#pragma unroll
            for (int j = 0; j < 8; ++j) { const int p = p0 + j; const float cr = Cre[co * 64 + p], cim = Cim[co * 64 + p], lr = Lre[(t + 1) * 64 + p], li = Lim[(t + 1) * 64 + p];
                v[j] = im ? -(cr * li + cim * lr) : (cr * lr - cim * li); }
        }
        u32x4 w; w.x = cvt_pk_bf16(v[0], v[1]); w.y = cvt_pk_bf16(v[2], v[3]); w.z = cvt_pk_bf16(v[4], v[5]); w.w = cvt_pk_bf16(v[6], v[7]);
        *(u32x4*)(T + (size_t)n * 640 + k8) = w;
    }
    bf16_t* We = Wend + (size_t)g * 256 * 512;
    for (int idx = tid; idx < 256 * 64; idx += 512) {
        const int j = idx >> 6, k8 = (idx & 63) * 8; float v[8];
        if (j < 128) { const int p = j & 63, im = j >> 6, s = k8 >> 4, ci = k8 & 15; const float lr = Lre[(31 - s) * 64 + p], li = Lim[(31 - s) * 64 + p];
#pragma unroll
            for (int e = 0; e < 8; ++e) { const float br = Bre[p * 16 + ci + e], bi = Bim[p * 16 + ci + e]; v[e] = im ? (lr * bi + li * br) : (lr * br - li * bi); }
        } else {
#pragma unroll
            for (int e = 0; e < 8; ++e) v[e] = 0.f;
        }
        u32x4 w; w.x = cvt_pk_bf16(v[0], v[1]); w.y = cvt_pk_bf16(v[2], v[3]); w.z = cvt_pk_bf16(v[4], v[5]); w.w = cvt_pk_bf16(v[6], v[7]);
        *(u32x4*)(We + (size_t)j * 512 + k8) = w;
    }
    __syncthreads();
}


template <int W> __device__ __forceinline__ u32x4 pool_item(const bf16_t* up, int t) {
    const int cnt = (t + 1 < W) ? t + 1 : W;
    u32x4 v[W];
#pragma unroll
    for (int i = 0; i < W; ++i) v[i] = (i < cnt) ? *(const u32x4*)(up - (size_t)i * 1536) : (u32x4){0u, 0u, 0u, 0u};
    float s[8];
#pragma unroll
    for (int j = 0; j < 8; ++j) s[j] = 0.f;
#pragma unroll
    for (int i = 0; i < W; ++i) { s[0] += bflo(v[i].x); s[1] += bfhi(v[i].x); s[2] += bflo(v[i].y); s[3] += bfhi(v[i].y); s[4] += bflo(v[i].z); s[5] += bfhi(v[i].z); s[6] += bflo(v[i].w); s[7] += bfhi(v[i].w); }
    const float inv = 1.0f / (float)cnt;
    u32x4 w; w.x = cvt_pk_bf16(s[0] * inv - bflo(v[0].x), s[1] * inv - bfhi(v[0].x)); w.y = cvt_pk_bf16(s[2] * inv - bflo(v[0].y), s[3] * inv - bfhi(v[0].y));
    w.z = cvt_pk_bf16(s[4] * inv - bflo(v[0].z), s[5] * inv - bfhi(v[0].z)); w.w = cvt_pk_bf16(s[6] * inv - bflo(v[0].w), s[7] * inv - bfhi(v[0].w));
    return w;
}

__device__ __forceinline__ void bf8_to_f(const u32x4 v, float (&f)[8]) { f[0] = bflo(v.x); f[1] = bfhi(v.x); f[2] = bflo(v.y); f[3] = bfhi(v.y); f[4] = bflo(v.z); f[5] = bfhi(v.z); f[6] = bflo(v.w); f[7] = bfhi(v.w); }
template <int W> __device__ __forceinline__ void pool_segment(const bf16_t* up, bf16_t* op, int t0) {
    float s[8];
#pragma unroll
    for (int j = 0; j < 8; ++j) s[j] = 0.f;
#pragma unroll
    for (int i = 1; i < W; ++i) {
        u32x4 v = (u32x4){0u, 0u, 0u, 0u};
        if (t0 - i >= 0) v = *(const u32x4*)(up - (size_t)i * 1536);
        float f[8]; bf8_to_f(v, f);
#pragma unroll
        for (int j = 0; j < 8; ++j) s[j] += f[j];
    }
#pragma unroll 4
    for (int r = 0; r < 32; ++r) {
        const int t = t0 + r;
        const u32x4 vc = *(const u32x4*)(up + (size_t)r * 1536);
        u32x4 vo = (u32x4){0u, 0u, 0u, 0u};
        if (t - (W - 1) >= 0) vo = *(const u32x4*)(up + (size_t)(r - (W - 1)) * 1536);
        float fc[8], fo[8]; bf8_to_f(vc, fc); bf8_to_f(vo, fo);
        const float inv = 1.0f / (float)((t + 1 < W) ? t + 1 : W);
        float o[8];
#pragma unroll
        for (int j = 0; j < 8; ++j) { s[j] += fc[j]; o[j] = s[j] * inv - fc[j]; s[j] -= fo[j]; }
        u32x4 w; w.x = cvt_pk_bf16(o[0], o[1]); w.y = cvt_pk_bf16(o[2], o[3]); w.z = cvt_pk_bf16(o[4], o[5]); w.w = cvt_pk_bf16(o[6], o[7]);
        *(u32x4*)(op + (size_t)r * DM) = w;
    }
}

__device__ __forceinline__ int crow(int r, int hi) { return (r & 3) + 8 * (r >> 2) + 4 * hi; }
__device__ __forceinline__ void sb_attn_task(const bf16_t* __restrict__ QKU, const bf16_t* __restrict__ VT, bf16_t* __restrict__ CAT, int b, int h, int qb, int lane) {
    const int r32 = lane & 31, hi = lane >> 5;
    const size_t tok0 = (size_t)b * SEQ; const int q0 = qb * 32;
    const bf16_t* qp = QKU + (tok0 + q0 + r32) * 1536 + h * 64 + 8 * hi;
    bf16x8 qf[4];
#pragma unroll
    for (int j = 0; j < 4; ++j) qf[j] = *(const bf16x8*)(qp + 16 * j);
    const bf16_t* kp = QKU + (tok0 + r32) * 1536 + 512 + h * 64 + 8 * hi;
    const bf16_t* vp = VT + (size_t)(h * 64 + r32) * VT_LD + tok0 + 4 * hi;
    f32x16 o0, o1;
#pragma unroll
    for (int r = 0; r < 16; ++r) { o0[r] = 0.f; o1[r] = 0.f; }
    float carry = 1.0f;
    bf16x8 kf[4]; s16x4 va[2][4]; bf16x8 k1[4]; s16x4 v1[2][4];
#define SB_LOAD(KF, VA, K0) do { const int k0_ = (K0); \
        _Pragma("unroll") for (int j = 0; j < 4; ++j) KF[j] = *(const bf16x8*)(kp + (size_t)k0_ * 1536 + 16 * j); \
        _Pragma("unroll") for (int dh = 0; dh < 2; ++dh) _Pragma("unroll") for (int c = 0; c < 4; ++c) VA[dh][c] = *(const s16x4*)(vp + (size_t)dh * 32 * VT_LD + k0_ + 8 * c); } while (0)
    asm volatile("s_waitcnt vmcnt(0)" ::: "memory");
    SB_LOAD(kf, va, q0);
    SB_LOAD(k1, v1, qb > 0 ? q0 - 32 : q0);
    for (int kt = qb; kt >= 0; --kt) {
        bf16x8 kn[4]; s16x4 vn[2][4];
        SB_LOAD(kn, vn, kt >= 2 ? (kt - 2) * 32 : 0);
        f32x16 s;
#pragma unroll
        for (int r = 0; r < 16; ++r) s[r] = 0.f;
#pragma unroll
        for (int j = 0; j < 4; ++j) s = __builtin_amdgcn_mfma_f32_32x32x16_bf16(kf[j], qf[j], s, 0, 0, 0);
        const bool diag = (kt == qb);
        float omb[16], bt[16];
#pragma unroll
        for (int r = 0; r < 16; ++r) {
            const float z2 = fminf(s[r] * (0.125f * LOG2E), 100.0f);
            const float e = fexp2(z2);
            const float ob = frcp(1.0f + e);
            const bool valid = !diag || (crow(r, hi) < r32);
            omb[r] = valid ? ob : 1.0f; bt[r] = valid ? e * ob : 0.0f;
        }
        float gp[4], pg[4];
#pragma unroll
        for (int g = 0; g < 4; ++g) { gp[g] = (omb[4 * g] * omb[4 * g + 1]) * (omb[4 * g + 2] * omb[4 * g + 3]); pg[g] = partner32(gp[g], hi); }
        float tp[4];
        tp[3] = 1.0f; tp[2] = gp[3] * pg[3]; tp[1] = tp[2] * (gp[2] * pg[2]); tp[0] = tp[1] * (gp[1] * pg[1]);
        const float total = tp[0] * (gp[0] * pg[0]);
        float w[16];
#pragma unroll
        for (int g = 0; g < 4; ++g) {
            const float base = carry * tp[g] * (hi ? 1.0f : pg[g]);
            const float a3 = base, a2 = a3 * omb[4 * g + 3], a1 = a2 * omb[4 * g + 2], a0 = a1 * omb[4 * g + 1];
            w[4 * g + 3] = bt[4 * g + 3] * a3;
            w[4 * g + 2] = bt[4 * g + 2] * a2;
            w[4 * g + 1] = bt[4 * g + 1] * a1;
            w[4 * g + 0] = bt[4 * g + 0] * a0;
        }
        carry *= total;
        u32x4 p0, p1;
        p0.x = cvt_pk_bf16(w[0], w[1]); p0.y = cvt_pk_bf16(w[2], w[3]); p0.z = cvt_pk_bf16(w[4], w[5]); p0.w = cvt_pk_bf16(w[6], w[7]);
        p1.x = cvt_pk_bf16(w[8], w[9]); p1.y = cvt_pk_bf16(w[10], w[11]); p1.z = cvt_pk_bf16(w[12], w[13]); p1.w = cvt_pk_bf16(w[14], w[15]);
        const bf16x8 pb0 = __builtin_bit_cast(bf16x8, p0), pb1 = __builtin_bit_cast(bf16x8, p1);
#define VA8(dh, c) (bf16x8){va[dh][c][0], va[dh][c][1], va[dh][c][2], va[dh][c][3], va[dh][(c) + 1][0], va[dh][(c) + 1][1], va[dh][(c) + 1][2], va[dh][(c) + 1][3]}
        const bf16x8 a00 = VA8(0, 0), a02 = VA8(0, 2), a10 = VA8(1, 0), a12 = VA8(1, 2);
#undef VA8
        o0 = __builtin_amdgcn_mfma_f32_32x32x16_bf16(a00, pb0, o0, 0, 0, 0);
        o0 = __builtin_amdgcn_mfma_f32_32x32x16_bf16(a02, pb1, o0, 0, 0, 0);
        o1 = __builtin_amdgcn_mfma_f32_32x32x16_bf16(a10, pb0, o1, 0, 0, 0);
        o1 = __builtin_amdgcn_mfma_f32_32x32x16_bf16(a12, pb1, o1, 0, 0, 0);
        __builtin_amdgcn_sched_barrier(0);
        asm volatile("s_nop 15\n\ts_nop 15\n\ts_nop 15\n\ts_nop 15\n\ts_nop 15" ::: "memory");
        asm volatile("" :: "v"(a00), "v"(a02), "v"(a10), "v"(a12), "v"(pb0), "v"(pb1), "v"(kf[0]), "v"(kf[1]), "v"(kf[2]), "v"(kf[3]));
        __builtin_amdgcn_sched_barrier(0);
        if (__all(carry == 0.0f)) break;
#pragma unroll
        for (int j = 0; j < 4; ++j) { kf[j] = k1[j]; k1[j] = kn[j]; }
#pragma unroll
        for (int dh = 0; dh < 2; ++dh)
#pragma unroll
            for (int c = 0; c < 4; ++c) { va[dh][c] = v1[dh][c]; v1[dh][c] = vn[dh][c]; }
    }
#undef SB_LOAD
    bf16_t* op = CAT + (tok0 + q0 + r32) * DM + h * 64 + 4 * hi;
#pragma unroll
    for (int g = 0; g < 4; ++g) {
        u32x2 w0, w1;
        w0.x = cvt_pk_bf16(o0[4 * g], o0[4 * g + 1]); w0.y = cvt_pk_bf16(o0[4 * g + 2], o0[4 * g + 3]);
        w1.x = cvt_pk_bf16(o1[4 * g], o1[4 * g + 1]); w1.y = cvt_pk_bf16(o1[4 * g + 2], o1[4 * g + 3]);
        *(u32x2*)(op + 8 * g) = w0; *(u32x2*)(op + 32 + 8 * g) = w1;
    }
}


constexpr int SBK_PITCH = 144, SBV_PITCH = 80, SBK_BYTES = 32 * SBK_PITCH, SBV_BYTES = 64 * SBV_PITCH, SB_TILE = SBK_BYTES + SBV_BYTES, SB_WIN = 14;
static_assert(SB_WIN * SB_TILE <= XBST_OFF, "attention LDS window must stay below the grid barrier's LDS words");
__device__ __forceinline__ void sb_attn_block(const bf16_t* __restrict__ QKU, const bf16_t* __restrict__ VT, bf16_t* __restrict__ CAT, int b, int h, int qb0,
                                              LAS unsigned char* lds, int tid, int wave, int lane) {
    const int r32 = lane & 31, hi = lane >> 5;
    const size_t tok0 = (size_t)b * SEQ; const int qb = qb0 + wave, q0 = qb * 32;
    const int lo = (qb0 >= 6) ? qb0 - 6 : 0, ntile = qb0 + 8 - lo;
    {
        const bool isk = tid < 256; const int t2 = tid & 255;
        const bf16_t* gsrc = isk ? QKU + (tok0 + (t2 >> 3)) * 1536 + 512 + h * 64 + (t2 & 7) * 8
                                 : VT + (size_t)(h * 64 + (t2 >> 2)) * VT_LD + tok0 + (t2 & 3) * 8;
        const size_t gstep = isk ? (size_t)32 * 1536 : (size_t)32;
        const int ldst = isk ? (t2 >> 3) * SBK_PITCH + (t2 & 7) * 16 : SBK_BYTES + (t2 >> 2) * SBV_PITCH + (t2 & 3) * 16;
        u32x4 stg[SB_WIN];
#pragma unroll
        for (int i = 0; i < SB_WIN; ++i) if (i < ntile) stg[i] = *(const u32x4*)(gsrc + (size_t)(lo + i) * gstep);
#pragma unroll
        for (int i = 0; i < SB_WIN; ++i) if (i < ntile) *(LAS u32x4*)(lds + i * SB_TILE + ldst) = stg[i];
    }
    const bf16_t* qp = QKU + (tok0 + q0 + r32) * 1536 + h * 64 + 8 * hi;
    bf16x8 qf[4];
#pragma unroll
    for (int j = 0; j < 4; ++j) qf[j] = *(const bf16x8*)(qp + 16 * j);
    const bf16_t* kp = QKU + (tok0 + r32) * 1536 + 512 + h * 64 + 8 * hi;
    const bf16_t* vp = VT + (size_t)(h * 64 + r32) * VT_LD + tok0 + 4 * hi;
    f32x16 o0, o1;
#pragma unroll
    for (int r = 0; r < 16; ++r) { o0[r] = 0.f; o1[r] = 0.f; }
    float carry = 1.0f;
    __syncthreads();
    for (int kt = qb; kt >= 0; --kt) {
        bf16x8 kf[4]; s16x4 va[2][4];
        if (kt >= lo) {
            LAS unsigned char* kb = lds + (kt - lo) * SB_TILE; LAS unsigned char* vb = kb + SBK_BYTES;
#pragma unroll
            for (int j = 0; j < 4; ++j) kf[j] = *(const LAS bf16x8*)(kb + r32 * SBK_PITCH + (16 * j + 8 * hi) * 2);
#pragma unroll
            for (int dh = 0; dh < 2; ++dh)
#pragma unroll
                for (int c = 0; c < 4; ++c) va[dh][c] = *(const LAS s16x4*)(vb + (dh * 32 + r32) * SBV_PITCH + (8 * c + 4 * hi) * 2);
        } else {
            const int k0 = kt * 32;
#pragma unroll
            for (int j = 0; j < 4; ++j) kf[j] = *(const bf16x8*)(kp + (size_t)k0 * 1536 + 16 * j);
#pragma unroll
            for (int dh = 0; dh < 2; ++dh)
#pragma unroll
                for (int c = 0; c < 4; ++c) va[dh][c] = *(const s16x4*)(vp + (size_t)dh * 32 * VT_LD + k0 + 8 * c);
        }
        f32x16 s;
#pragma unroll
        for (int r = 0; r < 16; ++r) s[r] = 0.f;
#pragma unroll
        for (int j = 0; j < 4; ++j) s = __builtin_amdgcn_mfma_f32_32x32x16_bf16(kf[j], qf[j], s, 0, 0, 0);
        const bool diag = (kt == qb);
        float omb[16], bt[16];
#pragma unroll
        for (int r = 0; r < 16; ++r) {
            const float z2 = fminf(s[r] * (0.125f * LOG2E), 100.0f);
            const float e = fexp2(z2);
            const float ob = frcp(1.0f + e);
            const bool valid = !diag || (crow(r, hi) < r32);
            omb[r] = valid ? ob : 1.0f; bt[r] = valid ? e * ob : 0.0f;
        }
        float gp[4], pg[4];
#pragma unroll
        for (int g = 0; g < 4; ++g) { gp[g] = (omb[4 * g] * omb[4 * g + 1]) * (omb[4 * g + 2] * omb[4 * g + 3]); pg[g] = partner32(gp[g], hi); }
        float tp[4];
        tp[3] = 1.0f; tp[2] = gp[3] * pg[3]; tp[1] = tp[2] * (gp[2] * pg[2]); tp[0] = tp[1] * (gp[1] * pg[1]);
        const float total = tp[0] * (gp[0] * pg[0]);
        float w[16];
#pragma unroll
        for (int g = 0; g < 4; ++g) {
            const float base = carry * tp[g] * (hi ? 1.0f : pg[g]);
            const float a3 = base, a2 = a3 * omb[4 * g + 3], a1 = a2 * omb[4 * g + 2], a0 = a1 * omb[4 * g + 1];
            w[4 * g + 3] = bt[4 * g + 3] * a3; w[4 * g + 2] = bt[4 * g + 2] * a2; w[4 * g + 1] = bt[4 * g + 1] * a1; w[4 * g + 0] = bt[4 * g + 0] * a0;
        }
        carry *= total;
        u32x4 p0, p1;
        p0.x = cvt_pk_bf16(w[0], w[1]); p0.y = cvt_pk_bf16(w[2], w[3]); p0.z = cvt_pk_bf16(w[4], w[5]); p0.w = cvt_pk_bf16(w[6], w[7]);
        p1.x = cvt_pk_bf16(w[8], w[9]); p1.y = cvt_pk_bf16(w[10], w[11]); p1.z = cvt_pk_bf16(w[12], w[13]); p1.w = cvt_pk_bf16(w[14], w[15]);
        const bf16x8 pb0 = __builtin_bit_cast(bf16x8, p0), pb1 = __builtin_bit_cast(bf16x8, p1);
#define VA8(dh, c) (bf16x8){va[dh][c][0], va[dh][c][1], va[dh][c][2], va[dh][c][3], va[dh][(c) + 1][0], va[dh][(c) + 1][1], va[dh][(c) + 1][2], va[dh][(c) + 1][3]}
        const bf16x8 a00 = VA8(0, 0), a02 = VA8(0, 2), a10 = VA8(1, 0), a12 = VA8(1, 2);
#undef VA8
        o0 = __builtin_amdgcn_mfma_f32_32x32x16_bf16(a00, pb0, o0, 0, 0, 0);
        o0 = __builtin_amdgcn_mfma_f32_32x32x16_bf16(a02, pb1, o0, 0, 0, 0);
        o1 = __builtin_amdgcn_mfma_f32_32x32x16_bf16(a10, pb0, o1, 0, 0, 0);
        o1 = __builtin_amdgcn_mfma_f32_32x32x16_bf16(a12, pb1, o1, 0, 0, 0);
        __builtin_amdgcn_sched_barrier(0);
        asm volatile("s_nop 15\n\ts_nop 15\n\ts_nop 15\n\ts_nop 15\n\ts_nop 15" ::: "memory");
        asm volatile("" :: "v"(a00), "v"(a02), "v"(a10), "v"(a12), "v"(pb0), "v"(pb1), "v"(kf[0]), "v"(kf[1]), "v"(kf[2]), "v"(kf[3]));
        __builtin_amdgcn_sched_barrier(0);
        if (__all(carry == 0.0f)) break;
    }
    bf16_t* op = CAT + (tok0 + q0 + r32) * DM + h * 64 + 4 * hi;
#pragma unroll
    for (int g = 0; g < 4; ++g) {
        u32x2 w0, w1;
        w0.x = cvt_pk_bf16(o0[4 * g], o0[4 * g + 1]); w0.y = cvt_pk_bf16(o0[4 * g + 2], o0[4 * g + 3]);
        w1.x = cvt_pk_bf16(o1[4 * g], o1[4 * g + 1]); w1.y = cvt_pk_bf16(o1[4 * g + 2], o1[4 * g + 3]);
        *(u32x2*)(op + 8 * g) = w0; *(u32x2*)(op + 32 + 8 * g) = w1;
    }
    __syncthreads();
}

#define XB_TMO      128
#define XB_XCNT(j)  (256  + 64 * (j))
#define XB_XSUB(j)  (1280 + 64 * (j))
#define XB_XGEN(j)  (2304 + 64 * (j))
#define XB_TOP      3328
#define XB_TOPGEN   3392
#define XCD_BAR_WORDS 3456
#define XB_SPIN_CAP (1u << 22)
__device__ __forceinline__ unsigned xb_ld(unsigned* p)              { return __hip_atomic_load(p, __ATOMIC_RELAXED, __HIP_MEMORY_SCOPE_AGENT); }
__device__ __forceinline__ unsigned xb_add(unsigned* p, unsigned v) { return __hip_atomic_fetch_add(p, v, __ATOMIC_RELAXED, __HIP_MEMORY_SCOPE_AGENT); }
__device__ __forceinline__ unsigned xb_xcc_id() { return (unsigned)__builtin_amdgcn_s_getreg((3 << 11) | 20) & 0xFu; }
#define XB_SPIN(cond, bar) do { unsigned _sp = 0; while (cond) { __builtin_amdgcn_s_sleep(1); \
    if ((++_sp & 255u) == 0u) { if (xb_ld(&(bar)[XB_TMO])) break; if (_sp > XB_SPIN_CAP) { atomicAdd(&(bar)[XB_TMO], 1u); break; } } } } while (0)
__device__ __forceinline__ void xcd_barrier_complete(unsigned* bar, unsigned x, unsigned G, unsigned& nloc, unsigned& nx) {
    unsigned sum, cnt, mine, sp = 0u;
    for (;;) {
        sum = 0u; cnt = 0u; mine = 0u;
#pragma unroll
        for (unsigned j = 0; j < 16; ++j) { const unsigned c = xb_ld(&bar[XB_XCNT(j)]); sum += c; cnt += (c > 0u) ? 1u : 0u; mine = (j == x) ? c : mine; }
        if (sum == G) break;
        __builtin_amdgcn_s_sleep(1);
        if ((++sp & 255u) == 0u) { if (xb_ld(&bar[XB_TMO])) break; if (sp > XB_SPIN_CAP) { atomicAdd(&bar[XB_TMO], 1u); break; } }
    }
    nloc = mine > 0u ? mine : 1u; nx = cnt > 0u ? cnt : 1u;
}
__device__ __forceinline__ void xcd_barrier(unsigned* bar, volatile LAS unsigned* st, bool leader, unsigned G) {
    asm volatile("s_waitcnt vmcnt(0)" ::: "memory");
    __syncthreads();
    if (leader) {
        const unsigned x = xb_xcc_id();
        __builtin_amdgcn_s_waitcnt(0);
        unsigned nloc = st[0], nx = st[1];
        if (nloc == 0u) { xcd_barrier_complete(bar, x, G, nloc, nx); st[0] = nloc; st[1] = nx; }
        const unsigned old = xb_add(&bar[XB_XSUB(x)], 1u);
        const unsigned gen = old / nloc;
        if (old + 1u == (gen + 1u) * nloc) {
            __builtin_amdgcn_fence(__ATOMIC_RELEASE, "agent");
            asm volatile("s_waitcnt vmcnt(0)" ::: "memory");
            const unsigned og = xb_add(&bar[XB_TOP], 1u);
            const unsigned tg = og / nx;
            if (og + 1u == (tg + 1u) * nx) xb_add(&bar[XB_TOPGEN], 1u);
            else XB_SPIN(xb_ld(&bar[XB_TOPGEN]) == tg, bar);
            __builtin_amdgcn_fence(__ATOMIC_ACQUIRE, "agent");
            xb_add(&bar[XB_XGEN(x)], 1u);
            asm volatile("s_waitcnt vmcnt(0)" ::: "memory");
        } else {
            XB_SPIN(xb_ld(&bar[XB_XGEN(x)]) == gen, bar);
            __builtin_amdgcn_fence(__ATOMIC_ACQUIRE, "agent");
            asm volatile("s_waitcnt vmcnt(0)" ::: "memory");
        }
    }
    __syncthreads();
}

__global__ void __launch_bounds__(512) mega_fwd(Args a) {
    __builtin_assume(__builtin_amdgcn_workitem_id_y() == 0); __builtin_assume(__builtin_amdgcn_workitem_id_z() == 0);
    extern __shared__ __attribute__((aligned(16))) unsigned char lds_raw[];
    LAS unsigned char* lds = (LAS unsigned char*)lds_raw;
    LAS unsigned char* xl = lds + XL_OFF;
    cg::grid_group grid = cg::this_grid();
#if !MK_MULTI_LAUNCH
    {
        volatile LAS unsigned* st = (volatile LAS unsigned*)(lds + XBST_OFF);
        if (threadIdx.x == 0) { st[0] = 0u; st[1] = 0u; KArgs ap0 = kargs(); xb_add(&((unsigned*)ap0->ws)[XB_XCNT(xb_xcc_id())], 1u); }
        if (a.ph_lo < 0) grid.sync();
        __syncthreads();
    }
#endif
#if MK_MULTI_LAUNCH
    const int lo = a.ph_lo, hi = a.ph_hi;
    int ph = 0;
#endif
#define PH_VARS int tid = threadIdx.x; asm volatile("" : "+v"(tid)); const int lane = tid & 63, wave = __builtin_amdgcn_readfirstlane(tid >> 6); int G_ = gridDim.x, bid_ = blockIdx.x; asm volatile("" : "+s"(G_), "+s"(bid_)); const int G = G_, bid = bid_; \
    const int gw = bid * 8 + wave, NGW = G * 8, gt = bid * 512 + tid, NGT = G * 512; (void)lane; (void)gw; (void)NGW; (void)gt; (void)NGT; KArgs ap = kargs(); unsigned char* ws = ap->ws; float* X = ap->out; float* SSQ = (float*)(ws + WS_SSQ); bf16_t* XB = (bf16_t*)(ws + WS_XB); bf16_t* MEMN = (bf16_t*)(ws + WS_MEMN); (void)X; (void)SSQ; (void)XB; (void)MEMN;
#if MK_MULTI_LAUNCH
#define PHASE_ON (ph >= lo && ph < hi)
#define PHASE_END do { if (ph >= lo && ph + 1 < hi) grid.sync(); ++ph; } while (0)
#define LOCAL_SEAM PHASE_END
#else
#define PHASE_ON (true)
#define LOCAL_SEAM do { asm volatile("s_waitcnt vmcnt(0)" ::: "memory"); __syncthreads(); { int tl = threadIdx.x; asm volatile("" : "+v"(tl)); \
    if (tl == 0) { __builtin_amdgcn_fence(__ATOMIC_ACQUIRE, "agent"); asm volatile("s_waitcnt vmcnt(0)" ::: "memory"); } } __syncthreads(); } while (0)
#define PHASE_END do { KArgs apb = kargs(); int tb = threadIdx.x; asm volatile("" : "+v"(tb)); int Gb = gridDim.x; asm volatile("" : "+s"(Gb)); \
    xcd_barrier((unsigned*)apb->ws, (volatile LAS unsigned*)(lds + XBST_OFF), tb == 0, (unsigned)Gb); } while (0)
#endif

    if (PHASE_ON) { PH_VARS
        if (bid < 64) ssm_tables(ap, bid, lds, (bf16_t*)(ws + WS_TG), (bf16_t*)(ws + WS_WEND));
        LAS float* scr = (LAS float*)(lds + wave * 16384);
        const bool weighted = (G > 64);
        const int n_tw = weighted ? 64 * 8 : 0, n_nw = weighted ? (G - 64) * 8 : G * 8;
        const int spw = weighted ? 4 : 1, S = n_nw * spw + n_tw;
        const bool is_tw = weighted && bid < 64;
        const int slot0 = is_tw ? n_nw * spw + gw : (weighted ? (gw - 512) * 4 : gw), nslot = is_tw ? 1 : spw;
        if (!is_tw) {
            const int nb_ = weighted ? G - 64 : G, b_ = weighted ? bid - 64 : bid;
            for (int it = b_ + wave * nb_; it < 256; it += nb_ * 8) {
                const int g = it >> 6, cb = (it >> 2) & 15, nb = it & 3;
                const float* pw = ap->in[8] + (size_t)(g * 128 + cb * 8) * 128; const float* sc = ap->in[9] + g * 128;
                const float* wo = ap->in[10] + (size_t)(512 + g * 128) * 1024 + nb * 256 + lane * 4;
                f32x4 acc8[8];
#pragma unroll
                for (int j = 0; j < 8; ++j) acc8[j] = (f32x4){0.f, 0.f, 0.f, 0.f};
#pragma unroll 8
                for (int d = 0; d < 128; ++d) {
                    const f32x4 wv = *(const f32x4*)(wo + (size_t)d * 1024); const float sd = sc[d];
#pragma unroll
                    for (int j = 0; j < 8; ++j) acc8[j] += wv * (pw[j * 128 + d] * sd);
                }
                bf16_t* D = (bf16_t*)(ws + WS_WOUT) + (size_t)(nb * 256 + lane * 4) * 1024 + 512 + g * 128 + cb * 8;
#pragma unroll
                for (int e = 0; e < 4; ++e) {
                    u32x4 w; w.x = cvt_pk_bf16(acc8[0][e], acc8[1][e]); w.y = cvt_pk_bf16(acc8[2][e], acc8[3][e]); w.z = cvt_pk_bf16(acc8[4][e], acc8[5][e]); w.w = cvt_pk_bf16(acc8[6][e], acc8[7][e]);
                    *(u32x4*)(D + (size_t)e * 1024) = w;
                }
            }
        }
        {
            float tv[32]; TItem cur, nxt; bool have = false, have_next = false;
            int sl = 0, it = slot0;
            auto decode = [&](int item, TItem& t) -> bool {
                int r = item; const float* W = nullptr; const float* gk = nullptr; int N = 0; bf16_t* D = nullptr; int ldt = 0, mode = 0; bool found = false;
#define TJOB(Wp, Kk, Nn, Dp, Ld, Md, Gp) if (!found) { const int cnt = ((Kk) / 64) * ((Nn) / 32); if (r < cnt) { W = (Wp); N = (Nn); D = (bf16_t*)(Dp); ldt = (Ld); mode = (Md); gk = (Gp); found = true; } else r -= cnt; }
                TJOB(ap->in[7], 1024, 2048, ws + WS_WIN, 1024, 1, nullptr)
            TJOB(ap->in[10], 512, 1024, ws + WS_WOUT, 1024, 0, nullptr)
            TJOB(ap->in[11], 1024, 1024, ws + WS_WSSM, 1024, 0, ap->in[2] + 1024)
            TJOB(ap->in[20], 1024, 2048, ws + WS_WGLU, 1024, 2, nullptr)
#pragma unroll
            for (int l = 0; l < 2; ++l) {
                unsigned char* lb = ws + WS_LAYER + l * LAYER_STRIDE;
                TJOB(ap->in[22] + (size_t)l * 1024 * 2048, 1024, 2048, lb + LO_WKV, 1024, 0, nullptr)
                TJOB(ap->in[23] + (size_t)l * 1024 * 1024, 1024, 1024, lb + LO_WO, 1024, 0, nullptr)
                TJOB(ap->in[24] + (size_t)l * 1024 * DFF2, 1024, DFF2, lb + LO_WUP, 1024, 3, ap->in[4] + l * 1024)
                TJOB(ap->in[27] + (size_t)l * DFF * 1024, DFF, 1024, lb + LO_WDN, DFF, 0, nullptr)
            }
#undef TJOB
                if (!found) return false;
                const int nblk = N / 32, kb = r / nblk, nb = r % nblk, n0 = nb * 32;
                int drow0 = n0;
                if (mode == 1) drow0 = (n0 < 1024) ? n0 : (n0 < 1536 ? n0 + 512 : n0 - 512);
                else if (mode == 2) drow0 = (n0 < 1024) ? (256 * (n0 >> 7) + (n0 & 127)) : (256 * ((n0 - 1024) >> 7) + 128 + ((n0 - 1024) & 127));
                else if (mode == 3) drow0 = (n0 < DFF) ? (256 * (n0 >> 7) + (n0 & 127)) : (256 * ((n0 - DFF) >> 7) + 128 + ((n0 - DFF) & 127));
                t.W = W; t.gk = gk; t.D = D; t.N = N; t.ldt = ldt; t.drow0 = drow0; t.k0 = kb * 64; t.n0 = n0; return true;
            };
            auto advance = [&](TItem& t) -> bool {
                while (sl < nslot) { if (decode(it, t)) { it += S; return true; } ++sl; it = slot0 + sl; }
                return false;
            };
            have = advance(cur);
            if (have) titem_load(tv, cur, lane);
            while (have) {
                titem_to_lds(tv, scr, lane);
                have_next = advance(nxt);
                if (have_next) titem_load(tv, nxt, lane);
                titem_store(cur, scr, lane);
                cur = nxt; have = have_next;
            }
        }
        for (int it = gt; it < 2 * 1024 * 256; it += NGT) {
            const int l = it >> 18, e = it & 262143, k = e >> 8, n4 = (e & 255) * 4;
            const f32x4 w = *(const f32x4*)(ap->in[21] + (size_t)l * 1048576 + (size_t)k * 1024 + n4); const float gk = ap->in[3][l * 1024 + k];
            u32x2 o; o.x = cvt_pk_bf16(w[0] * gk, w[1] * gk); o.y = cvt_pk_bf16(w[2] * gk, w[3] * gk);
            *(u32x2*)((bf16_t*)(ws + WS_LAYER + l * LAYER_STRIDE + LO_WQ) + (size_t)k * 1024 + n4) = o;
        }
        for (int r = gw; r < MEMTOK / 4; r += NGW) rms_rows4_to_bf16(ap->in[1] + (size_t)r * 4 * DM, ap->in[5], MEMN + (size_t)r * 4 * DM, lane);
        for (int r = gw; r < MTOK / 4; r += NGW) rms_rows4_to_bf16(ap->in[0] + (size_t)r * 4 * DM, ap->in[2], XB + (size_t)r * 4 * DM, lane);
        __syncthreads();
    }
    PHASE_END;

    if (PHASE_ON) { PH_VARS
        bf16_t* WIN = (bf16_t*)(ws + WS_WIN);
        { pg8::SchedStd S; S.init(XB, 256 * 2048, WIN, 256 * 2048, 128, 6, G, bid);
          pg8::EpiStore E{(bf16_t*)(ws + WS_QKU), 1536, nullptr, 0, 1.0f, 0};
          pg8::gemm_phase(lds, xl, 1024, 1024, 1024, S, E); }
        { pg8::SchedStd S; S.init(WIN + (size_t)1536 * 1024, 256 * 2048, XB, 256 * 2048, 2, 128, G, bid);
          pg8::EpiStore E{(bf16_t*)(ws + WS_VT), VT_LD, nullptr, 0, 1.0f, 0};
          pg8::gemm_phase(lds, xl, 1024, 1024, 1024, S, E); }
        for (int j = 0; j < 4; ++j) {
            const int l = j >> 1, isv = j & 1;
            bf16_t* WKV = (bf16_t*)(ws + WS_LAYER + l * LAYER_STRIDE + LO_WKV);
            const int c = (bid + 64 * (j + 1)) % G;
            pg8::SchedStd S;
            S.init(MEMN, 256 * 2048, WKV + (size_t)isv * 1024 * 1024, 256 * 2048, 16, 4, G, c);
            pg8::EpiStore E{isv ? (bf16_t*)(ws + WS_MEMVT + l * MEMVT_STRIDE) : (bf16_t*)(ws + WS_MEMK + l * 8 * MiB), 1024, nullptr, 0, 1.0f, 0};
            pg8::gemm_phase(lds, xl, 1024, 1024, 1024, S, E);
        }
    }
    PHASE_END;

    if (PHASE_ON) { PH_VARS
        const bf16_t* QKU = (const bf16_t*)(ws + WS_QKU); bf16_t* CAT = (bf16_t*)(ws + WS_CAT);
        for (int it = gt; it < 64 * (MTOK / 32); it += NGT) {
            const int ch = it & 63, seg = it >> 6, g = ch >> 4;
            const bf16_t* up = QKU + (size_t)seg * 32 * 1536 + 1024 + ch * 8;
            bf16_t* op = CAT + (size_t)seg * 32 * DM + 512 + ch * 8;
            const int t0 = (seg * 32) & (SEQ - 1);
            if (g == 0) pool_segment<2>(up, op, t0); else if (g == 1) pool_segment<4>(up, op, t0); else if (g == 2) pool_segment<8>(up, op, t0); else pool_segment<16>(up, op, t0);
        }
        for (int wt = bid; wt < 128 * 8; wt += G) {
            const int bh = wt >> 3, blk = wt & 7;
            sb_attn_block(QKU, (const bf16_t*)(ws + WS_VT), CAT, bh >> 3, bh & 7, blk * 8, lds, tid, wave, lane);
        }
    }
    PHASE_END;

    if (PHASE_ON) { PH_VARS
        pg8::SchedStd S; S.init(ws + WS_CAT, 256 * 2048, ws + WS_WOUT, 256 * 2048, 128, 4, G, bid);
        pg8::EpiResid E{ap->in[0], XB, SSQ};
        pg8::gemm_phase(lds, xl, 1024, 1024, 1024, S, E);
        pg8::SchedG SG{(const char*)(ws + WS_MEMK), (const char*)(ws + WS_LAYER + LO_WQ), G, bid};
        pg8::EpiStore EG{(bf16_t*)(ws + WS_GT), 1024, nullptr, 0, 1.0f, 0};
        pg8::gemm_phase(lds, xl, 1024, 1024, 256, SG, EG);
    }
    PHASE_END;

#pragma nounroll
    for (int layer = 0; layer < 2; ++layer) {
        if (layer == 1) {
            if (PHASE_ON) { PH_VARS
                pg8::SchedStd S; S.init(XB, 256 * 2048, ws + WS_WSSM, 256 * 2048, 128, 4, G, bid);
                pg8::EpiStore E{(bf16_t*)(ws + WS_UG), 0, SSQ, 16, 1.0f, 1};
                pg8::gemm_phase(lds, xl, 1024, 1024, 1024, S, E);
            }
            PHASE_END;
            if (PHASE_ON) { PH_VARS
                pg8::SchedS2 S{(const char*)(ws + WS_UG), (const char*)(ws + WS_WEND), G, bid};
                pg8::EpiHend E{(float*)(ws + WS_HEND)};
                pg8::gemm_phase(lds, xl, 640, 512, 512, S, E);
            }
            PHASE_END;
            if (PHASE_ON) { PH_VARS
                bf16_t* UG = (bf16_t*)(ws + WS_UG); const float* HE = (const float*)(ws + WS_HEND);
                for (int it = gt; it < NBATCH * 64 * 64; it += NGT) {
                    const int p = it & 63, g = (it >> 6) & 63, b = it >> 12;
                    const float dt = expf(ap->in[14][g]);
                    const float mag = expf(32.0f * (ap->in[12][g * 64 + p] * dt)), ang = 32.0f * (ap->in[13][g * 64 + p] * dt);
                    const float lr = mag * cosf(ang), li = mag * sinf(ang);
                    float hr = 0.f, hi_ = 0.f;
                    for (int c0 = 0; c0 < 64; c0 += 8) {
                        const size_t row0 = (size_t)g * 1024 + b * 64 + c0;
                        float er[8], ei[8];
#pragma unroll
                        for (int j = 0; j < 8; ++j) { er[j] = HE[(row0 + j) * 128 + p]; ei[j] = HE[(row0 + j) * 128 + 64 + p]; }
#pragma unroll
                        for (int j = 0; j < 8; ++j) {
                            UG[(row0 + j) * 640 + 512 + p] = (bf16_t)(cvt_pk_bf16(hr, 0.f) & 0xffffu);
                            UG[(row0 + j) * 640 + 576 + p] = (bf16_t)(cvt_pk_bf16(hi_, 0.f) & 0xffffu);
                            const float nr = lr * hr - li * hi_ + er[j], ni = lr * hi_ + li * hr + ei[j];
                            hr = nr; hi_ = ni;
                        }
                    }
                }
            }
            PHASE_END;
            if (PHASE_ON) { PH_VARS
                pg8::SchedS4 S{(const char*)(ws + WS_UG), (const char*)(ws + WS_TG), G, bid};
                pg8::EpiSsmY E{(const bf16_t*)(ws + WS_UG), ap->in[19], (bf16_t*)(ws + WS_YG)};
                pg8::gemm_phase(lds, xl, 640, 640, 640, S, E);
            }
            PHASE_END;
            if (PHASE_ON) { PH_VARS
                pg8::SchedStd S; S.init(ws + WS_YG, 256 * 2048, ws + WS_WGLU, 256 * 2048, 128, 8, G, bid);
                pg8::EpiGlu E{XB, SSQ};
                pg8::gemm_phase(lds, xl, 1024, 1024, 1024, S, E);
            }
            PHASE_END;
        }
        if (PHASE_ON) { PH_VARS
            pg8::SchedXS2 S{(const char*)XB, (const char*)(ws + WS_GT + (size_t)layer * 32 * MiB), G, bid};
            pg8::EpiSoftmax E{(bf16_t*)(ws + WS_P), SSQ, layer == 0 ? 16 : 32, 0.0625f};
            pg8::gemm_phase(lds, xl, 1024, 1024, 1024, S, E);
        }
        if (PHASE_ON) { PH_VARS
            unsigned char* lb = ws + WS_LAYER + layer * LAYER_STRIDE;
            pg8::SchedVW S{(const char*)(lb + LO_WO), (const char*)(ws + WS_MEMVT + layer * MEMVT_STRIDE), G, bid};
            pg8::EpiStore E{(bf16_t*)(ws + WS_QX), 1024, nullptr, 0, 1.0f, 0};
            pg8::gemm_phase(lds, xl, 1024, 1024, 256, S, E);
        }
        PHASE_END;
        if (PHASE_ON) { PH_VARS
            pg8::SchedXOut S{(const char*)(ws + WS_P), (const char*)(ws + WS_QX), G, bid};
            pg8::EpiResid E{nullptr, XB, SSQ};
            pg8::gemm_phase(lds, xl, 1024, 1024, 1024, S, E);
        }
        PHASE_END;
        if (PHASE_ON) { PH_VARS
            unsigned char* lb = ws + WS_LAYER + layer * LAYER_STRIDE;
            pg8::SchedStd S; S.init(XB, 256 * 2048, lb + LO_WUP, 256 * 2048, 128, 22, G, bid);
            pg8::EpiUpConv E{(bf16_t*)(ws + WS_H), (bf16_t*)(ws + WS_HALO), SSQ, ap->in[25] + (size_t)layer * 3 * DFF2, ap->in[26] + (size_t)layer * DFF2};
            pg8::gemm_phase(lds, xl, 1024, 1024, 1024, S, E);
        }
        PHASE_END;
        if (PHASE_ON) { PH_VARS
            const bf16_t* HALO = (const bf16_t*)(ws + WS_HALO); bf16_t* H = (bf16_t*)(ws + WS_H);
            const float* cw = ap->in[25] + (size_t)layer * 3 * DFF2; const float* cb = ap->in[26] + (size_t)layer * DFF2;
            pg8::SchedStd S0; S0.init(ws + WS_H, 256u * DFF * 2, ws, 0u, 128, 4, G, bid);
            pg8::Unit uu;
            for (int ui = 0; S0.next(ui, uu); ++ui) {
                const int pm = uu.pm;
                if ((pm & 7) == 0) continue;
                for (int it = tid; it < 2 * 352; it += 512) {
                    const int chk = it % 352, rr = it / 352, c0 = chk * 8;
                    const bf16_t* cur = HALO + (size_t)(pm * 4 + rr) * DFF2;
                    const bf16_t* p1 = rr ? HALO + (size_t)(pm * 4) * DFF2 : HALO + (size_t)(pm * 4 - 1) * DFF2;
                    const bf16_t* p2 = rr ? HALO + (size_t)(pm * 4 - 1) * DFF2 : HALO + (size_t)(pm * 4 - 2) * DFF2;
                    float o[8];
                    const u32x4 av = *(const u32x4*)(cur + c0), ag = *(const u32x4*)(cur + DFF + c0);
                    const u32x4 a1 = *(const u32x4*)(p1 + c0), g1 = *(const u32x4*)(p1 + DFF + c0), a2 = *(const u32x4*)(p2 + c0), g2 = *(const u32x4*)(p2 + DFF + c0);
                    const float v0[8] = {bflo(av.x), bfhi(av.x), bflo(av.y), bfhi(av.y), bflo(av.z), bfhi(av.z), bflo(av.w), bfhi(av.w)};
                    const float g0[8] = {bflo(ag.x), bfhi(ag.x), bflo(ag.y), bfhi(ag.y), bflo(ag.z), bfhi(ag.z), bflo(ag.w), bfhi(ag.w)};
                    const float v1[8] = {bflo(a1.x), bfhi(a1.x), bflo(a1.y), bfhi(a1.y), bflo(a1.z), bfhi(a1.z), bflo(a1.w), bfhi(a1.w)};
                    const float gg1[8] = {bflo(g1.x), bfhi(g1.x), bflo(g1.y), bfhi(g1.y), bflo(g1.z), bfhi(g1.z), bflo(g1.w), bfhi(g1.w)};
                    const float v2[8] = {bflo(a2.x), bfhi(a2.x), bflo(a2.y), bfhi(a2.y), bflo(a2.z), bfhi(a2.z), bflo(a2.w), bfhi(a2.w)};
                    const float gg2[8] = {bflo(g2.x), bfhi(g2.x), bflo(g2.y), bfhi(g2.y), bflo(g2.z), bfhi(g2.z), bflo(g2.w), bfhi(g2.w)};
    #pragma unroll
                    for (int j = 0; j < 8; ++j) {
                        const int c = c0 + j;
                        const float cv = cb[c] + cw[c] * v2[j] + cw[DFF2 + c] * v1[j] + cw[2 * DFF2 + c] * v0[j];
                        const float cgt = cb[DFF + c] + cw[DFF + c] * gg2[j] + cw[DFF2 + DFF + c] * gg1[j] + cw[2 * DFF2 + DFF + c] * g0[j];
                        o[j] = cv * cgt * frcp(1.0f + fexp(-cgt));
                    }
                    u32x4 w; w.x = cvt_pk_bf16(o[0], o[1]); w.y = cvt_pk_bf16(o[2], o[3]); w.z = cvt_pk_bf16(o[4], o[5]); w.w = cvt_pk_bf16(o[6], o[7]);
                    *(u32x4*)(H + (size_t)(pm * 256 + rr) * DFF + c0) = w;
                }
            }
        }
        LOCAL_SEAM;
        if (PHASE_ON) { PH_VARS
            unsigned char* lb = ws + WS_LAYER + layer * LAYER_STRIDE;
            pg8::SchedStd S; S.init(ws + WS_H, 256u * DFF * 2, lb + LO_WDN, 256u * DFF * 2, 128, 4, G, bid);
            pg8::EpiResid E{nullptr, XB, SSQ};
            pg8::gemm_phase(lds, xl, DFF, DFF, DFF, S, E);
        }
        PHASE_END;
    }

    if (PHASE_ON) { PH_VARS
        for (int m4 = gw; m4 < MTOK / 4; m4 += NGW) {
            const f32x4* gr = (const f32x4*)ap->in[6] + lane;
            f32x4 v[4][4]; float sq[4];
#pragma unroll
            for (int r = 0; r < 4; ++r)
#pragma unroll
                for (int j = 0; j < 4; ++j) { const u32x2 o = *((const u32x2*)(XB + (size_t)(m4 * 4 + r) * DM) + lane + 64 * j); v[r][j] = (f32x4){bflo(o.x), bfhi(o.x), bflo(o.y), bfhi(o.y)}; }
#pragma unroll
            for (int r = 0; r < 4; ++r) { sq[r] = 0.f;
#pragma unroll
                for (int j = 0; j < 4; ++j) sq[r] += (v[r][j].x * v[r][j].x + v[r][j].y * v[r][j].y) + (v[r][j].z * v[r][j].z + v[r][j].w * v[r][j].w); }
#pragma unroll
            for (int r = 0; r < 4; ++r) sq[r] = 1.f / sqrtf(wave_sum(sq[r]) * (1.f / DM) + EPS);
#pragma unroll
            for (int j = 0; j < 4; ++j) { const f32x4 gg = gr[64 * j];
#pragma unroll
                for (int r = 0; r < 4; ++r) *((f32x4*)(X + (size_t)(m4 * 4 + r) * DM) + lane + 64 * j) = v[r][j] * sq[r] * gg; }
        }
    }
#undef PHASE_ON
#undef PHASE_END
}

constexpr int N_PHASES = 4 + 7 + 5 + 7 + 1;

extern "C" void kernel_launch(void* const* d_in, const int* in_sizes, int n_in, void* d_out, int out_size, void* d_ws, size_t ws_size, hipStream_t stream) {
    static int grid = 0;
    if (grid == 0) {
        if (n_in != 28 || in_sizes[0] != MTOK * DM || out_size != MTOK * DM || ws_size < WS_END) {
            fprintf(stderr, "kernel_launch: unexpected shapes (n_in %d, in0 %d, out %d, ws %zu); nothing launched\n", n_in, n_in > 0 ? in_sizes[0] : -1, out_size, ws_size); grid = -1; return; }
        int dev = 0, cus = 0, per_cu = 0;
        if (hipGetDevice(&dev) != hipSuccess || hipDeviceGetAttribute(&cus, hipDeviceAttributeMultiprocessorCount, dev) != hipSuccess) { grid = -1; return; }
        if (hipFuncSetAttribute((const void*)mega_fwd, hipFuncAttributeMaxDynamicSharedMemorySize, LDS_BYTES) != hipSuccess) { fprintf(stderr, "kernel_launch: hipFuncSetAttribute failed\n"); grid = -1; return; }
        if (hipOccupancyMaxActiveBlocksPerMultiprocessor(&per_cu, (const void*)mega_fwd, 512, LDS_BYTES) != hipSuccess || per_cu < 1) per_cu = 1;
        (void)hipGetLastError();
        grid = cus * per_cu;
    }
    if (grid < 0) return;
    Args a{};
    for (int i = 0; i < 28; ++i) a.in[i] = (const float*)d_in[i];
    a.out = (float*)d_out; a.ws = (unsigned char*)d_ws;
#if MK_MULTI_LAUNCH
    for (int p = 0; p < N_PHASES; ++p) {
        a.ph_lo = p; a.ph_hi = p + 1;
        hipLaunchKernelGGL(mega_fwd, dim3(grid), dim3(512), LDS_BYTES, stream, a);
    }
#else
    a.ph_lo = 0; a.ph_hi = N_PHASES;
    if (hipMemsetAsync(d_ws, 0, 16384, stream) != hipSuccess) { fprintf(stderr, "kernel_launch: memset of the barrier words failed\n"); return; }
    void* args[] = {&a};
    hipError_t e = hipLaunchCooperativeKernel((const void*)mega_fwd, dim3(grid), dim3(512), args, LDS_BYTES, stream);
    if (e != hipSuccess) fprintf(stderr, "cooperative launch failed: %s (grid %d)\n", hipGetErrorString(e), grid);
#endif
}
```

```cpp
#include <hip/hip_runtime.h>
#include <hip/hip_cooperative_groups.h>
#include <cstdio>
#include <cstdint>
namespace cg = cooperative_groups;

#ifndef MK_MULTI_LAUNCH
#define MK_MULTI_LAUNCH 0
#endif

#define LAS __attribute__((address_space(3)))
typedef unsigned short bf16_t;
typedef short bf16x8 __attribute__((ext_vector_type(8)));
typedef short s16x4 __attribute__((ext_vector_type(4)));
typedef float f32x4 __attribute__((ext_vector_type(4)));
typedef float f32x16 __attribute__((ext_vector_type(16)));
typedef unsigned u32x4 __attribute__((ext_vector_type(4)));
typedef unsigned u32x2 __attribute__((ext_vector_type(2)));

constexpr int MTOK = 32768, DM = 1024, SEQ = 2048, NBATCH = 16, DFF = 2816, DFF2 = 5632, MEMTOK = 4096;
constexpr int MHALF = 16384;
constexpr float EPS = 1e-6f;
constexpr float LOG2E = 1.4426950408889634f, LN2 = 0.6931471805599453f;

constexpr size_t MiB = 1u << 20;
constexpr size_t WS_SSQ = 1 * MiB;
constexpr size_t WS_WIN = 5 * MiB;
constexpr size_t WS_WOUT = 9 * MiB;
constexpr size_t WS_WSSM = 11 * MiB;
constexpr size_t WS_WGLU = 13 * MiB;
constexpr size_t WS_LAYER = 17 * MiB, LAYER_STRIDE = 25 * MiB;
constexpr size_t LO_WQ = 0, LO_WKV = 2 * MiB, LO_WO = 6 * MiB, LO_WUP = 8 * MiB, LO_WDN = 19 * MiB;
constexpr size_t WS_WEND = 67 * MiB;
constexpr size_t WS_TG = 83 * MiB;
constexpr size_t WS_MEMN = 123 * MiB;
constexpr size_t WS_MEMK = 131 * MiB;
constexpr size_t WS_MEMVT = 147 * MiB, MEMVT_STRIDE = 9 * MiB;
constexpr size_t WS_XB = 165 * MiB;
constexpr size_t WS_T = 229 * MiB;
constexpr size_t WS_QKU = WS_T, WS_VT = WS_T + 96 * MiB, WS_CAT = WS_T + 132 * MiB;
constexpr int VT_LD = MTOK + 128, MVT_LD = 4096 + 128;
constexpr size_t WS_QX = WS_T, WS_P = WS_T + 64 * MiB, WS_O = WS_T + 128 * MiB;
constexpr size_t WS_H = WS_T, WS_HALO = WS_T + 176 * MiB;
constexpr size_t WS_UG = WS_T, WS_HEND = WS_T + 80 * MiB, WS_YG = WS_T + 112 * MiB;
constexpr size_t WS_GT = 426 * MiB;
constexpr size_t WS_END = 512 * MiB;
static_assert(WS_H + (size_t)MTOK * DFF * 2 <= WS_HALO && WS_HALO + (size_t)128 * 4 * DFF2 * 2 <= WS_GT && WS_CAT + (size_t)MTOK * DM * 2 <= WS_GT && WS_GT + 64 * MiB <= WS_END, "ws map");

typedef float f32x2_t __attribute__((ext_vector_type(2))); typedef __bf16 bf16x2_t __attribute__((ext_vector_type(2)));
__device__ __forceinline__ unsigned cvt_pk_bf16(float lo, float hi) { f32x2_t v = {lo, hi}; bf16x2_t b = __builtin_convertvector(v, bf16x2_t); return __builtin_bit_cast(unsigned, b); }
__device__ __forceinline__ float bf2f(unsigned short b) { return __uint_as_float(((unsigned)b) << 16); }
__device__ __forceinline__ float bflo(unsigned w) { return __uint_as_float(w << 16); }
__device__ __forceinline__ float bfhi(unsigned w) { return __uint_as_float(w & 0xffff0000u); }
__device__ __forceinline__ float fexp2(float x) { return __builtin_amdgcn_exp2f(x); }
__device__ __forceinline__ float flog2(float x) { return __builtin_amdgcn_logf(x); }
__device__ __forceinline__ float fexp(float x) { return __builtin_amdgcn_exp2f(x * LOG2E); }
__device__ __forceinline__ float frcp(float x) { return __builtin_amdgcn_rcpf(x); }
template <int M> __device__ __forceinline__ float swz_xor(float v) { return __int_as_float(__builtin_amdgcn_ds_swizzle(__float_as_int(v), (M << 10) | 0x1f)); }
__device__ __forceinline__ float sum_x16(float v) { auto r = __builtin_amdgcn_permlane16_swap(__float_as_uint(v), __float_as_uint(v), false, false); return __uint_as_float(r[0]) + __uint_as_float(r[1]); }
__device__ __forceinline__ float sum_x32(float v) { auto r = __builtin_amdgcn_permlane32_swap(__float_as_uint(v), __float_as_uint(v), false, false); return __uint_as_float(r[0]) + __uint_as_float(r[1]); }
__device__ __forceinline__ float max_x16(float v) { auto r = __builtin_amdgcn_permlane16_swap(__float_as_uint(v), __float_as_uint(v), false, false); return fmaxf(__uint_as_float(r[0]), __uint_as_float(r[1])); }
__device__ __forceinline__ float max_x32(float v) { auto r = __builtin_amdgcn_permlane32_swap(__float_as_uint(v), __float_as_uint(v), false, false); return fmaxf(__uint_as_float(r[0]), __uint_as_float(r[1])); }
__device__ __forceinline__ float partner32(float v, int hi) { auto r = __builtin_amdgcn_permlane32_swap(__float_as_uint(v), __float_as_uint(v), false, false); return hi ? __uint_as_float(r[0]) : __uint_as_float(r[1]); }
__device__ __forceinline__ float wave_sum(float v) {
    v += swz_xor<1>(v); v += swz_xor<2>(v); v += swz_xor<4>(v); v += swz_xor<8>(v); v = sum_x16(v); v = sum_x32(v);
    return v;
}
#define LDS_WAIT() asm volatile("s_waitcnt lgkmcnt(0)" ::: "memory")

namespace pg8 {
constexpr int BM = 256, BK = 64, HALF = 128, HTB = HALF * BK * 2, STAGE_BYTES = 8 * HTB, NXCD = 8, WGM = 8;
__host__ __device__ __forceinline__ int lds_byte(int r, int c) { const int st = (r >> 4) * 2 + (c >> 5), rr = r & 15, cc = c & 31, ob = rr * 64 + cc * 2; return st * 1024 + (ob ^ (((ob >> 9) & 1) << 5)); }
__host__ __device__ __forceinline__ void stage_rc(int b, int& R, int& C) { const int st = b / 1024, sb = b % 1024, swz = sb ^ (((sb >> 9) & 1) << 5); R = (st >> 1) * 16 + swz / 64; C = (st & 1) * 32 + (swz % 64) / 2; }
__host__ __device__ __forceinline__ int perm32(int rho) { const int n = rho >> 4, i = rho & 15; return 8 * (i >> 2) + 4 * n + (i & 3); }

struct Unit { int pm, pn; const char* a; const char* b; };

struct SchedStd {
    const char* A; const char* B; unsigned sA, sB; int nM, nN, G, c;
    __device__ __forceinline__ void init(const void* A_, unsigned sA_, const void* B_, unsigned sB_, int nM_, int nN_, int G_, int c_) { A = (const char*)A_; B = (const char*)B_; sA = sA_; sB = sB_; nM = nM_; nN = nN_; G = G_; c = c_; }
    __device__ __forceinline__ bool next(int i, Unit& u) const {
        const int nwg = nM * nN; const long L = (long)i * G + c; if (L >= nwg) return false;
        int wgid = (int)L; { const int q = nwg / NXCD, r = nwg % NXCD, xcd = wgid % NXCD, off = wgid / NXCD; wgid = (xcd < r ? xcd * (q + 1) : r * (q + 1) + (xcd - r) * q) + off; }
        const int nig = WGM * nN, gid = wgid / nig, fm = gid * WGM, gsz = (nM - fm) < WGM ? (nM - fm) : WGM;
        u.pm = fm + ((wgid % nig) % gsz); u.pn = (wgid % nig) / gsz;
        u.a = A + (size_t)u.pm * sA; u.b = B + (size_t)u.pn * sB; return true;
    }
};
struct SchedXS {
    const char* A; const char* B; int G, c;
    __device__ __forceinline__ bool next(int i, Unit& u) const {
        const long L = (long)i * G + c; if (L >= 512) return false;
        u.pm = (int)(L >> 2); u.pn = (int)(L & 3);
        u.a = A + (size_t)u.pm * 256 * 2048 + u.pn * 512; u.b = B + (size_t)(u.pm >> 3) * 256 * 2048 + u.pn * 512; return true;
    }
};
struct SchedXQ {
    const char* A; const char* B; int G, c;
    __device__ __forceinline__ bool next(int i, Unit& u) const {
        const long L = (long)i * G + c; if (L >= 512) return false;
        u.pm = (int)(L >> 2); u.pn = (int)(L & 3);
        u.a = A + (size_t)u.pm * 256 * 2048; u.b = B + (size_t)u.pn * 256 * 2048; return true;
    }
};
struct SchedG {
    const char* MK; const char* WQ; int G, c;
    __device__ __forceinline__ bool next(int i, Unit& u) const {
        const long L = (long)i * G + c; if (L >= 512) return false;
        const int l = (int)(L >> 8), r = (int)(L & 255), b = r >> 4, h = (r >> 2) & 3, pn = r & 3;
        u.pm = l * 64 + b * 4 + h; u.pn = pn;
        u.a = MK + (size_t)l * 8 * 1048576 + (size_t)b * 256 * 2048 + h * 512; u.b = WQ + (size_t)l * LAYER_STRIDE + (size_t)pn * 256 * 2048 + h * 512; return true;
    }
};
struct SchedXS2 {
    const char* A; const char* B; int G, c;
    __device__ __forceinline__ bool next(int i, Unit& u) const {
        const long L = (long)i * G + c; if (L >= 512) return false;
        u.pm = (int)(L >> 2); u.pn = (int)(L & 3);
        u.a = A + (size_t)u.pm * 256 * 2048; u.b = B + (size_t)((u.pm >> 3) * 4 + u.pn) * 256 * 2048; return true;
    }
};
struct SchedVW {
    const char* WO; const char* MV; int G, c;
    __device__ __forceinline__ bool next(int i, Unit& u) const {
        const long L = (long)i * G + c; if (L >= 256) return false;
        const int b = (int)(L >> 4), pq = (int)(L >> 2) & 3, h = (int)L & 3;
        u.pm = b * 4 + pq; u.pn = h;
        u.a = WO + (size_t)pq * 256 * 2048 + h * 512; u.b = MV + (size_t)b * 256 * 2048 + h * 512; return true;
    }
};
struct SchedXOut {
    const char* A; const char* B; int G, c;
    __device__ __forceinline__ bool next(int i, Unit& u) const {
        const long L = (long)i * G + c; if (L >= 512) return false;
        u.pm = (int)(L >> 2); u.pn = (int)(L & 3);
        u.a = A + (size_t)u.pm * 256 * 2048; u.b = B + ((size_t)(u.pm >> 3) * 1024 + (size_t)u.pn * 256) * 2048; return true;
    }
};
struct SchedXO {
    const char* A; const char* B; int G, c;
    __device__ __forceinline__ bool next(int i, Unit& u) const {
        const long L = (long)i * G + c; if (L >= 512) return false;
        u.pm = (int)(L >> 2); u.pn = (int)(L & 3);
        u.a = A + (size_t)u.pm * 256 * 2048 + u.pn * 512; u.b = B + (size_t)u.pn * 256 * (MVT_LD * 2) + (size_t)(u.pm >> 3) * 512; return true;
    }
};
struct SchedS2 {
    const char* A; const char* B; int G, c;
    __device__ __forceinline__ bool next(int i, Unit& u) const {
        const long L = (long)i * G + c; if (L >= 256) return false;
        u.pm = (int)L; u.pn = 0;
        u.a = A + (size_t)L * 256 * 1280; u.b = B + (size_t)(L >> 2) * 256 * 1024; return true;
    }
};
struct SchedS4 {
    const char* A; const char* B; int G, c;
    __device__ __forceinline__ bool next(int i, Unit& u) const {
        const long L = (long)i * G + c; if (L >= 512) return false;
        u.pm = (int)(L >> 1); u.pn = (int)(L & 1);
        u.a = A + (size_t)u.pm * 256 * 1280; u.b = B + ((size_t)(L >> 3) * 512 + (size_t)u.pn * 256) * 1280; return true;
    }
};

typedef f32x4 Acc[2][2][4][2];

__device__ __forceinline__ float row_rstd(const float* ssq_row, int nslots) {
    float s = 0.f;
    const f32x4* p = (const f32x4*)ssq_row;
    for (int i = 0; i < nslots / 4; ++i) { const f32x4 v = p[i]; s += (v[0] + v[1]) + (v[2] + v[3]); }
    return 1.0f / sqrtf(s * (1.0f / DM) + EPS);
}

struct EpiStore {
    static constexpr bool PERM = true;
    bf16_t* O; int ldc; const float* ssq; int nslots; float cs; int mode;
    __device__ __forceinline__ void operator()(Acc& acc, const Unit& u, int wr, int wc, int fr, int fq, LAS unsigned char* xl) const {
        const int row0 = u.pm * BM + wr * 64 + fr, col0 = u.pn * BM + wc * 32 + 8 * fq;
        LAS float* R = (LAS float*)xl;
        if (ssq) {
            const int wid = wr * 4 + wc, lane = fq * 16 + fr;
            if (lane < 32) R[wid * 32 + lane] = row_rstd(ssq + (size_t)(u.pm * BM + wid * 32 + lane) * 32, nslots);
            LDS_WAIT(); __builtin_amdgcn_s_barrier(); asm volatile("" ::: "memory");
        }
#pragma unroll
        for (int ai = 0; ai < 2; ++ai)
#pragma unroll
            for (int m = 0; m < 4; ++m) {
                const int row = row0 + ai * HALF + m * 16;
                float sc = cs;
                if (ssq) sc *= R[ai * HALF + wr * 64 + m * 16 + fr];
#pragma unroll
                for (int bj = 0; bj < 2; ++bj) {
                    const int col = col0 + bj * HALF;
                    const f32x4 v0 = acc[ai][bj][m][0] * sc, v1 = acc[ai][bj][m][1] * sc;
                    u32x4 w; w.x = cvt_pk_bf16(v0[0], v0[1]); w.y = cvt_pk_bf16(v0[2], v0[3]); w.z = cvt_pk_bf16(v1[0], v1[1]); w.w = cvt_pk_bf16(v1[2], v1[3]);
                    bf16_t* p = (mode == 0) ? O + (size_t)row * ldc + col
                                            : O + ((size_t)(col >> 4) * 1024 + (row >> 5)) * 640 + (row & 31) * 16 + (col & 15);
                    *(u32x4*)p = w;
                }
            }
    }
};

struct EpiResid {
    static constexpr bool PERM = true;
    const float* xf; bf16_t* xb; float* ssq;
    __device__ __forceinline__ void operator()(Acc& acc, const Unit& u, int wr, int wc, int fr, int fq, LAS unsigned char*) const {
        const int row0 = u.pm * BM + wr * 64 + fr, col0 = u.pn * BM + wc * 32 + 8 * fq;
#pragma unroll
        for (int ai = 0; ai < 2; ++ai) {
            f32x4 v0[4][2], v1[4][2];
            if (xf) {
#pragma unroll
                for (int m = 0; m < 4; ++m)
#pragma unroll
                    for (int bj = 0; bj < 2; ++bj) { const size_t off = (size_t)(row0 + ai * HALF + m * 16) * DM + col0 + bj * HALF;
                        v0[m][bj] = *(const f32x4*)(xf + off); v1[m][bj] = *(const f32x4*)(xf + off + 4); }
            } else {
                u32x4 o[4][2];
#pragma unroll
                for (int m = 0; m < 4; ++m)
#pragma unroll
                    for (int bj = 0; bj < 2; ++bj) o[m][bj] = *(const u32x4*)(xb + (size_t)(row0 + ai * HALF + m * 16) * DM + col0 + bj * HALF);
#pragma unroll
                for (int m = 0; m < 4; ++m)
#pragma unroll
                    for (int bj = 0; bj < 2; ++bj) { v0[m][bj] = (f32x4){bflo(o[m][bj].x), bfhi(o[m][bj].x), bflo(o[m][bj].y), bfhi(o[m][bj].y)};
                                                     v1[m][bj] = (f32x4){bflo(o[m][bj].z), bfhi(o[m][bj].z), bflo(o[m][bj].w), bfhi(o[m][bj].w)}; }
            }
#pragma unroll
            for (int m = 0; m < 4; ++m) {
                const int row = row0 + ai * HALF + m * 16; float q = 0.f;
#pragma unroll
                for (int bj = 0; bj < 2; ++bj) {
                    const f32x4 a0 = v0[m][bj] + acc[ai][bj][m][0], a1 = v1[m][bj] + acc[ai][bj][m][1];
                    q += ((a0[0] * a0[0] + a0[1] * a0[1]) + (a0[2] * a0[2] + a0[3] * a0[3])) + ((a1[0] * a1[0] + a1[1] * a1[1]) + (a1[2] * a1[2] + a1[3] * a1[3]));
                    u32x4 w; w.x = cvt_pk_bf16(a0[0], a0[1]); w.y = cvt_pk_bf16(a0[2], a0[3]); w.z = cvt_pk_bf16(a1[0], a1[1]); w.w = cvt_pk_bf16(a1[2], a1[3]);
                    *(u32x4*)(xb + (size_t)row * DM + col0 + bj * HALF) = w;
                }
                q = sum_x16(q); q = sum_x32(q);
                if (fq == 0) ssq[(size_t)row * 32 + u.pn * 4 + wc] = q;
            }
        }
    }
};

struct EpiGlu {
    static constexpr bool PERM = true;
    bf16_t* xb; float* ssq;
    __device__ __forceinline__ void operator()(Acc& acc, const Unit& u, int wr, int wc, int fr, int fq, LAS unsigned char*) const {
        const int row0 = u.pm * BM + wr * 64 + fr, col0 = u.pn * HALF + wc * 32 + 8 * fq;
        u32x4 o[2][4];
#pragma unroll
        for (int ai = 0; ai < 2; ++ai)
#pragma unroll
            for (int m = 0; m < 4; ++m) o[ai][m] = *(const u32x4*)(xb + (size_t)(row0 + ai * HALF + m * 16) * DM + col0);
#pragma unroll
        for (int ai = 0; ai < 2; ++ai)
#pragma unroll
            for (int m = 0; m < 4; ++m) {
                const int row = row0 + ai * HALF + m * 16; const size_t off = (size_t)row * DM + col0;
                const u32x4 oo = o[ai][m];
                float v[8] = {bflo(oo.x), bfhi(oo.x), bflo(oo.y), bfhi(oo.y), bflo(oo.z), bfhi(oo.z), bflo(oo.w), bfhi(oo.w)};
                float q = 0.f;
#pragma unroll
                for (int n = 0; n < 2; ++n) {
                    const f32x4 val = acc[ai][0][m][n], gt = acc[ai][1][m][n];
#pragma unroll
                    for (int j = 0; j < 4; ++j) { v[4 * n + j] += val[j] * frcp(1.0f + fexp(-gt[j])); q += v[4 * n + j] * v[4 * n + j]; }
                }
                u32x4 w; w.x = cvt_pk_bf16(v[0], v[1]); w.y = cvt_pk_bf16(v[2], v[3]); w.z = cvt_pk_bf16(v[4], v[5]); w.w = cvt_pk_bf16(v[6], v[7]);
                *(u32x4*)(xb + off) = w;
                q = sum_x16(q); q = sum_x32(q);
                if (fq == 0) ssq[(size_t)row * 32 + u.pn * 4 + wc] = q;
            }
    }
};

struct EpiSoftmax {
    static constexpr bool PERM = true;
    bf16_t* O; const float* ssq; int nslots; float cs;
    __device__ __forceinline__ void operator()(Acc& acc, const Unit& u, int wr, int wc, int fr, int fq, LAS unsigned char* xl) const {
        LAS float* tmax = (LAS float*)xl; LAS float* tsum = tmax + 1024; LAS float* R = tsum + 1024;
        { const int wid = wr * 4 + wc, lane = fq * 16 + fr;
          if (lane < 32) R[wid * 32 + lane] = row_rstd(ssq + (size_t)(u.pm * BM + wid * 32 + lane) * 32, nslots); }
        LDS_WAIT(); __builtin_amdgcn_s_barrier(); asm volatile("" ::: "memory");
#pragma unroll
        for (int ai = 0; ai < 2; ++ai)
#pragma unroll
            for (int m = 0; m < 4; ++m) {
                const float sc = cs * R[ai * HALF + wr * 64 + m * 16 + fr];
#pragma unroll
                for (int bj = 0; bj < 2; ++bj)
#pragma unroll
                    for (int n = 0; n < 2; ++n) acc[ai][bj][m][n] *= sc;
                float mx = -3.0e38f;
#pragma unroll
                for (int bj = 0; bj < 2; ++bj)
#pragma unroll
                    for (int n = 0; n < 2; ++n) { const f32x4 x = acc[ai][bj][m][n]; mx = fmaxf(mx, fmaxf(fmaxf(x[0], x[1]), fmaxf(x[2], x[3]))); }
                mx = max_x16(mx); mx = max_x32(mx);
                if (fq == 0) tmax[(ai * HALF + wr * 64 + m * 16 + fr) * 4 + wc] = mx;
            }
        LDS_WAIT(); __builtin_amdgcn_s_barrier(); asm volatile("" ::: "memory");
#pragma unroll
        for (int ai = 0; ai < 2; ++ai)
#pragma unroll
            for (int m = 0; m < 4; ++m) {
                const int r = ai * HALF + wr * 64 + m * 16 + fr;
                const f32x4 t = *(const LAS f32x4*)(tmax + r * 4);
                const float gm = fmaxf(fmaxf(t[0], t[1]), fmaxf(t[2], t[3])) * LOG2E; float s = 0.f;
#pragma unroll
                for (int bj = 0; bj < 2; ++bj)
#pragma unroll
                    for (int n = 0; n < 2; ++n) {
                        f32x4 x = acc[ai][bj][m][n];
#pragma unroll
                        for (int j = 0; j < 4; ++j) { x[j] = fexp2(x[j] * LOG2E - gm); s += x[j]; }
                        acc[ai][bj][m][n] = x;
                    }
                s = sum_x16(s); s = sum_x32(s);
                if (fq == 0) tsum[r * 4 + wc] = s;
            }
        LDS_WAIT(); __builtin_amdgcn_s_barrier(); asm volatile("" ::: "memory");
        const int row0 = u.pm * BM + wr * 64 + fr, col0 = u.pn * BM + wc * 32 + 8 * fq;
#pragma unroll
        for (int ai = 0; ai < 2; ++ai)
#pragma unroll
            for (int m = 0; m < 4; ++m) {
                const int r = ai * HALF + wr * 64 + m * 16 + fr;
                const f32x4 t = *(const LAS f32x4*)(tsum + r * 4);
                const float inv = 1.0f / ((t[0] + t[1]) + (t[2] + t[3]));
#pragma unroll
                for (int bj = 0; bj < 2; ++bj) {
                    const f32x4 v0 = acc[ai][bj][m][0] * inv, v1 = acc[ai][bj][m][1] * inv;
                    u32x4 w; w.x = cvt_pk_bf16(v0[0], v0[1]); w.y = cvt_pk_bf16(v0[2], v0[3]); w.z = cvt_pk_bf16(v1[0], v1[1]); w.w = cvt_pk_bf16(v1[2], v1[3]);
                    *(u32x4*)(O + (size_t)(row0 + ai * HALF + m * 16) * DM + col0 + bj * HALF) = w;
                }
            }
    }
};


__device__ __forceinline__ float dpp_ror1(float x) { return __int_as_float(__builtin_amdgcn_update_dpp(0, __float_as_int(x), 0x121, 0xf, 0xf, false)); }
__device__ __forceinline__ float dpp_ror2(float x) { return __int_as_float(__builtin_amdgcn_update_dpp(0, __float_as_int(x), 0x122, 0xf, 0xf, false)); }
__device__ __forceinline__ float dpp_ror1u(float x) { return __int_as_float(__builtin_amdgcn_mov_dpp(__float_as_int(x), 0x121, 0xf, 0xf, false)); }
__device__ __forceinline__ float dpp_ror2u(float x) { return __int_as_float(__builtin_amdgcn_mov_dpp(__float_as_int(x), 0x122, 0xf, 0xf, false)); }
__device__ __forceinline__ float dpp_shr1_old(float old, float x) { return __int_as_float(__builtin_amdgcn_update_dpp(__float_as_int(old), __float_as_int(x), 0x111, 0xf, 0xf, false)); }
__device__ __forceinline__ float dpp_shr2_old(float old, float x) { return __int_as_float(__builtin_amdgcn_update_dpp(__float_as_int(old), __float_as_int(x), 0x112, 0xf, 0xf, false)); }
struct EpiUpConv {
    static constexpr bool PERM = true;
    bf16_t* H; bf16_t* HALO; const float* ssq; const float* cw; const float* cb;
    __device__ __forceinline__ void operator()(Acc& acc, const Unit& u, int wr, int wc, int fr, int fq, LAS unsigned char* xl) const {
        LAS float* B = (LAS float*)xl;
        LAS float* Wl = B + 2048;
        LAS float* R = Wl + 1024;
        const int wid = wr * 4 + wc, lane = fq * 16 + fr, tid = wid * 64 + lane;
        const int row0 = u.pm * BM + wr * 64 + fr, colb = wc * 32 + 8 * fq, ch0 = u.pn * HALF + colb;
        {
#pragma unroll
            for (int i = 0; i < 2; ++i) { const int idx = tid + i * 512, t = idx >> 8, bj = (idx >> 7) & 1, chl = idx & 127;
                Wl[idx] = (t < 3) ? cw[t * DFF2 + bj * DFF + u.pn * HALF + chl] : cb[bj * DFF + u.pn * HALF + chl]; }
            if (lane < 32) R[wid * 32 + lane] = row_rstd(ssq + (size_t)(u.pm * BM + wid * 32 + lane) * 32, 16);
        }
        LDS_WAIT(); __builtin_amdgcn_s_barrier(); asm volatile("" ::: "memory");
#pragma unroll
        for (int ai = 0; ai < 2; ++ai)
#pragma unroll
            for (int m = 0; m < 4; ++m) {
                const float sc = R[ai * HALF + wr * 64 + m * 16 + fr];
#pragma unroll
                for (int bj = 0; bj < 2; ++bj)
#pragma unroll
                    for (int n = 0; n < 2; ++n) acc[ai][bj][m][n] *= sc;
            }
        if (fr >= 14) {
#pragma unroll
            for (int ai = 0; ai < 2; ++ai)
#pragma unroll
                for (int bj = 0; bj < 2; ++bj)
#pragma unroll
                    for (int n = 0; n < 2; ++n) *(LAS f32x4*)(B + ((ai * 2 + wr) * 2 + (fr - 14)) * 256 + bj * HALF + colb + 4 * n) = acc[ai][bj][3][n];
        }
        if (wr == 0 && fr < 2) {
#pragma unroll
            for (int bj = 0; bj < 2; ++bj) { const f32x4 v0 = acc[0][bj][0][0], v1 = acc[0][bj][0][1];
                u32x4 w; w.x = cvt_pk_bf16(v0[0], v0[1]); w.y = cvt_pk_bf16(v0[2], v0[3]); w.z = cvt_pk_bf16(v1[0], v1[1]); w.w = cvt_pk_bf16(v1[2], v1[3]);
                *(u32x4*)(HALO + (size_t)(u.pm * 4 + fr) * DFF2 + bj * DFF + ch0) = w; }
        }
        if (wr == 1 && fr >= 14) {
#pragma unroll
            for (int bj = 0; bj < 2; ++bj) { const f32x4 v0 = acc[1][bj][3][0], v1 = acc[1][bj][3][1];
                u32x4 w; w.x = cvt_pk_bf16(v0[0], v0[1]); w.y = cvt_pk_bf16(v0[2], v0[3]); w.z = cvt_pk_bf16(v1[0], v1[1]); w.w = cvt_pk_bf16(v1[2], v1[3]);
                *(u32x4*)(HALO + (size_t)(u.pm * 4 + 2 + (fr - 14)) * DFF2 + bj * DFF + ch0) = w; }
        }
        LDS_WAIT(); __builtin_amdgcn_s_barrier(); asm volatile("" ::: "memory");
#pragma unroll
        for (int ai = 0; ai < 2; ++ai) {
            const bool has = (wr == 1) || (ai == 1);
            const int sb = (wr == 1) ? (ai * 2) : 1;
#pragma unroll
            for (int n = 0; n < 2; ++n) {
                asm volatile("" ::: "memory");
                const int cl = colb + 4 * n;
                float hv[4][4];
                const f32x4 wv0 = *(const LAS f32x4*)(Wl + 0 * 128 + cl), wg0 = *(const LAS f32x4*)(Wl + 1 * 128 + cl);
                const f32x4 wv1 = *(const LAS f32x4*)(Wl + 2 * 128 + cl), wg1 = *(const LAS f32x4*)(Wl + 3 * 128 + cl);
                const f32x4 wv2 = *(const LAS f32x4*)(Wl + 4 * 128 + cl), wg2 = *(const LAS f32x4*)(Wl + 5 * 128 + cl);
                const f32x4 bvv = *(const LAS f32x4*)(Wl + 6 * 128 + cl), bgv = *(const LAS f32x4*)(Wl + 7 * 128 + cl);
                f32x4 b1v = (f32x4){0.f, 0.f, 0.f, 0.f}, b2v = b1v, b1g = b1v, b2g = b1v;
                if (has) {
                    b1v = *(const LAS f32x4*)(B + (sb * 2 + 1) * 256 + cl); b2v = *(const LAS f32x4*)(B + (sb * 2 + (fr & 1)) * 256 + cl);
                    b1g = *(const LAS f32x4*)(B + (sb * 2 + 1) * 256 + HALF + cl); b2g = *(const LAS f32x4*)(B + (sb * 2 + (fr & 1)) * 256 + HALF + cl);
                }
#pragma unroll
                for (int j = 0; j < 4; ++j) {
                    float r1p = b1v[j], r2p = b2v[j], q1p = b1g[j], q2p = b2g[j];
#pragma unroll
                    for (int m = 0; m < 4; ++m) {
                        const float xv = acc[ai][0][m][n][j], xg = acc[ai][1][m][n][j];
                        const float pv1 = dpp_shr1_old(r1p, xv), pv2 = dpp_shr2_old(r2p, xv), pg1 = dpp_shr1_old(q1p, xg), pg2 = dpp_shr2_old(q2p, xg);
                        const float cv = bvv[j] + wv0[j] * pv2 + wv1[j] * pv1 + wv2[j] * xv;
                        const float cg = bgv[j] + wg0[j] * pg2 + wg1[j] * pg1 + wg2[j] * xg;
                        hv[m][j] = cv * cg * frcp(1.0f + fexp(-cg));
                        if (m < 3) { r1p = dpp_ror1u(xv); r2p = dpp_ror2u(xv); q1p = dpp_ror1u(xg); q2p = dpp_ror2u(xg); }
                    }
                    __builtin_amdgcn_sched_barrier(0);
                }
#pragma unroll
                for (int m = 0; m < 4; ++m) {
                    u32x2 w; w.x = cvt_pk_bf16(hv[m][0], hv[m][1]); w.y = cvt_pk_bf16(hv[m][2], hv[m][3]);
                    *(u32x2*)(H + (size_t)(row0 + ai * HALF + m * 16) * DFF + ch0 + 4 * n) = w;
                }
            }
        }
    }
};

struct EpiHend {
    static constexpr bool PERM = false;
    float* Hout;
    __device__ __forceinline__ void operator()(Acc& acc, const Unit& u, int wr, int wc, int fr, int fq, LAS unsigned char*) const {
        const int row0 = u.pm * BM + wr * 64 + fr, col0 = wc * 32 + 4 * fq;
#pragma unroll
        for (int ai = 0; ai < 2; ++ai)
#pragma unroll
            for (int m = 0; m < 4; ++m)
#pragma unroll
                for (int n = 0; n < 2; ++n)
                    *(f32x4*)(Hout + (size_t)(row0 + ai * HALF + m * 16) * 128 + col0 + n * 16) = acc[ai][0][m][n];
    }
};

struct EpiSsmY {
    static constexpr bool PERM = true;
    const bf16_t* Ug; const float* Dskip; bf16_t* Yg;
    __device__ __forceinline__ void operator()(Acc& acc, const Unit& u, int wr, int wc, int fr, int fq, LAS unsigned char*) const {
        const int g = u.pm >> 2;
        const int rg0 = (u.pm & 3) * BM + wr * 64 + fr, col0 = u.pn * BM + wc * 32 + 8 * fq;
        const int co = col0 & 15;
        const f32x4 d0 = *(const f32x4*)(Dskip + g * 16 + co), d1 = *(const f32x4*)(Dskip + g * 16 + co + 4);
#pragma unroll
        for (int ai = 0; ai < 2; ++ai)
#pragma unroll
            for (int m = 0; m < 4; ++m) {
                const int rg = rg0 + ai * HALF + m * 16;
#pragma unroll
                for (int bj = 0; bj < 2; ++bj) {
                    const int col = col0 + bj * HALF;
                    const u32x4 uu = *(const u32x4*)(Ug + ((size_t)g * 1024 + rg) * 640 + col);
                    float y[8];
                    y[0] = acc[ai][bj][m][0][0] + d0[0] * bflo(uu.x); y[1] = acc[ai][bj][m][0][1] + d0[1] * bfhi(uu.x);
                    y[2] = acc[ai][bj][m][0][2] + d0[2] * bflo(uu.y); y[3] = acc[ai][bj][m][0][3] + d0[3] * bfhi(uu.y);
                    y[4] = acc[ai][bj][m][1][0] + d1[0] * bflo(uu.z); y[5] = acc[ai][bj][m][1][1] + d1[1] * bfhi(uu.z);
                    y[6] = acc[ai][bj][m][1][2] + d1[2] * bflo(uu.w); y[7] = acc[ai][bj][m][1][3] + d1[3] * bfhi(uu.w);
#pragma unroll
                    for (int j = 0; j < 8; ++j) { const float x = y[j]; const float k2 = 1.5957691216f * (x + 0.044715f * x * x * x); y[j] = x * frcp(1.0f + fexp(-k2)); }
                    u32x4 w; w.x = cvt_pk_bf16(y[0], y[1]); w.y = cvt_pk_bf16(y[2], y[3]); w.z = cvt_pk_bf16(y[4], y[5]); w.w = cvt_pk_bf16(y[6], y[7]);
                    const size_t tok = (size_t)rg * 32 + (col >> 4);
                    *(u32x4*)(Yg + tok * DM + g * 16 + co) = w;
                }
            }
    }
};

template <class Epi, class Sched>
__device__ __forceinline__ void gemm_phase(LAS unsigned char* lds, LAS unsigned char* xl, const int lda, const int ldb, const int K, const Sched& S, const Epi& E) {
    int tid_ = threadIdx.x; asm volatile("" : "+v"(tid_));
    const int tid = tid_, wid = __builtin_amdgcn_readfirstlane(tid >> 6), lane = tid & 63, wr = wid >> 2, wc = wid & 3, fr = lane & 15, fq = lane >> 4;
    const int nt = K / BK;
    unsigned voffA, voffB;
    { int R, C; stage_rc(tid * 16, R, C); const int Rb = Epi::PERM ? ((R & ~31) + perm32(R & 31)) : R;
      voffA = (unsigned)(R * lda + C) * 2u; voffB = (unsigned)(Rb * ldb + C) * 2u; }
    const size_t qstepA = (size_t)64 * lda * 2, qstepB = (size_t)64 * ldb * 2;
    const size_t kstep = (size_t)(BK * 2);
    const size_t hstepA = (size_t)HALF * lda * 2, hstepB = (size_t)HALF * ldb * 2;
    const unsigned ldsw = (unsigned)wid * 1024u;
    const int aoff = lds_byte(wr * 64 + fr, fq * 8), boff = lds_byte(wc * 32 + fr, fq * 8);
#define PG8_SA(b, h) (((b) * 2 + (h)) * HTB)
#define PG8_SB(b, h) ((4 + (b) * 2 + (h)) * HTB)
#define PG8_STAGE(bufoff, gbase, voff) do { _Pragma("unroll") for (int _i = 0; _i < 2; ++_i) \
        { const char* _gb = (const char*)(gbase) + (size_t)_i * q##voff; asm volatile("" : "+s"(_gb)); \
          __builtin_amdgcn_global_load_lds((const unsigned*)(_gb + (voff)), (LAS unsigned*)(lds + (bufoff) + ldsw + _i * 8192), 16, 0, 0); } } while (0)
#define qvoffA qstepA
#define qvoffB qstepB
#define PG8_LDA(dst, b, h) do { _Pragma("unroll") for (int m = 0; m < 4; ++m) _Pragma("unroll") for (int k = 0; k < 2; ++k) dst[m][k] = *(const LAS bf16x8*)(lds + PG8_SA(b, h) + aoff + m * 2048 + k * 1024); } while (0)
#define PG8_LDB(dst, b, h) do { _Pragma("unroll") for (int n = 0; n < 2; ++n) _Pragma("unroll") for (int k = 0; k < 2; ++k) dst[n][k] = *(const LAS bf16x8*)(lds + PG8_SB(b, h) + boff + n * 2048 + k * 1024); } while (0)
#define PG8_MMA(ai, bj, At, Bt) do { __builtin_amdgcn_s_setprio(1); _Pragma("unroll") for (int m = 0; m < 4; ++m) _Pragma("unroll") for (int n = 0; n < 2; ++n) _Pragma("unroll") for (int k = 0; k < 2; ++k) \
        acc[ai][bj][m][n] = __builtin_amdgcn_mfma_f32_16x16x32_bf16(Bt[n][k], At[m][k], acc[ai][bj][m][n], 0, 0, 0); __builtin_amdgcn_s_setprio(0); } while (0)
#define PG8_WAIT_V(n) asm volatile("s_waitcnt vmcnt(" #n ")" ::: "memory")
#define PG8_WAIT_L(n) asm volatile("s_waitcnt lgkmcnt(" #n ")" ::: "memory")
#define PG8_BAR __builtin_amdgcn_s_barrier()
#define PG8_SCHED __builtin_amdgcn_sched_barrier(0)
    Unit cur, nxt; int ui = 0;
    if (!S.next(0, cur)) return;
    Acc acc;
#pragma unroll
    for (int a = 0; a < 2; ++a)
#pragma unroll
        for (int b = 0; b < 2; ++b)
#pragma unroll
            for (int m = 0; m < 4; ++m)
#pragma unroll
                for (int n = 0; n < 2; ++n) acc[a][b][m][n] = (f32x4){0.f, 0.f, 0.f, 0.f};
    bf16x8 At[4][2], B0[2][2], B1[2][2];
    const char* cA = cur.a; const char* cB = cur.b;
    PG8_STAGE(PG8_SB(0, 0), cB, voffB); PG8_STAGE(PG8_SB(0, 1), cB + hstepB, voffB); PG8_STAGE(PG8_SA(0, 0), cA, voffA); PG8_STAGE(PG8_SA(0, 1), cA + hstepA, voffA);
    if (wr == 1) PG8_BAR;
    PG8_WAIT_V(2); PG8_BAR;
    PG8_STAGE(PG8_SB(1, 0), cB + kstep, voffB); PG8_STAGE(PG8_SA(1, 0), cA + kstep, voffA); PG8_STAGE(PG8_SB(1, 1), cB + hstepB + kstep, voffB);
    PG8_WAIT_V(6); PG8_BAR;
    for (;;) {
        const bool has_next = S.next(ui + 1, nxt);
        const char* nA = has_next ? nxt.a : cA; const char* nB = has_next ? nxt.b : cB;
        for (int t = 0; t < nt; t += 2) {
            const bool last = (t == nt - 2);
            const char* a1 = cA + (size_t)(t + 1) * kstep;
            const char* a2 = last ? nA : cA + (size_t)(t + 2) * kstep; const char* b2 = last ? nB : cB + (size_t)(t + 2) * kstep;
            const char* a3 = a2 + kstep; const char* b3 = b2 + kstep;
            PG8_LDB(B0, 0, 0); PG8_LDB(B1, 0, 1); PG8_SCHED; PG8_LDA(At, 0, 0); PG8_STAGE(PG8_SA(1, 1), a1 + hstepA, voffA);
            PG8_WAIT_V(8); PG8_WAIT_L(0); PG8_BAR; PG8_MMA(0, 0, At, B0); PG8_MMA(0, 1, At, B1); PG8_BAR; PG8_SCHED;
            PG8_LDA(At, 0, 1); PG8_STAGE(PG8_SB(0, 0), b2, voffB); PG8_STAGE(PG8_SB(0, 1), b2 + hstepB, voffB); PG8_STAGE(PG8_SA(0, 0), a2, voffA);
            PG8_WAIT_V(8); PG8_WAIT_L(0); PG8_BAR; PG8_MMA(1, 0, At, B0); PG8_MMA(1, 1, At, B1); PG8_BAR; PG8_SCHED;
            PG8_LDB(B0, 1, 0); PG8_LDB(B1, 1, 1); PG8_SCHED; PG8_LDA(At, 1, 0); PG8_STAGE(PG8_SA(0, 1), a2 + hstepA, voffA);
            PG8_WAIT_V(8); PG8_WAIT_L(0); PG8_BAR; PG8_MMA(0, 0, At, B0); PG8_MMA(0, 1, At, B1); PG8_BAR; PG8_SCHED;
            PG8_LDA(At, 1, 1); PG8_STAGE(PG8_SB(1, 0), b3, voffB); PG8_STAGE(PG8_SB(1, 1), b3 + hstepB, voffB); PG8_STAGE(PG8_SA(1, 0), a3, voffA);
            PG8_WAIT_V(8); PG8_WAIT_L(0); PG8_BAR; PG8_MMA(1, 0, At, B0); PG8_MMA(1, 1, At, B1); PG8_BAR; PG8_SCHED;
        }
        if (wr == 0) PG8_BAR;
        __builtin_amdgcn_sched_barrier(0); asm volatile("s_nop 15\n\ts_nop 15\n\ts_nop 15" ::: "memory"); __builtin_amdgcn_sched_barrier(0);
        { int t2 = threadIdx.x; asm volatile("" : "+v"(t2)); E(acc, cur, wr, wc, t2 & 15, (t2 >> 4) & 3, xl); }
        if (!has_next) break;
#pragma unroll
        for (int a = 0; a < 2; ++a)
#pragma unroll
            for (int b = 0; b < 2; ++b)
#pragma unroll
                for (int m = 0; m < 4; ++m)
#pragma unroll
                    for (int n = 0; n < 2; ++n) acc[a][b][m][n] = (f32x4){0.f, 0.f, 0.f, 0.f};
        cur = nxt; cA = nA; cB = nB; ++ui;
        if (wr == 1) PG8_BAR;
    }
    PG8_WAIT_V(0);
    PG8_BAR;
#undef PG8_SA
#undef PG8_SB
#undef PG8_STAGE
#undef qvoffA
#undef qvoffB
#undef PG8_LDA
#undef PG8_LDB
#undef PG8_MMA
#undef PG8_WAIT_V
#undef PG8_WAIT_L
#undef PG8_BAR
#undef PG8_SCHED
}
}

constexpr int RING_BYTES = 131072, XL_OFF = RING_BYTES, XBST_OFF = XL_OFF + 14336, LDS_BYTES = 147456;

struct TItem { const float* W; const float* gk; bf16_t* D; int N, ldt, drow0, k0, n0; };
__device__ __forceinline__ void titem_load(float (&v)[32], const TItem& t, int lane) {
#pragma unroll
    for (int i = 0; i < 32; ++i) { const int kk = 2 * i + (lane >> 5); v[i] = t.W[(size_t)(t.k0 + kk) * t.N + t.n0 + (lane & 31)]; }
}
__device__ __forceinline__ void titem_to_lds(const float (&v)[32], LAS float* scr, int lane) {
#pragma unroll
    for (int i = 0; i < 32; ++i) { const int kk = 2 * i + (lane >> 5); scr[kk * 33 + (lane & 31)] = v[i]; }
    LDS_WAIT(); asm volatile("" ::: "memory");
}
__device__ __forceinline__ void titem_store(const TItem& t, LAS float* scr, int lane) {
    const int c = lane & 7;
    f32x4 g0 = (f32x4){1.f, 1.f, 1.f, 1.f}, g1 = g0;
    if (t.gk) { g0 = *(const f32x4*)(t.gk + t.k0 + 8 * c); g1 = *(const f32x4*)(t.gk + t.k0 + 8 * c + 4); }
#pragma unroll
    for (int j = 0; j < 4; ++j) { const int n = (lane >> 3) + 8 * j; const LAS float* s = scr + (8 * c) * 33 + n;
        u32x4 o; o.x = cvt_pk_bf16(s[0 * 33] * g0[0], s[1 * 33] * g0[1]); o.y = cvt_pk_bf16(s[2 * 33] * g0[2], s[3 * 33] * g0[3]);
        o.z = cvt_pk_bf16(s[4 * 33] * g1[0], s[5 * 33] * g1[1]); o.w = cvt_pk_bf16(s[6 * 33] * g1[2], s[7 * 33] * g1[3]);
        *(u32x4*)(t.D + (size_t)(t.drow0 + n) * t.ldt + t.k0 + 8 * c) = o; }
    LDS_WAIT(); asm volatile("" ::: "memory");
}
__device__ __forceinline__ void rms_row_to_bf16(const float* xrow, const float* g, bf16_t* orow, int lane) {
    const f32x4* xr = (const f32x4*)xrow + lane; const f32x4* gr = (const f32x4*)g + lane;
    f32x4 v[4]; float s = 0.f;
#pragma unroll
    for (int j = 0; j < 4; ++j) { v[j] = xr[64 * j]; s += (v[j].x * v[j].x + v[j].y * v[j].y) + (v[j].z * v[j].z + v[j].w * v[j].w); }
    const float rstd = 1.f / sqrtf(wave_sum(s) * (1.f / DM) + EPS);
    u32x2* o8 = (u32x2*)orow + lane;
#pragma unroll
    for (int j = 0; j < 4; ++j) { const f32x4 gg = gr[64 * j]; u32x2 w; w.x = cvt_pk_bf16(v[j].x * rstd * gg.x, v[j].y * rstd * gg.y); w.y = cvt_pk_bf16(v[j].z * rstd * gg.z, v[j].w * rstd * gg.w); o8[64 * j] = w; }
}

__device__ __forceinline__ void rms_rows4_to_bf16(const float* xrow, const float* g, bf16_t* orow, int lane) {
    f32x4 v[4][4]; float s[4];
#pragma unroll
    for (int r = 0; r < 4; ++r)
#pragma unroll
        for (int j = 0; j < 4; ++j) v[r][j] = *((const f32x4*)(xrow + (size_t)r * DM) + lane + 64 * j);
#pragma unroll
    for (int r = 0; r < 4; ++r) { s[r] = 0.f;
#pragma unroll
        for (int j = 0; j < 4; ++j) s[r] += (v[r][j].x * v[r][j].x + v[r][j].y * v[r][j].y) + (v[r][j].z * v[r][j].z + v[r][j].w * v[r][j].w); }
#pragma unroll
    for (int r = 0; r < 4; ++r) s[r] = 1.f / sqrtf(wave_sum(s[r]) * (1.f / DM) + EPS);
#pragma unroll
    for (int j = 0; j < 4; ++j) { const f32x4 gg = *((const f32x4*)g + lane + 64 * j);
#pragma unroll
        for (int r = 0; r < 4; ++r) { u32x2 w; w.x = cvt_pk_bf16(v[r][j].x * s[r] * gg.x, v[r][j].y * s[r] * gg.y); w.y = cvt_pk_bf16(v[r][j].z * s[r] * gg.z, v[r][j].w * s[r] * gg.w);
            *((u32x2*)(orow + (size_t)r * DM) + lane + 64 * j) = w; } }
}

struct Args { const float* in[28]; float* out; unsigned char* ws; int ph_lo, ph_hi; };
typedef const __attribute__((address_space(4))) Args* KArgs;
__device__ __forceinline__ KArgs kargs() { KArgs p = (KArgs)__builtin_amdgcn_kernarg_segment_ptr(); asm volatile("" : "+s"(p)); return p; }

__device__ __forceinline__ void ssm_tables(KArgs ap, int g, LAS unsigned char* lds, bf16_t* Tg, bf16_t* Wend) {
    LAS float* Lre = (LAS float*)lds;
    LAS float* Lim = Lre + 33 * 64;
    LAS float* Bre = Lim + 33 * 64;
    LAS float* Bim = Bre + 1024;
    LAS float* Cre = Bim + 1024;
    LAS float* Cim = Cre + 1024;
    LAS float* Kern = Cim + 1024;
    const int tid = threadIdx.x;
    const float* lam_re = ap->in[12] + g * 64; const float* lam_im = ap->in[13] + g * 64;
    const float dt = expf(ap->in[14][g]);
    for (int idx = tid; idx < 33 * 64; idx += 512) {
        const int tau = idx >> 6, p = idx & 63;
        const float mag = expf((float)tau * (lam_re[p] * dt)); const float ang = (float)tau * (lam_im[p] * dt);
        Lre[idx] = mag * cosf(ang); Lim[idx] = mag * sinf(ang);
    }
    __syncthreads();
    for (int idx = tid; idx < 1024; idx += 512) {
        {
            const int p = idx >> 4;
            const float lr = lam_re[p], li = lam_im[p], lbr = Lre[64 + p], lbi = Lim[64 + p];
            const float nre = lbr - 1.0f, den = lr * lr + li * li;
            const float cr = (nre * lr + lbi * li) / den, ci = (lbi * lr - nre * li) / den;
            const float br = ap->in[15][(size_t)g * 1024 + idx], bi = ap->in[16][(size_t)g * 1024 + idx];
            Bre[idx] = cr * br - ci * bi; Bim[idx] = cr * bi + ci * br;
        }
        Cre[idx] = ap->in[17][(size_t)g * 1024 + idx]; Cim[idx] = ap->in[18][(size_t)g * 1024 + idx];
    }
    __syncthreads();
    {
        const int tau = tid >> 4, co = tid & 15; float kacc[16];
#pragma unroll
        for (int ci = 0; ci < 16; ++ci) kacc[ci] = 0.f;
        for (int p = 0; p < 64; ++p) {
            const float cr = Cre[co * 64 + p], cim = Cim[co * 64 + p], lr = Lre[tau * 64 + p], li = Lim[tau * 64 + p];
            const float gr = cr * lr - cim * li, gi = cr * li + cim * lr;
#pragma unroll
            for (int q = 0; q < 4; ++q) { const f32x4 br = *(const LAS f32x4*)(Bre + p * 16 + 4 * q), bi = *(const LAS f32x4*)(Bim + p * 16 + 4 * q);
#pragma unroll
                for (int e = 0; e < 4; ++e) kacc[4 * q + e] += gr * br[e] - gi * bi[e]; }
        }
#pragma unroll
        for (int ci = 0; ci < 16; ++ci) Kern[tid * 16 + ci] = kacc[ci];
    }
    __syncthreads();
    bf16_t* T = Tg + (size_t)g * 512 * 640;
    for (int idx = tid; idx < 512 * 80; idx += 512) {
        const int n = idx / 80, k8 = (idx % 80) * 8; const int t = n >> 4, co = n & 15;
        float v[8];
        if (k8 < 512) { const int s = k8 >> 4, ci = k8 & 15;
#pragma unroll
            for (int j = 0; j < 8; ++j) v[j] = (s <= t) ? Kern[((t - s) * 16 + co) * 16 + ci + j] : 0.f;
        } else { const int q = k8 - 512, im = q >> 6, p0 = q & 63;
#pragma unroll
            for (int j = 0; j < 8; ++j) { const int p = p0 + j; const float cr = Cre[co * 64 + p], cim = Cim[co * 64 + p], lr = Lre[(t + 1) * 64 + p], li = Lim[(t + 1) * 64 + p];
                v[j] = im ? -(cr * li + cim * lr) : (cr * lr - cim * li); }
        }
        u32x4 w; w.x = cvt_pk_bf16(v[0], v[1]); w.y = cvt_pk_bf16(v[2], v[3]); w.z = cvt_pk_bf16(v[4], v[5]); w.w = cvt_pk_bf16(v[6], v[7]);
        *(u32x4*)(T + (size_t)n * 640 + k8) = w;
    }
    bf16_t* We = Wend + (size_t)g * 256 * 512;
    for (int idx = tid; idx < 256 * 64; idx += 512) {
        const int j = idx >> 6, k8 = (idx & 63) * 8; float v[8];
        if (j < 128) { const int p = j & 63, im = j >> 6, s = k8 >> 4, ci = k8 & 15; const float lr = Lre[(31 - s) * 64 + p], li = Lim[(31 - s) * 64 + p];
#pragma unroll
            for (int e = 0; e < 8; ++e) { const float br = Bre[p * 16 + ci + e], bi = Bim[p * 16 + ci + e]; v[e] = im ? (lr * bi + li * br) : (lr * br - li * bi); }
        } else {
#pragma unroll
            for (int e = 0; e < 8; ++e) v[e] = 0.f;
        }
        u32x4 w; w.x = cvt_pk_bf16(v[0], v[1]); w.y = cvt_pk_bf16(v[2], v[3]); w.z = cvt_pk_bf16(v[4], v[5]); w.w = cvt_pk_bf16(v[6], v[7]);
        *(u32x4*)(We + (size_t)j * 512 + k8) = w;
    }
    __syncthreads();
}


template <int W> __device__ __forceinline__ u32x4 pool_item(const bf16_t* up, int t) {
    const int cnt = (t + 1 < W) ? t + 1 : W;
    u32x4 v[W];
#pragma unroll
    for (int i = 0; i < W; ++i) v[i] = (i < cnt) ? *(const u32x4*)(up - (size_t)i * 1536) : (u32x4){0u, 0u, 0u, 0u};
    float s[8];
#pragma unroll
    for (int j = 0; j < 8; ++j) s[j] = 0.f;
#pragma unroll
    for (int i = 0; i < W; ++i) { s[0] += bflo(v[i].x); s[1] += bfhi(v[i].x); s[2] += bflo(v[i].y); s[3] += bfhi(v[i].y); s[4] += bflo(v[i].z); s[5] += bfhi(v[i].z); s[6] += bflo(v[i].w); s[7] += bfhi(v[i].w); }
    const float inv = 1.0f / (float)cnt;
    u32x4 w; w.x = cvt_pk_bf16(s[0] * inv - bflo(v[0].x), s[1] * inv - bfhi(v[0].x)); w.y = cvt_pk_bf16(s[2] * inv - bflo(v[0].y), s[3] * inv - bfhi(v[0].y));
    w.z = cvt_pk_bf16(s[4] * inv - bflo(v[0].z), s[5] * inv - bfhi(v[0].z)); w.w = cvt_pk_bf16(s[6] * inv - bflo(v[0].w), s[7] * inv - bfhi(v[0].w));
    return w;
}

__device__ __forceinline__ void bf8_to_f(const u32x4 v, float (&f)[8]) { f[0] = bflo(v.x); f[1] = bfhi(v.x); f[2] = bflo(v.y); f[3] = bfhi(v.y); f[4] = bflo(v.z); f[5] = bfhi(v.z); f[6] = bflo(v.w); f[7] = bfhi(v.w); }
template <int W> __device__ __forceinline__ void pool_segment(const bf16_t* up, bf16_t* op, int t0) {
    float s[8];
#pragma unroll
    for (int j = 0; j < 8; ++j) s[j] = 0.f;
#pragma unroll
    for (int i = 1; i < W; ++i) {
        u32x4 v = (u32x4){0u, 0u, 0u, 0u};
        if (t0 - i >= 0) v = *(const u32x4*)(up - (size_t)i * 1536);
        float f[8]; bf8_to_f(v, f);
#pragma unroll
        for (int j = 0; j < 8; ++j) s[j] += f[j];
    }
#pragma unroll 4
    for (int r = 0; r < 32; ++r) {
        const int t = t0 + r;
        const u32x4 vc = *(const u32x4*)(up + (size_t)r * 1536);
        u32x4 vo = (u32x4){0u, 0u, 0u, 0u};
        if (t - (W - 1) >= 0) vo = *(const u32x4*)(up + (size_t)(r - (W - 1)) * 1536);
        float fc[8], fo[8]; bf8_to_f(vc, fc); bf8_to_f(vo, fo);
        const float inv = 1.0f / (float)((t + 1 < W) ? t + 1 : W);
        float o[8];
#pragma unroll
        for (int j = 0; j < 8; ++j) { s[j] += fc[j]; o[j] = s[j] * inv - fc[j]; s[j] -= fo[j]; }
        u32x4 w; w.x = cvt_pk_bf16(o[0], o[1]); w.y = cvt_pk_bf16(o[2], o[3]); w.z = cvt_pk_bf16(o[4], o[5]); w.w = cvt_pk_bf16(o[6], o[7]);
        *(u32x4*)(op + (size_t)r * DM) = w;
    }
}

__device__ __forceinline__ int crow(int r, int hi) { return (r & 3) + 8 * (r >> 2) + 4 * hi; }
__device__ __forceinline__ void sb_attn_task(const bf16_t* __restrict__ QKU, const bf16_t* __restrict__ VT, bf16_t* __restrict__ CAT, int b, int h, int qb, int lane) {
    const int r32 = lane & 31, hi = lane >> 5;
    const size_t tok0 = (size_t)b * SEQ; const int q0 = qb * 32;
    const bf16_t* qp = QKU + (tok0 + q0 + r32) * 1536 + h * 64 + 8 * hi;
    bf16x8 qf[4];
#pragma unroll
    for (int j = 0; j < 4; ++j) qf[j] = *(const bf16x8*)(qp + 16 * j);
    const bf16_t* kp = QKU + (tok0 + r32) * 1536 + 512 + h * 64 + 8 * hi;
    const bf16_t* vp = VT + (size_t)(h * 64 + r32) * VT_LD + tok0 + 4 * hi;
    f32x16 o0, o1;
#pragma unroll
    for (int r = 0; r < 16; ++r) { o0[r] = 0.f; o1[r] = 0.f; }
    float carry = 1.0f;
    bf16x8 kf[4]; s16x4 va[2][4]; bf16x8 k1[4]; s16x4 v1[2][4];
#define SB_LOAD(KF, VA, K0) do { const int k0_ = (K0); \
        _Pragma("unroll") for (int j = 0; j < 4; ++j) KF[j] = *(const bf16x8*)(kp + (size_t)k0_ * 1536 + 16 * j); \
        _Pragma("unroll") for (int dh = 0; dh < 2; ++dh) _Pragma("unroll") for (int c = 0; c < 4; ++c) VA[dh][c] = *(const s16x4*)(vp + (size_t)dh * 32 * VT_LD + k0_ + 8 * c); } while (0)
    asm volatile("s_waitcnt vmcnt(0)" ::: "memory");
    SB_LOAD(kf, va, q0);
    SB_LOAD(k1, v1, qb > 0 ? q0 - 32 : q0);
    for (int kt = qb; kt >= 0; --kt) {
        bf16x8 kn[4]; s16x4 vn[2][4];
        SB_LOAD(kn, vn, kt >= 2 ? (kt - 2) * 32 : 0);
        f32x16 s;
#pragma unroll
        for (int r = 0; r < 16; ++r) s[r] = 0.f;
#pragma unroll
        for (int j = 0; j < 4; ++j) s = __builtin_amdgcn_mfma_f32_32x32x16_bf16(kf[j], qf[j], s, 0, 0, 0);
        const bool diag = (kt == qb);
        float omb[16], bt[16];
#pragma unroll
        for (int r = 0; r < 16; ++r) {
            const float z2 = fminf(s[r] * (0.125f * LOG2E), 100.0f);
            const float e = fexp2(z2);
            const float ob = frcp(1.0f + e);
            const bool valid = !diag || (crow(r, hi) < r32);
            omb[r] = valid ? ob : 1.0f; bt[r] = valid ? e * ob : 0.0f;
        }
        float gp[4], pg[4];
#pragma unroll
        for (int g = 0; g < 4; ++g) { gp[g] = (omb[4 * g] * omb[4 * g + 1]) * (omb[4 * g + 2] * omb[4 * g + 3]); pg[g] = partner32(gp[g], hi); }
        float tp[4];
        tp[3] = 1.0f; tp[2] = gp[3] * pg[3]; tp[1] = tp[2] * (gp[2] * pg[2]); tp[0] = tp[1] * (gp[1] * pg[1]);
        const float total = tp[0] * (gp[0] * pg[0]);
        float w[16];
#pragma unroll
        for (int g = 0; g < 4; ++g) {
            const float base = carry * tp[g] * (hi ? 1.0f : pg[g]);
            const float a3 = base, a2 = a3 * omb[4 * g + 3], a1 = a2 * omb[4 * g + 2], a0 = a1 * omb[4 * g + 1];
            w[4 * g + 3] = bt[4 * g + 3] * a3;
            w[4 * g + 2] = bt[4 * g + 2] * a2;
            w[4 * g + 1] = bt[4 * g + 1] * a1;
            w[4 * g + 0] = bt[4 * g + 0] * a0;
        }
        carry *= total;
        u32x4 p0, p1;
        p0.x = cvt_pk_bf16(w[0], w[1]); p0.y = cvt_pk_bf16(w[2], w[3]); p0.z = cvt_pk_bf16(w[4], w[5]); p0.w = cvt_pk_bf16(w[6], w[7]);
        p1.x = cvt_pk_bf16(w[8], w[9]); p1.y = cvt_pk_bf16(w[10], w[11]); p1.z = cvt_pk_bf16(w[12], w[13]); p1.w = cvt_pk_bf16(w[14], w[15]);
        const bf16x8 pb0 = __builtin_bit_cast(bf16x8, p0), pb1 = __builtin_bit_cast(bf16x8, p1);
#define VA8(dh, c) (bf16x8){va[dh][c][0], va[dh][c][1], va[dh][c][2], va[dh][c][3], va[dh][(c) + 1][0], va[dh][(c) + 1][1], va[dh][(c) + 1][2], va[dh][(c) + 1][3]}
        const bf16x8 a00 = VA8(0, 0), a02 = VA8(0, 2), a10 = VA8(1, 0), a12 = VA8(1, 2);
#undef VA8
        o0 = __builtin_amdgcn_mfma_f32_32x32x16_bf16(a00, pb0, o0, 0, 0, 0);
        o0 = __builtin_amdgcn_mfma_f32_32x32x16_bf16(a02, pb1, o0, 0, 0, 0);
        o1 = __builtin_amdgcn_mfma_f32_32x32x16_bf16(a10, pb0, o1, 0, 0, 0);
        o1 = __builtin_amdgcn_mfma_f32_32x32x16_bf16(a12, pb1, o1, 0, 0, 0);
        __builtin_amdgcn_sched_barrier(0);
        asm volatile("s_nop 15\n\ts_nop 15\n\ts_nop 15\n\ts_nop 15\n\ts_nop 15" ::: "memory");
        asm volatile("" :: "v"(a00), "v"(a02), "v"(a10), "v"(a12), "v"(pb0), "v"(pb1), "v"(kf[0]), "v"(kf[1]), "v"(kf[2]), "v"(kf[3]));
        __builtin_amdgcn_sched_barrier(0);
        if (__all(carry == 0.0f)) break;
#pragma unroll
        for (int j = 0; j < 4; ++j) { kf[j] = k1[j]; k1[j] = kn[j]; }
#pragma unroll
        for (int dh = 0; dh < 2; ++dh)
#pragma unroll
            for (int c = 0; c < 4; ++c) { va[dh][c] = v1[dh][c]; v1[dh][c] = vn[dh][c]; }
    }
#undef SB_LOAD
    bf16_t* op = CAT + (tok0 + q0 + r32) * DM + h * 64 + 4 * hi;
#pragma unroll
    for (int g = 0; g < 4; ++g) {
        u32x2 w0, w1;
        w0.x = cvt_pk_bf16(o0[4 * g], o0[4 * g + 1]); w0.y = cvt_pk_bf16(o0[4 * g + 2], o0[4 * g + 3]);
        w1.x = cvt_pk_bf16(o1[4 * g], o1[4 * g + 1]); w1.y = cvt_pk_bf16(o1[4 * g + 2], o1[4 * g + 3]);
        *(u32x2*)(op + 8 * g) = w0; *(u32x2*)(op + 32 + 8 * g) = w1;
    }
}


constexpr int SBK_PITCH = 144, SBV_PITCH = 80, SBK_BYTES = 32 * SBK_PITCH, SBV_BYTES = 64 * SBV_PITCH, SB_TILE = SBK_BYTES + SBV_BYTES, SB_WIN = 14;
static_assert(SB_WIN * SB_TILE <= XBST_OFF, "attention LDS window must stay below the grid barrier's LDS words");
__device__ __forceinline__ void sb_attn_block(const bf16_t* __restrict__ QKU, const bf16_t* __restrict__ VT, bf16_t* __restrict__ CAT, int b, int h, int qb0,
                                              LAS unsigned char* lds, int tid, int wave, int lane) {
    const int r32 = lane & 31, hi = lane >> 5;
    const size_t tok0 = (size_t)b * SEQ; const int qb = qb0 + wave, q0 = qb * 32;
    const int lo = (qb0 >= 6) ? qb0 - 6 : 0, ntile = qb0 + 8 - lo;
    {
        const bool isk = tid < 256; const int t2 = tid & 255;
        const bf16_t* gsrc = isk ? QKU + (tok0 + (t2 >> 3)) * 1536 + 512 + h * 64 + (t2 & 7) * 8
                                 : VT + (size_t)(h * 64 + (t2 >> 2)) * VT_LD + tok0 + (t2 & 3) * 8;
        const size_t gstep = isk ? (size_t)32 * 1536 : (size_t)32;
        const int ldst = isk ? (t2 >> 3) * SBK_PITCH + (t2 & 7) * 16 : SBK_BYTES + (t2 >> 2) * SBV_PITCH + (t2 & 3) * 16;
        u32x4 stg[SB_WIN];
#pragma unroll
        for (int i = 0; i < SB_WIN; ++i) if (i < ntile) stg[i] = *(const u32x4*)(gsrc + (size_t)(lo + i) * gstep);
#pragma unroll
        for (int i = 0; i < SB_WIN; ++i) if (i < ntile) *(LAS u32x4*)(lds + i * SB_TILE + ldst) = stg[i];
    }
    const bf16_t* qp = QKU + (tok0 + q0 + r32) * 1536 + h * 64 + 8 * hi;
    bf16x8 qf[4];
#pragma unroll
    for (int j = 0; j < 4; ++j) qf[j] = *(const bf16x8*)(qp + 16 * j);
    const bf16_t* kp = QKU + (tok0 + r32) * 1536 + 512 + h * 64 + 8 * hi;
    const bf16_t* vp = VT + (size_t)(h * 64 + r32) * VT_LD + tok0 + 4 * hi;
    f32x16 o0, o1;
#pragma unroll
    for (int r = 0; r < 16; ++r) { o0[r] = 0.f; o1[r] = 0.f; }
    float carry = 1.0f;
    __syncthreads();
    for (int kt = qb; kt >= 0; --kt) {
        bf16x8 kf[4]; s16x4 va[2][4];
        if (kt >= lo) {
            LAS unsigned char* kb = lds + (kt - lo) * SB_TILE; LAS unsigned char* vb = kb + SBK_BYTES;
#pragma unroll
            for (int j = 0; j < 4; ++j) kf[j] = *(const LAS bf16x8*)(kb + r32 * SBK_PITCH + (16 * j + 8 * hi) * 2);
#pragma unroll
            for (int dh = 0; dh < 2; ++dh)
#pragma unroll
                for (int c = 0; c < 4; ++c) va[dh][c] = *(const LAS s16x4*)(vb + (dh * 32 + r32) * SBV_PITCH + (8 * c + 4 * hi) * 2);
        } else {
            const int k0 = kt * 32;
#pragma unroll
            for (int j = 0; j < 4; ++j) kf[j] = *(const bf16x8*)(kp + (size_t)k0 * 1536 + 16 * j);
#pragma unroll
            for (int dh = 0; dh < 2; ++dh)
#pragma unroll
                for (int c = 0; c < 4; ++c) va[dh][c] = *(const s16x4*)(vp + (size_t)dh * 32 * VT_LD + k0 + 8 * c);
        }
        f32x16 s;
#pragma unroll
        for (int r = 0; r < 16; ++r) s[r] = 0.f;
#pragma unroll
        for (int j = 0; j < 4; ++j) s = __builtin_amdgcn_mfma_f32_32x32x16_bf16(kf[j], qf[j], s, 0, 0, 0);
        const bool diag = (kt == qb);
        float omb[16], bt[16];
#pragma unroll
        for (int r = 0; r < 16; ++r) {
            const float z2 = fminf(s[r] * (0.125f * LOG2E), 100.0f);
            const float e = fexp2(z2);
            const float ob = frcp(1.0f + e);
            const bool valid = !diag || (crow(r, hi) < r32);
            omb[r] = valid ? ob : 1.0f; bt[r] = valid ? e * ob : 0.0f;
        }
        float gp[4], pg[4];
#pragma unroll
        for (int g = 0; g < 4; ++g) { gp[g] = (omb[4 * g] * omb[4 * g + 1]) * (omb[4 * g + 2] * omb[4 * g + 3]); pg[g] = partner32(gp[g], hi); }
        float tp[4];
        tp[3] = 1.0f; tp[2] = gp[3] * pg[3]; tp[1] = tp[2] * (gp[2] * pg[2]); tp[0] = tp[1] * (gp[1] * pg[1]);
        const float total = tp[0] * (gp[0] * pg[0]);
        float w[16];
#pragma unroll
        for (int g = 0; g < 4; ++g) {
            const float base = carry * tp[g] * (hi ? 1.0f : pg[g]);
            const float a3 = base, a2 = a3 * omb[4 * g + 3], a1 = a2 * omb[4 * g + 2], a0 = a1 * omb[4 * g + 1];
            w[4 * g + 3] = bt[4 * g + 3] * a3; w[4 * g + 2] = bt[4 * g + 2] * a2; w[4 * g + 1] = bt[4 * g + 1] * a1; w[4 * g + 0] = bt[4 * g + 0] * a0;
        }
        carry *= total;
        u32x4 p0, p1;
        p0.x = cvt_pk_bf16(w[0], w[1]); p0.y = cvt_pk_bf16(w[2], w[3]); p0.z = cvt_pk_bf16(w[4], w[5]); p0.w = cvt_pk_bf16(w[6], w[7]);
        p1.x = cvt_pk_bf16(w[8], w[9]); p1.y = cvt_pk_bf16(w[10], w[11]); p1.z = cvt_pk_bf16(w[12], w[13]); p1.w = cvt_pk_bf16(w[14], w[15]);
        const bf16x8 pb0 = __builtin_bit_cast(bf16x8, p0), pb1 = __builtin_bit_cast(bf16x8, p1);
#define VA8(dh, c) (bf16x8){va[dh][c][0], va[dh][c][1], va[dh][c][2], va[dh][c][3], va[dh][(c) + 1][0], va[dh][(c) + 1][1], va[dh][(c) + 1][2], va[dh][(c) + 1][3]}
        const bf16x8 a00 = VA8(0, 0), a02 = VA8(0, 2), a10 = VA8(1, 0), a12 = VA8(1, 2);
#undef VA8
        o0 = __builtin_amdgcn_mfma_f32_32x32x16_bf16(a00, pb0, o0, 0, 0, 0);
        o0 = __builtin_amdgcn_mfma_f32_32x32x16_bf16(a02, pb1, o0, 0, 0, 0);
        o1 = __builtin_amdgcn_mfma_f32_32x32x16_bf16(a10, pb0, o1, 0, 0, 0);
        o1 = __builtin_amdgcn_mfma_f32_32x32x16_bf16(a12, pb1, o1, 0, 0, 0);
        __builtin_amdgcn_sched_barrier(0);
        asm volatile("s_nop 15\n\ts_nop 15\n\ts_nop 15\n\ts_nop 15\n\ts_nop 15" ::: "memory");
        asm volatile("" :: "v"(a00), "v"(a02), "v"(a10), "v"(a12), "v"(pb0), "v"(pb1), "v"(kf[0]), "v"(kf[1]), "v"(kf[2]), "v"(kf[3]));
        __builtin_amdgcn_sched_barrier(0);
        if (__all(carry == 0.0f)) break;
    }
    bf16_t* op = CAT + (tok0 + q0 + r32) * DM + h * 64 + 4 * hi;
#pragma unroll
    for (int g = 0; g < 4; ++g) {
        u32x2 w0, w1;
        w0.x = cvt_pk_bf16(o0[4 * g], o0[4 * g + 1]); w0.y = cvt_pk_bf16(o0[4 * g + 2], o0[4 * g + 3]);
        w1.x = cvt_pk_bf16(o1[4 * g], o1[4 * g + 1]); w1.y = cvt_pk_bf16(o1[4 * g + 2], o1[4 * g + 3]);
        *(u32x2*)(op + 8 * g) = w0; *(u32x2*)(op + 32 + 8 * g) = w1;
    }
    __syncthreads();
}

#define XB_TMO      128
#define XB_XCNT(j)  (256  + 64 * (j))
#define XB_XSUB(j)  (1280 + 64 * (j))
#define XB_XGEN(j)  (2304 + 64 * (j))
#define XB_TOP      3328
#define XB_TOPGEN   3392
#define XCD_BAR_WORDS 3456
#define XB_SPIN_CAP (1u << 22)
__device__ __forceinline__ unsigned xb_ld(unsigned* p)              { return __hip_atomic_load(p, __ATOMIC_RELAXED, __HIP_MEMORY_SCOPE_AGENT); }
__device__ __forceinline__ unsigned xb_add(unsigned* p, unsigned v) { return __hip_atomic_fetch_add(p, v, __ATOMIC_RELAXED, __HIP_MEMORY_SCOPE_AGENT); }
__device__ __forceinline__ unsigned xb_xcc_id() { return (unsigned)__builtin_amdgcn_s_getreg((3 << 11) | 20) & 0xFu; }
#define XB_SPIN(cond, bar) do { unsigned _sp = 0; while (cond) { __builtin_amdgcn_s_sleep(1); \
    if ((++_sp & 255u) == 0u) { if (xb_ld(&(bar)[XB_TMO])) break; if (_sp > XB_SPIN_CAP) { atomicAdd(&(bar)[XB_TMO], 1u); break; } } } } while (0)
__device__ __forceinline__ void xcd_barrier_complete(unsigned* bar, unsigned x, unsigned G, unsigned& nloc, unsigned& nx) {
    unsigned sum, cnt, mine, sp = 0u;
    for (;;) {
        sum = 0u; cnt = 0u; mine = 0u;
#pragma unroll
        for (unsigned j = 0; j < 16; ++j) { const unsigned c = xb_ld(&bar[XB_XCNT(j)]); sum += c; cnt += (c > 0u) ? 1u : 0u; mine = (j == x) ? c : mine; }
        if (sum == G) break;
        __builtin_amdgcn_s_sleep(1);
        if ((++sp & 255u) == 0u) { if (xb_ld(&bar[XB_TMO])) break; if (sp > XB_SPIN_CAP) { atomicAdd(&bar[XB_TMO], 1u); break; } }
    }
    nloc = mine > 0u ? mine : 1u; nx = cnt > 0u ? cnt : 1u;
}
__device__ __forceinline__ void xcd_barrier(unsigned* bar, volatile LAS unsigned* st, bool leader, unsigned G) {
    asm volatile("s_waitcnt vmcnt(0)" ::: "memory");
    __syncthreads();
    if (leader) {
        const unsigned x = xb_xcc_id();
        __builtin_amdgcn_s_waitcnt(0);
        unsigned nloc = st[0], nx = st[1];
        if (nloc == 0u) { xcd_barrier_complete(bar, x, G, nloc, nx); st[0] = nloc; st[1] = nx; }
        const unsigned old = xb_add(&bar[XB_XSUB(x)], 1u);
        const unsigned gen = old / nloc;
        if (old + 1u == (gen + 1u) * nloc) {
            __builtin_amdgcn_fence(__ATOMIC_RELEASE, "agent");
            asm volatile("s_waitcnt vmcnt(0)" ::: "memory");
            const unsigned og = xb_add(&bar[XB_TOP], 1u);
            const unsigned tg = og / nx;
            if (og + 1u == (tg + 1u) * nx) xb_add(&bar[XB_TOPGEN], 1u);
            else XB_SPIN(xb_ld(&bar[XB_TOPGEN]) == tg, bar);
            __builtin_amdgcn_fence(__ATOMIC_ACQUIRE, "agent");
            xb_add(&bar[XB_XGEN(x)], 1u);
            asm volatile("s_waitcnt vmcnt(0)" ::: "memory");
        } else {
            XB_SPIN(xb_ld(&bar[XB_XGEN(x)]) == gen, bar);
            __builtin_amdgcn_fence(__ATOMIC_ACQUIRE, "agent");
            asm volatile("s_waitcnt vmcnt(0)" ::: "memory");
        }
    }
    __syncthreads();
}

__global__ void __launch_bounds__(512) mega_fwd(Args a) {
    __builtin_assume(__builtin_amdgcn_workitem_id_y() == 0); __builtin_assume(__builtin_amdgcn_workitem_id_z() == 0);
    extern __shared__ __attribute__((aligned(16))) unsigned char lds_raw[];
    LAS unsigned char* lds = (LAS unsigned char*)lds_raw;
    LAS unsigned char* xl = lds + XL_OFF;
    cg::grid_group grid = cg::this_grid();
#if !MK_MULTI_LAUNCH
    {
        volatile LAS unsigned* st = (volatile LAS unsigned*)(lds + XBST_OFF);
        if (threadIdx.x == 0) { st[0] = 0u; st[1] = 0u; KArgs ap0 = kargs(); xb_add(&((unsigned*)ap0->ws)[XB_XCNT(xb_xcc_id())], 1u); }
        if (a.ph_lo < 0) grid.sync();
        __syncthreads();
    }
#endif
#if MK_MULTI_LAUNCH
    const int lo = a.ph_lo, hi = a.ph_hi;
    int ph = 0;
#endif
#define PH_VARS int tid = threadIdx.x; asm volatile("" : "+v"(tid)); const int lane = tid & 63, wave = __builtin_amdgcn_readfirstlane(tid >> 6); int G_ = gridDim.x, bid_ = blockIdx.x; asm volatile("" : "+s"(G_), "+s"(bid_)); const int G = G_, bid = bid_; \
    const int gw = bid * 8 + wave, NGW = G * 8, gt = bid * 512 + tid, NGT = G * 512; (void)lane; (void)gw; (void)NGW; (void)gt; (void)NGT; KArgs ap = kargs(); unsigned char* ws = ap->ws; float* X = ap->out; float* SSQ = (float*)(ws + WS_SSQ); bf16_t* XB = (bf16_t*)(ws + WS_XB); bf16_t* MEMN = (bf16_t*)(ws + WS_MEMN); (void)X; (void)SSQ; (void)XB; (void)MEMN;
#if MK_MULTI_LAUNCH
#define PHASE_ON (ph >= lo && ph < hi)
#define PHASE_END do { if (ph >= lo && ph + 1 < hi) grid.sync(); ++ph; } while (0)
#define LOCAL_SEAM PHASE_END
#else
#define PHASE_ON (true)
#define LOCAL_SEAM do { asm volatile("s_waitcnt vmcnt(0)" ::: "memory"); __syncthreads(); { int tl = threadIdx.x; asm volatile("" : "+v"(tl)); \
    if (tl == 0) { __builtin_amdgcn_fence(__ATOMIC_ACQUIRE, "agent"); asm volatile("s_waitcnt vmcnt(0)" ::: "memory"); } } __syncthreads(); } while (0)
#define PHASE_END do { KArgs apb = kargs(); int tb = threadIdx.x; asm volatile("" : "+v"(tb)); int Gb = gridDim.x; asm volatile("" : "+s"(Gb)); \
    xcd_barrier((unsigned*)apb->ws, (volatile LAS unsigned*)(lds + XBST_OFF), tb == 0, (unsigned)Gb); } while (0)
#endif

    if (PHASE_ON) { PH_VARS
        if (bid < 64) ssm_tables(ap, bid, lds, (bf16_t*)(ws + WS_TG), (bf16_t*)(ws + WS_WEND));
        LAS float* scr = (LAS float*)(lds + wave * 16384);
        const bool weighted = (G > 64);
        const int n_tw = weighted ? 64 * 8 : 0, n_nw = weighted ? (G - 64) * 8 : G * 8;
        const int spw = weighted ? 4 : 1, S = n_nw * spw + n_tw;
        const bool is_tw = weighted && bid < 64;
        const int slot0 = is_tw ? n_nw * spw + gw : (weighted ? (gw - 512) * 4 : gw), nslot = is_tw ? 1 : spw;
        if (!is_tw) {
            const int nb_ = weighted ? G - 64 : G, b_ = weighted ? bid - 64 : bid;
            for (int it = b_ + wave * nb_; it < 256; it += nb_ * 8) {
                const int g = it >> 6, cb = (it >> 2) & 15, nb = it & 3;
                const float* pw = ap->in[8] + (size_t)(g * 128 + cb * 8) * 128; const float* sc = ap->in[9] + g * 128;
                const float* wo = ap->in[10] + (size_t)(512 + g * 128) * 1024 + nb * 256 + lane * 4;
                f32x4 acc8[8];
#pragma unroll
                for (int j = 0; j < 8; ++j) acc8[j] = (f32x4){0.f, 0.f, 0.f, 0.f};
#pragma unroll 8
                for (int d = 0; d < 128; ++d) {
                    const f32x4 wv = *(const f32x4*)(wo + (size_t)d * 1024); const float sd = sc[d];
#pragma unroll
                    for (int j = 0; j < 8; ++j) acc8[j] += wv * (pw[j * 128 + d] * sd);
                }
                bf16_t* D = (bf16_t*)(ws + WS_WOUT) + (size_t)(nb * 256 + lane * 4) * 1024 + 512 + g * 128 + cb * 8;
#pragma unroll
                for (int e = 0; e < 4; ++e) {
                    u32x4 w; w.x = cvt_pk_bf16(acc8[0][e], acc8[1][e]); w.y = cvt_pk_bf16(acc8[2][e], acc8[3][e]); w.z = cvt_pk_bf16(acc8[4][e], acc8[5][e]); w.w = cvt_pk_bf16(acc8[6][e], acc8[7][e]);
                    *(u32x4*)(D + (size_t)e * 1024) = w;
                }
            }
        }
        {
            float tv[32]; TItem cur, nxt; bool have = false, have_next = false;
            int sl = 0, it = slot0;
            auto decode = [&](int item, TItem& t) -> bool {
                int r = item; const float* W = nullptr; const float* gk = nullptr; int N = 0; bf16_t* D = nullptr; int ldt = 0, mode = 0; bool found = false;
#define TJOB(Wp, Kk, Nn, Dp, Ld, Md, Gp) if (!found) { const int cnt = ((Kk) / 64) * ((Nn) / 32); if (r < cnt) { W = (Wp); N = (Nn); D = (bf16_t*)(Dp); ldt = (Ld); mode = (Md); gk = (Gp); found = true; } else r -= cnt; }
                TJOB(ap->in[7], 1024, 2048, ws + WS_WIN, 1024, 1, nullptr)
            TJOB(ap->in[10], 512, 1024, ws + WS_WOUT, 1024, 0, nullptr)
            TJOB(ap->in[11], 1024, 1024, ws + WS_WSSM, 1024, 0, ap->in[2] + 1024)
            TJOB(ap->in[20], 1024, 2048, ws + WS_WGLU, 1024, 2, nullptr)
#pragma unroll
            for (int l = 0; l < 2; ++l) {
                unsigned char* lb = ws + WS_LAYER + l * LAYER_STRIDE;
                TJOB(ap->in[22] + (size_t)l * 1024 * 2048, 1024, 2048, lb + LO_WKV, 1024, 0, nullptr)
                TJOB(ap->in[23] + (size_t)l * 1024 * 1024, 1024, 1024, lb + LO_WO, 1024, 0, nullptr)
                TJOB(ap->in[24] + (size_t)l * 1024 * DFF2, 1024, DFF2, lb + LO_WUP, 1024, 3, ap->in[4] + l * 1024)
                TJOB(ap->in[27] + (size_t)l * DFF * 1024, DFF, 1024, lb + LO_WDN, DFF, 0, nullptr)
            }
#undef TJOB
                if (!found) return false;
                const int nblk = N / 32, kb = r / nblk, nb = r % nblk, n0 = nb * 32;
                int drow0 = n0;
                if (mode == 1) drow0 = (n0 < 1024) ? n0 : (n0 < 1536 ? n0 + 512 : n0 - 512);
                else if (mode == 2) drow0 = (n0 < 1024) ? (256 * (n0 >> 7) + (n0 & 127)) : (256 * ((n0 - 1024) >> 7) + 128 + ((n0 - 1024) & 127));
                else if (mode == 3) drow0 = (n0 < DFF) ? (256 * (n0 >> 7) + (n0 & 127)) : (256 * ((n0 - DFF) >> 7) + 128 + ((n0 - DFF) & 127));
                t.W = W; t.gk = gk; t.D = D; t.N = N; t.ldt = ldt; t.drow0 = drow0; t.k0 = kb * 64; t.n0 = n0; return true;
            };
            auto advance = [&](TItem& t) -> bool {
                while (sl < nslot) { if (decode(it, t)) { it += S; return true; } ++sl; it = slot0 + sl; }
                return false;
            };
            have = advance(cur);
            if (have) titem_load(tv, cur, lane);
            while (have) {
                titem_to_lds(tv, scr, lane);
                have_next = advance(nxt);
                if (have_next) titem_load(tv, nxt, lane);
                titem_store(cur, scr, lane);
                cur = nxt; have = have_next;
            }
        }
        for (int it = gt; it < 2 * 1024 * 256; it += NGT) {
            const int l = it >> 18, e = it & 262143, k = e >> 8, n4 = (e & 255) * 4;
            const f32x4 w = *(const f32x4*)(ap->in[21] + (size_t)l * 1048576 + (size_t)k * 1024 + n4); const float gk = ap->in[3][l * 1024 + k];
            u32x2 o; o.x = cvt_pk_bf16(w[0] * gk, w[1] * gk); o.y = cvt_pk_bf16(w[2] * gk, w[3] * gk);
            *(u32x2*)((bf16_t*)(ws + WS_LAYER + l * LAYER_STRIDE + LO_WQ) + (size_t)k * 1024 + n4) = o;
        }
        for (int r = gw; r < MEMTOK / 4; r += NGW) rms_rows4_to_bf16(ap->in[1] + (size_t)r * 4 * DM, ap->in[5], MEMN + (size_t)r * 4 * DM, lane);
        for (int r = gw; r < MTOK / 4; r += NGW) rms_rows4_to_bf16(ap->in[0] + (size_t)r * 4 * DM, ap->in[2], XB + (size_t)r * 4 * DM, lane);
        __syncthreads();
    }
    PHASE_END;

    if (PHASE_ON) { PH_VARS
        bf16_t* WIN = (bf16_t*)(ws + WS_WIN);
        { pg8::SchedStd S; S.init(XB, 256 * 2048, WIN, 256 * 2048, 128, 6, G, bid);
          pg8::EpiStore E{(bf16_t*)(ws + WS_QKU), 1536, nullptr, 0, 1.0f, 0};
          pg8::gemm_phase(lds, xl, 1024, 1024, 1024, S, E); }
        { pg8::SchedStd S; S.init(WIN + (size_t)1536 * 1024, 256 * 2048, XB, 256 * 2048, 2, 128, G, bid);
          pg8::EpiStore E{(bf16_t*)(ws + WS_VT), VT_LD, nullptr, 0, 1.0f, 0};
          pg8::gemm_phase(lds, xl, 1024, 1024, 1024, S, E); }
        for (int j = 0; j < 4; ++j) {
            const int l = j >> 1, isv = j & 1;
            bf16_t* WKV = (bf16_t*)(ws + WS_LAYER + l * LAYER_STRIDE + LO_WKV);
            const int c = (bid + 64 * (j + 1)) % G;
            pg8::SchedStd S;
            S.init(MEMN, 256 * 2048, WKV + (size_t)isv * 1024 * 1024, 256 * 2048, 16, 4, G, c);
            pg8::EpiStore E{isv ? (bf16_t*)(ws + WS_MEMVT + l * MEMVT_STRIDE) : (bf16_t*)(ws + WS_MEMK + l * 8 * MiB), 1024, nullptr, 0, 1.0f, 0};
            pg8::gemm_phase(lds, xl, 1024, 1024, 1024, S, E);
        }
    }
    PHASE_END;

    if (PHASE_ON) { PH_VARS
        const bf16_t* QKU = (const bf16_t*)(ws + WS_QKU); bf16_t* CAT = (bf16_t*)(ws + WS_CAT);
        for (int it = gt; it < 64 * (MTOK / 32); it += NGT) {
            const int ch = it & 63, seg = it >> 6, g = ch >> 4;
            const bf16_t* up = QKU + (size_t)seg * 32 * 1536 + 1024 + ch * 8;
            bf16_t* op = CAT + (size_t)seg * 32 * DM + 512 + ch * 8;
            const int t0 = (seg * 32) & (SEQ - 1);
            if (g == 0) pool_segment<2>(up, op, t0); else if (g == 1) pool_segment<4>(up, op, t0); else if (g == 2) pool_segment<8>(up, op, t0); else pool_segment<16>(up, op, t0);
        }
        for (int wt = bid; wt < 128 * 8; wt += G) {
            const int bh = wt >> 3, blk = wt & 7;
            sb_attn_block(QKU, (const bf16_t*)(ws + WS_VT), CAT, bh >> 3, bh & 7, blk * 8, lds, tid, wave, lane);
        }
    }
    PHASE_END;

    if (PHASE_ON) { PH_VARS
        pg8::SchedStd S; S.init(ws + WS_CAT, 256 * 2048, ws + WS_WOUT, 256 * 2048, 128, 4, G, bid);
        pg8::EpiResid E{ap->in[0], XB, SSQ};
        pg8::gemm_phase(lds, xl, 1024, 1024, 1024, S, E);
        pg8::SchedG SG{(const char*)(ws + WS_MEMK), (const char*)(ws + WS_LAYER + LO_WQ), G, bid};
        pg8::EpiStore EG{(bf16_t*)(ws + WS_GT), 1024, nullptr, 0, 1.0f, 0};
        pg8::gemm_phase(lds, xl, 1024, 1024, 256, SG, EG);
    }
    PHASE_END;

#pragma nounroll
    for (int layer = 0; layer < 2; ++layer) {
        if (layer == 1) {
            if (PHASE_ON) { PH_VARS
                pg8::SchedStd S; S.init(XB, 256 * 2048, ws + WS_WSSM, 256 * 2048, 128, 4, G, bid);
                pg8::EpiStore E{(bf16_t*)(ws + WS_UG), 0, SSQ, 16, 1.0f, 1};
                pg8::gemm_phase(lds, xl, 1024, 1024, 1024, S, E);
            }
            PHASE_END;
            if (PHASE_ON) { PH_VARS
                pg8::SchedS2 S{(const char*)(ws + WS_UG), (const char*)(ws + WS_WEND), G, bid};
                pg8::EpiHend E{(float*)(ws + WS_HEND)};
                pg8::gemm_phase(lds, xl, 640, 512, 512, S, E);
            }
            PHASE_END;
            if (PHASE_ON) { PH_VARS
                bf16_t* UG = (bf16_t*)(ws + WS_UG); const float* HE = (const float*)(ws + WS_HEND);
                for (int it = gt; it < NBATCH * 64 * 64; it += NGT) {
                    const int p = it & 63, g = (it >> 6) & 63, b = it >> 12;
                    const float dt = expf(ap->in[14][g]);
                    const float mag = expf(32.0f * (ap->in[12][g * 64 + p] * dt)), ang = 32.0f * (ap->in[13][g * 64 + p] * dt);
                    const float lr = mag * cosf(ang), li = mag * sinf(ang);
                    float hr = 0.f, hi_ = 0.f;
                    for (int c0 = 0; c0 < 64; c0 += 8) {
                        const size_t row0 = (size_t)g * 1024 + b * 64 + c0;
                        float er[8], ei[8];
#pragma unroll
                        for (int j = 0; j < 8; ++j) { er[j] = HE[(row0 + j) * 128 + p]; ei[j] = HE[(row0 + j) * 128 + 64 + p]; }
#pragma unroll
                        for (int j = 0; j < 8; ++j) {
                            UG[(row0 + j) * 640 + 512 + p] = (bf16_t)(cvt_pk_bf16(hr, 0.f) & 0xffffu);
                            UG[(row0 + j) * 640 + 576 + p] = (bf16_t)(cvt_pk_bf16(hi_, 0.f) & 0xffffu);
                            const float nr = lr * hr - li * hi_ + er[j], ni = lr * hi_ + li * hr + ei[j];
                            hr = nr; hi_ = ni;
                        }
                    }
                }
            }
            PHASE_END;
            if (PHASE_ON) { PH_VARS
                pg8::SchedS4 S{(const char*)(ws + WS_UG), (const char*)(ws + WS_TG), G, bid};
                pg8::EpiSsmY E{(const bf16_t*)(ws + WS_UG), ap->in[19], (bf16_t*)(ws + WS_YG)};
                pg8::gemm_phase(lds, xl, 640, 640, 640, S, E);
            }
            PHASE_END;
            if (PHASE_ON) { PH_VARS
                pg8::SchedStd S; S.init(ws + WS_YG, 256 * 2048, ws + WS_WGLU, 256 * 2048, 128, 8, G, bid);
                pg8::EpiGlu E{XB, SSQ};
                pg8::gemm_phase(lds, xl, 1024, 1024, 1024, S, E);
            }
            PHASE_END;
        }
        if (PHASE_ON) { PH_VARS
            pg8::SchedXS2 S{(const char*)XB, (const char*)(ws + WS_GT + (size_t)layer * 32 * MiB), G, bid};
            pg8::EpiSoftmax E{(bf16_t*)(ws + WS_P), SSQ, layer == 0 ? 16 : 32, 0.0625f};
            pg8::gemm_phase(lds, xl, 1024, 1024, 1024, S, E);
        }
        if (PHASE_ON) { PH_VARS
            unsigned char* lb = ws + WS_LAYER + layer * LAYER_STRIDE;
            pg8::SchedVW S{(const char*)(lb + LO_WO), (const char*)(ws + WS_MEMVT + layer * MEMVT_STRIDE), G, bid};
            pg8::EpiStore E{(bf16_t*)(ws + WS_QX), 1024, nullptr, 0, 1.0f, 0};
            pg8::gemm_phase(lds, xl, 1024, 1024, 256, S, E);
        }
        PHASE_END;
        if (PHASE_ON) { PH_VARS
            pg8::SchedXOut S{(const char*)(ws + WS_P), (const char*)(ws + WS_QX), G, bid};
            pg8::EpiResid E{nullptr, XB, SSQ};
            pg8::gemm_phase(lds, xl, 1024, 1024, 1024, S, E);
        }
        PHASE_END;
        if (PHASE_ON) { PH_VARS
            unsigned char* lb = ws + WS_LAYER + layer * LAYER_STRIDE;
            pg8::SchedStd S; S.init(XB, 256 * 2048, lb + LO_WUP, 256 * 2048, 128, 22, G, bid);
            pg8::EpiUpConv E{(bf16_t*)(ws + WS_H), (bf16_t*)(ws + WS_HALO), SSQ, ap->in[25] + (size_t)layer * 3 * DFF2, ap->in[26] + (size_t)layer * DFF2};
            pg8::gemm_phase(lds, xl, 1024, 1024, 1024, S, E);
        }
        PHASE_END;
        if (PHASE_ON) { PH_VARS
            const bf16_t* HALO = (const bf16_t*)(ws + WS_HALO); bf16_t* H = (bf16_t*)(ws + WS_H);
            const float* cw = ap->in[25] + (size_t)layer * 3 * DFF2; const float* cb = ap->in[26] + (size_t)layer * DFF2;
            pg8::SchedStd S0; S0.init(ws + WS_H, 256u * DFF * 2, ws, 0u, 128, 4, G, bid);
            pg8::Unit uu;
            for (int ui = 0; S0.next(ui, uu); ++ui) {
                const int pm = uu.pm;
                if ((pm & 7) == 0) continue;
                for (int it = tid; it < 2 * 352; it += 512) {
                    const int chk = it % 352, rr = it / 352, c0 = chk * 8;
                    const bf16_t* cur = HALO + (size_t)(pm * 4 + rr) * DFF2;
                    const bf16_t* p1 = rr ? HALO + (size_t)(pm * 4) * DFF2 : HALO + (size_t)(pm * 4 - 1) * DFF2;
                    const bf16_t* p2 = rr ? HALO + (size_t)(pm * 4 - 1) * DFF2 : HALO + (size_t)(pm * 4 - 2) * DFF2;
                    float o[8];
                    const u32x4 av = *(const u32x4*)(cur + c0), ag = *(const u32x4*)(cur + DFF + c0);
                    const u32x4 a1 = *(const u32x4*)(p1 + c0), g1 = *(const u32x4*)(p1 + DFF + c0), a2 = *(const u32x4*)(p2 + c0), g2 = *(const u32x4*)(p2 + DFF + c0);
                    const float v0[8] = {bflo(av.x), bfhi(av.x), bflo(av.y), bfhi(av.y), bflo(av.z), bfhi(av.z), bflo(av.w), bfhi(av.w)};
                    const float g0[8] = {bflo(ag.x), bfhi(ag.x), bflo(ag.y), bfhi(ag.y), bflo(ag.z), bfhi(ag.z), bflo(ag.w), bfhi(ag.w)};
                    const float v1[8] = {bflo(a1.x), bfhi(a1.x), bflo(a1.y), bfhi(a1.y), bflo(a1.z), bfhi(a1.z), bflo(a1.w), bfhi(a1.w)};
                    const float gg1[8] = {bflo(g1.x), bfhi(g1.x), bflo(g1.y), bfhi(g1.y), bflo(g1.z), bfhi(g1.z), bflo(g1.w), bfhi(g1.w)};
                    const float v2[8] = {bflo(a2.x), bfhi(a2.x), bflo(a2.y), bfhi(a2.y), bflo(a2.z), bfhi(a2.z), bflo(a2.w), bfhi(a2.w)};
                    const float gg2[8] = {bflo(g2.x), bfhi(g2.x), bflo(g2.y), bfhi(g2.y), bflo(g2.z), bfhi(g2.z), bflo(g2.w), bfhi(g2.w)};
    #pragma unroll
                    for (int j = 0; j < 8; ++j) {
                        const int c = c0 + j;
                        const float cv = cb[c] + cw[c] * v2[j] + cw[DFF2 + c] * v1[j] + cw[2 * DFF2 + c] * v0[j];
                        const float cgt = cb[DFF + c] + cw[DFF + c] * gg2[j] + cw[DFF2 + DFF + c] * gg1[j] + cw[2 * DFF2 + DFF + c] * g0[j];
                        o[j] = cv * cgt * frcp(1.0f + fexp(-cgt));
                    }
                    u32x4 w; w.x = cvt_pk_bf16(o[0], o[1]); w.y = cvt_pk_bf16(o[2], o[3]); w.z = cvt_pk_bf16(o[4], o[5]); w.w = cvt_pk_bf16(o[6], o[7]);
                    *(u32x4*)(H + (size_t)(pm * 256 + rr) * DFF + c0) = w;
                }
            }
        }
        LOCAL_SEAM;
        if (PHASE_ON) { PH_VARS
            unsigned char* lb = ws + WS_LAYER + layer * LAYER_STRIDE;
            pg8::SchedStd S; S.init(ws + WS_H, 256u * DFF * 2, lb + LO_WDN, 256u * DFF * 2, 128, 4, G, bid);
            pg8::EpiResid E{nullptr, XB, SSQ};
            pg8::gemm_phase(lds, xl, DFF, DFF, DFF, S, E);
        }
        PHASE_END;
    }

    if (PHASE_ON) { PH_VARS
        for (int m4 = gw; m4 < MTOK / 4; m4 += NGW) {
            const f32x4* gr = (const f32x4*)ap->in[6] + lane;
            f32x4 v[4][4]; float sq[4];
#pragma unroll
            for (int r = 0; r < 4; ++r)
#pragma unroll
                for (int j = 0; j < 4; ++j) { const u32x2 o = *((const u32x2*)(XB + (size_t)(m4 * 4 + r) * DM) + lane + 64 * j); v[r][j] = (f32x4){bflo(o.x), bfhi(o.x), bflo(o.y), bfhi(o.y)}; }
#pragma unroll
            for (int r = 0; r < 4; ++r) { sq[r] = 0.f;
#pragma unroll
                for (int j = 0; j < 4; ++j) sq[r] += (v[r][j].x * v[r][j].x + v[r][j].y * v[r][j].y) + (v[r][j].z * v[r][j].z + v[r][j].w * v[r][j].w); }
#pragma unroll
            for (int r = 0; r < 4; ++r) sq[r] = 1.f / sqrtf(wave_sum(sq[r]) * (1.f / DM) + EPS);
#pragma unroll
            for (int j = 0; j < 4; ++j) { const f32x4 gg = gr[64 * j];
#pragma unroll
                for (int r = 0; r < 4; ++r) *((f32x4*)(X + (size_t)(m4 * 4 + r) * DM) + lane + 64 * j) = v[r][j] * sq[r] * gg; }
        }
    }
#undef PHASE_ON
#undef PHASE_END
}

constexpr int N_PHASES = 4 + 7 + 5 + 7 + 1;

extern "C" void kernel_launch(void* const* d_in, const int* in_sizes, int n_in, void* d_out, int out_size, void* d_ws, size_t ws_size, hipStream_t stream) {
    static int grid = 0;
    if (grid == 0) {
        if (n_in != 28 || in_sizes[0] != MTOK * DM || out_size != MTOK * DM || ws_size < WS_END) {
            fprintf(stderr, "kernel_launch: unexpected shapes (n_in %d, in0 %d, out %d, ws %zu); nothing launched\n", n_in, n_in > 0 ? in_sizes[0] : -1, out_size, ws_size); grid = -1; return; }
        int dev = 0, cus = 0, per_cu = 0;
        if (hipGetDevice(&dev) != hipSuccess || hipDeviceGetAttribute(&cus, hipDeviceAttributeMultiprocessorCount, dev) != hipSuccess) { grid = -1; return; }
        if (hipFuncSetAttribute((const void*)mega_fwd, hipFuncAttributeMaxDynamicSharedMemorySize, LDS_BYTES) != hipSuccess) { fprintf(stderr, "kernel_launch: hipFuncSetAttribute failed\n"); grid = -1; return; }
        if (hipOccupancyMaxActiveBlocksPerMultiprocessor(&per_cu, (const void*)mega_fwd, 512, LDS_BYTES) != hipSuccess || per_cu < 1) per_cu = 1;
        (void)hipGetLastError();
        grid = cus * per_cu;
    }
    if (grid < 0) return;
    Args a{};
    for (int i = 0; i < 28; ++i) a.in[i] = (const float*)d_in[i];
    a.out = (float*)d_out; a.ws = (unsigned char*)d_ws;
#if MK_MULTI_LAUNCH
    for (int p = 0; p < N_PHASES; ++p) {
        a.ph_lo = p; a.ph_hi = p + 1;
        hipLaunchKernelGGL(mega_fwd, dim3(grid), dim3(512), LDS_BYTES, stream, a);
    }
#else
    a.ph_lo = 0; a.ph_hi = N_PHASES;
    if (hipMemsetAsync(d_ws, 0, 16384, stream) != hipSuccess) { fprintf(stderr, "kernel_launch: memset of the barrier words failed\n"); return; }
    void* args[] = {&a};
    hipError_t e = hipLaunchCooperativeKernel((const void*)mega_fwd, dim3(grid), dim3(512), args, LDS_BYTES, stream);
    if (e != hipSuccess) fprintf(stderr, "cooperative launch failed: %s (grid %d)\n", hipGetErrorString(e), grid);
#endif
}
```

```cpp
#include <hip/hip_runtime.h>
#include <hip/hip_cooperative_groups.h>
#include <cstdio>
#include <cstdint>
namespace cg = cooperative_groups;

#ifndef MK_MULTI_LAUNCH
#define MK_MULTI_LAUNCH 0
#endif

#define LAS __attribute__((address_space(3)))
typedef unsigned short bf16_t;
typedef short bf16x8 __attribute__((ext_vector_type(8)));
typedef short s16x4 __attribute__((ext_vector_type(4)));
typedef float f32x4 __attribute__((ext_vector_type(4)));
typedef float f32x16 __attribute__((ext_vector_type(16)));
typedef unsigned u32x4 __attribute__((ext_vector_type(4)));
typedef unsigned u32x2 __attribute__((ext_vector_type(2)));

constexpr int MTOK = 32768, DM = 1024, SEQ = 2048, NBATCH = 16, DFF = 2816, DFF2 = 5632, MEMTOK = 4096;
constexpr int MHALF = 16384;
constexpr float EPS = 1e-6f;
constexpr float LOG2E = 1.4426950408889634f, LN2 = 0.6931471805599453f;

constexpr size_t MiB = 1u << 20;
constexpr size_t WS_SSQ = 1 * MiB;
constexpr size_t WS_WIN = 5 * MiB;
constexpr size_t WS_WOUT = 9 * MiB;
constexpr size_t WS_WSSM = 11 * MiB;
constexpr size_t WS_WGLU = 13 * MiB;
constexpr size_t WS_LAYER = 17 * MiB, LAYER_STRIDE = 25 * MiB;
constexpr size_t LO_WQ = 0, LO_WKV = 2 * MiB, LO_WO = 6 * MiB, LO_WUP = 8 * MiB, LO_WDN = 19 * MiB;
constexpr size_t WS_WEND = 67 * MiB;
constexpr size_t WS_TG = 83 * MiB;
constexpr size_t WS_MEMN = 123 * MiB;
constexpr size_t WS_MEMK = 131 * MiB;
constexpr size_t WS_MEMVT = 147 * MiB, MEMVT_STRIDE = 9 * MiB;
constexpr size_t WS_XB = 165 * MiB;
constexpr size_t WS_T = 229 * MiB;
constexpr size_t WS_QKU = WS_T, WS_VT = WS_T + 96 * MiB, WS_CAT = WS_T + 132 * MiB;
constexpr int VT_LD = MTOK + 128, MVT_LD = 4096 + 128;
constexpr size_t WS_QX = WS_T, WS_P = WS_T + 64 * MiB, WS_O = WS_T + 128 * MiB;
constexpr size_t WS_H = WS_T, WS_HALO = WS_T + 176 * MiB;
constexpr size_t WS_UG = WS_T, WS_HEND = WS_T + 80 * MiB, WS_YG = WS_T + 112 * MiB;
constexpr size_t WS_GT = 426 * MiB;
constexpr size_t WS_END = 512 * MiB;
static_assert(WS_H + (size_t)MTOK * DFF * 2 <= WS_HALO && WS_HALO + (size_t)128 * 4 * DFF2 * 2 <= WS_GT && WS_CAT + (size_t)MTOK * DM * 2 <= WS_GT && WS_GT + 64 * MiB <= WS_END, "ws map");

typedef float f32x2_t __attribute__((ext_vector_type(2))); typedef __bf16 bf16x2_t __attribute__((ext_vector_type(2)));
__device__ __forceinline__ unsigned cvt_pk_bf16(float lo, float hi) { f32x2_t v = {lo, hi}; bf16x2_t b = __builtin_convertvector(v, bf16x2_t); return __builtin_bit_cast(unsigned, b); }
__device__ __forceinline__ float bf2f(unsigned short b) { return __uint_as_float(((unsigned)b) << 16); }
__device__ __forceinline__ float bflo(unsigned w) { return __uint_as_float(w << 16); }
__device__ __forceinline__ float bfhi(unsigned w) { return __uint_as_float(w & 0xffff0000u); }
__device__ __forceinline__ float fexp2(float x) { return __builtin_amdgcn_exp2f(x); }
__device__ __forceinline__ float flog2(float x) { return __builtin_amdgcn_logf(x); }
__device__ __forceinline__ float fexp(float x) { return __builtin_amdgcn_exp2f(x * LOG2E); }
__device__ __forceinline__ float frcp(float x) { return __builtin_amdgcn_rcpf(x); }
template <int M> __device__ __forceinline__ float swz_xor(float v) { return __int_as_float(__builtin_amdgcn_ds_swizzle(__float_as_int(v), (M << 10) | 0x1f)); }
__device__ __forceinline__ float sum_x16(float v) { auto r = __builtin_amdgcn_permlane16_swap(__float_as_uint(v), __float_as_uint(v), false, false); return __uint_as_float(r[0]) + __uint_as_float(r[1]); }
__device__ __forceinline__ float sum_x32(float v) { auto r = __builtin_amdgcn_permlane32_swap(__float_as_uint(v), __float_as_uint(v), false, false); return __uint_as_float(r[0]) + __uint_as_float(r[1]); }
__device__ __forceinline__ float max_x16(float v) { auto r = __builtin_amdgcn_permlane16_swap(__float_as_uint(v), __float_as_uint(v), false, false); return fmaxf(__uint_as_float(r[0]), __uint_as_float(r[1])); }
__device__ __forceinline__ float max_x32(float v) { auto r = __builtin_amdgcn_permlane32_swap(__float_as_uint(v), __float_as_uint(v), false, false); return fmaxf(__uint_as_float(r[0]), __uint_as_float(r[1])); }
__device__ __forceinline__ float partner32(float v, int hi) { auto r = __builtin_amdgcn_permlane32_swap(__float_as_uint(v), __float_as_uint(v), false, false); return hi ? __uint_as_float(r[0]) : __uint_as_float(r[1]); }
__device__ __forceinline__ float wave_sum(float v) {
    v += swz_xor<1>(v); v += swz_xor<2>(v); v += swz_xor<4>(v); v += swz_xor<8>(v); v = sum_x16(v); v = sum_x32(v);
    return v;
}
#define LDS_WAIT() asm volatile("s_waitcnt lgkmcnt(0)" ::: "memory")

namespace pg8 {
constexpr int BM = 256, BK = 64, HALF = 128, HTB = HALF * BK * 2, STAGE_BYTES = 8 * HTB, NXCD = 8, WGM = 8;
__host__ __device__ __forceinline__ int lds_byte(int r, int c) { const int st = (r >> 4) * 2 + (c >> 5), rr = r & 15, cc = c & 31, ob = rr * 64 + cc * 2; return st * 1024 + (ob ^ (((ob >> 9) & 1) << 5)); }
__host__ __device__ __forceinline__ void stage_rc(int b, int& R, int& C) { const int st = b / 1024, sb = b % 1024, swz = sb ^ (((sb >> 9) & 1) << 5); R = (st >> 1) * 16 + swz / 64; C = (st & 1) * 32 + (swz % 64) / 2; }
__host__ __device__ __forceinline__ int perm32(int rho) { const int n = rho >> 4, i = rho & 15; return 8 * (i >> 2) + 4 * n + (i & 3); }

struct Unit { int pm, pn; const char* a; const char* b; };

struct SchedStd {
    const char* A; const char* B; unsigned sA, sB; int nM, nN, G, c;
    __device__ __forceinline__ void init(const void* A_, unsigned sA_, const void* B_, unsigned sB_, int nM_, int nN_, int G_, int c_) { A = (const char*)A_; B = (const char*)B_; sA = sA_; sB = sB_; nM = nM_; nN = nN_; G = G_; c = c_; }
    __device__ __forceinline__ bool next(int i, Unit& u) const {
        const int nwg = nM * nN; const long L = (long)i * G + c; if (L >= nwg) return false;
        int wgid = (int)L; { const int q = nwg / NXCD, r = nwg % NXCD, xcd = wgid % NXCD, off = wgid / NXCD; wgid = (xcd < r ? xcd * (q + 1) : r * (q + 1) + (xcd - r) * q) + off; }
        const int nig = WGM * nN, gid = wgid / nig, fm = gid * WGM, gsz = (nM - fm) < WGM ? (nM - fm) : WGM;
        u.pm = fm + ((wgid % nig) % gsz); u.pn = (wgid % nig) / gsz;
        u.a = A + (size_t)u.pm * sA; u.b = B + (size_t)u.pn * sB; return true;
    }
};
struct SchedXS {
    const char* A; const char* B; int G, c;
    __device__ __forceinline__ bool next(int i, Unit& u) const {
        const long L = (long)i * G + c; if (L >= 512) return false;
        u.pm = (int)(L >> 2); u.pn = (int)(L & 3);
        u.a = A + (size_t)u.pm * 256 * 2048 + u.pn * 512; u.b = B + (size_t)(u.pm >> 3) * 256 * 2048 + u.pn * 512; return true;
    }
};
struct SchedXQ {
    const char* A; const char* B; int G, c;
    __device__ __forceinline__ bool next(int i, Unit& u) const {
        const long L = (long)i * G + c; if (L >= 512) return false;
        u.pm = (int)(L >> 2); u.pn = (int)(L & 3);
        u.a = A + (size_t)u.pm * 256 * 2048; u.b = B + (size_t)u.pn * 256 * 2048; return true;
    }
};
struct SchedG {
    const char* MK; const char* WQ; int G, c;
    __device__ __forceinline__ bool next(int i, Unit& u) const {
        const long L = (long)i * G + c; if (L >= 512) return false;
        const int l = (int)(L >> 8), r = (int)(L & 255), b = r >> 4, h = (r >> 2) & 3, pn = r & 3;
        u.pm = l * 64 + b * 4 + h; u.pn = pn;
        u.a = MK + (size_t)l * 8 * 1048576 + (size_t)b * 256 * 2048 + h * 512; u.b = WQ + (size_t)l * LAYER_STRIDE + (size_t)pn * 256 * 2048 + h * 512; return true;
    }
};
struct SchedXS2 {
    const char* A; const char* B; int G, c;
    __device__ __forceinline__ bool next(int i, Unit& u) const {
        const long L = (long)i * G + c; if (L >= 512) return false;
        u.pm = (int)(L >> 2); u.pn = (int)(L & 3);
        u.a = A + (size_t)u.pm * 256 * 2048; u.b = B + (size_t)((u.pm >> 3) * 4 + u.pn) * 256 * 2048; return true;
    }
};
struct SchedVW {
    const char* WO; const char* MV; int G, c;
    __device__ __forceinline__ bool next(int i, Unit& u) const {
        const long L = (long)i * G + c; if (L >= 256) return false;
        const int b = (int)(L >> 4), pq = (int)(L >> 2) & 3, h = (int)L & 3;
        u.pm = b * 4 + pq; u.pn = h;
        u.a = WO + (size_t)pq * 256 * 2048 + h * 512; u.b = MV + (size_t)b * 256 * 2048 + h * 512; return true;
    }
};
struct SchedXOut {
    const char* A; const char* B; int G, c;
    __device__ __forceinline__ bool next(int i, Unit& u) const {
        const long L = (long)i * G + c; if (L >= 512) return false;
        u.pm = (int)(L >> 2); u.pn = (int)(L & 3);
        u.a = A + (size_t)u.pm * 256 * 2048; u.b = B + ((size_t)(u.pm >> 3) * 1024 + (size_t)u.pn * 256) * 2048; return true;
    }
};
struct SchedXO {
    const char* A; const char* B; int G, c;
    __device__ __forceinline__ bool next(int i, Unit& u) const {
        const long L = (long)i * G + c; if (L >= 512) return false;
        u.pm = (int)(L >> 2); u.pn = (int)(L & 3);
        u.a = A + (size_t)u.pm * 256 * 2048 + u.pn * 512; u.b = B + (size_t)u.pn * 256 * (MVT_LD * 2) + (size_t)(u.pm >> 3) * 512; return true;
    }
};
struct SchedS2 {
    const char* A; const char* B; int G, c;
    __device__ __forceinline__ bool next(int i, Unit& u) const {
        const long L = (long)i * G + c; if (L >= 256) return false;
        u.pm = (int)L; u.pn = 0;
        u.a = A + (size_t)L * 256 * 1280; u.b = B + (size_t)(L >> 2) * 256 * 1024; return true;
    }
};
struct SchedS4 {
    const char* A; const char* B; int G, c;
    __device__ __forceinline__ bool next(int i, Unit& u) const {
        const long L = (long)i * G + c; if (L >= 512) return false;
        u.pm = (int)(L >> 1); u.pn = (int)(L & 1);
        u.a = A + (size_t)u.pm * 256 * 1280; u.b = B + ((size_t)(L >> 3) * 512 + (size_t)u.pn * 256) * 1280; return true;
    }
};

typedef f32x4 Acc[2][2][4][2];

__device__ __forceinline__ float row_rstd(const float* ssq_row, int nslots) {
    float s = 0.f;
    const f32x4* p = (const f32x4*)ssq_row;
    for (int i = 0; i < nslots / 4; ++i) { const f32x4 v = p[i]; s += (v[0] + v[1]) + (v[2] + v[3]); }
    return 1.0f / sqrtf(s * (1.0f / DM) + EPS);
}

struct EpiStore {
    static constexpr bool PERM = true;
    bf16_t* O; int ldc; const float* ssq; int nslots; float cs; int mode;
    __device__ __forceinline__ void operator()(Acc& acc, const Unit& u, int wr, int wc, int fr, int fq, LAS unsigned char* xl) const {
        const int row0 = u.pm * BM + wr * 64 + fr, col0 = u.pn * BM + wc * 32 + 8 * fq;
        LAS float* R = (LAS float*)xl;
        if (ssq) {
            const int wid = wr * 4 + wc, lane = fq * 16 + fr;
            if (lane < 32) R[wid * 32 + lane] = row_rstd(ssq + (size_t)(u.pm * BM + wid * 32 + lane) * 32, nslots);
            LDS_WAIT(); __builtin_amdgcn_s_barrier(); asm volatile("" ::: "memory");
        }
#pragma unroll
        for (int ai = 0; ai < 2; ++ai)
#pragma unroll
            for (int m = 0; m < 4; ++m) {
                const int row = row0 + ai * HALF + m * 16;
                float sc = cs;
                if (ssq) sc *= R[ai * HALF + wr * 64 + m * 16 + fr];
#pragma unroll
                for (int bj = 0; bj < 2; ++bj) {
                    const int col = col0 + bj * HALF;
                    const f32x4 v0 = acc[ai][bj][m][0] * sc, v1 = acc[ai][bj][m][1] * sc;
                    u32x4 w; w.x = cvt_pk_bf16(v0[0], v0[1]); w.y = cvt_pk_bf16(v0[2], v0[3]); w.z = cvt_pk_bf16(v1[0], v1[1]); w.w = cvt_pk_bf16(v1[2], v1[3]);
                    bf16_t* p = (mode == 0) ? O + (size_t)row * ldc + col
                                            : O + ((size_t)(col >> 4) * 1024 + (row >> 5)) * 640 + (row & 31) * 16 + (col & 15);
                    *(u32x4*)p = w;
                }
            }
    }
};

struct EpiResid {
    static constexpr bool PERM = true;
    const float* xf; bf16_t* xb; float* ssq;
    __device__ __forceinline__ void operator()(Acc& acc, const Unit& u, int wr, int wc, int fr, int fq, LAS unsigned char*) const {
        const int row0 = u.pm * BM + wr * 64 + fr, col0 = u.pn * BM + wc * 32 + 8 * fq;
#pragma unroll
        for (int ai = 0; ai < 2; ++ai) {
            f32x4 v0[4][2], v1[4][2];
            if (xf) {
#pragma unroll
                for (int m = 0; m < 4; ++m)
#pragma unroll
                    for (int bj = 0; bj < 2; ++bj) { const size_t off = (size_t)(row0 + ai * HALF + m * 16) * DM + col0 + bj * HALF;
                        v0[m][bj] = *(const f32x4*)(xf + off); v1[m][bj] = *(const f32x4*)(xf + off + 4); }
            } else {
                u32x4 o[4][2];
#pragma unroll
                for (int m = 0; m < 4; ++m)
#pragma unroll
                    for (int bj = 0; bj < 2; ++bj) o[m][bj] = *(const u32x4*)(xb + (size_t)(row0 + ai * HALF + m * 16) * DM + col0 + bj * HALF);
#pragma unroll
                for (int m = 0; m < 4; ++m)
#pragma unroll
                    for (int bj = 0; bj < 2; ++bj) { v0[m][bj] = (f32x4){bflo(o[m][bj].x), bfhi(o[m][bj].x), bflo(o[m][bj].y), bfhi(o[m][bj].y)};
                                                     v1[m][bj] = (f32x4){bflo(o[m][bj].z), bfhi(o[m][bj].z), bflo(o[m][bj].w), bfhi(o[m][bj].w)}; }
            }
#pragma unroll
            for (int m = 0; m < 4; ++m) {
                const int row = row0 + ai * HALF + m * 16; float q = 0.f;
#pragma unroll
                for (int bj = 0; bj < 2; ++bj) {
                    const f32x4 a0 = v0[m][bj] + acc[ai][bj][m][0], a1 = v1[m][bj] + acc[ai][bj][m][1];
                    q += ((a0[0] * a0[0] + a0[1] * a0[1]) + (a0[2] * a0[2] + a0[3] * a0[3])) + ((a1[0] * a1[0] + a1[1] * a1[1]) + (a1[2] * a1[2] + a1[3] * a1[3]));
                    u32x4 w; w.x = cvt_pk_bf16(a0[0], a0[1]); w.y = cvt_pk_bf16(a0[2], a0[3]); w.z = cvt_pk_bf16(a1[0], a1[1]); w.w = cvt_pk_bf16(a1[2], a1[3]);
                    *(u32x4*)(xb + (size_t)row * DM + col0 + bj * HALF) = w;
                }
                q = sum_x16(q); q = sum_x32(q);
                if (fq == 0) ssq[(size_t)row * 32 + u.pn * 4 + wc] = q;
            }
        }
    }
};

struct EpiGlu {
    static constexpr bool PERM = true;
    bf16_t* xb; float* ssq;
    __device__ __forceinline__ void operator()(Acc& acc, const Unit& u, int wr, int wc, int fr, int fq, LAS unsigned char*) const {
        const int row0 = u.pm * BM + wr * 64 + fr, col0 = u.pn * HALF + wc * 32 + 8 * fq;
        u32x4 o[2][4];
#pragma unroll
        for (int ai = 0; ai < 2; ++ai)
#pragma unroll
            for (int m = 0; m < 4; ++m) o[ai][m] = *(const u32x4*)(xb + (size_t)(row0 + ai * HALF + m * 16) * DM + col0);
#pragma unroll
        for (int ai = 0; ai < 2; ++ai)
#pragma unroll
            for (int m = 0; m < 4; ++m) {
                const int row = row0 + ai * HALF + m * 16; const size_t off = (size_t)row * DM + col0;
                const u32x4 oo = o[ai][m];
                float v[8] = {bflo(oo.x), bfhi(oo.x), bflo(oo.y), bfhi(oo.y), bflo(oo.z), bfhi(oo.z), bflo(oo.w), bfhi(oo.w)};
                float q = 0.f;
#pragma unroll
                for (int n = 0; n < 2; ++n) {
                    const f32x4 val = acc[ai][0][m][n], gt = acc[ai][1][m][n];
#pragma unroll
                    for (int j = 0; j < 4; ++j) { v[4 * n + j] += val[j] * frcp(1.0f + fexp(-gt[j])); q += v[4 * n + j] * v[4 * n + j]; }
                }
                u32x4 w; w.x = cvt_pk_bf16(v[0], v[1]); w.y = cvt_pk_bf16(v[2], v[3]); w.z = cvt_pk_bf16(v[4], v[5]); w.w = cvt_pk_bf16(v[6], v[7]);
                *(u32x4*)(xb + off) = w;
                q = sum_x16(q); q = sum_x32(q);
                if (fq == 0) ssq[(size_t)row * 32 + u.pn * 4 + wc] = q;
            }
    }
};

struct EpiSoftmax {
    static constexpr bool PERM = true;
    bf16_t* O; const float* ssq; int nslots; float cs;
    __device__ __forceinline__ void operator()(Acc& acc, const Unit& u, int wr, int wc, int fr, int fq, LAS unsigned char* xl) const {
        LAS float* tmax = (LAS float*)xl; LAS float* tsum = tmax + 1024; LAS float* R = tsum + 1024;
        { const int wid = wr * 4 + wc, lane = fq * 16 + fr;
          if (lane < 32) R[wid * 32 + lane] = row_rstd(ssq + (size_t)(u.pm * BM + wid * 32 + lane) * 32, nslots); }
        LDS_WAIT(); __builtin_amdgcn_s_barrier(); asm volatile("" ::: "memory");
#pragma unroll
        for (int ai = 0; ai < 2; ++ai)
#pragma unroll
            for (int m = 0; m < 4; ++m) {
                const float sc = cs * R[ai * HALF + wr * 64 + m * 16 + fr];
#pragma unroll
                for (int bj = 0; bj < 2; ++bj)
#pragma unroll
                    for (int n = 0; n < 2; ++n) acc[ai][bj][m][n] *= sc;
                float mx = -3.0e38f;
#pragma unroll
                for (int bj = 0; bj < 2; ++bj)
#pragma unroll
                    for (int n = 0; n < 2; ++n) { const f32x4 x = acc[ai][bj][m][n]; mx = fmaxf(mx, fmaxf(fmaxf(x[0], x[1]), fmaxf(x[2], x[3]))); }
                mx = max_x16(mx); mx = max_x32(mx);
                if (fq == 0) tmax[(ai * HALF + wr * 64 + m * 16 + fr) * 4 + wc] = mx;
            }
        LDS_WAIT(); __builtin_amdgcn_s_barrier(); asm volatile("" ::: "memory");
#pragma unroll
        for (int ai = 0; ai < 2; ++ai)
#pragma unroll
            for (int m = 0; m < 4; ++m) {
                const int r = ai * HALF + wr * 64 + m * 16 + fr;
                const f32x4 t = *(const LAS f32x4*)(tmax + r * 4);
                const float gm = fmaxf(fmaxf(t[0], t[1]), fmaxf(t[2], t[3])) * LOG2E; float s = 0.f;
#pragma unroll
                for (int bj = 0; bj < 2; ++bj)
#pragma unroll
                    for (int n = 0; n < 2; ++n) {
                        f32x4 x = acc[ai][bj][m][n];
#pragma unroll
                        for (int j = 0; j < 4; ++j) { x[j] = fexp2(x[j] * LOG2E - gm); s += x[j]; }
                        acc[ai][bj][m][n] = x;
                    }
                s = sum_x16(s); s = sum_x32(s);
                if (fq == 0) tsum[r * 4 + wc] = s;
            }
        LDS_WAIT(); __builtin_amdgcn_s_barrier(); asm volatile("" ::: "memory");
        const int row0 = u.pm * BM + wr * 64 + fr, col0 = u.pn * BM + wc * 32 + 8 * fq;
#pragma unroll
        for (int ai = 0; ai < 2; ++ai)
#pragma unroll
            for (int m = 0; m < 4; ++m) {
                const int r = ai * HALF + wr * 64 + m * 16 + fr;
                const f32x4 t = *(const LAS f32x4*)(tsum + r * 4);
                const float inv = 1.0f / ((t[0] + t[1]) + (t[2] + t[3]));
#pragma unroll
                for (int bj = 0; bj < 2; ++bj) {
                    const f32x4 v0 = acc[ai][bj][m][0] * inv, v1 = acc[ai][bj][m][1] * inv;
                    u32x4 w; w.x = cvt_pk_bf16(v0[0], v0[1]); w.y = cvt_pk_bf16(v0[2], v0[3]); w.z = cvt_pk_bf16(v1[0], v1[1]); w.w = cvt_pk_bf16(v1[2], v1[3]);
                    *(u32x4*)(O + (size_t)(row0 + ai * HALF + m * 16) * DM + col0 + bj * HALF) = w;
                }
            }
    }
};


__device__ __forceinline__ float dpp_ror1(float x) { return __int_as_float(__builtin_amdgcn_update_dpp(0, __float_as_int(x), 0x121, 0xf, 0xf, false)); }
__device__ __forceinline__ float dpp_ror2(float x) { return __int_as_float(__builtin_amdgcn_update_dpp(0, __float_as_int(x), 0x122, 0xf, 0xf, false)); }
__device__ __forceinline__ float dpp_ror1u(float x) { return __int_as_float(__builtin_amdgcn_mov_dpp(__float_as_int(x), 0x121, 0xf, 0xf, false)); }
__device__ __forceinline__ float dpp_ror2u(float x) { return __int_as_float(__builtin_amdgcn_mov_dpp(__float_as_int(x), 0x122, 0xf, 0xf, false)); }
__device__ __forceinline__ float dpp_shr1_old(float old, float x) { return __int_as_float(__builtin_amdgcn_update_dpp(__float_as_int(old), __float_as_int(x), 0x111, 0xf, 0xf, false)); }
__device__ __forceinline__ float dpp_shr2_old(float old, float x) { return __int_as_float(__builtin_amdgcn_update_dpp(__float_as_int(old), __float_as_int(x), 0x112, 0xf, 0xf, false)); }
struct EpiUpConv {
    static constexpr bool PERM = true;
    bf16_t* H; bf16_t* HALO; const float* ssq; const float* cw; const float* cb;
    __device__ __forceinline__ void operator()(Acc& acc, const Unit& u, int wr, int wc, int fr, int fq, LAS unsigned char* xl) const {
        LAS float* B = (LAS float*)xl;
        LAS float* Wl = B + 2048;
        LAS float* R = Wl + 1024;
        const int wid = wr * 4 + wc, lane = fq * 16 + fr, tid = wid * 64 + lane;
        const int row0 = u.pm * BM + wr * 64 + fr, colb = wc * 32 + 8 * fq, ch0 = u.pn * HALF + colb;
        {
#pragma unroll
            for (int i = 0; i < 2; ++i) { const int idx = tid + i * 512, t = idx >> 8, bj = (idx >> 7) & 1, chl = idx & 127;
                Wl[idx] = (t < 3) ? cw[t * DFF2 + bj * DFF + u.pn * HALF + chl] : cb[bj * DFF + u.pn * HALF + chl]; }
            if (lane < 32) R[wid * 32 + lane] = row_rstd(ssq + (size_t)(u.pm * BM + wid * 32 + lane) * 32, 16);
        }
        LDS_WAIT(); __builtin_amdgcn_s_barrier(); asm volatile("" ::: "memory");
#pragma unroll
        for (int ai = 0; ai < 2; ++ai)
#pragma unroll
            for (int m = 0; m < 4; ++m) {
                const float sc = R[ai * HALF + wr * 64 + m * 16 + fr];
#pragma unroll
                for (int bj = 0; bj < 2; ++bj)
#pragma unroll
                    for (int n = 0; n < 2; ++n) acc[ai][bj][m][n] *= sc;
            }
        if (fr >= 14) {
#pragma unroll
            for (int ai = 0; ai < 2; ++ai)
#pragma unroll
                for (int bj = 0; bj < 2; ++bj)
#pragma unroll
                    for (int n = 0; n < 2; ++n) *(LAS f32x4*)(B + ((ai * 2 + wr) * 2 + (fr - 14)) * 256 + bj * HALF + colb + 4 * n) = acc[ai][bj][3][n];
        }
        if (wr == 0 && fr < 2) {
#pragma unroll
            for (int bj = 0; bj < 2; ++bj) { const f32x4 v0 = acc[0][bj][0][0], v1 = acc[0][bj][0][1];
                u32x4 w; w.x = cvt_pk_bf16(v0[0], v0[1]); w.y = cvt_pk_bf16(v0[2], v0[3]); w.z = cvt_pk_bf16(v1[0], v1[1]); w.w = cvt_pk_bf16(v1[2], v1[3]);
                *(u32x4*)(HALO + (size_t)(u.pm * 4 + fr) * DFF2 + bj * DFF + ch0) = w; }
        }
        if (wr == 1 && fr >= 14) {
#pragma unroll
            for (int bj = 0; bj < 2; ++bj) { const f32x4 v0 = acc[1][bj][3][0], v1 = acc[1][bj][3][1];
                u32x4 w; w.x = cvt_pk_bf16(v0[0], v0[1]); w.y = cvt_pk_bf16(v0[2], v0[3]); w.z = cvt_pk_bf16(v1[0], v1[1]); w.w = cvt_pk_bf16(v1[2], v1[3]);
                *(u32x4*)(HALO + (size_t)(u.pm * 4 + 2 + (fr - 14)) * DFF2 + bj * DFF + ch0) = w; }
        }
        LDS_WAIT(); __builtin_amdgcn_s_barrier(); asm volatile("" ::: "memory");
#pragma unroll
        for (int ai = 0; ai < 2; ++ai) {
            const bool has = (wr == 1) || (ai == 1);
            const int sb = (wr == 1) ? (ai * 2) : 1;
#pragma unroll
            for (int n = 0; n < 2; ++n) {
                asm volatile("" ::: "memory");
                const int cl = colb + 4 * n;
                float hv[4][4];
                const f32x4 wv0 = *(const LAS f32x4*)(Wl + 0 * 128 + cl), wg0 = *(const LAS f32x4*)(Wl + 1 * 128 + cl);
                const f32x4 wv1 = *(const LAS f32x4*)(Wl + 2 * 128 + cl), wg1 = *(const LAS f32x4*)(Wl + 3 * 128 + cl);
                const f32x4 wv2 = *(const LAS f32x4*)(Wl + 4 * 128 + cl), wg2 = *(const LAS f32x4*)(Wl + 5 * 128 + cl);
                const f32x4 bvv = *(const LAS f32x4*)(Wl + 6 * 128 + cl), bgv = *(const LAS f32x4*)(Wl + 7 * 128 + cl);
                f32x4 b1v = (f32x4){0.f, 0.f, 0.f, 0.f}, b2v = b1v, b1g = b1v, b2g = b1v;
                if (has) {
                    b1v = *(const LAS f32x4*)(B + (sb * 2 + 1) * 256 + cl); b2v = *(const LAS f32x4*)(B + (sb * 2 + (fr & 1)) * 256 + cl);
                    b1g = *(const LAS f32x4*)(B + (sb * 2 + 1) * 256 + HALF + cl); b2g = *(const LAS f32x4*)(B + (sb * 2 + (fr & 1)) * 256 + HALF + cl);
                }
#pragma unroll
                for (int j = 0; j < 4; ++j) {
                    float r1p = b1v[j], r2p = b2v[j], q1p = b1g[j], q2p = b2g[j];
#pragma unroll
                    for (int m = 0; m < 4; ++m) {
                        const float xv = acc[ai][0][m][n][j], xg = acc[ai][1][m][n][j];
                        const float pv1 = dpp_shr1_old(r1p, xv), pv2 = dpp_shr2_old(r2p, xv), pg1 = dpp_shr1_old(q1p, xg), pg2 = dpp_shr2_old(q2p, xg);
                        const float cv = bvv[j] + wv0[j] * pv2 + wv1[j] * pv1 + wv2[j] * xv;
                        const float cg = bgv[j] + wg0[j] * pg2 + wg1[j] * pg1 + wg2[j] * xg;
                        hv[m][j] = cv * cg * frcp(1.0f + fexp(-cg));
                        if (m < 3) { r1p = dpp_ror1u(xv); r2p = dpp_ror2u(xv); q1p = dpp_ror1u(xg); q2p = dpp_ror2u(xg); }
                    }
                    __builtin_amdgcn_sched_barrier(0);
                }
#pragma unroll
                for (int m = 0; m < 4; ++m) {
                    u32x2 w; w.x = cvt_pk_bf16(hv[m][0], hv[m][1]); w.y = cvt_pk_bf16(hv[m][2], hv[m][3]);
                    *(u32x2*)(H + (size_t)(row0 + ai * HALF + m * 16) * DFF + ch0 + 4 * n) = w;
                }
            }
        }
    }
};

struct EpiHend {
    static constexpr bool PERM = false;
    float* Hout;
    __device__ __forceinline__ void operator()(Acc& acc, const Unit& u, int wr, int wc, int fr, int fq, LAS unsigned char*) const {
        const int row0 = u.pm * BM + wr * 64 + fr, col0 = wc * 32 + 4 * fq;
#pragma unroll
        for (int ai = 0; ai < 2; ++ai)
#pragma unroll
            for (int m = 0; m < 4; ++m)
#pragma unroll
                for (int n = 0; n < 2; ++n)
                    *(f32x4*)(Hout + (size_t)(row0 + ai * HALF + m * 16) * 128 + col0 + n * 16) = acc[ai][0][m][n];
    }
};

struct EpiSsmY {
    static constexpr bool PERM = true;
    const bf16_t* Ug; const float* Dskip; bf16_t* Yg;
    __device__ __forceinline__ void operator()(Acc& acc, const Unit& u, int wr, int wc, int fr, int fq, LAS unsigned char*) const {
        const int g = u.pm >> 2;
        const int rg0 = (u.pm & 3) * BM + wr * 64 + fr, col0 = u.pn * BM + wc * 32 + 8 * fq;
        const int co = col0 & 15;
        const f32x4 d0 = *(const f32x4*)(Dskip + g * 16 + co), d1 = *(const f32x4*)(Dskip + g * 16 + co + 4);
#pragma unroll
        for (int ai = 0; ai < 2; ++ai)
#pragma unroll
            for (int m = 0; m < 4; ++m) {
                const int rg = rg0 + ai * HALF + m * 16;
#pragma unroll
                for (int bj = 0; bj < 2; ++bj) {
                    const int col = col0 + bj * HALF;
                    const u32x4 uu = *(const u32x4*)(Ug + ((size_t)g * 1024 + rg) * 640 + col);
                    float y[8];
                    y[0] = acc[ai][bj][m][0][0] + d0[0] * bflo(uu.x); y[1] = acc[ai][bj][m][0][1] + d0[1] * bfhi(uu.x);
                    y[2] = acc[ai][bj][m][0][2] + d0[2] * bflo(uu.y); y[3] = acc[ai][bj][m][0][3] + d0[3] * bfhi(uu.y);
                    y[4] = acc[ai][bj][m][1][0] + d1[0] * bflo(uu.z); y[5] = acc[ai][bj][m][1][1] + d1[1] * bfhi(uu.z);
                    y[6] = acc[ai][bj][m][1][2] + d1[2] * bflo(uu.w); y[7] = acc[ai][bj][m][1][3] + d1[3] * bfhi(uu.w);
#pragma unroll
                    for (int j = 0; j < 8; ++j) { const float x = y[j]; const float k2 = 1.5957691216f * (x + 0.044715f * x * x * x); y[j] = x * frcp(1.0f + fexp(-k2)); }
                    u32x4 w; w.x = cvt_pk_bf16(y[0], y[1]); w.y = cvt_pk_bf16(y[2], y[3]); w.z = cvt_pk_bf16(y[4], y[5]); w.w = cvt_pk_bf16(y[6], y[7]);
                    const size_t tok = (size_t)rg * 32 + (col >> 4);
                    *(u32x4*)(Yg + tok * DM + g * 16 + co) = w;
                }
            }
    }
};

template <class Epi, class Sched>
__device__ __forceinline__ void gemm_phase(LAS unsigned char* lds, LAS unsigned char* xl, const int lda, const int ldb, const int K, const Sched& S, const Epi& E) {
    int tid_ = threadIdx.x; asm volatile("" : "+v"(tid_));
    const int tid = tid_, wid = __builtin_amdgcn_readfirstlane(tid >> 6), lane = tid & 63, wr = wid >> 2, wc = wid & 3, fr = lane & 15, fq = lane >> 4;
    const int nt = K / BK;
    unsigned voffA, voffB;
    { int R, C; stage_rc(tid * 16, R, C); const int Rb = Epi::PERM ? ((R & ~31) + perm32(R & 31)) : R;
      voffA = (unsigned)(R * lda + C) * 2u; voffB = (unsigned)(Rb * ldb + C) * 2u; }
    const size_t qstepA = (size_t)64 * lda * 2, qstepB = (size_t)64 * ldb * 2;
    const size_t kstep = (size_t)(BK * 2);
    const size_t hstepA = (size_t)HALF * lda * 2, hstepB = (size_t)HALF * ldb * 2;
    const unsigned ldsw = (unsigned)wid * 1024u;
    const int aoff = lds_byte(wr * 64 + fr, fq * 8), boff = lds_byte(wc * 32 + fr, fq * 8);
#define PG8_SA(b, h) (((b) * 2 + (h)) * HTB)
#define PG8_SB(b, h) ((4 + (b) * 2 + (h)) * HTB)
#define PG8_STAGE(bufoff, gbase, voff) do { _Pragma("unroll") for (int _i = 0; _i < 2; ++_i) \
        { const char* _gb = (const char*)(gbase) + (size_t)_i * q##voff; asm volatile("" : "+s"(_gb)); \
          __builtin_amdgcn_global_load_lds((const unsigned*)(_gb + (voff)), (LAS unsigned*)(lds + (bufoff) + ldsw + _i * 8192), 16, 0, 0); } } while (0)
#define qvoffA qstepA
#define qvoffB qstepB
#define PG8_LDA(dst, b, h) do { _Pragma("unroll") for (int m = 0; m < 4; ++m) _Pragma("unroll") for (int k = 0; k < 2; ++k) dst[m][k] = *(const LAS bf16x8*)(lds + PG8_SA(b, h) + aoff + m * 2048 + k * 1024); } while (0)
#define PG8_LDB(dst, b, h) do { _Pragma("unroll") for (int n = 0; n < 2; ++n) _Pragma("unroll") for (int k = 0; k < 2; ++k) dst[n][k] = *(const LAS bf16x8*)(lds + PG8_SB(b, h) + boff + n * 2048 + k * 1024); } while (0)
#define PG8_MMA(ai, bj, At, Bt) do { __builtin_amdgcn_s_setprio(1); _Pragma("unroll") for (int m = 0; m < 4; ++m) _Pragma("unroll") for (int n = 0; n < 2; ++n) _Pragma("unroll") for (int k = 0; k < 2; ++k) \
        acc[ai][bj][m][n] = __builtin_amdgcn_mfma_f32_16x16x32_bf16(Bt[n][k], At[m][k], acc[ai][bj][m][n], 0, 0, 0); __builtin_amdgcn_s_setprio(0); } while (0)
#define PG8_WAIT_V(n) asm volatile("s_waitcnt vmcnt(" #n ")" ::: "memory")
#define PG8_WAIT_L(n) asm volatile("s_waitcnt lgkmcnt(" #n ")" ::: "memory")
#define PG8_BAR __builtin_amdgcn_s_barrier()
#define PG8_SCHED __builtin_amdgcn_sched_barrier(0)
    Unit cur, nxt; int ui = 0;
    if (!S.next(0, cur)) return;
    Acc acc;
#pragma unroll
    for (int a = 0; a < 2; ++a)
#pragma unroll
        for (int b = 0; b < 2; ++b)
#pragma unroll
            for (int m = 0; m < 4; ++m)
#pragma unroll
                for (int n = 0; n < 2; ++n) acc[a][b][m][n] = (f32x4){0.f, 0.f, 0.f, 0.f};
    bf16x8 At[4][2], B0[2][2], B1[2][2];
    const char* cA = cur.a; const char* cB = cur.b;
    PG8_STAGE(PG8_SB(0, 0), cB, voffB); PG8_STAGE(PG8_SB(0, 1), cB + hstepB, voffB); PG8_STAGE(PG8_SA(0, 0), cA, voffA); PG8_STAGE(PG8_SA(0, 1), cA + hstepA, voffA);
    if (wr == 1) PG8_BAR;
    PG8_WAIT_V(2); PG8_BAR;
    PG8_STAGE(PG8_SB(1, 0), cB + kstep, voffB); PG8_STAGE(PG8_SA(1, 0), cA + kstep, voffA); PG8_STAGE(PG8_SB(1, 1), cB + hstepB + kstep, voffB);
    PG8_WAIT_V(6); PG8_BAR;
    for (;;) {
        const bool has_next = S.next(ui + 1, nxt);
        const char* nA = has_next ? nxt.a : cA; const char* nB = has_next ? nxt.b : cB;
        for (int t = 0; t < nt; t += 2) {
            const bool last = (t == nt - 2);
            const char* a1 = cA + (size_t)(t + 1) * kstep;
            const char* a2 = last ? nA : cA + (size_t)(t + 2) * kstep; const char* b2 = last ? nB : cB + (size_t)(t + 2) * kstep;
            const char* a3 = a2 + kstep; const char* b3 = b2 + kstep;
            PG8_LDB(B0, 0, 0); PG8_LDB(B1, 0, 1); PG8_SCHED; PG8_LDA(At, 0, 0); PG8_STAGE(PG8_SA(1, 1), a1 + hstepA, voffA);
            PG8_WAIT_V(8); PG8_WAIT_L(0); PG8_BAR; PG8_MMA(0, 0, At, B0); PG8_MMA(0, 1, At, B1); PG8_BAR; PG8_SCHED;
            PG8_LDA(At, 0, 1); PG8_STAGE(PG8_SB(0, 0), b2, voffB); PG8_STAGE(PG8_SB(0, 1), b2 + hstepB, voffB); PG8_STAGE(PG8_SA(0, 0), a2, voffA);
            PG8_WAIT_V(8); PG8_WAIT_L(0); PG8_BAR; PG8_MMA(1, 0, At, B0); PG8_MMA(1, 1, At, B1); PG8_BAR; PG8_SCHED;
            PG8_LDB(B0, 1, 0); PG8_LDB(B1, 1, 1); PG8_SCHED; PG8_LDA(At, 1, 0); PG8_STAGE(PG8_SA(0, 1), a2 + hstepA, voffA);
            PG8_WAIT_V(8); PG8_WAIT_L(0); PG8_BAR; PG8_MMA(0, 0, At, B0); PG8_MMA(0, 1, At, B1); PG8_BAR; PG8_SCHED;
            PG8_LDA(At, 1, 1); PG8_STAGE(PG8_SB(1, 0), b3, voffB); PG8_STAGE(PG8_SB(1, 1), b3 + hstepB, voffB); PG8_STAGE(PG8_SA(1, 0), a3, voffA);
            PG8_WAIT_V(8); PG8_WAIT_L(0); PG8_BAR; PG8_MMA(1, 0, At, B0); PG8_MMA(1, 1, At, B1); PG8_BAR; PG8_SCHED;
        }
        if (wr == 0) PG8_BAR;
        __builtin_amdgcn_sched_barrier(0); asm volatile("s_nop 15\n\ts_nop 15\n\ts_nop 15" ::: "memory"); __builtin_amdgcn_sched_barrier(0);
        { int t2 = threadIdx.x; asm volatile("" : "+v"(t2)); E(acc, cur, wr, wc, t2 & 15, (t2 >> 4) & 3, xl); }
        if (!has_next) break;
#pragma unroll
        for (int a = 0; a < 2; ++a)
#pragma unroll
            for (int b = 0; b < 2; ++b)
#pragma unroll
                for (int m = 0; m < 4; ++m)
#pragma unroll
                    for (int n = 0; n < 2; ++n) acc[a][b][m][n] = (f32x4){0.f, 0.f, 0.f, 0.f};
        cur = nxt; cA = nA; cB = nB; ++ui;
        if (wr == 1) PG8_BAR;
    }
    PG8_WAIT_V(0);
    PG8_BAR;
#undef PG8_SA
#undef PG8_SB
#undef PG8_STAGE
#undef qvoffA
#undef qvoffB
#undef PG8_LDA
#undef PG8_LDB
#undef PG8_MMA
#undef PG8_WAIT_V
#undef PG8_WAIT_L
#undef PG8_BAR
#undef PG8_SCHED
}
}

constexpr int RING_BYTES = 131072, XL_OFF = RING_BYTES, XBST_OFF = XL_OFF + 14336, LDS_BYTES = 147456;

struct TItem { const float* W; const float* gk; bf16_t* D; int N, ldt, drow0, k0, n0; };
__device__ __forceinline__ void titem_load(float (&v)[32], const TItem& t, int lane) {
#pragma unroll
    for (int i = 0; i < 32; ++i) { const int kk = 2 * i + (lane >> 5); v[i] = t.W[(size_t)(t.k0 + kk) * t.N + t.n0 + (lane & 31)]; }
}
__device__ __forceinline__ void titem_to_lds(const float (&v)[32], LAS float* scr, int lane) {
#pragma unroll
    for (int i = 0; i < 32; ++i) { const int kk = 2 * i + (lane >> 5); scr[kk * 33 + (lane & 31)] = v[i]; }
    LDS_WAIT(); asm volatile("" ::: "memory");
}
__device__ __forceinline__ void titem_store(const TItem& t, LAS float* scr, int lane) {
    const int c = lane & 7;
    f32x4 g0 = (f32x4){1.f, 1.f, 1.f, 1.f}, g1 = g0;
    if (t.gk) { g0 = *(const f32x4*)(t.gk + t.k0 + 8 * c); g1 = *(const f32x4*)(t.gk + t.k0 + 8 * c + 4); }
#pragma unroll
    for (int j = 0; j < 4; ++j) { const int n = (lane >> 3) + 8 * j; const LAS float* s = scr + (8 * c) * 33 + n;
        u32x4 o; o.x = cvt_pk_bf16(s[0 * 33] * g0[0], s[1 * 33] * g0[1]); o.y = cvt_pk_bf16(s[2 * 33] * g0[2], s[3 * 33] * g0[3]);
        o.z = cvt_pk_bf16(s[4 * 33] * g1[0], s[5 * 33] * g1[1]); o.w = cvt_pk_bf16(s[6 * 33] * g1[2], s[7 * 33] * g1[3]);
        *(u32x4*)(t.D + (size_t)(t.drow0 + n) * t.ldt + t.k0 + 8 * c) = o; }
    LDS_WAIT(); asm volatile("" ::: "memory");
}
__device__ __forceinline__ void rms_row_to_bf16(const float* xrow, const float* g, bf16_t* orow, int lane) {
    const f32x4* xr = (const f32x4*)xrow + lane; const f32x4* gr = (const f32x4*)g + lane;
    f32x4 v[4]; float s = 0.f;
#pragma unroll
    for (int j = 0; j < 4; ++j) { v[j] = xr[64 * j]; s += (v[j].x * v[j].x + v[j].y * v[j].y) + (v[j].z * v[j].z + v[j].w * v[j].w); }
    const float rstd = 1.f / sqrtf(wave_sum(s) * (1.f / DM) + EPS);
    u32x2* o8 = (u32x2*)orow + lane;
#pragma unroll
    for (int j = 0; j < 4; ++j) { const f32x4 gg = gr[64 * j]; u32x2 w; w.x = cvt_pk_bf16(v[j].x * rstd * gg.x, v[j].y * rstd * gg.y); w.y = cvt_pk_bf16(v[j].z * rstd * gg.z, v[j].w * rstd * gg.w); o8[64 * j] = w; }
}

__device__ __forceinline__ void rms_rows4_to_bf16(const float* xrow, const float* g, bf16_t* orow, int lane) {
    f32x4 v[4][4]; float s[4];
#pragma unroll
    for (int r = 0; r < 4; ++r)
#pragma unroll
        for (int j = 0; j < 4; ++j) v[r][j] = *((const f32x4*)(xrow + (size_t)r * DM) + lane + 64 * j);
#pragma unroll
    for (int r = 0; r < 4; ++r) { s[r] = 0.f;
#pragma unroll
        for (int j = 0; j < 4; ++j) s[r] += (v[r][j].x * v[r][j].x + v[r][j].y * v[r][j].y) + (v[r][j].z * v[r][j].z + v[r][j].w * v[r][j].w); }
#pragma unroll
    for (int r = 0; r < 4; ++r) s[r] = 1.f / sqrtf(wave_sum(s[r]) * (1.f / DM) + EPS);
#pragma unroll
    for (int j = 0; j < 4; ++j) { const f32x4 gg = *((const f32x4*)g + lane + 64 * j);
#pragma unroll
        for (int r = 0; r < 4; ++r) { u32x2 w; w.x = cvt_pk_bf16(v[r][j].x * s[r] * gg.x, v[r][j].y * s[r] * gg.y); w.y = cvt_pk_bf16(v[r][j].z * s[r] * gg.z, v[r][j].w * s[r] * gg.w);
            *((u32x2*)(orow + (size_t)r * DM) + lane + 64 * j) = w; } }
}

struct Args { const float* in[28]; float* out; unsigned char* ws; int ph_lo, ph_hi; };
typedef const __attribute__((address_space(4))) Args* KArgs;
__device__ __forceinline__ KArgs kargs() { KArgs p = (KArgs)__builtin_amdgcn_kernarg_segment_ptr(); asm volatile("" : "+s"(p)); return p; }

__device__ __forceinline__ void ssm_tables(KArgs ap, int g, LAS unsigned char* lds, bf16_t* Tg, bf16_t* Wend) {
    LAS float* Lre = (LAS float*)lds;
    LAS float* Lim = Lre + 33 * 64;
    LAS float* Bre = Lim + 33 * 64;
    LAS float* Bim = Bre + 1024;
    LAS float* Cre = Bim + 1024;
    LAS float* Cim = Cre + 1024;
    LAS float* Kern = Cim + 1024;
    const int tid = threadIdx.x;
    const float* lam_re = ap->in[12] + g * 64; const float* lam_im = ap->in[13] + g * 64;
    const float dt = expf(ap->in[14][g]);
    for (int idx = tid; idx < 33 * 64; idx += 512) {
        const int tau = idx >> 6, p = idx & 63;
        const float mag = expf((float)tau * (lam_re[p] * dt)); const float ang = (float)tau * (lam_im[p] * dt);
        Lre[idx] = mag * cosf(ang); Lim[idx] = mag * sinf(ang);
    }
    __syncthreads();
    for (int idx = tid; idx < 1024; idx += 512) {
        {
            const int p = idx >> 4;
            const float lr = lam_re[p], li = lam_im[p], lbr = Lre[64 + p], lbi = Lim[64 + p];
            const float nre = lbr - 1.0f, den = lr * lr + li * li;
            const float cr = (nre * lr + lbi * li) / den, ci = (lbi * lr - nre * li) / den;
            const float br = ap->in[15][(size_t)g * 1024 + idx], bi = ap->in[16][(size_t)g * 1024 + idx];
            Bre[idx] = cr * br - ci * bi; Bim[idx] = cr * bi + ci * br;
        }
        Cre[idx] = ap->in[17][(size_t)g * 1024 + idx]; Cim[idx] = ap->in[18][(size_t)g * 1024 + idx];
    }
    __syncthreads();
    {
        const int tau = tid >> 4, co = tid & 15; float kacc[16];
#pragma unroll
        for (int ci = 0; ci < 16; ++ci) kacc[ci] = 0.f;
        for (int p = 0; p < 64; ++p) {
            const float cr = Cre[co * 64 + p], cim = Cim[co * 64 + p], lr = Lre[tau * 64 + p], li = Lim[tau * 64 + p];
            const float gr = cr * lr - cim * li, gi = cr * li + cim * lr;
#pragma unroll
            for (int q = 0; q < 4; ++q) { const f32x4 br = *(const LAS f32x4*)(Bre + p * 16 + 4 * q), bi = *(const LAS f32x4*)(Bim + p * 16 + 4 * q);
#pragma unroll
                for (int e = 0; e < 4; ++e) kacc[4 * q + e] += gr * br[e] - gi * bi[e]; }
        }
#pragma unroll
        for (int ci = 0; ci < 16; ++ci) Kern[tid * 16 + ci] = kacc[ci];
    }
    __syncthreads();
    bf16_t* T = Tg + (size_t)g * 512 * 640;
    for (int idx = tid; idx < 512 * 80; idx += 512) {
        const int n = idx / 80, k8 = (idx % 80) * 8; const int t = n >> 4, co = n & 15;
        float v[8];
        if (k8 < 512) { const int s = k8 >> 4, ci = k8 & 15;
#pragma unroll
            for (int j = 0; j < 8; ++j) v[j] = (s <= t) ? Kern[((t - s) * 16 + co) * 16 + ci + j] : 0.f;
        } else { const int q = k8 - 512, im = q >> 6, p0 = q & 63;
#pragma unroll
            for (int j = 0; j < 8; ++j) { const int p = p0 + j; const float cr = Cre[co * 64 + p], cim = Cim[co * 64 + p], lr = Lre[(t + 1) * 64 + p], li = Lim[(t + 1) * 64 + p];
                v[j] = im ? -(cr * li + cim * lr) : (cr * lr - cim * li); }
        }
        u32x4 w; w.x = cvt_pk_bf16(v[0], v[1]); w.y = cvt_pk_bf16(v[2], v[3]); w.z = cvt_pk_bf16(v[4], v[5]); w.w = cvt_pk_bf16(v[6], v[7]);
        *(u32x4*)(T + (size_t)n * 640 + k8) = w;
    }
    bf16_t* We = Wend + (size_t)g * 256 * 512;
    for (int idx = tid; idx < 256 * 64; idx += 512) {
        const int j = idx >> 6, k8 = (idx & 63) * 8; float v[8];
        if (j < 128) { const int p = j & 63, im = j >> 6, s = k8 >> 4, ci = k8 & 15; const float lr = Lre[(31 - s) * 64 + p], li = Lim[(31 - s) * 64 + p];
#pragma unroll
            for (int e = 0; e < 8; ++e) { const float br = Bre[p * 16 + ci + e], bi = Bim[p * 16 + ci + e]; v[e] = im ? (lr * bi + li * br) : (lr * br - li * bi); }
        } else {
#pragma unroll
            for (int e = 0; e < 8; ++e) v[e] = 0.f;
        }
        u32x4 w; w.x = cvt_pk_bf16(v[0], v[1]); w.y = cvt_pk_bf16(v[2], v[3]); w.z = cvt_pk_bf16(v[4], v[5]); w.w = cvt_pk_bf16(v[6], v[7]);
        *(u32x4*)(We + (size_t)j * 512 + k8) = w;
    }
    __syncthreads();
}


template <int W> __device__ __forceinline__ u32x4 pool_item(const bf16_t* up, int t) {
    const int cnt = (t + 1 < W) ? t + 1 : W;
    u32x4 v[W];
#pragma unroll
    for (int i = 0; i < W; ++i) v[i] = (i < cnt) ? *(const u32x4*)(up - (size_t)i * 1536) : (u32x4){0u, 0u, 0u, 0u};
    float s[8];
#pragma unroll
    for (int j = 0; j < 8; ++j) s[j] = 0.f;
#pragma unroll
    for (int i = 0; i < W; ++i) { s[0] += bflo(v[i].x); s[1] += bfhi(v[i].x); s[2] += bflo(v[i].y); s[3] += bfhi(v[i].y); s[4] += bflo(v[i].z); s[5] += bfhi(v[i].z); s[6] += bflo(v[i].w); s[7] += bfhi(v[i].w); }
    const float inv = 1.0f / (float)cnt;
    u32x4 w; w.x = cvt_pk_bf16(s[0] * inv - bflo(v[0].x), s[1] * inv - bfhi(v[0].x)); w.y = cvt_pk_bf16(s[2] * inv - bflo(v[0].y), s[3] * inv - bfhi(v[0].y));
    w.z = cvt_pk_bf16(s[4] * inv - bflo(v[0].z), s[5] * inv - bfhi(v[0].z)); w.w = cvt_pk_bf16(s[6] * inv - bflo(v[0].w), s[7] * inv - bfhi(v[0].w));
    return w;
}

__device__ __forceinline__ void bf8_to_f(const u32x4 v, float (&f)[8]) { f[0] = bflo(v.x); f[1] = bfhi(v.x); f[2] = bflo(v.y); f[3] = bfhi(v.y); f[4] = bflo(v.z); f[5] = bfhi(v.z); f[6] = bflo(v.w); f[7] = bfhi(v.w); }
template <int W> __device__ __forceinline__ void pool_segment(const bf16_t* up, bf16_t* op, int t0) {
    float s[8];
#pragma unroll
    for (int j = 0; j < 8; ++j) s[j] = 0.f;
#pragma unroll
    for (int i = 1; i < W; ++i) {
        u32x4 v = (u32x4){0u, 0u, 0u, 0u};
        if (t0 - i >= 0) v = *(const u32x4*)(up - (size_t)i * 1536);
        float f[8]; bf8_to_f(v, f);
#pragma unroll
        for (int j = 0; j < 8; ++j) s[j] += f[j];
    }
#pragma unroll 4
    for (int r = 0; r < 16; ++r) {
        const int t = t0 + r;
        const u32x4 vc = *(const u32x4*)(up + (size_t)r * 1536);
        u32x4 vo = (u32x4){0u, 0u, 0u, 0u};
        if (t - (W - 1) >= 0) vo = *(const u32x4*)(up + (size_t)(r - (W - 1)) * 1536);
        float fc[8], fo[8]; bf8_to_f(vc, fc); bf8_to_f(vo, fo);
        const float inv = 1.0f / (float)((t + 1 < W) ? t + 1 : W);
        float o[8];
#pragma unroll
        for (int j = 0; j < 8; ++j) { s[j] += fc[j]; o[j] = s[j] * inv - fc[j]; s[j] -= fo[j]; }
        u32x4 w; w.x = cvt_pk_bf16(o[0], o[1]); w.y = cvt_pk_bf16(o[2], o[3]); w.z = cvt_pk_bf16(o[4], o[5]); w.w = cvt_pk_bf16(o[6], o[7]);
        *(u32x4*)(op + (size_t)r * DM) = w;
    }
}

__device__ __forceinline__ int crow(int r, int hi) { return (r & 3) + 8 * (r >> 2) + 4 * hi; }
__device__ __forceinline__ void sb_attn_task(const bf16_t* __restrict__ QKU, const bf16_t* __restrict__ VT, bf16_t* __restrict__ CAT, int b, int h, int qb, int lane) {
    const int r32 = lane & 31, hi = lane >> 5;
    const size_t tok0 = (size_t)b * SEQ; const int q0 = qb * 32;
    const bf16_t* qp = QKU + (tok0 + q0 + r32) * 1536 + h * 64 + 8 * hi;
    bf16x8 qf[4];
#pragma unroll
    for (int j = 0; j < 4; ++j) qf[j] = *(const bf16x8*)(qp + 16 * j);
    const bf16_t* kp = QKU + (tok0 + r32) * 1536 + 512 + h * 64 + 8 * hi;
    const bf16_t* vp = VT + (size_t)(h * 64 + r32) * VT_LD + tok0 + 4 * hi;
    f32x16 o0, o1;
#pragma unroll
    for (int r = 0; r < 16; ++r) { o0[r] = 0.f; o1[r] = 0.f; }
    float carry = 1.0f;
    bf16x8 kf[4]; s16x4 va[2][4]; bf16x8 k1[4]; s16x4 v1[2][4];
#define SB_LOAD(KF, VA, K0) do { const int k0_ = (K0); \
        _Pragma("unroll") for (int j = 0; j < 4; ++j) KF[j] = *(const bf16x8*)(kp + (size_t)k0_ * 1536 + 16 * j); \
        _Pragma("unroll") for (int dh = 0; dh < 2; ++dh) _Pragma("unroll") for (int c = 0; c < 4; ++c) VA[dh][c] = *(const s16x4*)(vp + (size_t)dh * 32 * VT_LD + k0_ + 8 * c); } while (0)
    asm volatile("s_waitcnt vmcnt(0)" ::: "memory");
    SB_LOAD(kf, va, q0);
    SB_LOAD(k1, v1, qb > 0 ? q0 - 32 : q0);
    for (int kt = qb; kt >= 0; --kt) {
        bf16x8 kn[4]; s16x4 vn[2][4];
        SB_LOAD(kn, vn, kt >= 2 ? (kt - 2) * 32 : 0);
        f32x16 s;
#pragma unroll
        for (int r = 0; r < 16; ++r) s[r] = 0.f;
#pragma unroll
        for (int j = 0; j < 4; ++j) s = __builtin_amdgcn_mfma_f32_32x32x16_bf16(kf[j], qf[j], s, 0, 0, 0);
        const bool diag = (kt == qb);
        float omb[16], bt[16];
#pragma unroll
        for (int r = 0; r < 16; ++r) {
            const float z2 = fminf(s[r] * (0.125f * LOG2E), 100.0f);
            const float e = fexp2(z2);
            const float ob = frcp(1.0f + e);
            const bool valid = !diag || (crow(r, hi) < r32);
            omb[r] = valid ? ob : 1.0f; bt[r] = valid ? e * ob : 0.0f;
        }
        float gp[4], pg[4];
#pragma unroll
        for (int g = 0; g < 4; ++g) { gp[g] = (omb[4 * g] * omb[4 * g + 1]) * (omb[4 * g + 2] * omb[4 * g + 3]); pg[g] = partner32(gp[g], hi); }
        float tp[4];
        tp[3] = 1.0f; tp[2] = gp[3] * pg[3]; tp[1] = tp[2] * (gp[2] * pg[2]); tp[0] = tp[1] * (gp[1] * pg[1]);
        const float total = tp[0] * (gp[0] * pg[0]);
        float w[16];
#pragma unroll
        for (int g = 0; g < 4; ++g) {
            const float base = carry * tp[g] * (hi ? 1.0f : pg[g]);
            const float a3 = base, a2 = a3 * omb[4 * g + 3], a1 = a2 * omb[4 * g + 2], a0 = a1 * omb[4 * g + 1];
            w[4 * g + 3] = bt[4 * g + 3] * a3;
            w[4 * g + 2] = bt[4 * g + 2] * a2;
            w[4 * g + 1] = bt[4 * g + 1] * a1;
            w[4 * g + 0] = bt[4 * g + 0] * a0;
        }
        carry *= total;
        u32x4 p0, p1;
        p0.x = cvt_pk_bf16(w[0], w[1]); p0.y = cvt_pk_bf16(w[2], w[3]); p0.z = cvt_pk_bf16(w[4], w[5]); p0.w = cvt_pk_bf16(w[6], w[7]);
        p1.x = cvt_pk_bf16(w[8], w[9]); p1.y = cvt_pk_bf16(w[10], w[11]); p1.z = cvt_pk_bf16(w[12], w[13]); p1.w = cvt_pk_bf16(w[14], w[15]);
        const bf16x8 pb0 = __builtin_bit_cast(bf16x8, p0), pb1 = __builtin_bit_cast(bf16x8, p1);
#define VA8(dh, c) (bf16x8){va[dh][c][0], va[dh][c][1], va[dh][c][2], va[dh][c][3], va[dh][(c) + 1][0], va[dh][(c) + 1][1], va[dh][(c) + 1][2], va[dh][(c) + 1][3]}
        const bf16x8 a00 = VA8(0, 0), a02 = VA8(0, 2), a10 = VA8(1, 0), a12 = VA8(1, 2);
#undef VA8
        o0 = __builtin_amdgcn_mfma_f32_32x32x16_bf16(a00, pb0, o0, 0, 0, 0);
        o0 = __builtin_amdgcn_mfma_f32_32x32x16_bf16(a02, pb1, o0, 0, 0, 0);
        o1 = __builtin_amdgcn_mfma_f32_32x32x16_bf16(a10, pb0, o1, 0, 0, 0);
        o1 = __builtin_amdgcn_mfma_f32_32x32x16_bf16(a12, pb1, o1, 0, 0, 0);
        __builtin_amdgcn_sched_barrier(0);
        asm volatile("s_nop 15\n\ts_nop 15\n\ts_nop 15\n\ts_nop 15\n\ts_nop 15" ::: "memory");
        asm volatile("" :: "v"(a00), "v"(a02), "v"(a10), "v"(a12), "v"(pb0), "v"(pb1), "v"(kf[0]), "v"(kf[1]), "v"(kf[2]), "v"(kf[3]));
        __builtin_amdgcn_sched_barrier(0);
        if (__all(carry == 0.0f)) break;
#pragma unroll
        for (int j = 0; j < 4; ++j) { kf[j] = k1[j]; k1[j] = kn[j]; }
#pragma unroll
        for (int dh = 0; dh < 2; ++dh)
#pragma unroll
            for (int c = 0; c < 4; ++c) { va[dh][c] = v1[dh][c]; v1[dh][c] = vn[dh][c]; }
    }
#undef SB_LOAD
    bf16_t* op = CAT + (tok0 + q0 + r32) * DM + h * 64 + 4 * hi;
#pragma unroll
    for (int g = 0; g < 4; ++g) {
        u32x2 w0, w1;
        w0.x = cvt_pk_bf16(o0[4 * g], o0[4 * g + 1]); w0.y = cvt_pk_bf16(o0[4 * g + 2], o0[4 * g + 3]);
        w1.x = cvt_pk_bf16(o1[4 * g], o1[4 * g + 1]); w1.y = cvt_pk_bf16(o1[4 * g + 2], o1[4 * g + 3]);
        *(u32x2*)(op + 8 * g) = w0; *(u32x2*)(op + 32 + 8 * g) = w1;
    }
}


constexpr int SBK_PITCH = 144, SBV_PITCH = 80, SBK_BYTES = 32 * SBK_PITCH, SBV_BYTES = 64 * SBV_PITCH, SB_TILE = SBK_BYTES + SBV_BYTES, SB_WIN = 14;
static_assert(SB_WIN * SB_TILE <= XBST_OFF, "attention LDS window must stay below the grid barrier's LDS words");
__device__ __forceinline__ void sb_attn_block(const bf16_t* __restrict__ QKU, const bf16_t* __restrict__ VT, bf16_t* __restrict__ CAT, int b, int h, int qb0,
                                              LAS unsigned char* lds, int tid, int wave, int lane) {
    const int r32 = lane & 31, hi = lane >> 5;
    const size_t tok0 = (size_t)b * SEQ; const int qb = qb0 + wave, q0 = qb * 32;
    const int lo = (qb0 >= 6) ? qb0 - 6 : 0, ntile = qb0 + 8 - lo;
    {
        const bool isk = tid < 256; const int t2 = tid & 255;
        const bf16_t* gsrc = isk ? QKU + (tok0 + (t2 >> 3)) * 1536 + 512 + h * 64 + (t2 & 7) * 8
                                 : VT + (size_t)(h * 64 + (t2 >> 2)) * VT_LD + tok0 + (t2 & 3) * 8;
        const size_t gstep = isk ? (size_t)32 * 1536 : (size_t)32;
        const int ldst = isk ? (t2 >> 3) * SBK_PITCH + (t2 & 7) * 16 : SBK_BYTES + (t2 >> 2) * SBV_PITCH + (t2 & 3) * 16;
        u32x4 stg[SB_WIN];
#pragma unroll
        for (int i = 0; i < SB_WIN; ++i) if (i < ntile) stg[i] = *(const u32x4*)(gsrc + (size_t)(lo + i) * gstep);
#pragma unroll
        for (int i = 0; i < SB_WIN; ++i) if (i < ntile) *(LAS u32x4*)(lds + i * SB_TILE + ldst) = stg[i];
    }
    const bf16_t* qp = QKU + (tok0 + q0 + r32) * 1536 + h * 64 + 8 * hi;
    bf16x8 qf[4];
#pragma unroll
    for (int j = 0; j < 4; ++j) qf[j] = *(const bf16x8*)(qp + 16 * j);
    const bf16_t* kp = QKU + (tok0 + r32) * 1536 + 512 + h * 64 + 8 * hi;
    const bf16_t* vp = VT + (size_t)(h * 64 + r32) * VT_LD + tok0 + 4 * hi;
    f32x16 o0, o1;
#pragma unroll
    for (int r = 0; r < 16; ++r) { o0[r] = 0.f; o1[r] = 0.f; }
    float carry = 1.0f;
    __syncthreads();
    for (int kt = qb; kt >= 0; --kt) {
        bf16x8 kf[4]; s16x4 va[2][4];
        if (kt >= lo) {
            LAS unsigned char* kb = lds + (kt - lo) * SB_TILE; LAS unsigned char* vb = kb + SBK_BYTES;
#pragma unroll
            for (int j = 0; j < 4; ++j) kf[j] = *(const LAS bf16x8*)(kb + r32 * SBK_PITCH + (16 * j + 8 * hi) * 2);
#pragma unroll
            for (int dh = 0; dh < 2; ++dh)
#pragma unroll
                for (int c = 0; c < 4; ++c) va[dh][c] = *(const LAS s16x4*)(vb + (dh * 32 + r32) * SBV_PITCH + (8 * c + 4 * hi) * 2);
        } else {
            const int k0 = kt * 32;
#pragma unroll
            for (int j = 0; j < 4; ++j) kf[j] = *(const bf16x8*)(kp + (size_t)k0 * 1536 + 16 * j);
#pragma unroll
            for (int dh = 0; dh < 2; ++dh)
#pragma unroll
                for (int c = 0; c < 4; ++c) va[dh][c] = *(const s16x4*)(vp + (size_t)dh * 32 * VT_LD + k0 + 8 * c);
        }
        f32x16 s;
#pragma unroll
        for (int r = 0; r < 16; ++r) s[r] = 0.f;
#pragma unroll
        for (int j = 0; j < 4; ++j) s = __builtin_amdgcn_mfma_f32_32x32x16_bf16(kf[j], qf[j], s, 0, 0, 0);
        const bool diag = (kt == qb);
        float omb[16], bt[16];
#pragma unroll
        for (int r = 0; r < 16; ++r) {
            const float z2 = fminf(s[r] * (0.125f * LOG2E), 100.0f);
            const float e = fexp2(z2);
            const float ob = frcp(1.0f + e);
            const bool valid = !diag || (crow(r, hi) < r32);
            omb[r] = valid ? ob : 1.0f; bt[r] = valid ? e * ob : 0.0f;
        }
        float gp[4], pg[4];
#pragma unroll
        for (int g = 0; g < 4; ++g) { gp[g] = (omb[4 * g] * omb[4 * g + 1]) * (omb[4 * g + 2] * omb[4 * g + 3]); pg[g] = partner32(gp[g], hi); }
        float tp[4];
        tp[3] = 1.0f; tp[2] = gp[3] * pg[3]; tp[1] = tp[2] * (gp[2] * pg[2]); tp[0] = tp[1] * (gp[1] * pg[1]);
        const float total = tp[0] * (gp[0] * pg[0]);
        float w[16];
#pragma unroll
        for (int g = 0; g < 4; ++g) {
            const float base = carry * tp[g] * (hi ? 1.0f : pg[g]);
            const float a3 = base, a2 = a3 * omb[4 * g + 3], a1 = a2 * omb[4 * g + 2], a0 = a1 * omb[4 * g + 1];
            w[4 * g + 3] = bt[4 * g + 3] * a3; w[4 * g + 2] = bt[4 * g + 2] * a2; w[4 * g + 1] = bt[4 * g + 1] * a1; w[4 * g + 0] = bt[4 * g + 0] * a0;
        }
        carry *= total;
        u32x4 p0, p1;
        p0.x = cvt_pk_bf16(w[0], w[1]); p0.y = cvt_pk_bf16(w[2], w[3]); p0.z = cvt_pk_bf16(w[4], w[5]); p0.w = cvt_pk_bf16(w[6], w[7]);
        p1.x = cvt_pk_bf16(w[8], w[9]); p1.y = cvt_pk_bf16(w[10], w[11]); p1.z = cvt_pk_bf16(w[12], w[13]); p1.w = cvt_pk_bf16(w[14], w[15]);
        const bf16x8 pb0 = __builtin_bit_cast(bf16x8, p0), pb1 = __builtin_bit_cast(bf16x8, p1);
#define VA8(dh, c) (bf16x8){va[dh][c][0], va[dh][c][1], va[dh][c][2], va[dh][c][3], va[dh][(c) + 1][0], va[dh][(c) + 1][1], va[dh][(c) + 1][2], va[dh][(c) + 1][3]}
        const bf16x8 a00 = VA8(0, 0), a02 = VA8(0, 2), a10 = VA8(1, 0), a12 = VA8(1, 2);
#undef VA8
        o0 = __builtin_amdgcn_mfma_f32_32x32x16_bf16(a00, pb0, o0, 0, 0, 0);
        o0 = __builtin_amdgcn_mfma_f32_32x32x16_bf16(a02, pb1, o0, 0, 0, 0);
        o1 = __builtin_amdgcn_mfma_f32_32x32x16_bf16(a10, pb0, o1, 0, 0, 0);
        o1 = __builtin_amdgcn_mfma_f32_32x32x16_bf16(a12, pb1, o1, 0, 0, 0);
        __builtin_amdgcn_sched_barrier(0);
        asm volatile("s_nop 15\n\ts_nop 15\n\ts_nop 15\n\ts_nop 15\n\ts_nop 15" ::: "memory");
        asm volatile("" :: "v"(a00), "v"(a02), "v"(a10), "v"(a12), "v"(pb0), "v"(pb1), "v"(kf[0]), "v"(kf[1]), "v"(kf[2]), "v"(kf[3]));
        __builtin_amdgcn_sched_barrier(0);
        if (__all(carry == 0.0f)) break;
    }
    bf16_t* op = CAT + (tok0 + q0 + r32) * DM + h * 64 + 4 * hi;
#pragma unroll
    for (int g = 0; g < 4; ++g) {
        u32x2 w0, w1;
        w0.x = cvt_pk_bf16(o0[4 * g], o0[4 * g + 1]); w0.y = cvt_pk_bf16(o0[4 * g + 2], o0[4 * g + 3]);
        w1.x = cvt_pk_bf16(o1[4 * g], o1[4 * g + 1]); w1.y = cvt_pk_bf16(o1[4 * g + 2], o1[4 * g + 3]);
        *(u32x2*)(op + 8 * g) = w0; *(u32x2*)(op + 32 + 8 * g) = w1;
    }
    __syncthreads();
}

#define XB_TMO      128
#define XB_XCNT(j)  (256  + 64 * (j))
#define XB_XSUB(j)  (1280 + 64 * (j))
#define XB_XGEN(j)  (2304 + 64 * (j))
#define XB_TOP      3328
#define XB_TOPGEN   3392
#define XCD_BAR_WORDS 3456
#define XB_SPIN_CAP (1u << 22)
__device__ __forceinline__ unsigned xb_ld(unsigned* p)              { return __hip_atomic_load(p, __ATOMIC_RELAXED, __HIP_MEMORY_SCOPE_AGENT); }
__device__ __forceinline__ unsigned xb_add(unsigned* p, unsigned v) { return __hip_atomic_fetch_add(p, v, __ATOMIC_RELAXED, __HIP_MEMORY_SCOPE_AGENT); }
__device__ __forceinline__ unsigned xb_xcc_id() { return (unsigned)__builtin_amdgcn_s_getreg((3 << 11) | 20) & 0xFu; }
#define XB_SPIN(cond, bar) do { unsigned _sp = 0; while (cond) { __builtin_amdgcn_s_sleep(1); \
    if ((++_sp & 255u) == 0u) { if (xb_ld(&(bar)[XB_TMO])) break; if (_sp > XB_SPIN_CAP) { atomicAdd(&(bar)[XB_TMO], 1u); break; } } } } while (0)
__device__ __forceinline__ void xcd_barrier_complete(unsigned* bar, unsigned x, unsigned G, unsigned& nloc, unsigned& nx) {
    unsigned sum, cnt, mine, sp = 0u;
    for (;;) {
        sum = 0u; cnt = 0u; mine = 0u;
#pragma unroll
        for (unsigned j = 0; j < 16; ++j) { const unsigned c = xb_ld(&bar[XB_XCNT(j)]); sum += c; cnt += (c > 0u) ? 1u : 0u; mine = (j == x) ? c : mine; }
        if (sum == G) break;
        __builtin_amdgcn_s_sleep(1);
        if ((++sp & 255u) == 0u) { if (xb_ld(&bar[XB_TMO])) break; if (sp > XB_SPIN_CAP) { atomicAdd(&bar[XB_TMO], 1u); break; } }
    }
    nloc = mine > 0u ? mine : 1u; nx = cnt > 0u ? cnt : 1u;
}
__device__ __forceinline__ void xcd_barrier(unsigned* bar, volatile LAS unsigned* st, bool leader, unsigned G) {
    asm volatile("s_waitcnt vmcnt(0)" ::: "memory");
    __syncthreads();
    if (leader) {
        const unsigned x = xb_xcc_id();
        __builtin_amdgcn_s_waitcnt(0);
        unsigned nloc = st[0], nx = st[1];
        if (nloc == 0u) { xcd_barrier_complete(bar, x, G, nloc, nx); st[0] = nloc; st[1] = nx; }
        const unsigned old = xb_add(&bar[XB_XSUB(x)], 1u);
        const unsigned gen = old / nloc;
        if (old + 1u == (gen + 1u) * nloc) {
            __builtin_amdgcn_fence(__ATOMIC_RELEASE, "agent");
            asm volatile("s_waitcnt vmcnt(0)" ::: "memory");
            const unsigned og = xb_add(&bar[XB_TOP], 1u);
            const unsigned tg = og / nx;
            if (og + 1u == (tg + 1u) * nx) xb_add(&bar[XB_TOPGEN], 1u);
            else XB_SPIN(xb_ld(&bar[XB_TOPGEN]) == tg, bar);
            __builtin_amdgcn_fence(__ATOMIC_ACQUIRE, "agent");
            xb_add(&bar[XB_XGEN(x)], 1u);
            asm volatile("s_waitcnt vmcnt(0)" ::: "memory");
        } else {
            XB_SPIN(xb_ld(&bar[XB_XGEN(x)]) == gen, bar);
            __builtin_amdgcn_fence(__ATOMIC_ACQUIRE, "agent");
            asm volatile("s_waitcnt vmcnt(0)" ::: "memory");
        }
    }
    __syncthreads();
}

__global__ void __launch_bounds__(512) mega_fwd(Args a) {
    __builtin_assume(__builtin_amdgcn_workitem_id_y() == 0); __builtin_assume(__builtin_amdgcn_workitem_id_z() == 0);
    extern __shared__ __attribute__((aligned(16))) unsigned char lds_raw[];
    LAS unsigned char* lds = (LAS unsigned char*)lds_raw;
    LAS unsigned char* xl = lds + XL_OFF;
    cg::grid_group grid = cg::this_grid();
#if !MK_MULTI_LAUNCH
    {
        volatile LAS unsigned* st = (volatile LAS unsigned*)(lds + XBST_OFF);
        if (threadIdx.x == 0) { st[0] = 0u; st[1] = 0u; KArgs ap0 = kargs(); xb_add(&((unsigned*)ap0->ws)[XB_XCNT(xb_xcc_id())], 1u); }
        if (a.ph_lo < 0) grid.sync();
        __syncthreads();
    }
#endif
#if MK_MULTI_LAUNCH
    const int lo = a.ph_lo, hi = a.ph_hi;
    int ph = 0;
#endif
#define PH_VARS int tid = threadIdx.x; asm volatile("" : "+v"(tid)); const int lane = tid & 63, wave = __builtin_amdgcn_readfirstlane(tid >> 6); int G_ = gridDim.x, bid_ = blockIdx.x; asm volatile("" : "+s"(G_), "+s"(bid_)); const int G = G_, bid = bid_; \
    const int gw = bid * 8 + wave, NGW = G * 8, gt = bid * 512 + tid, NGT = G * 512; (void)lane; (void)gw; (void)NGW; (void)gt; (void)NGT; KArgs ap = kargs(); unsigned char* ws = ap->ws; float* X = ap->out; float* SSQ = (float*)(ws + WS_SSQ); bf16_t* XB = (bf16_t*)(ws + WS_XB); bf16_t* MEMN = (bf16_t*)(ws + WS_MEMN); (void)X; (void)SSQ; (void)XB; (void)MEMN;
#if MK_MULTI_LAUNCH
#define PHASE_ON (ph >= lo && ph < hi)
#define PHASE_END do { if (ph >= lo && ph + 1 < hi) grid.sync(); ++ph; } while (0)
#define LOCAL_SEAM PHASE_END
#else
#define PHASE_ON (true)
#define LOCAL_SEAM do { asm volatile("s_waitcnt vmcnt(0)" ::: "memory"); __syncthreads(); { int tl = threadIdx.x; asm volatile("" : "+v"(tl)); \
    if (tl == 0) { __builtin_amdgcn_fence(__ATOMIC_ACQUIRE, "agent"); asm volatile("s_waitcnt vmcnt(0)" ::: "memory"); } } __syncthreads(); } while (0)
#define PHASE_END do { KArgs apb = kargs(); int tb = threadIdx.x; asm volatile("" : "+v"(tb)); int Gb = gridDim.x; asm volatile("" : "+s"(Gb)); \
    xcd_barrier((unsigned*)apb->ws, (volatile LAS unsigned*)(lds + XBST_OFF), tb == 0, (unsigned)Gb); } while (0)
#endif

    if (PHASE_ON) { PH_VARS
        if (bid < 64) ssm_tables(ap, bid, lds, (bf16_t*)(ws + WS_TG), (bf16_t*)(ws + WS_WEND));
        LAS float* scr = (LAS float*)(lds + wave * 16384);
        const bool weighted = (G > 64);
        const int n_tw = weighted ? 64 * 8 : 0, n_nw = weighted ? (G - 64) * 8 : G * 8;
        const int spw = weighted ? 4 : 1, S = n_nw * spw + n_tw;
        const bool is_tw = weighted && bid < 64;
        const int slot0 = is_tw ? n_nw * spw + gw : (weighted ? (gw - 512) * 4 : gw), nslot = is_tw ? 1 : spw;
        if (!is_tw) {
            const int nb_ = weighted ? G - 64 : G, b_ = weighted ? bid - 64 : bid;
            for (int it = b_ + wave * nb_; it < 256; it += nb_ * 8) {
                const int g = it >> 6, cb = (it >> 2) & 15, nb = it & 3;
                const float* pw = ap->in[8] + (size_t)(g * 128 + cb * 8) * 128; const float* sc = ap->in[9] + g * 128;
                const float* wo = ap->in[10] + (size_t)(512 + g * 128) * 1024 + nb * 256 + lane * 4;
                f32x4 acc8[8];
#pragma unroll
                for (int j = 0; j < 8; ++j) acc8[j] = (f32x4){0.f, 0.f, 0.f, 0.f};
#pragma unroll 8
                for (int d = 0; d < 128; ++d) {
                    const f32x4 wv = *(const f32x4*)(wo + (size_t)d * 1024); const float sd = sc[d];
#pragma unroll
                    for (int j = 0; j < 8; ++j) acc8[j] += wv * (pw[j * 128 + d] * sd);
                }
                bf16_t* D = (bf16_t*)(ws + WS_WOUT) + (size_t)(nb * 256 + lane * 4) * 1024 + 512 + g * 128 + cb * 8;
#pragma unroll
                for (int e = 0; e < 4; ++e) {
                    u32x4 w; w.x = cvt_pk_bf16(acc8[0][e], acc8[1][e]); w.y = cvt_pk_bf16(acc8[2][e], acc8[3][e]); w.z = cvt_pk_bf16(acc8[4][e], acc8[5][e]); w.w = cvt_pk_bf16(acc8[6][e], acc8[7][e]);
                    *(u32x4*)(D + (size_t)e * 1024) = w;
                }
            }
        }
        {
            float tv[32]; TItem cur, nxt; bool have = false, have_next = false;
            int sl = 0, it = slot0;
            auto decode = [&](int item, TItem& t) -> bool {
                int r = item; const float* W = nullptr; const float* gk = nullptr; int N = 0; bf16_t* D = nullptr; int ldt = 0, mode = 0; bool found = false;
#define TJOB(Wp, Kk, Nn, Dp, Ld, Md, Gp) if (!found) { const int cnt = ((Kk) / 64) * ((Nn) / 32); if (r < cnt) { W = (Wp); N = (Nn); D = (bf16_t*)(Dp); ldt = (Ld); mode = (Md); gk = (Gp); found = true; } else r -= cnt; }
                TJOB(ap->in[7], 1024, 2048, ws + WS_WIN, 1024, 1, nullptr)
            TJOB(ap->in[10], 512, 1024, ws + WS_WOUT, 1024, 0, nullptr)
            TJOB(ap->in[11], 1024, 1024, ws + WS_WSSM, 1024, 0, ap->in[2] + 1024)
            TJOB(ap->in[20], 1024, 2048, ws + WS_WGLU, 1024, 2, nullptr)
#pragma unroll
            for (int l = 0; l < 2; ++l) {
                unsigned char* lb = ws + WS_LAYER + l * LAYER_STRIDE;
                TJOB(ap->in[22] + (size_t)l * 1024 * 2048, 1024, 2048, lb + LO_WKV, 1024, 0, nullptr)
                TJOB(ap->in[23] + (size_t)l * 1024 * 1024, 1024, 1024, lb + LO_WO, 1024, 0, nullptr)
                TJOB(ap->in[24] + (size_t)l * 1024 * DFF2, 1024, DFF2, lb + LO_WUP, 1024, 3, ap->in[4] + l * 1024)
                TJOB(ap->in[27] + (size_t)l * DFF * 1024, DFF, 1024, lb + LO_WDN, DFF, 0, nullptr)
            }
#undef TJOB
                if (!found) return false;
                const int nblk = N / 32, kb = r / nblk, nb = r % nblk, n0 = nb * 32;
                int drow0 = n0;
                if (mode == 1) drow0 = (n0 < 1024) ? n0 : (n0 < 1536 ? n0 + 512 : n0 - 512);
                else if (mode == 2) drow0 = (n0 < 1024) ? (256 * (n0 >> 7) + (n0 & 127)) : (256 * ((n0 - 1024) >> 7) + 128 + ((n0 - 1024) & 127));
                else if (mode == 3) drow0 = (n0 < DFF) ? (256 * (n0 >> 7) + (n0 & 127)) : (256 * ((n0 - DFF) >> 7) + 128 + ((n0 - DFF) & 127));
                t.W = W; t.gk = gk; t.D = D; t.N = N; t.ldt = ldt; t.drow0 = drow0; t.k0 = kb * 64; t.n0 = n0; return true;
            };
            auto advance = [&](TItem& t) -> bool {
                while (sl < nslot) { if (decode(it, t)) { it += S; return true; } ++sl; it = slot0 + sl; }
                return false;
            };
            have = advance(cur);
            if (have) titem_load(tv, cur, lane);
            while (have) {
                titem_to_lds(tv, scr, lane);
                have_next = advance(nxt);
                if (have_next) titem_load(tv, nxt, lane);
                titem_store(cur, scr, lane);
                cur = nxt; have = have_next;
            }
        }
        for (int it = gt; it < 2 * 1024 * 256; it += NGT) {
            const int l = it >> 18, e = it & 262143, k = e >> 8, n4 = (e & 255) * 4;
            const f32x4 w = *(const f32x4*)(ap->in[21] + (size_t)l * 1048576 + (size_t)k * 1024 + n4); const float gk = ap->in[3][l * 1024 + k];
            u32x2 o; o.x = cvt_pk_bf16(w[0] * gk, w[1] * gk); o.y = cvt_pk_bf16(w[2] * gk, w[3] * gk);
            *(u32x2*)((bf16_t*)(ws + WS_LAYER + l * LAYER_STRIDE + LO_WQ) + (size_t)k * 1024 + n4) = o;
        }
        for (int r = gw; r < MEMTOK / 4; r += NGW) rms_rows4_to_bf16(ap->in[1] + (size_t)r * 4 * DM, ap->in[5], MEMN + (size_t)r * 4 * DM, lane);
        for (int r = gw; r < MTOK / 4; r += NGW) rms_rows4_to_bf16(ap->in[0] + (size_t)r * 4 * DM, ap->in[2], XB + (size_t)r * 4 * DM, lane);
        __syncthreads();
    }
    PHASE_END;

    if (PHASE_ON) { PH_VARS
        bf16_t* WIN = (bf16_t*)(ws + WS_WIN);
        { pg8::SchedStd S; S.init(XB, 256 * 2048, WIN, 256 * 2048, 128, 6, G, bid);
          pg8::EpiStore E{(bf16_t*)(ws + WS_QKU), 1536, nullptr, 0, 1.0f, 0};
          pg8::gemm_phase(lds, xl, 1024, 1024, 1024, S, E); }
        { pg8::SchedStd S; S.init(WIN + (size_t)1536 * 1024, 256 * 2048, XB, 256 * 2048, 2, 128, G, bid);
          pg8::EpiStore E{(bf16_t*)(ws + WS_VT), VT_LD, nullptr, 0, 1.0f, 0};
          pg8::gemm_phase(lds, xl, 1024, 1024, 1024, S, E); }
        for (int j = 0; j < 4; ++j) {
            const int l = j >> 1, isv = j & 1;
            bf16_t* WKV = (bf16_t*)(ws + WS_LAYER + l * LAYER_STRIDE + LO_WKV);
            const int c = (bid + 64 * (j + 1)) % G;
            pg8::SchedStd S;
            S.init(MEMN, 256 * 2048, WKV + (size_t)isv * 1024 * 1024, 256 * 2048, 16, 4, G, c);
            pg8::EpiStore E{isv ? (bf16_t*)(ws + WS_MEMVT + l * MEMVT_STRIDE) : (bf16_t*)(ws + WS_MEMK + l * 8 * MiB), 1024, nullptr, 0, 1.0f, 0};
            pg8::gemm_phase(lds, xl, 1024, 1024, 1024, S, E);
        }
    }
    PHASE_END;

    if (PHASE_ON) { PH_VARS
        const bf16_t* QKU = (const bf16_t*)(ws + WS_QKU); bf16_t* CAT = (bf16_t*)(ws + WS_CAT);
        for (int it = gt; it < 64 * (MTOK / 16); it += NGT) {
            const int ch = it & 63, seg = it >> 6, g = ch >> 4;
            const bf16_t* up = QKU + (size_t)seg * 16 * 1536 + 1024 + ch * 8;
            bf16_t* op = CAT + (size_t)seg * 16 * DM + 512 + ch * 8;
            const int t0 = (seg * 16) & (SEQ - 1);
            if (g == 0) pool_segment<2>(up, op, t0); else if (g == 1) pool_segment<4>(up, op, t0); else if (g == 2) pool_segment<8>(up, op, t0); else pool_segment<16>(up, op, t0);
        }
        for (int wt = bid; wt < 128 * 8; wt += G) {
            const int bh = wt >> 3, blk = wt & 7;
            sb_attn_block(QKU, (const bf16_t*)(ws + WS_VT), CAT, bh >> 3, bh & 7, blk * 8, lds, tid, wave, lane);
        }
    }
    PHASE_END;

    if (PHASE_ON) { PH_VARS
        pg8::SchedStd S; S.init(ws + WS_CAT, 256 * 2048, ws + WS_WOUT, 256 * 2048, 128, 4, G, bid);
        pg8::EpiResid E{ap->in[0], XB, SSQ};
        pg8::gemm_phase(lds, xl, 1024, 1024, 1024, S, E);
        pg8::SchedG SG{(const char*)(ws + WS_MEMK), (const char*)(ws + WS_LAYER + LO_WQ), G, bid};
        pg8::EpiStore EG{(bf16_t*)(ws + WS_GT), 1024, nullptr, 0, 1.0f, 0};
        pg8::gemm_phase(lds, xl, 1024, 1024, 256, SG, EG);
    }
    PHASE_END;

#pragma nounroll
    for (int layer = 0; layer < 2; ++layer) {
        if (layer == 1) {
            if (PHASE_ON) { PH_VARS
                pg8::SchedStd S; S.init(XB, 256 * 2048, ws + WS_WSSM, 256 * 2048, 128, 4, G, bid);
                pg8::EpiStore E{(bf16_t*)(ws + WS_UG), 0, SSQ, 16, 1.0f, 1};
                pg8::gemm_phase(lds, xl, 1024, 1024, 1024, S, E);
            }
            PHASE_END;
            if (PHASE_ON) { PH_VARS
                pg8::SchedS2 S{(const char*)(ws + WS_UG), (const char*)(ws + WS_WEND), G, bid};
                pg8::EpiHend E{(float*)(ws + WS_HEND)};
                pg8::gemm_phase(lds, xl, 640, 512, 512, S, E);
            }
            PHASE_END;
            if (PHASE_ON) { PH_VARS
                bf16_t* UG = (bf16_t*)(ws + WS_UG); const float* HE = (const float*)(ws + WS_HEND);
                for (int it = gt; it < NBATCH * 64 * 64; it += NGT) {
                    const int p = it & 63, g = (it >> 6) & 63, b = it >> 12;
                    const float dt = expf(ap->in[14][g]);
                    const float mag = expf(32.0f * (ap->in[12][g * 64 + p] * dt)), ang = 32.0f * (ap->in[13][g * 64 + p] * dt);
                    const float lr = mag * cosf(ang), li = mag * sinf(ang);
                    float hr = 0.f, hi_ = 0.f;
                    for (int c0 = 0; c0 < 64; c0 += 8) {
                        const size_t row0 = (size_t)g * 1024 + b * 64 + c0;
                        float er[8], ei[8];
#pragma unroll
                        for (int j = 0; j < 8; ++j) { er[j] = HE[(row0 + j) * 128 + p]; ei[j] = HE[(row0 + j) * 128 + 64 + p]; }
#pragma unroll
                        for (int j = 0; j < 8; ++j) {
                            UG[(row0 + j) * 640 + 512 + p] = (bf16_t)(cvt_pk_bf16(hr, 0.f) & 0xffffu);
                            UG[(row0 + j) * 640 + 576 + p] = (bf16_t)(cvt_pk_bf16(hi_, 0.f) & 0xffffu);
                            const float nr = lr * hr - li * hi_ + er[j], ni = lr * hi_ + li * hr + ei[j];
                            hr = nr; hi_ = ni;
                        }
                    }
                }
            }
            PHASE_END;
            if (PHASE_ON) { PH_VARS
                pg8::SchedS4 S{(const char*)(ws + WS_UG), (const char*)(ws + WS_TG), G, bid};
                pg8::EpiSsmY E{(const bf16_t*)(ws + WS_UG), ap->in[19], (bf16_t*)(ws + WS_YG)};
                pg8::gemm_phase(lds, xl, 640, 640, 640, S, E);
            }
            PHASE_END;
            if (PHASE_ON) { PH_VARS
                pg8::SchedStd S; S.init(ws + WS_YG, 256 * 2048, ws + WS_WGLU, 256 * 2048, 128, 8, G, bid);
                pg8::EpiGlu E{XB, SSQ};
                pg8::gemm_phase(lds, xl, 1024, 1024, 1024, S, E);
            }
            PHASE_END;
        }
        if (PHASE_ON) { PH_VARS
            pg8::SchedXS2 S{(const char*)XB, (const char*)(ws + WS_GT + (size_t)layer * 32 * MiB), G, bid};
            pg8::EpiSoftmax E{(bf16_t*)(ws + WS_P), SSQ, layer == 0 ? 16 : 32, 0.0625f};
            pg8::gemm_phase(lds, xl, 1024, 1024, 1024, S, E);
        }
        if (PHASE_ON) { PH_VARS
            unsigned char* lb = ws + WS_LAYER + layer * LAYER_STRIDE;
            pg8::SchedVW S{(const char*)(lb + LO_WO), (const char*)(ws + WS_MEMVT + layer * MEMVT_STRIDE), G, bid};
            pg8::EpiStore E{(bf16_t*)(ws + WS_QX), 1024, nullptr, 0, 1.0f, 0};
            pg8::gemm_phase(lds, xl, 1024, 1024, 256, S, E);
        }
        PHASE_END;
        if (PHASE_ON) { PH_VARS
            pg8::SchedXOut S{(const char*)(ws + WS_P), (const char*)(ws + WS_QX), G, bid};
            pg8::EpiResid E{nullptr, XB, SSQ};
            pg8::gemm_phase(lds, xl, 1024, 1024, 1024, S, E);
        }
        PHASE_END;
        if (PHASE_ON) { PH_VARS
            unsigned char* lb = ws + WS_LAYER + layer * LAYER_STRIDE;
            pg8::SchedStd S; S.init(XB, 256 * 2048, lb + LO_WUP, 256 * 2048, 128, 22, G, bid);
            pg8::EpiUpConv E{(bf16_t*)(ws + WS_H), (bf16_t*)(ws + WS_HALO), SSQ, ap->in[25] + (size_t)layer * 3 * DFF2, ap->in[26] + (size_t)layer * DFF2};
            pg8::gemm_phase(lds, xl, 1024, 1024, 1024, S, E);
        }
        PHASE_END;
        if (PHASE_ON) { PH_VARS
            const bf16_t* HALO = (const bf16_t*)(ws + WS_HALO); bf16_t* H = (bf16_t*)(ws + WS_H);
            const float* cw = ap->in[25] + (size_t)layer * 3 * DFF2; const float* cb = ap->in[26] + (size_t)layer * DFF2;
            pg8::SchedStd S0; S0.init(ws + WS_H, 256u * DFF * 2, ws, 0u, 128, 4, G, bid);
            pg8::Unit uu;
            for (int ui = 0; S0.next(ui, uu); ++ui) {
                const int pm = uu.pm;
                if ((pm & 7) == 0) continue;
                for (int it = tid; it < 2 * 352; it += 512) {
                    const int chk = it % 352, rr = it / 352, c0 = chk * 8;
                    const bf16_t* cur = HALO + (size_t)(pm * 4 + rr) * DFF2;
                    const bf16_t* p1 = rr ? HALO + (size_t)(pm * 4) * DFF2 : HALO + (size_t)(pm * 4 - 1) * DFF2;
                    const bf16_t* p2 = rr ? HALO + (size_t)(pm * 4 - 1) * DFF2 : HALO + (size_t)(pm * 4 - 2) * DFF2;
                    float o[8];
                    const u32x4 av = *(const u32x4*)(cur + c0), ag = *(const u32x4*)(cur + DFF + c0);
                    const u32x4 a1 = *(const u32x4*)(p1 + c0), g1 = *(const u32x4*)(p1 + DFF + c0), a2 = *(const u32x4*)(p2 + c0), g2 = *(const u32x4*)(p2 + DFF + c0);
                    const float v0[8] = {bflo(av.x), bfhi(av.x), bflo(av.y), bfhi(av.y), bflo(av.z), bfhi(av.z), bflo(av.w), bfhi(av.w)};
                    const float g0[8] = {bflo(ag.x), bfhi(ag.x), bflo(ag.y), bfhi(ag.y), bflo(ag.z), bfhi(ag.z), bflo(ag.w), bfhi(ag.w)};
                    const float v1[8] = {bflo(a1.x), bfhi(a1.x), bflo(a1.y), bfhi(a1.y), bflo(a1.z), bfhi(a1.z), bflo(a1.w), bfhi(a1.w)};
                    const float gg1[8] = {bflo(g1.x), bfhi(g1.x), bflo(g1.y), bfhi(g1.y), bflo(g1.z), bfhi(g1.z), bflo(g1.w), bfhi(g1.w)};
                    const float v2[8] = {bflo(a2.x), bfhi(a2.x), bflo(a2.y), bfhi(a2.y), bflo(a2.z), bfhi(a2.z), bflo(a2.w), bfhi(a2.w)};
                    const float gg2[8] = {bflo(g2.x), bfhi(g2.x), bflo(g2.y), bfhi(g2.y), bflo(g2.z), bfhi(g2.z), bflo(g2.w), bfhi(g2.w)};
    #pragma unroll
                    for (int j = 0; j < 8; ++j) {
                        const int c = c0 + j;
                        const float cv = cb[c] + cw[c] * v2[j] + cw[DFF2 + c] * v1[j] + cw[2 * DFF2 + c] * v0[j];
                        const float cgt = cb[DFF + c] + cw[DFF + c] * gg2[j] + cw[DFF2 + DFF + c] * gg1[j] + cw[2 * DFF2 + DFF + c] * g0[j];
                        o[j] = cv * cgt * frcp(1.0f + fexp(-cgt));
                    }
                    u32x4 w; w.x = cvt_pk_bf16(o[0], o[1]); w.y = cvt_pk_bf16(o[2], o[3]); w.z = cvt_pk_bf16(o[4], o[5]); w.w = cvt_pk_bf16(o[6], o[7]);
                    *(u32x4*)(H + (size_t)(pm * 256 + rr) * DFF + c0) = w;
                }
            }
        }
        LOCAL_SEAM;
        if (PHASE_ON) { PH_VARS
            unsigned char* lb = ws + WS_LAYER + layer * LAYER_STRIDE;
            pg8::SchedStd S; S.init(ws + WS_H, 256u * DFF * 2, lb + LO_WDN, 256u * DFF * 2, 128, 4, G, bid);
            pg8::EpiResid E{nullptr, XB, SSQ};
            pg8::gemm_phase(lds, xl, DFF, DFF, DFF, S, E);
        }
        PHASE_END;
    }

    if (PHASE_ON) { PH_VARS
        for (int m4 = gw; m4 < MTOK / 4; m4 += NGW) {
            const f32x4* gr = (const f32x4*)ap->in[6] + lane;
            f32x4 v[4][4]; float sq[4];
#pragma unroll
            for (int r = 0; r < 4; ++r)
#pragma unroll
                for (int j = 0; j < 4; ++j) { const u32x2 o = *((const u32x2*)(XB + (size_t)(m4 * 4 + r) * DM) + lane + 64 * j); v[r][j] = (f32x4){bflo(o.x), bfhi(o.x), bflo(o.y), bfhi(o.y)}; }
#pragma unroll
            for (int r = 0; r < 4; ++r) { sq[r] = 0.f;
#pragma unroll
                for (int j = 0; j < 4; ++j) sq[r] += (v[r][j].x * v[r][j].x + v[r][j].y * v[r][j].y) + (v[r][j].z * v[r][j].z + v[r][j].w * v[r][j].w); }
#pragma unroll
            for (int r = 0; r < 4; ++r) sq[r] = 1.f / sqrtf(wave_sum(sq[r]) * (1.f / DM) + EPS);
#pragma unroll
            for (int j = 0; j < 4; ++j) { const f32x4 gg = gr[64 * j];
#pragma unroll
                for (int r = 0; r < 4; ++r) *((f32x4*)(X + (size_t)(m4 * 4 + r) * DM) + lane + 64 * j) = v[r][j] * sq[r] * gg; }
        }
    }
#undef PHASE_ON
#undef PHASE_END
}

constexpr int N_PHASES = 4 + 7 + 5 + 7 + 1;

extern "C" void kernel_launch(void* const* d_in, const int* in_sizes, int n_in, void* d_out, int out_size, void* d_ws, size_t ws_size, hipStream_t stream) {
    static int grid = 0;
    if (grid == 0) {
        if (n_in != 28 || in_sizes[0] != MTOK * DM || out_size != MTOK * DM || ws_size < WS_END) {
            fprintf(stderr, "kernel_launch: unexpected shapes (n_in %d, in0 %d, out %d, ws %zu); nothing launched\n", n_in, n_in > 0 ? in_sizes[0] : -1, out_size, ws_size); grid = -1; return; }
        int dev = 0, cus = 0, per_cu = 0;
        if (hipGetDevice(&dev) != hipSuccess || hipDeviceGetAttribute(&cus, hipDeviceAttributeMultiprocessorCount, dev) != hipSuccess) { grid = -1; return; }
        if (hipFuncSetAttribute((const void*)mega_fwd, hipFuncAttributeMaxDynamicSharedMemorySize, LDS_BYTES) != hipSuccess) { fprintf(stderr, "kernel_launch: hipFuncSetAttribute failed\n"); grid = -1; return; }
        if (hipOccupancyMaxActiveBlocksPerMultiprocessor(&per_cu, (const void*)mega_fwd, 512, LDS_BYTES) != hipSuccess || per_cu < 1) per_cu = 1;
        (void)hipGetLastError();
        grid = cus * per_cu;
    }
    if (grid < 0) return;
    Args a{};
    for (int i = 0; i < 28; ++i) a.in[i] = (const float*)d_in[i];
    a.out = (float*)d_out; a.ws = (unsigned char*)d_ws;
#if MK_MULTI_LAUNCH
    for (int p = 0; p < N_PHASES; ++p) {
        a.ph_lo = p; a.ph_hi = p + 1;
        hipLaunchKernelGGL(mega_fwd, dim3(grid), dim3(512), LDS_BYTES, stream, a);
    }
#else
    a.ph_lo = 0; a.ph_hi = N_PHASES;
    if (hipMemsetAsync(d_ws, 0, 16384, stream) != hipSuccess) { fprintf(stderr, "kernel_launch: memset of the barrier words failed\n"); return; }
    void* args[] = {&a};
    hipError_t e = hipLaunchCooperativeKernel((const void*)mega_fwd, dim3(grid), dim3(512), args, LDS_BYTES, stream);
    if (e != hipSuccess) fprintf(stderr, "cooperative launch failed: %s (grid %d)\n", hipGetErrorString(e), grid);
#endif
}
```
